# Optimizing an MI355X kernel written in HIP

```python
import math
import jax
import jax.numpy as jnp
from jax import lax
import numpy as np

D_MODEL = 1024
BATCH = 2
SEQ = 8192
DEPTH = 1

CTX_LEN = 256
GRID_W = 64
POS_BASE = 10000.0
NORM_EPS = 1e-6
N_ADA = 6

HY_WIDTH = 512
HY_ORDER = 2
HY_PROJ = (HY_ORDER + 1) * HY_WIDTH
HY_SHORT = 3
HY_EMB = 33
HY_BANDS = (HY_EMB - 1) // 2
HY_FILTER_HIDDEN = 64
HY_N_FILTERS = HY_ORDER * 2 * HY_WIDTH
HY_DECAY_TARGET = 1e-2
HY_FAST_PCT = 0.3
HY_SLOW_PCT = 1.5
HY_MIN_DECAY = math.log(HY_DECAY_TARGET) / HY_SLOW_PCT
HY_MAX_DECAY = math.log(HY_DECAY_TARGET) / HY_FAST_PCT

HG_HEADS = 4
HG_DK = 128
HG_DV = 128
HG_KW = HG_HEADS * HG_DK
HG_WIDTH = HG_HEADS * HG_DV
HG_CHUNK = 64

IN_SIZES = (HY_PROJ, HG_KW, HG_WIDTH, HG_KW, HG_KW, HG_WIDTH, D_MODEL, D_MODEL)
IN_COLS = sum(IN_SIZES)
IN_SPLITS = tuple(int(v) for v in np.cumsum(IN_SIZES)[:-1])

N_EXPERTS = 256
TOP_K = 8
N_GROUPS = 8
TOPK_GROUPS = 4
EXPERT_HIDDEN = 256
SHARED_HIDDEN = 256
ROUTED_SCALE = 2.5
MOE_BLOCK = 128

kernel_name = 'hyena_hgrn2_moe_prefix_dit_block'


def rmsnorm(x, g):
    xf = x.astype(jnp.float32)
    y = xf * lax.rsqrt(jnp.mean(xf * xf, axis=-1, keepdims=True) + NORM_EPS)
    return (y * g.astype(jnp.float32)).astype(x.dtype)


def modulate(h, shift, scale):
    return h * (1 + scale) + shift


def grid_pos_embed(rows, cols, dim):
    quarter = dim // 4
    omega = 1.0 / (POS_BASE ** (jnp.arange(quarter, dtype=jnp.float32) / quarter))
    ang_r = jnp.arange(rows, dtype=jnp.float32)[:, None] * omega
    ang_c = jnp.arange(cols, dtype=jnp.float32)[:, None] * omega
    emb_r = jnp.concatenate([jnp.sin(ang_r), jnp.cos(ang_r)], axis=-1)
    emb_c = jnp.concatenate([jnp.sin(ang_c), jnp.cos(ang_c)], axis=-1)
    emb = jnp.concatenate([jnp.broadcast_to(emb_r[:, None], (rows, cols, dim // 2)),
                           jnp.broadcast_to(emb_c[None], (rows, cols, dim // 2))], axis=-1)
    return emb.reshape(rows * cols, dim)


def short_conv(u, w, b):
    L = u.shape[1]
    half = HY_SHORT // 2
    up = jnp.pad(u, ((0, 0), (half, half), (0, 0)))
    return sum(up[:, j:j + L] * w[j] for j in range(HY_SHORT)) + b


def hyena_filters(L, w1, b1, w2, b2, w3, b3, w4, freq):
    f32 = lambda a: a.astype(jnp.float32)
    t = jnp.arange(L, dtype=jnp.float32)
    tn = t / max(L - 1, 1)
    ang = (2 * math.pi / L) * t[:, None] * jnp.linspace(1e-4, HY_BANDS - 1, HY_BANDS, dtype=jnp.float32)
    z = jnp.concatenate([tn[:, None], jnp.cos(ang), -jnp.sin(ang)], axis=-1)
    fr = f32(freq)
    a = jnp.sin(fr * (z @ f32(w1) + f32(b1)))
    a = jnp.sin(fr * (a @ f32(w2) + f32(b2)))
    a = jnp.sin(fr * (a @ f32(w3) + f32(b3)))
    h = (a @ f32(w4)).reshape(L, HY_ORDER, 2, HY_WIDTH)
    deltas = jnp.abs(jnp.linspace(HY_MIN_DECAY, HY_MAX_DECAY, HY_WIDTH, dtype=jnp.float32))
    return h * jnp.exp(-tn[:, None] * deltas)[:, None, None, :]


def long_conv(u, h_fwd, h_bwd, skip):
    L = u.shape[1]
    kern = jnp.concatenate([h_fwd, jnp.zeros_like(h_fwd[:1]), h_bwd[:0:-1]], axis=0)
    kern = kern / jnp.sum(jnp.abs(kern), axis=0, keepdims=True)
    uf = u.astype(jnp.float32)
    spec = jnp.fft.rfft(uf, n=2 * L, axis=1) * jnp.fft.rfft(kern, n=2 * L, axis=0)[None]
    y = jnp.fft.irfft(spec, n=2 * L, axis=1)[:, :L]
    return (y + uf * skip.astype(jnp.float32)).astype(u.dtype)


def hyena_branch(p_hy, conv_w, conv_b, filt, skip):
    u = short_conv(p_hy, conv_w, conv_b)
    v, x1, x2 = jnp.split(u, HY_ORDER + 1, axis=-1)
    z = x1 * long_conv(v, filt[:, 0, 0], filt[:, 0, 1], skip[0])
    return x2 * long_conv(z, filt[:, 1, 0], filt[:, 1, 1], skip[1])


def hgrn2_chunk_scan(q, k, v, logf, s0):
    B, L, H, DK = q.shape
    DV = v.shape[-1]
    C = HG_CHUNK
    n = L // C
    q, k, v, logf = [a.reshape(B, n, C, H, a.shape[-1]) for a in (q, k, v, logf)]
    b = jnp.cumsum(logf, axis=2)
    b_end = b[:, :, -1]
    b_ref = b[:, :, C // 2 - 1][:, :, None]
    qd = q * jnp.exp(b - b_ref)
    kd = k * jnp.exp(b_ref - b)
    tri = jnp.tril(jnp.ones((C, C), dtype=bool))
    att = jnp.where(tri, jnp.einsum('bnthd,bnshd->bnhts', qd, kd), 0.0)
    o_intra = jnp.einsum('bnhts,bnshe->bnthe', att, v)
    delta = jnp.einsum('bnshd,bnshe->bnhde', k * jnp.exp(b_end[:, :, None] - b), v)
    decay = jnp.exp(b_end)

    def step(S, xs):
        dec, dlt = xs
        return dec[..., None] * S + dlt, S

    s_fin, s_start = lax.scan(step, s0, (jnp.moveaxis(decay, 1, 0), jnp.moveaxis(delta, 1, 0)))
    o_inter = jnp.einsum('bnthd,nbhde->bnthe', q * jnp.exp(b), s_start)
    return (o_intra + o_inter).reshape(B, L, H, DV), s_fin


def hgrn2_branch(q_raw, i_raw, ff_raw, fb_raw, g_raw, lb_f, lb_b, norm_g, s0_f, s0_b):
    B, L, _ = q_raw.shape
    f32 = lambda a: a.astype(jnp.float32)
    q = jax.nn.silu(f32(q_raw)).reshape(B, L, HG_HEADS, HG_DK)
    v = f32(i_raw).reshape(B, L, HG_HEADS, HG_DV)

    def gates(f_raw, lb):
        f = (lb + (1 - lb) * jax.nn.sigmoid(f32(f_raw))).reshape(B, L, HG_HEADS, HG_DK)
        return 1 - f, jnp.log(f)

    k_f, lf_f = gates(ff_raw, lb_f)
    k_b, lf_b = gates(fb_raw, lb_b)
    rev = lambda a: jnp.flip(a, axis=1)
    o_f, s_f = hgrn2_chunk_scan(q, k_f, v, lf_f, s0_f)
    o_b, s_b = hgrn2_chunk_scan(rev(q), rev(k_b), rev(v), rev(lf_b), s0_b)
    o = o_f + rev(o_b)
    o = o * lax.rsqrt(jnp.mean(o * o, axis=-1, keepdims=True) + NORM_EPS) * f32(norm_g)
    o = o.reshape(B, L, HG_WIDTH) * jax.nn.silu(f32(g_raw))
    return o.astype(q_raw.dtype), s_f, s_b


def merge_branches(y_hy, y_hg, gate_hy, gate_hg, w_hy_out, w_hg_out, w_out):
    m = jax.nn.sigmoid(gate_hy) * (y_hy @ w_hy_out) + jax.nn.sigmoid(gate_hg) * (y_hg @ w_hg_out)
    return m @ w_out


def swiglu(t, wg, wu, wd):
    return (jax.nn.silu(t @ wg) * (t @ wu)) @ wd


def moe_ffn(h, router_w, router_bias, w_gate, w_up, w_down, sh_gate, sh_up, sh_down):
    Bh, Lh, D = h.shape
    t = h.reshape(-1, D)
    T = t.shape[0]
    scores = jax.nn.sigmoid(t.astype(jnp.float32) @ router_w.astype(jnp.float32))
    biased = scores + router_bias.astype(jnp.float32)
    grp_score = lax.top_k(biased.reshape(T, N_GROUPS, -1), 2)[0].sum(-1)
    _, gidx = lax.top_k(grp_score, TOPK_GROUPS)
    gmask = jnp.any(gidx[..., None] == jnp.arange(N_GROUPS), axis=1)
    emask = jnp.repeat(gmask, N_EXPERTS // N_GROUPS, axis=1)
    _, eidx = lax.top_k(jnp.where(emask, biased, -jnp.inf), TOP_K)
    wsel = jnp.take_along_axis(scores, eidx, axis=1)
    wsel = wsel / jnp.sum(wsel, axis=-1, keepdims=True) * ROUTED_SCALE

    A = T * TOP_K
    eid = eidx.reshape(-1)
    tok = jnp.repeat(jnp.arange(T, dtype=jnp.int32), TOP_K)
    order = jnp.argsort(eid)
    eid_s = eid[order]
    counts = jnp.bincount(eid, length=N_EXPERTS)
    padded = (counts + MOE_BLOCK - 1) // MOE_BLOCK * MOE_BLOCK
    starts = jnp.cumsum(counts) - counts
    pad_ends = jnp.cumsum(padded)
    pad_starts = pad_ends - padded
    dest = pad_starts[eid_s] + jnp.arange(A) - starts[eid_s]
    n_blocks = (A + N_EXPERTS * (MOE_BLOCK - 1) + MOE_BLOCK - 1) // MOE_BLOCK
    P = n_blocks * MOE_BLOCK
    tok_buf = jnp.full((P,), T, dtype=jnp.int32).at[dest].set(tok[order])
    w_buf = jnp.zeros((P,), jnp.float32).at[dest].set(wsel.reshape(-1)[order])
    block_e = jnp.minimum(jnp.searchsorted(pad_ends, jnp.arange(n_blocks) * MOE_BLOCK, side='right'),
                          N_EXPERTS - 1)
    t_pad = jnp.concatenate([t, jnp.zeros((1, D), t.dtype)], axis=0)

    def block_fn(args):
        e, toks, wb = args
        xb = t_pad[toks]
        return swiglu(xb, w_gate[e], w_up[e], w_down[e]) * wb[:, None].astype(xb.dtype)

    y = lax.map(block_fn, (block_e, tok_buf.reshape(n_blocks, MOE_BLOCK), w_buf.reshape(n_blocks, MOE_BLOCK)))
    routed = jax.ops.segment_sum(y.reshape(P, D), tok_buf, num_segments=T + 1)[:T]
    out = routed + swiglu(t, sh_gate, sh_up, sh_down)
    return out.reshape(Bh, Lh, D)


def setup_inputs(seed: int = 0) -> dict:
    key = jax.random.key(seed)
    ks = iter(jax.random.split(key, 40))
    nrm = lambda shape, scale: jax.random.normal(next(ks), shape, jnp.float32) * scale
    D = D_MODEL
    NL = DEPTH
    F = EXPERT_HIDDEN
    FS = SHARED_HIDDEN
    HF = HY_FILTER_HIDDEN
    return {
        'x': nrm((BATCH, SEQ, D), 1.0),
        'c': nrm((BATCH, D), 1.0),
        'ctx': nrm((BATCH, CTX_LEN, D), 1.0),
        'c_ctx': nrm((D,), 1.0),
        'norm1_g': 1.0 + nrm((NL, D), 0.02),
        'norm2_g': 1.0 + nrm((NL, D), 0.02),
        'ada_w': nrm((NL, D, N_ADA * D), 0.5 * D ** -0.5),
        'ada_b': nrm((NL, N_ADA * D), 0.02),
        'w_in': nrm((NL, D, IN_COLS), D ** -0.5),
        'hy_conv_w': nrm((NL, HY_SHORT, HY_PROJ), HY_SHORT ** -0.5),
        'hy_conv_b': nrm((NL, HY_PROJ), 0.02),
        'hy_f_w1': nrm((NL, HY_EMB, HF), HY_EMB ** -0.5),
        'hy_f_b1': nrm((NL, HF), 0.02),
        'hy_f_w2': nrm((NL, HF, HF), HF ** -0.5),
        'hy_f_b2': nrm((NL, HF), 0.02),
        'hy_f_w3': nrm((NL, HF, HF), HF ** -0.5),
        'hy_f_b3': nrm((NL, HF), 0.02),
        'hy_f_w4': nrm((NL, HF, HY_N_FILTERS), HF ** -0.5),
        'hy_f_freq': 1.0 + nrm((NL, HF), 0.02),
        'hy_skip': nrm((NL, HY_ORDER, HY_WIDTH), 1.0),
        'hg_lb_logits': nrm((NL + 1, 2, HG_KW), 0.1),
        'hg_norm_g': 1.0 + nrm((NL, HG_DV), 0.02),
        'w_hy_out': nrm((NL, HY_WIDTH, D), HY_WIDTH ** -0.5),
        'w_hg_out': nrm((NL, HG_WIDTH, D), HG_WIDTH ** -0.5),
        'w_out': nrm((NL, D, D), D ** -0.5),
        'router_w': nrm((NL, D, N_EXPERTS), D ** -0.5),
        'router_bias': nrm((NL, N_EXPERTS), 0.01),
        'exp_w_gate': nrm((NL, N_EXPERTS, D, F), D ** -0.5),
        'exp_w_up': nrm((NL, N_EXPERTS, D, F), D ** -0.5),
        'exp_w_down': nrm((NL, N_EXPERTS, F, D), F ** -0.5),
        'sh_w_gate': nrm((NL, D, FS), D ** -0.5),
        'sh_w_up': nrm((NL, D, FS), D ** -0.5),
        'sh_w_down': nrm((NL, FS, D), FS ** -0.5),
        'final_g': 1.0 + nrm((D,), 0.02),
    }


def reference(x, c, ctx, c_ctx, norm1_g, norm2_g, ada_w, ada_b, w_in, hy_conv_w, hy_conv_b,
              hy_f_w1, hy_f_b1, hy_f_w2, hy_f_b2, hy_f_w3, hy_f_b3, hy_f_w4, hy_f_freq, hy_skip,
              hg_lb_logits, hg_norm_g, w_hy_out, w_hg_out, w_out, router_w, router_bias,
              exp_w_gate, exp_w_up, exp_w_down, sh_w_gate, sh_w_up, sh_w_down, final_g):
    B, S, D = x.shape
    rows = S // GRID_W
    x = x + grid_pos_embed(rows, GRID_W, D).astype(x.dtype)
    xc = ctx
    n_ctx = xc.shape[1]
    s_lat = jax.nn.silu(c)
    s_ctx = jax.nn.silu(c_ctx)
    lbs = jnp.cumsum(jax.nn.softmax(hg_lb_logits.astype(jnp.float32), axis=0), axis=0)
    zero_state = jnp.zeros((B, HG_HEADS, HG_DK, HG_DV), jnp.float32)

    for l in range(DEPTH):
        last = l == DEPTH - 1
        sh1, sc1, g1, sh2, sc2, g2 = jnp.split((s_lat @ ada_w[l] + ada_b[l])[:, None, :], N_ADA, axis=-1)
        csh1, csc1, cg1, csh2, csc2, cg2 = jnp.split(s_ctx @ ada_w[l] + ada_b[l], N_ADA, axis=-1)
        filt_w = (hy_f_w1[l], hy_f_b1[l], hy_f_w2[l], hy_f_b2[l], hy_f_w3[l], hy_f_b3[l], hy_f_w4[l], hy_f_freq[l])

        p = jnp.split(modulate(rmsnorm(x, norm1_g[l]), sh1, sc1) @ w_in[l], IN_SPLITS, axis=-1)
        pc = jnp.split(modulate(rmsnorm(xc, norm1_g[l]), csh1, csc1) @ w_in[l], IN_SPLITS, axis=-1)
        lb_f, lb_b = lbs[l, 0], lbs[l, 1]
        hg_c, st_f, st_b = hgrn2_branch(*pc[1:6], lb_f, lb_b, hg_norm_g[l], zero_state, zero_state)
        hg_x, _, _ = hgrn2_branch(*p[1:6], lb_f, lb_b, hg_norm_g[l], st_f, st_b)
        hy_x = hyena_branch(p[0], hy_conv_w[l], hy_conv_b[l], hyena_filters(S, *filt_w), hy_skip[l])
        x = x + g1 * merge_branches(hy_x, hg_x, p[6], p[7], w_hy_out[l], w_hg_out[l], w_out[l])
        if not last:
            hy_c = hyena_branch(pc[0], hy_conv_w[l], hy_conv_b[l], hyena_filters(n_ctx, *filt_w), hy_skip[l])
            xc = xc + cg1 * merge_branches(hy_c, hg_c, pc[6], pc[7], w_hy_out[l], w_hg_out[l], w_out[l])

        moe_w = (router_w[l], router_bias[l], exp_w_gate[l], exp_w_up[l], exp_w_down[l],
                 sh_w_gate[l], sh_w_up[l], sh_w_down[l])
        h2 = modulate(rmsnorm(x, norm2_g[l]), sh2, sc2)
        if last:
            x = x + g2 * moe_ffn(h2, *moe_w)
        else:
            hc2 = modulate(rmsnorm(xc, norm2_g[l]), csh2, csc2)
            y = moe_ffn(jnp.concatenate([hc2, h2], axis=1), *moe_w)
            xc = xc + cg2 * y[:, :n_ctx]
            x = x + g2 * y[:, n_ctx:]

    return rmsnorm(x, final_g)
```

```cpp
#include <hip/hip_runtime.h>
#include <hip/hip_cooperative_groups.h>
#include <cstdio>
#include <cstdint>
namespace cg = cooperative_groups;

#define LAS __attribute__((address_space(3)))
typedef unsigned short bf16_t;
typedef short bf16x8 __attribute__((ext_vector_type(8)));
typedef float f32x4 __attribute__((ext_vector_type(4)));
typedef float f32x2 __attribute__((ext_vector_type(2)));
typedef unsigned u32x4 __attribute__((ext_vector_type(4)));
typedef unsigned u32x2 __attribute__((ext_vector_type(2)));

constexpr int D = 1024, NB = 2, SEQ = 8192, T = NB * SEQ, CTXL = 256, TC = NB * CTXL, MA = T + TC, NEXT = CTXL + SEQ;
constexpr int HYW = 512, HYP = 1536, HGW = 512, INC = 6144;
constexpr int NE = 256, TOPK = 8, EH = 256, NASG = T * TOPK;
constexpr int NCH_EXT = NEXT / 64  , NCH_LAT = SEQ / 64  , NCHAIN = 16, NAITEM = NCHAIN * NCH_EXT  ;
constexpr int FFTN = 16384;
constexpr float EPS = 1e-6f;

constexpr size_t al256(size_t x) { return (x + 255) & ~(size_t)255; }
constexpr size_t WS_CTL = 0, CTL_BYTES = 65536;
constexpr size_t WS_WINT = WS_CTL + CTL_BYTES;
constexpr size_t WS_WHYT = WS_WINT + (size_t)INC * D * 2;
constexpr size_t WS_WHGT = WS_WHYT + (size_t)D * HYW * 2;
constexpr size_t WS_WOUTT = WS_WHGT + (size_t)D * HGW * 2;
constexpr size_t WS_ROUT = WS_WOUTT + (size_t)D * D * 2;
constexpr size_t WS_SHGUT = WS_ROUT + (size_t)NE * D * 2;
constexpr size_t WS_SHDT = WS_SHGUT + (size_t)512 * D * 2;
constexpr size_t WS_ADAP = WS_SHDT + (size_t)D * 256 * 2;
constexpr size_t WS_ADA = WS_ADAP + (size_t)32 * 3 * 6144 * 4;
constexpr size_t WS_POSR = WS_ADA + (size_t)3 * 6144 * 4;
constexpr size_t WS_POSC = WS_POSR + (size_t)128 * 512 * 4;
constexpr size_t WS_LBS = WS_POSC + (size_t)64 * 512 * 4;
constexpr size_t WS_ROUTE_E = WS_LBS + 4096;
constexpr size_t WS_ROUTE_W = WS_ROUTE_E + (size_t)NASG * 4;
constexpr size_t WS_ROUTE_P = WS_ROUTE_W + (size_t)NASG * 4;
constexpr size_t WS_SLOTOF = WS_ROUTE_P + (size_t)NASG * 4;
constexpr size_t WS_SLOT_TOK = WS_SLOTOF + (size_t)NASG * 4;
constexpr size_t WS_SLOT_W = WS_SLOT_TOK + (size_t)(NASG + 256) * 4;
constexpr size_t WS_EGUT = al256(WS_SLOT_W + (size_t)(NASG + 256) * 4);
constexpr size_t WS_EDT = WS_EGUT + (size_t)NE * 512 * D * 2;
constexpr size_t WS_RA = WS_EDT + (size_t)NE * D * EH * 2;
constexpr size_t RA_BYTES = (size_t)NASG * D * 2;
constexpr size_t WS_HF = WS_RA;
constexpr size_t WS_KS = WS_HF + (size_t)2048 * SEQ * 4;
constexpr size_t WS_DELTA = WS_KS + (size_t)256 * 2 * FFTN * 8;
constexpr size_t WS_DECAY = WS_DELTA + (size_t)NAITEM * 16384 * 2;
constexpr size_t WS_PHYT = WS_DECAY + (size_t)NAITEM * 128 * 4;
static_assert(WS_PHYT + (size_t)NB * HYP * SEQ * 2 <= WS_RA + RA_BYTES, "region A overflow");
constexpr size_t WS_YBUF = WS_RA;
constexpr size_t WS_RB = WS_RA + RA_BYTES;
constexpr size_t WS_VT = WS_RB;
constexpr size_t WS_Q = WS_VT + (size_t)NB * HGW * NEXT * 2;
constexpr size_t WS_LF = WS_Q + (size_t)T * HGW * 2;
constexpr size_t WS_LB = WS_LF + (size_t)NB * NEXT * HGW * 4;
constexpr size_t WS_G = WS_LB + (size_t)NB * NEXT * HGW * 4;
constexpr size_t WS_SG1 = WS_G + (size_t)T * HGW * 2;
constexpr size_t WS_SG2 = WS_SG1 + (size_t)T * D * 2;
constexpr size_t WS_A1 = WS_SG2 + (size_t)T * D * 2;
constexpr size_t WS_SST = WS_A1 + (size_t)MA * D * 2;
constexpr size_t WS_YHG = WS_SST + (size_t)NCHAIN * NCH_LAT * 16384 * 2 + 256 * 512;
constexpr size_t WS_T1 = WS_YHG + (size_t)T * HGW * 2;
constexpr size_t WS_END = WS_T1 + (size_t)T * D * 4;
constexpr size_t WS_LOGIT = WS_VT, WS_HSH = WS_Q, WS_MB = WS_LF, WS_H2 = WS_LB, WS_YSH = WS_SG1, WS_YHYT = WS_A1, WS_YHY = WS_A1 + (size_t)NB * HYW * SEQ * 2, WS_HBUF = WS_SST;
static_assert((size_t)T * 256 * 4 <= (size_t)NB * HGW * NEXT * 2, "LOGIT fits VT");
static_assert(WS_YHY + (size_t)T * HYW * 2 <= WS_SST, "YHY fits A1");
static_assert((size_t)(NASG + 256) * EH * 2 <= (size_t)NCHAIN * NCH_LAT * 16384 * 2 + 256 * 512, "HBUF fits SST");
static_assert(WS_END <= (size_t)1073741824, "workspace map exceeds 1 GiB");
constexpr int CW_CNT = 0;
constexpr int CW_START = 512;
constexpr int CW_TOFF = 1024;
constexpr int CW_BAR = 4096;
constexpr int CW_UNITS = 8192;

constexpr int LDS_BYTES = 147456;
constexpr int LDS_BARST = LDS_BYTES - 64;

__device__ __forceinline__ unsigned f2bf(float f) { unsigned u = __float_as_uint(f); return (u + 0x7fffu + ((u >> 16) & 1u)) >> 16; }
__device__ __forceinline__ unsigned pk2(float lo, float hi) { return f2bf(lo) | (f2bf(hi) << 16); }
__device__ __forceinline__ float bf2f(unsigned b) { return __uint_as_float(b << 16); }
__device__ __forceinline__ float bflo(unsigned w) { return __uint_as_float(w << 16); }
__device__ __forceinline__ float bfhi(unsigned w) { return __uint_as_float(w & 0xffff0000u); }
__device__ __forceinline__ float sigmoidf_(float x) { return __builtin_amdgcn_rcpf(1.0f + __expf(-x)); }
__device__ __forceinline__ float siluf_(float x) { return x * __builtin_amdgcn_rcpf(1.0f + __expf(-x)); }
__device__ __forceinline__ unsigned f2h(float f) { return (unsigned)__builtin_bit_cast(unsigned short, (_Float16)f); }
__device__ __forceinline__ unsigned pkh2(float lo, float hi) { return f2h(lo) | (f2h(hi) << 16); }
__device__ __forceinline__ float h2f(unsigned short b) { return (float)__builtin_bit_cast(_Float16, b); }
__device__ __forceinline__ float wave_sum(float v) {
#pragma unroll
    for (int o = 1; o < 64; o <<= 1) v += __shfl_xor(v, o);
    return v;
}
#define LDS_WAIT() asm volatile("s_waitcnt lgkmcnt(0)" ::: "memory")

struct Params {
    const float* in[34];
    float* out;
    unsigned char* ws;
    int ph_lo, ph_hi;
};
enum { I_X = 0, I_C, I_CTX, I_CCTX, I_N1G, I_N2G, I_ADAW, I_ADAB, I_WIN, I_HCW, I_HCB, I_FW1, I_FB1, I_FW2, I_FB2, I_FW3, I_FB3, I_FW4, I_FFREQ, I_HSKIP,
       I_LBL, I_HGNG, I_WHY, I_WHG, I_WOUT, I_RW, I_RB, I_EG, I_EU, I_ED, I_SG, I_SU, I_SD, I_FG };
namespace pg8 {
constexpr int BM = 256, BK = 64, HALF = 128, HTB = HALF * BK * 2, STAGE_BYTES = 8 * HTB;
__host__ __device__ __forceinline__ int lds_byte(int r, int c) { const int st = (r >> 4) * 2 + (c >> 5), rr = r & 15, cc = c & 31, ob = rr * 64 + cc * 2; return st * 1024 + (ob ^ (((ob >> 9) & 1) << 5)); }
__host__ __device__ __forceinline__ void stage_rc(int b, int& R, int& C) { const int st = b / 1024, sb = b % 1024, swz = sb ^ (((sb >> 9) & 1) << 5); R = (st >> 1) * 16 + swz / 64; C = (st & 1) * 32 + (swz % 64) / 2; }
__host__ __device__ __forceinline__ int perm32(int rho) { const int n = rho >> 4, i = rho & 15; return 8 * (i >> 2) + 4 * n + (i & 3); }

struct Unit { int row0, lrow, pn, nvalid, aux, kind; unsigned boff; };
struct Gemm { const bf16_t* A; const bf16_t* Bt; int K; const int* rows; int ldb, kstepB; };

__device__ __forceinline__ unsigned cvt_pk_bf16(float lo, float hi) { unsigned r; asm volatile("v_cvt_pk_bf16_f32 %0, %1, %2" : "=v"(r) : "v"(lo), "v"(hi)); return r; }

template <class Epi, class Sched, bool GATHER>
__device__ __forceinline__ void gemm_phase(LAS unsigned char* lds, const Gemm g, const Sched& S, const Epi& E) {
    const int tid = threadIdx.x, wid = __builtin_amdgcn_readfirstlane(tid >> 6), lane = tid & 63, wr = wid >> 2, wc = wid & 3, fr = lane & 15, fq = lane >> 4;
    int K_ = g.K; asm volatile("" : "+s"(K_));
    const int K = K_, nt = K / BK; int ldb_ = g.ldb, ksb_ = g.kstepB; asm volatile("" : "+s"(ldb_), "+s"(ksb_));
    unsigned voffA[2], voffB[2]; int RA[2], CA[2];
#pragma unroll
    for (int i = 0; i < 2; ++i) { int R, C; stage_rc(tid * 16 + i * 8192, R, C); const int Rb = Epi::PERM ? ((R & ~31) + perm32(R & 31)) : R;
        voffA[i] = (unsigned)(R * K + C) * 2u; voffB[i] = (unsigned)(Rb * ldb_ + C * 2); RA[i] = R; CA[i] = C; }
    const size_t kstep = (size_t)(BK * 2);
    const size_t hstep = (size_t)HALF * K * 2;
    const size_t kstepB = (size_t)ksb_, hstepB = (size_t)HALF * ldb_;
    const unsigned ldsw = (unsigned)wid * 1024u;
    const int aoff = lds_byte(wr * 64 + fr, fq * 8), boff = lds_byte(wc * 32 + fr, fq * 8);
    unsigned vg0[2][2], vg1[2][2];
#define PG8_SA(b, h) (((b) * 2 + (h)) * HTB)
#define PG8_SB(b, h) ((4 + (b) * 2 + (h)) * HTB)
#define PG8_STAGE(bufoff, gbase, voff) do { _Pragma("unroll") for (int _i = 0; _i < 2; ++_i) \
        __builtin_amdgcn_global_load_lds((const unsigned*)((const char*)(gbase) + (voff)[_i]), (LAS unsigned*)(lds + (bufoff) + ldsw + _i * 8192), 16, 0, 0); } while (0)
#define PG8_STAGE_A(bufoff, gbase, h, w) do { _Pragma("unroll") for (int _i = 0; _i < 2; ++_i) { \
        const unsigned _o = GATHER ? ((w) ? vg1[h][_i] : vg0[h][_i]) : (voffA[_i] + (unsigned)((h) * hstep)); \
        __builtin_amdgcn_global_load_lds((const unsigned*)((const char*)(gbase) + _o), (LAS unsigned*)(lds + (bufoff) + ldsw + _i * 8192), 16, 0, 0); } } while (0)
#define PG8_LDA(dst, b, h) do { _Pragma("unroll") for (int m = 0; m < 4; ++m) _Pragma("unroll") for (int k = 0; k < 2; ++k) dst[m][k] = *(const LAS bf16x8*)(lds + PG8_SA(b, h) + aoff + m * 2048 + k * 1024); } while (0)
#define PG8_LDB(dst, b, h) do { _Pragma("unroll") for (int n = 0; n < 2; ++n) _Pragma("unroll") for (int k = 0; k < 2; ++k) dst[n][k] = *(const LAS bf16x8*)(lds + PG8_SB(b, h) + boff + n * 2048 + k * 1024); } while (0)
#define PG8_MMA(ai, bj, At, Bt) do { __builtin_amdgcn_s_setprio(1); _Pragma("unroll") for (int m = 0; m < 4; ++m) _Pragma("unroll") for (int n = 0; n < 2; ++n) _Pragma("unroll") for (int k = 0; k < 2; ++k) \
        acc[ai][bj][m][n] = __builtin_amdgcn_mfma_f32_16x16x32_bf16(Bt[n][k], At[m][k], acc[ai][bj][m][n], 0, 0, 0); __builtin_amdgcn_s_setprio(0); } while (0)
#define PG8_WAIT_V(n) asm volatile("s_waitcnt vmcnt(" #n ")" ::: "memory")
#define PG8_WAIT_L(n) asm volatile("s_waitcnt lgkmcnt(" #n ")" ::: "memory")
#define PG8_BAR __builtin_amdgcn_s_barrier()
#define PG8_SCHED __builtin_amdgcn_sched_barrier(0)
#define PG8_GOFF(dst, u) do { if (GATHER) { _Pragma("unroll") for (int _h = 0; _h < 2; ++_h) _Pragma("unroll") for (int _i = 0; _i < 2; ++_i) \
        dst[_h][_i] = (unsigned)(g.rows[(u).row0 + _h * HALF + RA[_i]] * K + CA[_i]) * 2u; } } while (0)
    Unit cur, nxt; int ui = 0;
    if (!S.next(0, cur)) return;
    f32x4 acc[2][2][4][2];
#pragma unroll
    for (int a = 0; a < 2; ++a)
#pragma unroll
        for (int b = 0; b < 2; ++b)
#pragma unroll
            for (int m = 0; m < 4; ++m)
#pragma unroll
                for (int n = 0; n < 2; ++n) acc[a][b][m][n] = (f32x4){0.f, 0.f, 0.f, 0.f};
    bf16x8 At[4][2], B0[2][2], B1[2][2];
    const char* cA = (const char*)g.A + (GATHER ? (size_t)0 : (size_t)cur.row0 * K * 2); const char* cB = (const char*)g.Bt + cur.boff;
    PG8_GOFF(vg0, cur);
#pragma unroll
    for (int _h = 0; _h < 2; ++_h)
#pragma unroll
        for (int _i = 0; _i < 2; ++_i) vg1[_h][_i] = vg0[_h][_i];
    PG8_STAGE(PG8_SB(0, 0), cB, voffB); PG8_STAGE_A(PG8_SA(0, 0), cA, 0, false); PG8_STAGE(PG8_SB(0, 1), cB + hstepB, voffB); PG8_STAGE_A(PG8_SA(0, 1), cA, 1, false);
    if (wr == 1) PG8_BAR;
    PG8_WAIT_V(4); PG8_BAR;
    PG8_STAGE(PG8_SB(1, 0), cB + kstepB, voffB); PG8_STAGE_A(PG8_SA(1, 0), cA + kstep, 0, false); PG8_STAGE(PG8_SB(1, 1), cB + hstepB + kstepB, voffB);
    PG8_WAIT_V(6); PG8_BAR;
    for (;;) {
        const bool has_next = S.next(ui + 1, nxt);
        if (has_next) PG8_GOFF(vg1, nxt);
        const char* nA = has_next ? (const char*)g.A + (GATHER ? (size_t)0 : (size_t)nxt.row0 * K * 2) : cA; const char* nB = has_next ? (const char*)g.Bt + nxt.boff : cB;
        const bool full = cur.nvalid > HALF;
        for (int t = 0; t < nt; t += 2) {
            const bool last = (t == nt - 2);
            const bool wn = last && has_next;
            const char* a1 = cA + (size_t)(t + 1) * kstep;
            const char* a2 = last ? nA : cA + (size_t)(t + 2) * kstep; const char* b2 = last ? nB : cB + (size_t)(t + 2) * kstepB;
            const char* a3 = a2 + kstep; const char* b3 = b2 + kstepB;
            PG8_LDB(B0, 0, 0); PG8_SCHED; PG8_LDA(At, 0, 0); PG8_STAGE_A(PG8_SA(1, 1), a1, 1, false);
            PG8_WAIT_L(8); PG8_BAR; PG8_WAIT_L(0); PG8_MMA(0, 0, At, B0); PG8_BAR; PG8_SCHED;
            PG8_LDB(B1, 0, 1); PG8_STAGE(PG8_SB(0, 0), b2, voffB);
            PG8_BAR; PG8_WAIT_L(0); PG8_MMA(0, 1, At, B1); PG8_BAR;
            if (full) PG8_LDA(At, 0, 1); PG8_STAGE_A(PG8_SA(0, 0), a2, 0, wn);
            PG8_BAR; PG8_WAIT_L(0); if (full) PG8_MMA(1, 0, At, B0); PG8_BAR; PG8_SCHED;
            PG8_STAGE(PG8_SB(0, 1), b2 + hstepB, voffB);
            PG8_WAIT_V(6); PG8_BAR; if (full) PG8_MMA(1, 1, At, B1); PG8_BAR;
            PG8_LDB(B0, 1, 0); PG8_SCHED; PG8_LDA(At, 1, 0); PG8_STAGE_A(PG8_SA(0, 1), a2, 1, wn);
            PG8_WAIT_L(8); PG8_BAR; PG8_WAIT_L(0); PG8_MMA(0, 0, At, B0); PG8_BAR; PG8_SCHED;
            PG8_LDB(B1, 1, 1); PG8_STAGE(PG8_SB(1, 0), b3, voffB);
            PG8_BAR; PG8_WAIT_L(0); PG8_MMA(0, 1, At, B1); PG8_BAR;
            if (full) PG8_LDA(At, 1, 1); PG8_STAGE_A(PG8_SA(1, 0), a3, 0, wn);
            PG8_BAR; PG8_WAIT_L(0); if (full) PG8_MMA(1, 0, At, B0); PG8_BAR; PG8_SCHED;
            PG8_STAGE(PG8_SB(1, 1), b3 + hstepB, voffB);
            PG8_WAIT_V(6); PG8_BAR; if (full) PG8_MMA(1, 1, At, B1); PG8_BAR;
        }
        { int fr_ = fr, fq_ = fq; asm volatile("" : "+v"(fr_), "+v"(fq_)); E(acc, cur, wr, wc, fr_, fq_); }
        if (!has_next) break;
#pragma unroll
        for (int a = 0; a < 2; ++a)
#pragma unroll
            for (int b = 0; b < 2; ++b)
#pragma unroll
                for (int m = 0; m < 4; ++m)
#pragma unroll
                    for (int n = 0; n < 2; ++n) acc[a][b][m][n] = (f32x4){0.f, 0.f, 0.f, 0.f};
        cur = nxt; cA = nA; cB = nB; ++ui;
#pragma unroll
        for (int _h = 0; _h < 2; ++_h)
#pragma unroll
            for (int _i = 0; _i < 2; ++_i) vg0[_h][_i] = vg1[_h][_i];
    }
    PG8_WAIT_V(0);
    if (wr == 0) PG8_BAR;
    PG8_BAR;
#undef PG8_SA
#undef PG8_SB
#undef PG8_STAGE
#undef PG8_STAGE_A
#undef PG8_LDA
#undef PG8_LDB
#undef PG8_MMA
#undef PG8_WAIT_V
#undef PG8_WAIT_L
#undef PG8_BAR
#undef PG8_SCHED
#undef PG8_GOFF
}

struct StaticOrder {
    int nM, nN, nwg, G, c, Kb;
    __device__ void init(int M, int N, int K, int G_, int c_) { nM = M / BM; nN = N / BM; nwg = nM * nN; G = G_; c = c_; Kb = K; }
    __device__ bool next(int i, Unit& u) const {
        const long L = (long)i * G + c; if (L >= nwg) return false;
        int wgid = (int)L; { const int NXCD = 8; const int q = nwg / NXCD, r = nwg % NXCD, xcd = wgid % NXCD, off = wgid / NXCD; wgid = (xcd < r ? xcd * (q + 1) : r * (q + 1) + (xcd - r) * q) + off; }
        const int WGM = 8; const int nig = WGM * nN, gid = wgid / nig, fm = gid * WGM, gsz = (nM - fm) < WGM ? (nM - fm) : WGM;
        u.row0 = (fm + ((wgid % nig) % gsz)) * BM; u.lrow = u.row0; u.pn = (wgid % nig) / gsz; u.nvalid = BM; u.aux = u.pn; u.kind = 0; u.boff = (unsigned)u.pn * (unsigned)(BM * 2) * (unsigned)Kb; return true;
    }
};
}
using pg8::Unit; using pg8::cvt_pk_bf16;
typedef const f32x4 (&AccRef)[2][2][4][2];

struct MoeOrder {
    const unsigned* units; int ntile, nsub, G, c; unsigned ebytes;
    __device__ bool next(int i, Unit& u) const {
        const long L = (long)i * G + c; const int nun = ntile * nsub; if (L >= nun) return false;
        int idx = (int)L; { const int q = nun / 8, r = nun % 8, xcd = idx % 8, off = idx / 8; idx = (xcd < r ? xcd * (q + 1) : r * (q + 1) + (xcd - r) * q) + off; }
        const int tile = idx / nsub, sub = idx % nsub;
        const u32x4 d = *(const u32x4*)(units + 4 * tile);
        u.row0 = (int)d.x; u.lrow = u.row0; u.pn = (int)d.y * nsub + sub; u.nvalid = (int)d.z; u.aux = sub; u.kind = 0; u.boff = d.y * ebytes + (unsigned)sub * 32768u; return true;
    }
};

struct EpiInT {
    static constexpr bool PERM = true;
    bf16_t* phyt; bf16_t* vt;
    __device__ __forceinline__ void operator()(AccRef acc, const Unit& u, int wr, int wc, int fr, int fq) const {
        const int pm = u.lrow >> 8, tb = u.pn * 256; const bool isctx = tb >= T;
        int b, nbase; if (!isctx) { b = tb >> 13; nbase = tb & (SEQ - 1); } else { b = (tb - T) >> 8; nbase = 0; }
        if (pm < 6 && isctx) return;
#pragma unroll
        for (int ai = 0; ai < 2; ++ai)
#pragma unroll
            for (int m = 0; m < 4; ++m) {
                const int f = u.lrow + ai * 128 + wr * 64 + m * 16 + fr;
                bf16_t* rowp = (pm < 6) ? phyt + ((size_t)(b * HYP + f) * SEQ + nbase) : vt + ((size_t)(b * HGW + (f - HYP)) * NEXT + (isctx ? 0 : CTXL) + nbase);
#pragma unroll
                for (int bj = 0; bj < 2; ++bj) { const int cu = bj * 128 + wc * 32 + 8 * fq; const f32x4 v0 = acc[ai][bj][m][0], v1 = acc[ai][bj][m][1];
                    u32x4 w; w.x = cvt_pk_bf16(v0[0], v0[1]); w.y = cvt_pk_bf16(v0[2], v0[3]); w.z = cvt_pk_bf16(v1[0], v1[1]); w.w = cvt_pk_bf16(v1[2], v1[3]);
                    *(u32x4*)(rowp + cu) = w; }
            }
    }
};
struct EpiInN {
    static constexpr bool PERM = true;
    bf16_t *q, *g, *sg1, *sg2; bf16_t *lf, *lb; const float* lbs;
    __device__ __forceinline__ void operator()(AccRef acc, const Unit& u, int wr, int wc, int fr, int fq) const {
        const int pn = u.pn; const bool isctx = u.lrow >= T;
        if (isctx && (pn < 2 || pn > 5)) return;
        float lbu[2][8];
        if (pn >= 2 && pn < 6) {
#pragma unroll
            for (int bj = 0; bj < 2; ++bj) { const float* lbp = lbs + (pn >= 4) * 512 + (pn & 1) * 256 + bj * 128 + wc * 32 + 8 * fq; const f32x4 l0 = *(const f32x4*)lbp, l1 = *(const f32x4*)(lbp + 4);
                lbu[bj][0] = l0[0]; lbu[bj][1] = l0[1]; lbu[bj][2] = l0[2]; lbu[bj][3] = l0[3]; lbu[bj][4] = l1[0]; lbu[bj][5] = l1[1]; lbu[bj][6] = l1[2]; lbu[bj][7] = l1[3]; } }
#pragma unroll
        for (int ai = 0; ai < 2; ++ai)
#pragma unroll
            for (int m = 0; m < 4; ++m) {
                const int r = u.lrow + ai * 128 + wr * 64 + m * 16 + fr;
                int b, nx; if (!isctx) { b = r >> 13; nx = CTXL + (r & (SEQ - 1)); } else { const int rr = r - T; b = rr >> 8; nx = rr & 255; }
#pragma unroll
                for (int bj = 0; bj < 2; ++bj) { const int cu = bj * 128 + wc * 32 + 8 * fq; const f32x4 v0 = acc[ai][bj][m][0], v1 = acc[ai][bj][m][1];
                    float x[8] = {v0[0], v0[1], v0[2], v0[3], v1[0], v1[1], v1[2], v1[3]};
                    if (pn >= 2 && pn < 6) {
                        const int dir = pn >= 4, col = (pn & 1) * 256 + cu;
                        float o[8];
#pragma unroll
                        for (int j = 0; j < 8; ++j) o[j] = __logf(lbu[bj][j] + (1.0f - lbu[bj][j]) * sigmoidf_(x[j]));
                        bf16_t* dst = (dir ? lb : lf) + ((size_t)(b * NEXT + nx) * HGW + col);
                        *(u32x4*)dst = (u32x4){pkh2(o[0], o[1]), pkh2(o[2], o[3]), pkh2(o[4], o[5]), pkh2(o[6], o[7])};
                    } else {
                        bf16_t* dst;
                        if (pn < 2) { dst = q + (size_t)r * HGW + pn * 256 + cu;
#pragma unroll
                            for (int j = 0; j < 8; ++j) x[j] = siluf_(x[j]); }
                        else if (pn < 8) { dst = g + (size_t)r * HGW + (pn - 6) * 256 + cu;
#pragma unroll
                            for (int j = 0; j < 8; ++j) x[j] = siluf_(x[j]); }
                        else { dst = (pn < 12 ? sg1 + (size_t)r * D + (pn - 8) * 256 : sg2 + (size_t)r * D + (pn - 12) * 256) + cu;
#pragma unroll
                            for (int j = 0; j < 8; ++j) x[j] = sigmoidf_(x[j]); }
                        u32x4 w; w.x = cvt_pk_bf16(x[0], x[1]); w.y = cvt_pk_bf16(x[2], x[3]); w.z = cvt_pk_bf16(x[4], x[5]); w.w = cvt_pk_bf16(x[6], x[7]);
                        *(u32x4*)dst = w;
                    }
                }
            }
    }
};
struct EpiMerge1 {
    static constexpr bool PERM = false;
    const bf16_t* sg1; float* t1;
    __device__ __forceinline__ void operator()(AccRef acc, const Unit& u, int wr, int wc, int fr, int fq) const {
#pragma unroll
        for (int ai = 0; ai < 2; ++ai) { u32x2 s[4][2][2];
#pragma unroll
            for (int m = 0; m < 4; ++m) { const size_t ro = (size_t)(u.lrow + ai * 128 + wr * 64 + m * 16 + fr) * D + u.pn * 256 + wc * 32 + 4 * fq;
#pragma unroll
                for (int bj = 0; bj < 2; ++bj)
#pragma unroll
                    for (int n = 0; n < 2; ++n) s[m][bj][n] = *(const u32x2*)(sg1 + ro + bj * 128 + n * 16); }
#pragma unroll
            for (int m = 0; m < 4; ++m) { const size_t ro = (size_t)(u.lrow + ai * 128 + wr * 64 + m * 16 + fr) * D + u.pn * 256 + wc * 32 + 4 * fq;
#pragma unroll
                for (int bj = 0; bj < 2; ++bj)
#pragma unroll
                    for (int n = 0; n < 2; ++n) { const f32x4 a = acc[ai][bj][m][n]; const u32x2 sv = s[m][bj][n];
                        *(f32x4*)(t1 + ro + bj * 128 + n * 16) = (f32x4){a[0] * bflo(sv.x), a[1] * bfhi(sv.x), a[2] * bflo(sv.y), a[3] * bfhi(sv.y)}; } } }
    }
};
struct EpiMerge2 {
    static constexpr bool PERM = false;
    const bf16_t* sg2; const float* t1; bf16_t* mb;
    __device__ __forceinline__ void operator()(AccRef acc, const Unit& u, int wr, int wc, int fr, int fq) const {
#pragma unroll
        for (int ai = 0; ai < 2; ++ai)
#pragma unroll
            for (int m = 0; m < 4; ++m) { u32x2 s[2][2]; f32x4 p[2][2];
                const size_t ro = (size_t)(u.lrow + ai * 128 + wr * 64 + m * 16 + fr) * D + u.pn * 256 + wc * 32 + 4 * fq;
#pragma unroll
                for (int bj = 0; bj < 2; ++bj)
#pragma unroll
                    for (int n = 0; n < 2; ++n) { s[bj][n] = *(const u32x2*)(sg2 + ro + bj * 128 + n * 16); p[bj][n] = *(const f32x4*)(t1 + ro + bj * 128 + n * 16); }
#pragma unroll
                for (int bj = 0; bj < 2; ++bj)
#pragma unroll
                    for (int n = 0; n < 2; ++n) { const f32x4 a = acc[ai][bj][m][n], pv = p[bj][n]; const u32x2 sv = s[bj][n];
                        u32x2 w; w.x = cvt_pk_bf16(pv[0] + a[0] * bflo(sv.x), pv[1] + a[1] * bfhi(sv.x)); w.y = cvt_pk_bf16(pv[2] + a[2] * bflo(sv.y), pv[3] + a[3] * bfhi(sv.y));
                        *(u32x2*)(mb + ro + bj * 128 + n * 16) = w; } }
    }
};
struct EpiWout {
    static constexpr bool PERM = false;
    const float* x; const float* posr; const float* posc; const float* ada; float* x1;
    __device__ __forceinline__ void operator()(AccRef acc, const Unit& u, int wr, int wc, int fr, int fq) const {
        const int b = u.lrow >> 13, cb = u.pn * 256 + wc * 32 + 4 * fq;
        f32x4 g1[2][2];
#pragma unroll
        for (int bj = 0; bj < 2; ++bj)
#pragma unroll
            for (int nn = 0; nn < 2; ++nn) g1[bj][nn] = *(const f32x4*)(ada + b * 6144 + 2 * D + cb + bj * 128 + nn * 16);
#pragma unroll
        for (int ai = 0; ai < 2; ++ai)
#pragma unroll
            for (int m = 0; m < 4; ++m) { f32x4 xv[2][2], pe[2][2];
                const int r = u.lrow + ai * 128 + wr * 64 + m * 16 + fr, n = r & (SEQ - 1);
#pragma unroll
                for (int bj = 0; bj < 2; ++bj)
#pragma unroll
                    for (int nn = 0; nn < 2; ++nn) { const int c = cb + bj * 128 + nn * 16; xv[bj][nn] = *(const f32x4*)(x + (size_t)r * D + c);
                        pe[bj][nn] = (c < 512) ? *(const f32x4*)(posr + (n >> 6) * 512 + c) : *(const f32x4*)(posc + (n & 63) * 512 + (c - 512)); }
#pragma unroll
                for (int bj = 0; bj < 2; ++bj)
#pragma unroll
                    for (int nn = 0; nn < 2; ++nn) *(f32x4*)(x1 + (size_t)r * D + cb + bj * 128 + nn * 16) = xv[bj][nn] + pe[bj][nn] + g1[bj][nn] * acc[ai][bj][m][nn]; }
    }
};
struct EpiLogit {
    static constexpr bool PERM = true;
    float* lg;
    __device__ __forceinline__ void operator()(AccRef acc, const Unit& u, int wr, int wc, int fr, int fq) const {
#pragma unroll
        for (int ai = 0; ai < 2; ++ai)
#pragma unroll
            for (int m = 0; m < 4; ++m) { float* rp = lg + (size_t)(u.lrow + ai * 128 + wr * 64 + m * 16 + fr) * NE + wc * 32 + 8 * fq;
#pragma unroll
                for (int bj = 0; bj < 2; ++bj) { *(f32x4*)(rp + bj * 128) = acc[ai][bj][m][0]; *(f32x4*)(rp + bj * 128 + 4) = acc[ai][bj][m][1]; } }
    }
};
struct EpiGU {
    static constexpr bool PERM = true;
    bf16_t* hout;
    __device__ __forceinline__ void operator()(AccRef acc, const Unit& u, int wr, int wc, int fr, int fq) const {
#pragma unroll
        for (int ai = 0; ai < 2; ++ai)
#pragma unroll
            for (int m = 0; m < 4; ++m) { const int rl = ai * 128 + wr * 64 + m * 16 + fr;
                if (rl < u.nvalid) { const f32x4 g0 = acc[ai][0][m][0], g1 = acc[ai][0][m][1], u0 = acc[ai][1][m][0], u1 = acc[ai][1][m][1];
                    u32x4 w; w.x = cvt_pk_bf16(siluf_(g0[0]) * u0[0], siluf_(g0[1]) * u0[1]); w.y = cvt_pk_bf16(siluf_(g0[2]) * u0[2], siluf_(g0[3]) * u0[3]);
                    w.z = cvt_pk_bf16(siluf_(g1[0]) * u1[0], siluf_(g1[1]) * u1[1]); w.w = cvt_pk_bf16(siluf_(g1[2]) * u1[2], siluf_(g1[3]) * u1[3]);
                    *(u32x4*)(hout + (size_t)(u.lrow + rl) * EH + u.aux * 128 + wc * 32 + 8 * fq) = w; } }
    }
};
template <bool HASW, bool FP8 = false> struct EpiDown {
    static constexpr bool PERM = true;
    bf16_t* yout; const float* wrow;
    __device__ __forceinline__ void operator()(AccRef acc, const Unit& u, int wr, int wc, int fr, int fq) const {
        char* base = (char*)yout + ((size_t)u.lrow * D + u.aux * 256 + wc * 32) * (FP8 ? 1 : 2);
        float wv[2][4];
#pragma unroll
        for (int ai = 0; ai < 2; ++ai)
#pragma unroll
            for (int m = 0; m < 4; ++m) { const int rl = ai * 128 + wr * 64 + m * 16 + fr; wv[ai][m] = (HASW && rl < u.nvalid) ? wrow[u.lrow + rl] : 1.0f; }
#pragma unroll
        for (int ai = 0; ai < 2; ++ai)
#pragma unroll
            for (int m = 0; m < 4; ++m) { const int rl = ai * 128 + wr * 64 + m * 16 + fr;
                if (rl < u.nvalid) { const float w_ = wv[ai][m];
                    const unsigned off = (unsigned)(rl * D + 8 * fq) * (FP8 ? 1u : 2u);
#pragma unroll
                    for (int bj = 0; bj < 2; ++bj) { const f32x4 v0 = acc[ai][bj][m][0] * w_, v1 = acc[ai][bj][m][1] * w_;
                        if (FP8) { int a = __builtin_amdgcn_cvt_pk_fp8_f32(v0[0], v0[1], 0, false); a = __builtin_amdgcn_cvt_pk_fp8_f32(v0[2], v0[3], a, true);
                            int c = __builtin_amdgcn_cvt_pk_fp8_f32(v1[0], v1[1], 0, false); c = __builtin_amdgcn_cvt_pk_fp8_f32(v1[2], v1[3], c, true);
                            *(u32x2*)(base + off + bj * 128) = (u32x2){(unsigned)a, (unsigned)c}; }
                        else { u32x4 w; w.x = cvt_pk_bf16(v0[0], v0[1]); w.y = cvt_pk_bf16(v0[2], v0[3]); w.z = cvt_pk_bf16(v1[0], v1[1]); w.w = cvt_pk_bf16(v1[2], v1[3]);
                            *(u32x4*)(base + off + bj * 256) = w; } } } }
    }
};

constexpr int RA1 = (int)((WS_A1 - WS_WINT) / (D * 2));
static_assert((WS_A1 - WS_WINT) % (D * 2) == 0, "A1 must sit a whole number of rows above WINT");
struct InOrder {
    int G, c;
    static constexpr int N0 = 6 * 64, N1 = 2 * 64, N2 = 64 * 16, NU = N0 + N1 + N2;
    __device__ bool next(int i, Unit& u) const {
        const long L = (long)i * G + c; if (L >= NU) return false;
        int idx = (int)L; { const int q = NU / 8, r = NU % 8, xcd = idx % 8, off = idx / 8; idx = (xcd < r ? xcd * (q + 1) : r * (q + 1) + (xcd - r) * q) + off; }
        int pm, pn, kind;
        if (idx < N0 + N1) { const int g = idx >> 5, jj = idx & 31; kind = 0; pm = 4 * (g & 1) + (jj & 3); pn = 8 * (g >> 1) + (jj >> 2); }
        else { const int j = idx - N0 - N1, g = j >> 7, jj = j & 127; kind = 1; pm = 8 * g + (jj & 7); pn = jj >> 3; }
        fill(u, kind, pm, pn); return true;
    }
    __device__ static void fill(Unit& u, int kind, int pm, int pn) {
        u.kind = kind; u.pn = pn; u.lrow = pm * 256; u.nvalid = 256; u.aux = pn;
        if (kind == 0) { u.row0 = pm * 256; u.boff = (unsigned)(RA1 + pn * 256) * (unsigned)(D * 2); }
        else { u.row0 = RA1 + pm * 256; u.boff = (unsigned)(2048 + pn * 256) * (unsigned)(D * 2); }
    }
};
struct CtxUnit {
    int idx;
    __device__ static int tile(int idx) { return idx < 4 ? (idx & 1) : ((idx - 4) >> 2); }
    __device__ bool next(int i, Unit& u) const { if (i) return false;
        if (idx < 4) InOrder::fill(u, 0, 6 + (idx >> 1), 64 + (idx & 1)); else InOrder::fill(u, 1, 64 + ((idx - 4) >> 2), 2 + ((idx - 4) & 3)); return true; }
};
struct EpiIn {
    static constexpr bool PERM = true;
    EpiInT t; EpiInN n;
    __device__ __forceinline__ void operator()(AccRef acc, const Unit& u, int wr, int wc, int fr, int fq) const { if (u.kind == 0) t(acc, u, wr, wc, fr, fq); else n(acc, u, wr, wc, fr, fq); }
};
struct P9Order {
    int G, c;
    __device__ bool next(int i, Unit& u) const {
        const long L = (long)i * G + c; if (L >= 192) return false; int idx = (int)L;
        { const int xcd = idx % 8, off = idx / 8; idx = xcd * 24 + off; }
        const int pm = idx / 3, k3 = idx % 3;
        u.row0 = pm * 256;
        if (k3 == 0) { u.kind = 0; u.pn = 0; u.aux = 0; u.boff = 0u; }
        else { u.kind = 1; u.pn = k3 - 1; u.aux = k3 - 1; u.boff = (unsigned)(WS_SHGUT - WS_ROUT) + (unsigned)(k3 - 1) * (unsigned)(256 * D * 2); }
        u.lrow = u.row0; u.nvalid = 256; return true;
    }
};
struct EpiP9 {
    static constexpr bool PERM = true;
    EpiLogit l; EpiGU g;
    __device__ __forceinline__ void operator()(AccRef acc, const Unit& u, int wr, int wc, int fr, int fq) const { if (u.kind == 0) l(acc, u, wr, wc, fr, fq); else g(acc, u, wr, wc, fr, fq); }
};
#define XB_TMO      128
#define XB_XCNT(j)  (256  + 64 * (j))
#define XB_XSUB(j)  (1280 + 64 * (j))
#define XB_XGEN(j)  (2304 + 64 * (j))
#define XB_TOP      3328
#define XB_TOPGEN   3392
#define XCD_BAR_WORDS 3456
#define XB_SPIN_CAP (1u << 18)

__device__ __forceinline__ unsigned xb_ld(unsigned* p)              { return __hip_atomic_load(p, __ATOMIC_RELAXED, __HIP_MEMORY_SCOPE_AGENT); }
__device__ __forceinline__ unsigned xb_add(unsigned* p, unsigned v) { return __hip_atomic_fetch_add(p, v, __ATOMIC_RELAXED, __HIP_MEMORY_SCOPE_AGENT); }
__device__ __forceinline__ unsigned xb_xcc_id() { return (unsigned)__builtin_amdgcn_s_getreg((3 << 11) | 20) & 0xFu; }
#define XB_SPIN(cond, bar) do { unsigned _sp = 0; while (cond) { __builtin_amdgcn_s_sleep(1); \
    if ((++_sp & 255u) == 0u) { if (xb_ld(&(bar)[XB_TMO])) break; if (_sp > XB_SPIN_CAP) { atomicAdd(&(bar)[XB_TMO], 1u); break; } } } } while (0)

struct XcdBarrier {
    unsigned* bar; unsigned x;
    volatile LAS unsigned* st;
};

__device__ __forceinline__ XcdBarrier xcd_barrier_post(unsigned* bar, volatile LAS unsigned* st) {
    XcdBarrier b; b.bar = bar; b.x = xb_xcc_id(); b.st = st;
    if (threadIdx.x == 0) (void)xb_add(&bar[XB_XCNT(b.x)], 1u);
    return b;
}
__device__ __forceinline__ void xcd_barrier_complete(unsigned* bar, unsigned x, unsigned& nloc, unsigned& nx) {
    const unsigned G = gridDim.x * gridDim.y * gridDim.z;
    unsigned sum, cnt, mine, sp = 0u;
    for (;;) {
        sum = 0u; cnt = 0u; mine = 0u;
#pragma unroll
        for (unsigned j = 0; j < 16; ++j) { const unsigned c = xb_ld(&bar[XB_XCNT(j)]); sum += c; cnt += (c > 0u) ? 1u : 0u; mine = (j == x) ? c : mine; }
        if (sum == G) break;
        __builtin_amdgcn_s_sleep(1);
        if ((++sp & 255u) == 0u) { if (xb_ld(&bar[XB_TMO])) break; if (sp > XB_SPIN_CAP) { atomicAdd(&bar[XB_TMO], 1u); break; } }
    }
    nloc = mine > 0u ? mine : 1u; nx = cnt > 0u ? cnt : 1u;
}

__device__ __forceinline__ void xcd_barrier(const XcdBarrier& b) {
    asm volatile("s_waitcnt vmcnt(0)" ::: "memory");
    __syncthreads();
    if (threadIdx.x == 0) {
        unsigned* bar = b.bar;
        __builtin_amdgcn_s_waitcnt(0);
        unsigned nloc = b.st[0], nx = b.st[1];
        if (nloc == 0u) { xcd_barrier_complete(bar, b.x, nloc, nx); b.st[0] = nloc; b.st[1] = nx; }
        const unsigned old = xb_add(&bar[XB_XSUB(b.x)], 1u);
        const unsigned gen = old / nloc;
        if (old + 1u == (gen + 1u) * nloc) {
            __builtin_amdgcn_fence(__ATOMIC_RELEASE, "agent");
            asm volatile("s_waitcnt vmcnt(0)" ::: "memory");
            const unsigned og = xb_add(&bar[XB_TOP], 1u);
            const unsigned tg = og / nx;
            if (og + 1u == (tg + 1u) * nx) xb_add(&bar[XB_TOPGEN], 1u);
            else XB_SPIN(xb_ld(&bar[XB_TOPGEN]) == tg, bar);
            __builtin_amdgcn_fence(__ATOMIC_ACQUIRE, "agent");
            xb_add(&bar[XB_XGEN(b.x)], 1u);
            asm volatile("s_waitcnt vmcnt(0)" ::: "memory");
        } else {
            XB_SPIN(xb_ld(&bar[XB_XGEN(b.x)]) == gen, bar);
            __builtin_amdgcn_fence(__ATOMIC_ACQUIRE, "agent");
            asm volatile("s_waitcnt vmcnt(0)" ::: "memory");
        }
    }
    __syncthreads();
}


struct Frame {
    LAS unsigned char* lds;
    const Params* p;
    unsigned char* ws;
    int tid, lane, wave, G, bx;
};
#define WSP(T_, off) ((T_*)(F.ws + (off)))

__device__ __forceinline__ void p0_transpose_item(const float* W, int N, bf16_t* WT, int K, int k0, int n0, int row0, LAS float* scr, int lane) {
#pragma unroll 8
    for (int i = 0; i < 32; ++i) { const int kk = 2 * i + (lane >> 5); scr[kk * 33 + (lane & 31)] = W[(size_t)(k0 + kk) * N + n0 + (lane & 31)]; }
    LDS_WAIT(); asm volatile("" ::: "memory");
    const int c = lane & 7;
#pragma unroll
    for (int j = 0; j < 4; ++j) { const int n = (lane >> 3) + 8 * j; const LAS float* s = scr + (8 * c) * 33 + n;
        u32x4 o; o.x = pk2(s[0 * 33], s[1 * 33]); o.y = pk2(s[2 * 33], s[3 * 33]); o.z = pk2(s[4 * 33], s[5 * 33]); o.w = pk2(s[6 * 33], s[7 * 33]);
        *(u32x4*)(WT + (size_t)(row0 + n) * K + k0 + 8 * c) = o; }
    LDS_WAIT(); asm volatile("" ::: "memory");
}
__device__ __forceinline__ int gu_row(int n0, int up) { return (n0 >> 7) * 256 + up * 128 + (n0 & 127); }

__device__ __forceinline__ void p0_transposes(Frame& F) {
    LAS float* scr = (LAS float*)(F.lds + F.wave * 16384);
    const int gw = F.bx * 8 + F.wave, NGW = F.G * 8;
    const float* const* in = F.p->in;
    constexpr int I_WIN_ = 16 * 192, I_WHY_ = 8 * 32, I_WHG_ = 8 * 32, I_WOUT_ = 16 * 32, I_R_ = 16 * 8, I_SG_ = 16 * 8, I_SU_ = 16 * 8, I_SD_ = 4 * 32;
    constexpr int NSMALL = I_WIN_ + I_WHY_ + I_WHG_ + I_WOUT_ + I_R_ + I_SG_ + I_SU_ + I_SD_;
    for (int it = gw; it < NSMALL; it += NGW) {
        int r = it;
        {
            if (r < I_WIN_) { const int kb = r / 192, nb = r % 192, n0 = nb * 32; const int f0 = (n0 >= 1536 && n0 < 2048) ? n0 + 512 : ((n0 >= 2048 && n0 < 2560) ? n0 - 512 : n0);
                p0_transpose_item(in[I_WIN], INC, WSP(bf16_t, WS_WINT), D, kb * 64, n0, f0, scr, F.lane); continue; } r -= I_WIN_;
            if (r < I_WHY_) { p0_transpose_item(in[I_WHY], D, WSP(bf16_t, WS_WHYT), HYW, (r / 32) * 64, (r % 32) * 32, (r % 32) * 32, scr, F.lane); continue; } r -= I_WHY_;
            if (r < I_WHG_) { p0_transpose_item(in[I_WHG], D, WSP(bf16_t, WS_WHGT), HGW, (r / 32) * 64, (r % 32) * 32, (r % 32) * 32, scr, F.lane); continue; } r -= I_WHG_;
            if (r < I_WOUT_) { p0_transpose_item(in[I_WOUT], D, WSP(bf16_t, WS_WOUTT), D, (r / 32) * 64, (r % 32) * 32, (r % 32) * 32, scr, F.lane); continue; } r -= I_WOUT_;
            if (r < I_R_) { p0_transpose_item(in[I_RW], NE, WSP(bf16_t, WS_ROUT), D, (r / 8) * 64, (r % 8) * 32, (r % 8) * 32, scr, F.lane); continue; } r -= I_R_;
            if (r < I_SG_) { p0_transpose_item(in[I_SG], EH, WSP(bf16_t, WS_SHGUT), D, (r / 8) * 64, (r % 8) * 32, gu_row((r % 8) * 32, 0), scr, F.lane); continue; } r -= I_SG_;
            if (r < I_SU_) { p0_transpose_item(in[I_SU], EH, WSP(bf16_t, WS_SHGUT), D, (r / 8) * 64, (r % 8) * 32, gu_row((r % 8) * 32, 1), scr, F.lane); continue; } r -= I_SU_;
            p0_transpose_item(in[I_SD], D, WSP(bf16_t, WS_SHDT), EH, (r / 32) * 64, (r % 32) * 32, (r % 32) * 32, scr, F.lane); continue;
        }
    }
}

template <int MODE  >
__device__ __forceinline__ void p0_x256_load(const float* W, int N, int k0, int n0, int tid, f32x4 (&v)[8]) {
    const int n4 = MODE ? ((tid >> 6) * 8 + (tid & 7)) : (tid & 63), kq = MODE ? ((tid >> 3) & 7) : (tid >> 6); const float* src = W + (size_t)(k0 + 8 * kq) * N + n0 + 4 * n4;
#pragma unroll
    for (int r = 0; r < 8; ++r) v[r] = __builtin_nontemporal_load((const f32x4*)(src + (size_t)r * N));
}
__device__ __forceinline__ void p0_x256_store(LAS unsigned char* ts, bf16_t* WT, int K, int k0, int row0, int mode, int tid, const f32x4 (&v)[8]) {
    const int n4 = tid & 63, kq = tid >> 6;
    __syncthreads();
#pragma unroll
    for (int i = 0; i < 4; ++i) { const int n = 4 * n4 + i;
        u32x4 o; o.x = pk2(v[0][i], v[1][i]); o.y = pk2(v[2][i], v[3][i]); o.z = pk2(v[4][i], v[5][i]); o.w = pk2(v[6][i], v[7][i]);
        *(LAS u32x4*)(ts + n * 128 + ((kq ^ (n4 & 7)) << 4)) = o; }
    __syncthreads();
#pragma unroll
    for (int q = 0; q < 4; ++q) { const int task = tid + 512 * q, n = task >> 3, part = task & 7;
        const u32x4 o = *(const LAS u32x4*)(ts + n * 128 + ((part ^ ((n >> 2) & 7)) << 4));
        const int row = mode == 0 ? row0 + n : ((n >> 7) * 256 + (mode - 1) * 128 + (n & 127));
        *(u32x4*)(WT + (size_t)(k0 >> 6) * K + row * 64 + 8 * part) = o; }
}
__device__ __forceinline__ void p0_x256_decode(const float* const* in, unsigned char* ws, int item, const float*& W, int& N, bf16_t*& WT, int& K, int& k0, int& n0, int& mode) {
    const int e = item / 48, r = item % 48;
    if (r < 16) { W = in[I_EG] + (size_t)e * D * EH; N = EH; WT = (bf16_t*)(ws + WS_EGUT) + (size_t)e * 512 * D; K = 512 * 64; k0 = r * 64; n0 = 0; mode = 1; }
    else if (r < 32) { W = in[I_EU] + (size_t)e * D * EH; N = EH; WT = (bf16_t*)(ws + WS_EGUT) + (size_t)e * 512 * D; K = 512 * 64; k0 = (r - 16) * 64; n0 = 0; mode = 2; }
    else { const int q = r - 32; W = in[I_ED] + (size_t)e * EH * D; N = D; WT = (bf16_t*)(ws + WS_EDT) + (size_t)e * D * EH; K = D * 64; k0 = (q >> 2) * 64; n0 = (q & 3) * 256; mode = 0; }
}
struct XpState { f32x4 v[8]; int it, end, stride; bool live; };
__device__ __forceinline__ void xp_issue(XpState& s, const float* const* in, unsigned char* ws, int tid) {
    s.live = s.it < s.end;
    if (s.live) { const float* W; int N, K, k0, n0, mode; bf16_t* WT; p0_x256_decode(in, ws, s.it, W, N, WT, K, k0, n0, mode); p0_x256_load<1>(W, N, k0, n0, tid, s.v); }
}
__device__ __forceinline__ void xp_finish(XpState& s, const float* const* in, unsigned char* ws, int tid) {
    if (s.live) { const float* W; int N, K, k0, n0, mode; bf16_t* WT; p0_x256_decode(in, ws, s.it, W, N, WT, K, k0, n0, mode);
        const int n4 = (tid >> 6) * 8 + (tid & 7), kq = (tid >> 3) & 7;
#pragma unroll
        for (int i = 0; i < 4; ++i) { const int n = 4 * n4 + i; const int row = mode == 0 ? n0 + n : ((n >> 7) * 256 + (mode - 1) * 128 + (n & 127));
            u32x4 o; o.x = pk2(s.v[0][i], s.v[1][i]); o.y = pk2(s.v[2][i], s.v[3][i]); o.z = pk2(s.v[4][i], s.v[5][i]); o.w = pk2(s.v[6][i], s.v[7][i]);
            *(u32x4*)(WT + (size_t)(k0 >> 6) * K + row * 64 + 8 * kq) = o; }
        s.it += s.stride; s.live = false; }
}
__device__ __forceinline__ void xp_step(XpState& s, const float* const* in, unsigned char* ws, int tid) { xp_finish(s, in, ws, tid); xp_issue(s, in, ws, tid); }
constexpr int XP_BG = 30;

__device__ __forceinline__ void p0_expert_transposes(Frame& F) {
    int tid = F.tid; asm volatile("" : "+v"(tid));
    constexpr int NIT = NE * 48;
    int it = F.bx + XP_BG * F.G; if (it >= NIT) return;
    const float* W; int N, K, k0, n0, mode; bf16_t* WT;
    const float* W2; int N2, K2, k2, n2, mode2; bf16_t* WT2;
    f32x4 va[8], vb[8];
    p0_x256_decode(F.p->in, F.ws, it, W, N, WT, K, k0, n0, mode);
    p0_x256_load<0>(W, N, k0, n0, tid, va);
    for (;;) {
        __builtin_amdgcn_s_waitcnt(0);
        int nx = it + F.G; bool has = nx < NIT;
        if (has) { p0_x256_decode(F.p->in, F.ws, nx, W2, N2, WT2, K2, k2, n2, mode2); p0_x256_load<0>(W2, N2, k2, n2, tid, vb); }
        p0_x256_store(F.lds, WT, K, k0, n0, mode, tid, va);
        if (!has) break;
        it = nx;
        __builtin_amdgcn_s_waitcnt(0);
        nx = it + F.G; has = nx < NIT;
        if (has) { p0_x256_decode(F.p->in, F.ws, nx, W, N, WT, K, k0, n0, mode); p0_x256_load<0>(W, N, k0, n0, tid, va); }
        p0_x256_store(F.lds, WT2, K2, k2, n2, mode2, tid, vb);
        if (!has) break;
        it = nx;
    }
}

constexpr int ADA_KC = 4;
__device__ __forceinline__ void p0_ada_item(Frame& F, int item) {
    const int kc = item / 12, cb = item % 12, col = cb * 512 + F.tid;
    const float* in_c = F.p->in[I_C]; const float* in_cc = F.p->in[I_CCTX]; const float* w = F.p->in[I_ADAW];
    LAS float* sv = (LAS float*)F.lds;
    __syncthreads();
    for (int i = F.tid; i < 768; i += 512) { const int wh = i >> 8, k = kc * 256 + (i & 255); sv[i] = siluf_(wh == 0 ? in_c[k] : (wh == 1 ? in_c[D + k] : in_cc[k])); }
    __syncthreads();
    float a0 = 0.f, a1 = 0.f, a2 = 0.f;
    const float* wp = w + (size_t)(kc * 256) * 6144 + col;
#pragma unroll 16
    for (int k = 0; k < 256; ++k) { const float wv = wp[(size_t)k * 6144]; a0 += sv[k] * wv; a1 += sv[256 + k] * wv; a2 += sv[512 + k] * wv; }
    float* o = WSP(float, WS_ADAP) + (size_t)kc * 3 * 6144 + col;
    o[0] = a0; o[6144] = a1; o[2 * 6144] = a2;
}

__device__ __forceinline__ void p0_filter_item(Frame& F, int item) {
    LAS float* zb = (LAS float*)F.lds;
    LAS float* ab1 = zb + 32 * 36;
    LAS float* ab2 = ab1 + 32 * 64;
    const float* const* in = F.p->in; const int t0 = item * 32; int tid = F.tid; asm volatile("" : "+v"(tid));
    __syncthreads();
    for (int idx = tid; idx < 32 * 33; idx += 512) { const int t = idx / 33, e = idx % 33; const float tf = (float)(t0 + t); float v;
        if (e == 0) v = tf / (float)(SEQ - 1);
        else { const int k = (e - 1) & 15; const float band = 1e-4f + (float)k * ((15.0f - 1e-4f) / 15.0f); float sn, cs; sincospif(2.0f * tf * band / (float)SEQ, &sn, &cs); v = (e <= 16) ? cs : -sn; }
        zb[t * 36 + e] = v; }
    __syncthreads();
    {
        const int t = tid >> 4, jj = tid & 15;
#pragma unroll 1
        for (int q = 0; q < 4; ++q) { const int j = jj + 16 * q; float s = in[I_FB1][j];
#pragma unroll 3
            for (int e = 0; e < 33; ++e) s += zb[t * 36 + e] * in[I_FW1][e * 64 + j];
            ab1[t * 64 + j] = sinf(in[I_FFREQ][j] * s); }
    }
    __syncthreads();
    { const int t = tid >> 4, jj = tid & 15;
#pragma unroll 1
        for (int q = 0; q < 4; ++q) { const int j = jj + 16 * q; float s = in[I_FB2][j];
#pragma unroll 4
            for (int e = 0; e < 64; ++e) s += ab1[t * 64 + e] * in[I_FW2][e * 64 + j];
            ab2[t * 64 + j] = sinf(in[I_FFREQ][j] * s); }
    }
    __syncthreads();
    { const int t = tid >> 4, jj = tid & 15;
#pragma unroll 1
        for (int q = 0; q < 4; ++q) { const int j = jj + 16 * q; float s = in[I_FB3][j];
#pragma unroll 4
            for (int e = 0; e < 64; ++e) s += ab2[t * 64 + e] * in[I_FW3][e * 64 + j];
            ab1[t * 64 + j] = sinf(in[I_FFREQ][j] * s); }
    }
    __syncthreads();
    const float* w4 = in[I_FW4];
    const float MIND = -3.0701134573253945f, MAXD = -15.350567286626973f;
    const float delta = fabsf(MIND + (MAXD - MIND) * ((float)tid / 511.0f));
    bf16_t* hf = WSP(bf16_t, WS_HF);
#pragma unroll 1
    for (int half = 0; half < 4; ++half) {
        f32x2 acc[8][2];
#pragma unroll
        for (int t = 0; t < 8; ++t) { acc[t][0] = (f32x2){0.f, 0.f}; acc[t][1] = (f32x2){0.f, 0.f}; }
        f32x2 wa[4][2], wb[4][2];
#pragma unroll
        for (int jj = 0; jj < 4; ++jj) { wa[jj][0] = (f32x2){w4[(size_t)jj * 2048 + tid], w4[(size_t)jj * 2048 + tid + 512]}; wa[jj][1] = (f32x2){w4[(size_t)jj * 2048 + tid + 1024], w4[(size_t)jj * 2048 + tid + 1536]}; }
#pragma unroll 1
        for (int j4 = 0; j4 < 16; j4 += 2) {
#pragma unroll
            for (int jj = 0; jj < 4; ++jj) { const size_t o = (size_t)(4 * (j4 + 1) + jj) * 2048 + tid; wb[jj][0] = (f32x2){w4[o], w4[o + 512]}; wb[jj][1] = (f32x2){w4[o + 1024], w4[o + 1536]}; }
#pragma unroll
            for (int t = 0; t < 8; ++t) { const f32x4 a = *(const LAS f32x4*)(ab1 + (8 * half + t) * 64 + 4 * j4);
#pragma unroll
                for (int jj = 0; jj < 4; ++jj) { const f32x2 aa = (f32x2){a[jj], a[jj]}; acc[t][0] += aa * wa[jj][0]; acc[t][1] += aa * wa[jj][1]; } }
            if (j4 + 2 < 16) {
#pragma unroll
                for (int jj = 0; jj < 4; ++jj) { const size_t o = (size_t)(4 * (j4 + 2) + jj) * 2048 + tid; wa[jj][0] = (f32x2){w4[o], w4[o + 512]}; wa[jj][1] = (f32x2){w4[o + 1024], w4[o + 1536]}; } }
#pragma unroll
            for (int t = 0; t < 8; ++t) { const f32x4 a = *(const LAS f32x4*)(ab1 + (8 * half + t) * 64 + 4 * (j4 + 1));
#pragma unroll
                for (int jj = 0; jj < 4; ++jj) { const f32x2 aa = (f32x2){a[jj], a[jj]}; acc[t][0] += aa * wb[jj][0]; acc[t][1] += aa * wb[jj][1]; } }
        }
#pragma unroll
        for (int t4 = 0; t4 < 2; ++t4) { const int tb = t0 + 8 * half + 4 * t4;
            float dc[4];
#pragma unroll
            for (int k = 0; k < 4; ++k) dc[k] = expf(-((float)(tb + k) / (float)(SEQ - 1)) * delta);
#pragma unroll
            for (int i = 0; i < 4; ++i)
                *(u32x2*)(hf + (size_t)(tid + 512 * i) * SEQ + tb) = (u32x2){pk2(acc[4 * t4][i >> 1][i & 1] * dc[0], acc[4 * t4 + 1][i >> 1][i & 1] * dc[1]), pk2(acc[4 * t4 + 2][i >> 1][i & 1] * dc[2], acc[4 * t4 + 3][i >> 1][i & 1] * dc[3])};
        }
    }
}

__device__ __forceinline__ void p0_tables(Frame& F, int item) {
    if (item < 6) {
        const int idx = item * 16384 + F.tid * 32;
        for (int k = 0; k < 32; ++k) { const int id = idx + k; if (id >= 192 * 512) break;
            const int row = id >> 9, col = id & 511, i = col & 255; const float omega = 1.0f / powf(10000.0f, (float)i / 256.0f);
            const float pos = (float)(row < 128 ? row : row - 128); const float ang = pos * omega;
            const float v = (col < 256) ? sinf(ang) : cosf(ang);
            if (row < 128) WSP(float, WS_POSR)[row * 512 + col] = v; else WSP(float, WS_POSC)[(row - 128) * 512 + col] = v; }
    } else {
        for (int id = F.tid; id < 1024; id += 512) { const float l0 = F.p->in[I_LBL][id], l1 = F.p->in[I_LBL][1024 + id];
            WSP(float, WS_LBS)[id] = 1.0f / (1.0f + expf(l1 - l0)); }
    }
}

__device__ __forceinline__ void phase0(Frame& F) {
    for (int it = F.bx; it < 311; it += F.G) {
        if (it < 48) p0_ada_item(F, it);
        else if (it < 304) p0_filter_item(F, it - 48);
        else p0_tables(F, it - 304);
    }
    __syncthreads();
    p0_transposes(F);
    __syncthreads();
    p0_expert_transposes(F);
}

__device__ __forceinline__ void phase1(Frame& F) {
    const float* adap = WSP(float, WS_ADAP); const float* adab = F.p->in[I_ADAB];
    { const int gid = F.bx * 512 + F.tid; if (gid < 3 * 6144) { const int wh = gid / 6144, col = gid % 6144; float s = adab[col];
#pragma unroll
        for (int kc = 0; kc < ADA_KC; ++kc) s += adap[(size_t)(kc * 3 + wh) * 6144 + col]; WSP(float, WS_ADA)[gid] = s; } }
    LAS float* md = (LAS float*)F.lds;
    __syncthreads();
    for (int id = F.tid; id < 3 * 2048; id += 512) { const int wh = id >> 11, col = id & 2047; float s = adab[col];
#pragma unroll
        for (int kc = 0; kc < ADA_KC; ++kc) s += adap[(size_t)(kc * 3 + wh) * 6144 + col]; md[id] = s; }
    __syncthreads();
    const float* x = F.p->in[I_X]; const float* ctx = F.p->in[I_CTX]; const float* g1 = F.p->in[I_N1G];
    const float* posr = WSP(float, WS_POSR); const float* posc = WSP(float, WS_POSC); bf16_t* a1 = WSP(bf16_t, WS_A1);
    const int lane = F.lane;
#define P1_GG() f32x4 ggv[4]; _Pragma("unroll") for (int j = 0; j < 4; ++j) ggv[j] = *(const f32x4*)(g1 + 256 * j + 4 * lane)
#define P1_ROWS4(r0) do { f32x4 v[4][4]; const int wh = (r0) < T ? ((r0) >> 13) : 2; \
        _Pragma("unroll") for (int q = 0; q < 4; ++q) { const int r = (r0) + q; \
            if ((r0) < T) { const int n = r & (SEQ - 1); const f32x4* xr = (const f32x4*)(x + (size_t)r * D) + lane; \
                _Pragma("unroll") for (int j = 0; j < 4; ++j) { const int c = 256 * j + 4 * lane; const f32x4 pe = (c < 512) ? *(const f32x4*)(posr + (n >> 6) * 512 + c) : *(const f32x4*)(posc + (n & 63) * 512 + c - 512); v[q][j] = xr[64 * j] + pe; } \
            } else { const f32x4* xr = (const f32x4*)(ctx + (size_t)(r - T) * D) + lane; \
                _Pragma("unroll") for (int j = 0; j < 4; ++j) v[q][j] = xr[64 * j]; } } \
        _Pragma("unroll") for (int q = 0; q < 4; ++q) { float ss = 0.f; \
            _Pragma("unroll") for (int j = 0; j < 4; ++j) ss += (v[q][j][0] * v[q][j][0] + v[q][j][1] * v[q][j][1]) + (v[q][j][2] * v[q][j][2] + v[q][j][3] * v[q][j][3]); \
            const float rs = rsqrtf(wave_sum(ss) * (1.0f / D) + EPS); \
            u32x2* o8 = (u32x2*)(a1 + (size_t)((r0) + q) * D) + lane; \
            _Pragma("unroll") for (int j = 0; j < 4; ++j) { const int c = 256 * j + 4 * lane; const f32x4 gg = ggv[j]; \
                const f32x4 sh = *(const LAS f32x4*)(md + wh * 2048 + c), sc = *(const LAS f32x4*)(md + wh * 2048 + 1024 + c); \
                const f32x4 y = v[q][j] * rs * gg * (sc + 1.0f) + sh; \
                u32x2 w; w.x = pk2(y[0], y[1]); w.y = pk2(y[2], y[3]); o8[64 * j] = w; } } } while (0)
    const int nded = F.G > 24 ? 12 : 0;
    if (F.bx >= nded) { const int gw = (F.bx - nded) * 8 + F.wave, NGW = (F.G - nded) * 8; P1_GG();
        for (int r0 = gw * 4; r0 < T; r0 += NGW * 4) P1_ROWS4(r0); }
    for (int idx = F.bx; idx < 12; idx += (nded ? 12 : F.G)) {
        if (nded && F.bx >= 12) break;
        const int rbase = T + CtxUnit::tile(idx) * 256 + F.wave * 32;
        { P1_GG(); for (int i = 0; i < 32; i += 4) P1_ROWS4(rbase + i); }
        asm volatile("s_waitcnt vmcnt(0)" ::: "memory"); __syncthreads();
        { pg8::Gemm g{WSP(bf16_t, WS_WINT), WSP(bf16_t, WS_WINT), D, nullptr, 2 * D, 128}; CtxUnit S{idx};
          EpiIn E{EpiInT{WSP(bf16_t, WS_PHYT), WSP(bf16_t, WS_VT)}, EpiInN{WSP(bf16_t, WS_Q), WSP(bf16_t, WS_G), WSP(bf16_t, WS_SG1), WSP(bf16_t, WS_SG2), WSP(bf16_t, WS_LF), WSP(bf16_t, WS_LB), WSP(float, WS_LBS)}};
          pg8::gemm_phase<EpiIn, CtxUnit, false>(F.lds, g, S, E); }
        if (!nded) { __syncthreads(); for (int id = F.tid; id < 3 * 2048; id += 512) { const int wh = id >> 11, col = id & 2047; float s = adab[col];
            for (int kc = 0; kc < ADA_KC; ++kc) s += adap[(size_t)(kc * 3 + wh) * 6144 + col]; md[id] = s; } __syncthreads(); }
    }
#undef P1_ROWS4
#undef P1_GG
}

__device__ __forceinline__ void phase_h2(Frame& F) {
    const float* x1 = F.p->out; const float* g2 = F.p->in[I_N2G]; const float* ada = WSP(float, WS_ADA); bf16_t* h2 = WSP(bf16_t, WS_H2);
    const int gw = F.bx * 8 + F.wave, NGW = F.G * 8, lane = F.lane;
    f32x4 ggv[4];
#pragma unroll
    for (int j = 0; j < 4; ++j) ggv[j] = *(const f32x4*)(g2 + 256 * j + 4 * lane);
    const bool al = (F.G == 256); const int vw = ((F.bx & 7) * 32 + (F.bx >> 3)) * 8 + F.wave;
    for (int r0 = al ? vw * 8 : gw * 4, it_ = 0; al ? it_ < 2 : r0 < T; r0 += al ? 4 : NGW * 4, ++it_) { const int b = r0 >> 13;
        f32x4 v[4][4], shv[4], scv[4];
#pragma unroll
        for (int j = 0; j < 4; ++j) { const int c = 256 * j + 4 * lane; shv[j] = *(const f32x4*)(ada + b * 6144 + 3 * D + c); scv[j] = *(const f32x4*)(ada + b * 6144 + 4 * D + c); }
#pragma unroll
        for (int q = 0; q < 4; ++q) { const f32x4* xr = (const f32x4*)(x1 + (size_t)(r0 + q) * D) + lane;
#pragma unroll
            for (int j = 0; j < 4; ++j) v[q][j] = xr[64 * j]; }
#pragma unroll
        for (int q = 0; q < 4; ++q) { float ss = 0.f;
#pragma unroll
            for (int j = 0; j < 4; ++j) ss += (v[q][j][0] * v[q][j][0] + v[q][j][1] * v[q][j][1]) + (v[q][j][2] * v[q][j][2] + v[q][j][3] * v[q][j][3]);
            const float rs = rsqrtf(wave_sum(ss) * (1.0f / D) + EPS);
            u32x2* o8 = (u32x2*)(h2 + (size_t)(r0 + q) * D) + lane;
#pragma unroll
            for (int j = 0; j < 4; ++j) { const f32x4 gg = ggv[j], sh = shv[j], sc = scv[j];
                const f32x4 y = v[q][j] * rs * gg * (sc + 1.0f) + sh;
                u32x2 w; w.x = pk2(y[0], y[1]); w.y = pk2(y[2], y[3]); o8[64 * j] = w; } }
    }
}
constexpr int FPAD = 17920;
__device__ __forceinline__ int fphys(int i) { return i + (i >> 4) + ((i >> 9) << 4); }
__device__ constexpr float TWC[16] = {1.0f, 0.98078528040323044913f, 0.92387953251128675613f, 0.83146961230254523708f, 0.70710678118654752440f, 0.55557023301960222474f, 0.38268343236508977173f, 0.19509032201612826785f,
                                      0.0f, -0.19509032201612826785f, -0.38268343236508977173f, -0.55557023301960222474f, -0.70710678118654752440f, -0.83146961230254523708f, -0.92387953251128675613f, -0.98078528040323044913f};
__device__ constexpr float TWS[16] = {0.0f, 0.19509032201612826785f, 0.38268343236508977173f, 0.55557023301960222474f, 0.70710678118654752440f, 0.83146961230254523708f, 0.92387953251128675613f, 0.98078528040323044913f,
                                      1.0f, 0.98078528040323044913f, 0.92387953251128675613f, 0.83146961230254523708f, 0.70710678118654752440f, 0.55557023301960222474f, 0.38268343236508977173f, 0.19509032201612826785f};
__host__ __device__ constexpr int brev_c(int x, int bits) { int r = 0; for (int i = 0; i < bits; ++i) r = (r << 1) | ((x >> i) & 1); return r; }

typedef f32x2 cpx;
__device__ __forceinline__ cpx cmul(cpx a, cpx w) { return (cpx){a.x, a.x} * w + (cpx){a.y, a.y} * (cpx){-w.y, w.x}; }
template <int S0, int R, bool INV, bool ZHI = false, bool OLO = false>
__device__ __forceinline__ void fft_pass(LAS cpx* X, int tid) {
    constexpr int LOW = 14 - S0 - R, NR = 1 << R, NTASK = (1 << (14 - R)) / 512;
    asm volatile("" : "+v"(tid));
#pragma unroll 1
    for (int task = 0; task < NTASK; ++task) {
        const int g = tid + 512 * task;
        const int blo = g & ((1 << LOW) - 1), bhi = g >> LOW;
        const int base = (bhi << (LOW + R)) | blo;
        cpx v[NR];
#pragma unroll
        for (int j = 0; j < NR; ++j) { if (ZHI && j >= NR / 2) v[j] = (cpx){0.f, 0.f}; else v[j] = X[fphys(base | (j << LOW))]; }
        cpx w0 = (cpx){1.f, 0.f};
        if (LOW > 0) { float s, c; sincospif(-(float)blo * (1.0f / (float)(1 << (13 - S0))), &s, &c); w0 = (cpx){c, INV ? -s : s}; }
        if (INV && LOW > 0) {
            cpx cw = w0;
#pragma unroll
            for (int m = 1; m < NR; ++m) { const int j = brev_c(m, R); v[j] = cmul(v[j], cw); if (m + 1 < NR) cw = cmul(cw, w0); }
        }
        if (!INV) {
#pragma unroll
            for (int q = 0; q < R; ++q) { const int hj = 1 << (R - 1 - q);
#pragma unroll
                for (int j = 0; j < NR; ++j) { if (j & hj) continue; const int k32 = (j & (hj - 1)) << (5 - R + q);
                    cpx d;
                    if (ZHI && q == 0) d = v[j];
                    else { const cpx a = v[j], bb = v[j + hj]; v[j] = a + bb; d = a - bb; }
                    if (k32 == 0) v[j + hj] = d;
                    else if (k32 == 8) v[j + hj] = (cpx){d.y, -d.x};
                    else v[j + hj] = cmul(d, (cpx){TWC[k32], -TWS[k32]}); } }
        } else {
#pragma unroll
            for (int q = R - 1; q >= 0; --q) { const int hj = 1 << (R - 1 - q);
#pragma unroll
                for (int j = 0; j < NR; ++j) { if (j & hj) continue; const int k32 = (j & (hj - 1)) << (5 - R + q);
                    const cpx p = v[j], bb = v[j + hj]; cpx t;
                    if (k32 == 0) t = bb;
                    else if (k32 == 8) t = (cpx){-bb.y, bb.x};
                    else t = cmul(bb, (cpx){TWC[k32], TWS[k32]});
                    v[j] = p + t; if (!(OLO && q == 0)) v[j + hj] = p - t; } }
        }
        if (!INV && LOW > 0) {
            cpx cw = w0;
#pragma unroll
            for (int m = 1; m < NR; ++m) { const int j = brev_c(m, R); v[j] = cmul(v[j], cw); if (m + 1 < NR) cw = cmul(cw, w0); }
        }
#pragma unroll
        for (int j = 0; j < NR; ++j) { if (OLO && j >= NR / 2) continue; X[fphys(base | (j << LOW))] = v[j]; }
    }
}
#define XP_HOOK() xp_step(xp, F.p->in, F.ws, tid)
template <bool ZHI> __device__ __forceinline__ void fft_fwd(Frame& F, XpState& xp, LAS cpx* X, int tid) {
    fft_pass<0, 5, false, ZHI>(X, tid); __syncthreads(); XP_HOOK(); fft_pass<5, 5, false>(X, tid); __syncthreads(); XP_HOOK(); fft_pass<10, 4, false>(X, tid); __syncthreads(); XP_HOOK();
}
__device__ __forceinline__ void fft_inv(Frame& F, XpState& xp, LAS cpx* X, int tid) {
    fft_pass<10, 4, true>(X, tid); __syncthreads(); XP_HOOK(); fft_pass<5, 5, true>(X, tid); __syncthreads(); XP_HOOK(); fft_pass<0, 5, true, false, true>(X, tid); __syncthreads(); XP_HOOK();
}
struct SC8 { u32x4 c; unsigned l, r; };
__device__ __forceinline__ SC8 sconv8_load(const bf16_t* p, int n) {
    SC8 s; s.c = *(const u32x4*)(p + n); s.l = n > 0 ? (unsigned)p[n - 1] : 0u; s.r = n + 8 < SEQ ? (unsigned)p[n + 8] : 0u; return s;
}
__device__ __forceinline__ void sconv8_eval(const SC8& s, float w0, float w1, float w2, float bias, float (&o)[8]) {
    float v[10]; v[0] = bf2f(s.l); v[1] = bflo(s.c.x); v[2] = bfhi(s.c.x); v[3] = bflo(s.c.y); v[4] = bfhi(s.c.y); v[5] = bflo(s.c.z); v[6] = bfhi(s.c.z); v[7] = bflo(s.c.w); v[8] = bfhi(s.c.w); v[9] = bf2f(s.r);
#pragma unroll
    for (int i = 0; i < 8; ++i) o[i] = w0 * v[i] + w1 * v[i + 1] + w2 * v[i + 2] + bias;
}
__device__ __forceinline__ void hyena_item(Frame& F, int c, XpState& xp) {
    LAS cpx* X = (LAS cpx*)F.lds; LAS float* red = (LAS float*)(F.lds + (size_t)FPAD * 8);
    int tid = F.tid; asm volatile("" : "+v"(tid));
    const bf16_t* hf = WSP(bf16_t, WS_HF);
    __syncthreads();
    float s0 = 0.f, s1 = 0.f;
    {
        f32x4 fa[4], fb[4], ba[4], bb[4];
#pragma unroll
        for (int it = 0; it < 4; ++it) { const int j = 4 * (tid + 512 * it);
            const u32x2 w0 = *(const u32x2*)(hf + (size_t)c * SEQ + j), w1 = *(const u32x2*)(hf + (size_t)(1024 + c) * SEQ + j), w2 = *(const u32x2*)(hf + (size_t)(512 + c) * SEQ + j), w3 = *(const u32x2*)(hf + (size_t)(1536 + c) * SEQ + j);
            fa[it] = (f32x4){bflo(w0.x), bfhi(w0.x), bflo(w0.y), bfhi(w0.y)}; fb[it] = (f32x4){bflo(w1.x), bfhi(w1.x), bflo(w1.y), bfhi(w1.y)};
            ba[it] = (f32x4){bflo(w2.x), bfhi(w2.x), bflo(w2.y), bfhi(w2.y)}; bb[it] = (f32x4){bflo(w3.x), bfhi(w3.x), bflo(w3.y), bfhi(w3.y)}; }
#pragma unroll
        for (int it = 0; it < 4; ++it) { const int j = 4 * (tid + 512 * it);
#pragma unroll
            for (int i = 0; i < 4; ++i) { X[fphys(j + i)] = (cpx){fa[it][i], fb[it][i]}; s0 += fabsf(fa[it][i]); s1 += fabsf(fb[it][i]);
                const int m = j + i; if (m > 0) { X[fphys(FFTN - m)] = (cpx){ba[it][i], bb[it][i]}; s0 += fabsf(ba[it][i]); s1 += fabsf(bb[it][i]); } } }
        if (tid == 0) X[fphys(SEQ)] = (cpx){0.f, 0.f};
    }
    s0 = wave_sum(s0); s1 = wave_sum(s1);
    if (F.lane == 0) { red[F.wave] = s0; red[8 + F.wave] = s1; }
    __syncthreads();
    float S0 = 0.f, S1 = 0.f;
#pragma unroll
    for (int w = 0; w < 8; ++w) { S0 += red[w]; S1 += red[8 + w]; }
    fft_fwd<false>(F, xp, X, tid);
    unsigned* ks = WSP(unsigned, WS_KS) + (size_t)F.bx * 2 * FFTN;
    { const float i0 = 1.0f / S0, i1 = 1.0f / S1, sk0 = F.p->in[I_HSKIP][c], sk1 = F.p->in[I_HSKIP][512 + c];
#pragma unroll 8
        for (int it = 0; it < 32; ++it) { const int p = tid + 512 * it; const int k = (int)(__brev((unsigned)p) >> 18); const int pp = (int)(__brev((unsigned)((FFTN - k) & (FFTN - 1))) >> 18);
            const cpx A = X[fphys(p)], B = X[fphys(pp)];
            const float k1r = 0.5f * (A.x + B.x), k1i = 0.5f * (A.y - B.y), k2r = 0.5f * (A.y + B.y), k2i = -0.5f * (A.x - B.x);
            ks[p] = pkh2(k1r * i0 + sk0, k1i * i0); ks[FFTN + p] = pkh2(k2r * i1 + sk1, k2i * i1); } }
    __syncthreads();
    const bf16_t* ph = WSP(bf16_t, WS_PHYT); const float* cw = F.p->in[I_HCW]; const float* cb = F.p->in[I_HCB];
    { const float w0 = cw[c], w1 = cw[HYP + c], w2 = cw[2 * HYP + c], bs = cb[c];
        SC8 sa[2], sb[2];
#pragma unroll
        for (int it = 0; it < 2; ++it) { const int n = 8 * (tid + 512 * it); sa[it] = sconv8_load(ph + (size_t)c * SEQ, n); sb[it] = sconv8_load(ph + (size_t)(HYP + c) * SEQ, n); }
#pragma unroll
        for (int it = 0; it < 2; ++it) { const int n = 8 * (tid + 512 * it); float a[8], b[8]; sconv8_eval(sa[it], w0, w1, w2, bs, a); sconv8_eval(sb[it], w0, w1, w2, bs, b);
#pragma unroll
            for (int i = 0; i < 8; ++i) X[fphys(n + i)] = (cpx){a[i], b[i]}; } }
    __syncthreads();
    fft_fwd<true>(F, xp, X, tid);
    { unsigned kk[32]; const float invN = 1.0f / (float)FFTN;
#pragma unroll
        for (int it = 0; it < 32; ++it) kk[it] = ks[tid + 512 * it];
#pragma unroll
        for (int it = 0; it < 32; ++it) { const int q = fphys(tid + 512 * it); X[q] = cmul(X[q], (cpx){h2f((unsigned short)(kk[it] & 0xffffu)) * invN, h2f((unsigned short)(kk[it] >> 16)) * invN}); } }
    __syncthreads();
    fft_inv(F, xp, X, tid);
    { const int col = HYW + c; const float w0 = cw[col], w1 = cw[HYP + col], w2 = cw[2 * HYP + col], bs = cb[col];
        SC8 sa[2], sb[2];
#pragma unroll
        for (int it = 0; it < 2; ++it) { const int n = 8 * (tid + 512 * it); sa[it] = sconv8_load(ph + (size_t)col * SEQ, n); sb[it] = sconv8_load(ph + (size_t)(HYP + col) * SEQ, n); }
#pragma unroll
        for (int it = 0; it < 2; ++it) { const int n = 8 * (tid + 512 * it); float a[8], b[8]; sconv8_eval(sa[it], w0, w1, w2, bs, a); sconv8_eval(sb[it], w0, w1, w2, bs, b);
#pragma unroll
            for (int i = 0; i < 8; ++i) { const int q = fphys(n + i); X[q] = X[q] * (cpx){a[i], b[i]}; } } }
    __syncthreads();
    fft_fwd<true>(F, xp, X, tid);
    { unsigned kk[32]; const float invN = 1.0f / (float)FFTN;
#pragma unroll
        for (int it = 0; it < 32; ++it) kk[it] = ks[FFTN + tid + 512 * it];
#pragma unroll
        for (int it = 0; it < 32; ++it) { const int q = fphys(tid + 512 * it); X[q] = cmul(X[q], (cpx){h2f((unsigned short)(kk[it] & 0xffffu)) * invN, h2f((unsigned short)(kk[it] >> 16)) * invN}); } }
    __syncthreads();
    fft_inv(F, xp, X, tid);
    { const int col = 2 * HYW + c; const float w0 = cw[col], w1 = cw[HYP + col], w2 = cw[2 * HYP + col], bs = cb[col];
        bf16_t* yt = WSP(bf16_t, WS_YHYT);
        SC8 sa[2], sb[2]; u32x4 oa[2], ob[2];
#pragma unroll
        for (int it = 0; it < 2; ++it) { const int n = 8 * (tid + 512 * it); sa[it] = sconv8_load(ph + (size_t)col * SEQ, n); sb[it] = sconv8_load(ph + (size_t)(HYP + col) * SEQ, n); }
#pragma unroll
        for (int it = 0; it < 2; ++it) { const int n = 8 * (tid + 512 * it); float a[8], b[8]; sconv8_eval(sa[it], w0, w1, w2, bs, a); sconv8_eval(sb[it], w0, w1, w2, bs, b);
            cpx y[8];
#pragma unroll
            for (int i = 0; i < 8; ++i) y[i] = X[fphys(n + i)];
            oa[it] = (u32x4){pk2(y[0].x * a[0], y[1].x * a[1]), pk2(y[2].x * a[2], y[3].x * a[3]), pk2(y[4].x * a[4], y[5].x * a[5]), pk2(y[6].x * a[6], y[7].x * a[7])};
            ob[it] = (u32x4){pk2(y[0].y * b[0], y[1].y * b[1]), pk2(y[2].y * b[2], y[3].y * b[3]), pk2(y[4].y * b[4], y[5].y * b[5]), pk2(y[6].y * b[6], y[7].y * b[7])}; }
#pragma unroll
        for (int it = 0; it < 2; ++it) { const int n = 8 * (tid + 512 * it);
            *(u32x4*)(yt + (size_t)c * SEQ + n) = oa[it]; *(u32x4*)(yt + (size_t)(HYW + c) * SEQ + n) = ob[it]; } }
}

__device__ __forceinline__ bf16x8 lds_frag(const LAS bf16_t* base, int row, int stride, int k) { return *(const LAS bf16x8*)(base + row * stride + k); }
#define MFMA16(a, b, c) __builtin_amdgcn_mfma_f32_16x16x32_bf16(a, b, c, 0, 0, 0)

__device__ __forceinline__ void hg_delta_item(Frame& F, int item) {
    const int chain = item / NCH_EXT, j = item % NCH_EXT, dir = chain & 1, h = (chain >> 1) & 3, b = chain >> 3;
    const int cj = dir == 0 ? j : (j < 4 ? 3 - j : 135 - j), n0 = cj * 64;
    LAS float* segtot = (LAS float*)F.lds;
    LAS bf16_t* Kt = (LAS bf16_t*)(F.lds + 2048);
    LAS bf16_t* VTs = (LAS bf16_t*)(F.lds + 2048 + 18432);
    const int tid = F.tid, d = tid & 127, seg = tid >> 7, lane = F.lane;
    const bf16_t* lfp = (dir ? WSP(bf16_t, WS_LB) : WSP(bf16_t, WS_LF)) + ((size_t)(b * NEXT + n0) * HGW + h * 128 + d);
    float lf[16], tot = 0.f;
#pragma unroll
    for (int i = 0; i < 16; ++i) { lf[i] = h2f(lfp[(size_t)(16 * seg + i) * HGW]); tot += lf[i]; }
    __syncthreads();
    segtot[seg * 128 + d] = tot;
    { const bf16_t* vt = WSP(bf16_t, WS_VT) + ((size_t)(b * HGW + h * 128) * NEXT + n0);
        u32x4 tv[2];
#pragma unroll
        for (int q = 0; q < 2; ++q) { const int piece = tid + 512 * q, e = piece >> 3, part = piece & 7; tv[q] = *(const u32x4*)(vt + (size_t)e * NEXT + part * 8); }
#pragma unroll
        for (int q = 0; q < 2; ++q) { const int piece = tid + 512 * q, e = piece >> 3, part = piece & 7; *(LAS u32x4*)(VTs + e * 72 + part * 8) = tv[q]; } }
    __syncthreads();
    float later = 0.f, total = 0.f;
#pragma unroll
    for (int s = 0; s < 4; ++s) { const float v = segtot[s * 128 + d]; total += v; if (dir == 0 ? (s > seg) : (s < seg)) later += v; }
    float E[16];
    if (dir == 0) { float run = later;
#pragma unroll
        for (int i = 15; i >= 0; --i) { E[i] = run; run += lf[i]; } }
    else { float run = later;
#pragma unroll
        for (int i = 0; i < 16; ++i) { E[i] = run; run += lf[i]; } }
    unsigned pk[8];
#pragma unroll
    for (int i = 0; i < 8; ++i) pk[i] = pk2((1.0f - __expf(lf[2 * i])) * __expf(E[2 * i]), (1.0f - __expf(lf[2 * i + 1])) * __expf(E[2 * i + 1]));
    *(LAS u32x4*)(Kt + d * 72 + 16 * seg) = (u32x4){pk[0], pk[1], pk[2], pk[3]};
    *(LAS u32x4*)(Kt + d * 72 + 16 * seg + 8) = (u32x4){pk[4], pk[5], pk[6], pk[7]};
    if (seg == 0) WSP(float, WS_DECAY)[(size_t)item * 128 + d] = __expf(total);
    __syncthreads();
    const int w = F.wave, lr = lane & 15, lq = lane >> 4;
    f32x4 acc[8];
#pragma unroll
    for (int et = 0; et < 8; ++et) acc[et] = (f32x4){0.f, 0.f, 0.f, 0.f};
#pragma unroll
    for (int ksi = 0; ksi < 2; ++ksi) { const bf16x8 a = lds_frag(Kt, 16 * w + lr, 72, 32 * ksi + 8 * lq);
#pragma unroll
        for (int et = 0; et < 8; ++et) acc[et] = MFMA16(a, lds_frag(VTs, 16 * et + lr, 72, 32 * ksi + 8 * lq), acc[et]); }
    bf16_t* dl = WSP(bf16_t, WS_DELTA) + (size_t)item * 16384;
#pragma unroll
    for (int et = 0; et < 8; ++et) { const int e = 16 * et + lr, d0 = 16 * w + 4 * lq;
        u32x2 o; o.x = pk2(acc[et][0], acc[et][1]); o.y = pk2(acc[et][2], acc[et][3]); *(u32x2*)(dl + e * 128 + d0) = o; }
}

__device__ __forceinline__ void hg_scan(Frame& F) {
    for (int gid = F.bx * 512 + F.tid; gid < NCHAIN * 8192; gid += F.G * 512) {
        const int chain = gid >> 13, idx = gid & 8191, dd = (2 * idx) & 127;
        const unsigned* dl = WSP(unsigned, WS_DELTA) + (size_t)chain * NCH_EXT * 8192 + idx;
        const float* dc = WSP(float, WS_DECAY) + (size_t)chain * NCH_EXT * 128 + dd;
        unsigned* ss = WSP(unsigned, WS_SST) + (size_t)chain * NCH_LAT * 8192 + idx;
        float s0 = 0.f, s1 = 0.f;
        unsigned dv[12], dw[12]; f32x2 cv[12], cw[12];
#pragma unroll
        for (int u = 0; u < 12; ++u) { dv[u] = dl[(size_t)u * 8192]; cv[u] = *(const f32x2*)(dc + (size_t)u * 128); }
#pragma unroll 1
        for (int j0 = 0; j0 < NCH_EXT; j0 += 12) {
            const bool more = j0 + 12 < NCH_EXT;
            if (more) {
#pragma unroll
                for (int u = 0; u < 12; ++u) { dw[u] = dl[(size_t)(j0 + 12 + u) * 8192]; cw[u] = *(const f32x2*)(dc + (size_t)(j0 + 12 + u) * 128); } }
#pragma unroll
            for (int u = 0; u < 12; ++u) { const int j = j0 + u;
                if (j >= 4) ss[(size_t)(j - 4) * 8192] = pk2(s0, s1);
                s0 = cv[u].x * s0 + bflo(dv[u]); s1 = cv[u].y * s1 + bfhi(dv[u]); }
#pragma unroll
            for (int u = 0; u < 12; ++u) { dv[u] = dw[u]; cv[u] = cw[u]; }
        }
    }
}

__device__ __forceinline__ void yhy_transpose_item(Frame& F, int item) {
    const int b = item >> 7, nb = item & 127, tid = F.tid;
    LAS bf16_t* ts = (LAS bf16_t*)F.lds;
    const bf16_t* src = WSP(bf16_t, WS_YHYT) + (size_t)b * HYW * SEQ + nb * 64;
    __syncthreads();
    { u32x4 tv[8];
#pragma unroll
    for (int q = 0; q < 8; ++q) { const int piece = tid + 512 * q, c = piece >> 3, part = piece & 7; tv[q] = *(const u32x4*)(src + (size_t)c * SEQ + part * 8); }
#pragma unroll
    for (int q = 0; q < 8; ++q) { const int piece = tid + 512 * q, c = piece >> 3, part = piece & 7; *(LAS u32x4*)(ts + c * 72 + part * 8) = tv[q]; } }
    __syncthreads();
    bf16_t* dst = WSP(bf16_t, WS_YHY) + (size_t)(b * SEQ + nb * 64) * HYW;
#pragma unroll
    for (int q = 0; q < 8; ++q) { const int task = tid + 512 * q, n = task & 63, cg = task >> 6;
        unsigned v[8];
#pragma unroll
        for (int i = 0; i < 8; ++i) v[i] = ts[(8 * cg + i) * 72 + n];
        *(u32x4*)(dst + (size_t)n * HYW + 8 * cg) = (u32x4){v[0] | (v[1] << 16), v[2] | (v[3] << 16), v[4] | (v[5] << 16), v[6] | (v[7] << 16)}; }
}

__device__ __forceinline__ void hg_out_item(Frame& F, int item) {
    const int b = item >> 9, h = (item >> 7) & 3, nc = item & 127;
    LAS float* segtot = (LAS float*)F.lds;
    LAS float* bref = (LAS float*)(F.lds + 2048);
    LAS float* red = (LAS float*)(F.lds + 2560);
    LAS bf16_t* Qd = (LAS bf16_t*)(F.lds + 3072);
    LAS bf16_t* Kd = (LAS bf16_t*)(F.lds + 20480);
    LAS bf16_t* Qb = (LAS bf16_t*)(F.lds + 37888);
    LAS bf16_t* VTs = (LAS bf16_t*)(F.lds + 55296);
    LAS bf16_t* Ss = (LAS bf16_t*)(F.lds + 73728);
    LAS bf16_t* att = (LAS bf16_t*)(F.lds + 108544);
    const int tid = F.tid, d = tid & 127, seg = tid >> 7, lane = F.lane, w = F.wave, lr = lane & 15, lq = lane >> 4;
    const int nx0 = CTXL + nc * 64, r0 = b * SEQ + nc * 64;
    __syncthreads();
    { const bf16_t* vt = WSP(bf16_t, WS_VT) + ((size_t)(b * HGW + h * 128) * NEXT + nx0);
        u32x4 tv[2];
#pragma unroll
        for (int q = 0; q < 2; ++q) { const int piece = tid + 512 * q, e = piece >> 3, part = piece & 7; tv[q] = *(const u32x4*)(vt + (size_t)e * NEXT + part * 8); }
#pragma unroll
        for (int q = 0; q < 2; ++q) { const int piece = tid + 512 * q, e = piece >> 3, part = piece & 7; *(LAS u32x4*)(VTs + e * 72 + part * 8) = tv[q]; } }
    f32x4 acc[4];
#pragma unroll
    for (int i = 0; i < 4; ++i) acc[i] = (f32x4){0.f, 0.f, 0.f, 0.f};
    const bf16_t* qp = WSP(bf16_t, WS_Q) + ((size_t)r0 * HGW + h * 128 + d);
#pragma unroll 1
    for (int dir = 0; dir < 2; ++dir) {
        const int chain = (b * 4 + h) * 2 + dir, jlat = dir == 0 ? nc : 127 - nc;
        __syncthreads();
        { const bf16_t* sp = WSP(bf16_t, WS_SST) + (size_t)(chain * NCH_LAT + jlat) * 16384;
            u32x4 sv[4];
#pragma unroll
            for (int q = 0; q < 4; ++q) { const int piece = tid + 512 * q, e = piece >> 4, part = piece & 15; sv[q] = *(const u32x4*)(sp + e * 128 + part * 8); }
#pragma unroll
            for (int q = 0; q < 4; ++q) { const int piece = tid + 512 * q, e = piece >> 4, part = piece & 15; *(LAS u32x4*)(Ss + e * 136 + part * 8) = sv[q]; } }
        const bf16_t* lfp = (dir ? WSP(bf16_t, WS_LB) : WSP(bf16_t, WS_LF)) + ((size_t)(b * NEXT + nx0) * HGW + h * 128 + d);
        float lf[16], qv[16], tot = 0.f;
#pragma unroll
        for (int i = 0; i < 16; ++i) { lf[i] = h2f(lfp[(size_t)(16 * seg + i) * HGW]); qv[i] = bf2f(qp[(size_t)(16 * seg + i) * HGW]); tot += lf[i]; }
        segtot[seg * 128 + d] = tot;
        __syncthreads();
        float off = 0.f;
#pragma unroll
        for (int s = 0; s < 4; ++s) { const float v = segtot[s * 128 + d]; if (dir == 0 ? (s < seg) : (s > seg)) off += v; }
        float bb[16];
        if (dir == 0) { float run = off;
#pragma unroll
            for (int i = 0; i < 16; ++i) { run += lf[i]; bb[i] = run; } if (seg == 1) bref[d] = bb[15]; }
        else { float run = off;
#pragma unroll
            for (int i = 15; i >= 0; --i) { run += lf[i]; bb[i] = run; } if (seg == 2) bref[d] = bb[0]; }
        __syncthreads();
        const float br = bref[d];
#pragma unroll
        for (int i = 0; i < 16; ++i) { const int t = 16 * seg + i; const float kk = 1.0f - __expf(lf[i]);
            Qd[t * 136 + d] = (bf16_t)f2bf(qv[i] * __expf(bb[i] - br)); Kd[t * 136 + d] = (bf16_t)f2bf(kk * __expf(br - bb[i])); Qb[t * 136 + d] = (bf16_t)f2bf(qv[i] * __expf(bb[i])); }
        __syncthreads();
        {
            const int st = w & 3; f32x4 a2[2] = {(f32x4){0.f, 0.f, 0.f, 0.f}, (f32x4){0.f, 0.f, 0.f, 0.f}};
#pragma unroll
            for (int ksi = 0; ksi < 4; ++ksi) { const bf16x8 a = lds_frag(Kd, 16 * st + lr, 136, 32 * ksi + 8 * lq);
#pragma unroll
                for (int q = 0; q < 2; ++q) a2[q] = MFMA16(a, lds_frag(Qd, 16 * (2 * (w >> 2) + q) + lr, 136, 32 * ksi + 8 * lq), a2[q]); }
#pragma unroll
            for (int q = 0; q < 2; ++q) { const int t = 16 * (2 * (w >> 2) + q) + lr, s0 = 16 * st + 4 * lq; float v[4];
#pragma unroll
                for (int r = 0; r < 4; ++r) { const int s = s0 + r; v[r] = (dir == 0 ? (s <= t) : (s >= t)) ? a2[q][r] : 0.f; }
                u32x2 o; o.x = pk2(v[0], v[1]); o.y = pk2(v[2], v[3]); *(LAS u32x2*)(att + t * 72 + s0) = o; }
        }
        __syncthreads();
        { const int tt = w & 3;
#pragma unroll
            for (int ksi = 0; ksi < 2; ++ksi) { const bf16x8 a = lds_frag(att, 16 * tt + lr, 72, 32 * ksi + 8 * lq);
#pragma unroll
                for (int i = 0; i < 4; ++i) acc[i] = MFMA16(a, lds_frag(VTs, 16 * (4 * (w >> 2) + i) + lr, 72, 32 * ksi + 8 * lq), acc[i]); }
#pragma unroll
            for (int ksi = 0; ksi < 4; ++ksi) { const bf16x8 a = lds_frag(Qb, 16 * tt + lr, 136, 32 * ksi + 8 * lq);
#pragma unroll
                for (int i = 0; i < 4; ++i) acc[i] = MFMA16(a, lds_frag(Ss, 16 * (4 * (w >> 2) + i) + lr, 136, 32 * ksi + 8 * lq), acc[i]); }
        }
    }
    const int tt = w & 3, eh = w >> 2;
    float ssq[4];
#pragma unroll
    for (int r = 0; r < 4; ++r) { float s = 0.f;
#pragma unroll
        for (int i = 0; i < 4; ++i) s += acc[i][r] * acc[i][r];
        s += __shfl_xor(s, 1); s += __shfl_xor(s, 2); s += __shfl_xor(s, 4); s += __shfl_xor(s, 8); ssq[r] = s; }
    if (lr == 0) {
#pragma unroll
        for (int r = 0; r < 4; ++r) red[eh * 64 + 16 * tt + 4 * lq + r] = ssq[r]; }
    __syncthreads();
    const float* ng = F.p->in[I_HGNG]; const bf16_t* gp = WSP(bf16_t, WS_G); bf16_t* yo = WSP(bf16_t, WS_YHG);
    float ngv[4], gv[4][4];
#pragma unroll
    for (int i = 0; i < 4; ++i) ngv[i] = ng[16 * (4 * eh + i) + lr];
#pragma unroll
    for (int r = 0; r < 4; ++r)
#pragma unroll
        for (int i = 0; i < 4; ++i) gv[r][i] = bf2f(gp[(size_t)(r0 + 16 * tt + 4 * lq + r) * HGW + h * 128 + 16 * (4 * eh + i) + lr]);
#pragma unroll
    for (int r = 0; r < 4; ++r) { const int t = 16 * tt + 4 * lq + r; const float rs = rsqrtf((red[t] + red[64 + t]) * (1.0f / 128.0f) + EPS);
#pragma unroll
        for (int i = 0; i < 4; ++i) { const int e = 16 * (4 * eh + i) + lr; const size_t o = (size_t)(r0 + t) * HGW + h * 128 + e;
            yo[o] = (bf16_t)f2bf(acc[i][r] * rs * ngv[i] * gv[r][i]); } }
}
__device__ __forceinline__ void phase_route(Frame& F) {
    const float* lg = WSP(float, WS_LOGIT); const float* rb = F.p->in[I_RB];
    unsigned* cnt = WSP(unsigned, WS_CTL) + CW_CNT;
    int* re_ = WSP(int, WS_ROUTE_E); float* rw_ = WSP(float, WS_ROUTE_W); int* rp_ = WSP(int, WS_ROUTE_P);
    const int gw = F.bx * 8 + F.wave, NGW = F.G * 8, lane = F.lane;
    const f32x4 bias = *(const f32x4*)(rb + 4 * lane);
    const float NINF = -__builtin_inff();
    const bool al = (F.G == 256); const int tbase = al ? (((F.bx & 7) * 32 + (F.bx >> 3)) * 8 + F.wave) * 8 : gw, tstr = al ? 1 : NGW;
    f32x4 lpre[8];
#pragma unroll
    for (int i = 0; i < 8; ++i) { const int t = tbase + i * tstr; lpre[i] = t < T ? *(const f32x4*)(lg + (size_t)t * NE + 4 * lane) : (f32x4){0.f, 0.f, 0.f, 0.f}; }
    int ti = 0;
    for (int t = tbase; al ? ti < 8 : t < T; t += tstr, ++ti) {
        f32x4 l4 = lpre[0];
#pragma unroll
        for (int i = 1; i < 8; ++i) if (ti == i) l4 = lpre[i];
        if (ti >= 8) l4 = *(const f32x4*)(lg + (size_t)t * NE + 4 * lane);
        float sc[4], bs[4];
#pragma unroll
        for (int i = 0; i < 4; ++i) { sc[i] = sigmoidf_(l4[i]); bs[i] = sc[i] + bias[i]; }
        float m1 = fmaxf(bs[0], bs[1]), m2 = fminf(bs[0], bs[1]);
#pragma unroll
        for (int i = 2; i < 4; ++i) { const float v = bs[i]; m2 = fmaxf(m2, fminf(m1, v)); m1 = fmaxf(m1, v); }
#pragma unroll
        for (int o = 1; o < 8; o <<= 1) { const float o1 = __shfl_xor(m1, o), o2 = __shfl_xor(m2, o); const float n1 = fmaxf(m1, o1), n2 = fmaxf(fminf(m1, o1), fmaxf(m2, o2)); m1 = n1; m2 = n2; }
        const float gs = m1 + m2; const int mg = lane >> 3; int rank = 0;
#pragma unroll
        for (int g = 0; g < 8; ++g) { const float v = __shfl(gs, g * 8); rank += (v > gs || (v == gs && g < mg)) ? 1 : 0; }
        const bool sel = rank < 4;
        float cd[4];
#pragma unroll
        for (int i = 0; i < 4; ++i) cd[i] = sel ? bs[i] : NINF;
        int ek[8]; float sk[8]; float ssum = 0.f;
#pragma unroll
        for (int k = 0; k < 8; ++k) {
            float bv = cd[0]; int bi = 4 * lane;
#pragma unroll
            for (int i = 1; i < 4; ++i) if (cd[i] > bv) { bv = cd[i]; bi = 4 * lane + i; }
#pragma unroll
            for (int o = 32; o >= 1; o >>= 1) { const float ov = __shfl_xor(bv, o); const int oi = __shfl_xor(bi, o); if (ov > bv || (ov == bv && oi < bi)) { bv = ov; bi = oi; } }
            const int sub = bi & 3; const float mysc = sub == 0 ? sc[0] : (sub == 1 ? sc[1] : (sub == 2 ? sc[2] : sc[3]));
            const float s = __shfl(mysc, bi >> 2);
            if ((bi >> 2) == lane) {
#pragma unroll
                for (int i = 0; i < 4; ++i) if (i == sub) cd[i] = NINF; }
            ek[k] = bi; sk[k] = s; ssum += s;
        }
        const float scale = 2.5f / ssum;
        int me = ek[0]; float mw = sk[0];
#pragma unroll
        for (int k = 1; k < 8; ++k) if (lane == k) { me = ek[k]; mw = sk[k]; }
        if (lane < 8) { const int pos = (int)atomicAdd(cnt + me, 1u); re_[t * 8 + lane] = me; rw_[t * 8 + lane] = mw * scale; rp_[t * 8 + lane] = pos; }
    }
}
__device__ __forceinline__ void phase_scatter(Frame& F) {
    LAS int* st = (LAS int*)F.lds; LAS int* cn = st + 512;
    const unsigned* cnt = WSP(unsigned, WS_CTL) + CW_CNT;
    __syncthreads();
    if (F.tid < NE) cn[F.tid] = (int)cnt[F.tid];
    __syncthreads();
    if (F.tid <= NE) { int s = 0, tl = 0; for (int e = 0; e < F.tid; ++e) { s += cn[e]; tl += (cn[e] + 255) >> 8; } st[F.tid] = s;
        if (F.bx == 0) { unsigned* ctl = WSP(unsigned, WS_CTL); ctl[CW_START + F.tid] = (unsigned)s; ctl[CW_TOFF + F.tid] = (unsigned)tl;
            if (F.tid < NE) { const int c_ = cn[F.tid]; for (int j = 0; j * 256 < c_; ++j) { unsigned* up = ctl + CW_UNITS + 4 * (tl + j); up[0] = (unsigned)(s + 256 * j); up[1] = (unsigned)F.tid; up[2] = (unsigned)(c_ - 256 * j < 256 ? c_ - 256 * j : 256); up[3] = 0u; } } } }
    __syncthreads();
    const int* re_ = WSP(int, WS_ROUTE_E); const float* rw_ = WSP(float, WS_ROUTE_W); const int* rp_ = WSP(int, WS_ROUTE_P);
    int* stok = WSP(int, WS_SLOT_TOK); float* sw = WSP(float, WS_SLOT_W); int* sof = WSP(int, WS_SLOTOF);
    for (int a = F.bx * 512 + F.tid; a < NASG; a += F.G * 512) { const int slot = st[re_[a]] + rp_[a]; stok[slot] = a >> 3; sw[slot] = rw_[a]; sof[a] = slot; }
    if (F.bx == 0 && F.tid < 256) { stok[NASG + F.tid] = 0; sw[NASG + F.tid] = 0.f; }
}
__device__ __forceinline__ void phase_final(Frame& F) {
    float* out = F.p->out; const float* x1 = F.p->out;     const float* fg = F.p->in[I_FG]; const float* ada = WSP(float, WS_ADA);
    const unsigned char* yb8 = WSP(unsigned char, WS_YBUF); const bf16_t* ysh = WSP(bf16_t, WS_YSH); const int* sof = WSP(int, WS_SLOTOF);
    const int lane = F.lane, NGW = F.G * 8;
    const bool al = (F.G == 256); const int tbase = al ? (((F.bx & 7) * 32 + (F.bx >> 3)) * 8 + F.wave) * 8 : F.bx * 8 + F.wave, tstr = al ? 1 : NGW;
    f32x4 fgv[2][2];
#pragma unroll
    for (int j = 0; j < 2; ++j) { fgv[j][0] = *(const f32x4*)(fg + 512 * j + 8 * lane); fgv[j][1] = *(const f32x4*)(fg + 512 * j + 8 * lane + 4); }
    int it_ = 0;
    for (int t = tbase; al ? it_ < 8 : t < T; t += tstr, ++it_) { const int b = t >> 13;
        int sl[8];
#pragma unroll
        for (int k = 0; k < 8; ++k) sl[k] = sof[t * 8 + k];
        u32x4 ys[2]; u32x2 y[8][2]; f32x4 xv[2][2], g2[2][2];
#pragma unroll
        for (int j = 0; j < 2; ++j) { const int c = 512 * j + 8 * lane;
            ys[j] = *(const u32x4*)(ysh + (size_t)t * D + c); xv[j][0] = *(const f32x4*)(x1 + (size_t)t * D + c); xv[j][1] = *(const f32x4*)(x1 + (size_t)t * D + c + 4);
            g2[j][0] = *(const f32x4*)(ada + b * 6144 + 5 * D + c); g2[j][1] = *(const f32x4*)(ada + b * 6144 + 5 * D + c + 4);
#pragma unroll
            for (int k = 0; k < 8; ++k) y[k][j] = *(const u32x2*)(yb8 + (size_t)sl[k] * D + c); }
        f32x4 v[2][2]; float ss = 0.f;
#pragma unroll
        for (int j = 0; j < 2; ++j) { f32x4 m0 = (f32x4){bflo(ys[j].x), bfhi(ys[j].x), bflo(ys[j].y), bfhi(ys[j].y)}, m1 = (f32x4){bflo(ys[j].z), bfhi(ys[j].z), bflo(ys[j].w), bfhi(ys[j].w)};
#pragma unroll
            for (int k = 0; k < 8; ++k) { const f32x2 a0 = __builtin_amdgcn_cvt_pk_f32_fp8((int)y[k][j].x, false), a1 = __builtin_amdgcn_cvt_pk_f32_fp8((int)y[k][j].x, true), b0 = __builtin_amdgcn_cvt_pk_f32_fp8((int)y[k][j].y, false), b1 = __builtin_amdgcn_cvt_pk_f32_fp8((int)y[k][j].y, true);
                m0 += (f32x4){a0.x, a0.y, a1.x, a1.y}; m1 += (f32x4){b0.x, b0.y, b1.x, b1.y}; }
            v[j][0] = xv[j][0] + g2[j][0] * m0; v[j][1] = xv[j][1] + g2[j][1] * m1;
#pragma unroll
            for (int h = 0; h < 2; ++h) ss += (v[j][h][0] * v[j][h][0] + v[j][h][1] * v[j][h][1]) + (v[j][h][2] * v[j][h][2] + v[j][h][3] * v[j][h][3]); }
        const float rs = rsqrtf(wave_sum(ss) * (1.0f / D) + EPS);
#pragma unroll
        for (int j = 0; j < 2; ++j) { const int c = 512 * j + 8 * lane; *(f32x4*)(out + (size_t)t * D + c) = v[j][0] * rs * fgv[j][0]; *(f32x4*)(out + (size_t)t * D + c + 4) = v[j][1] * rs * fgv[j][1]; }
    }
}

constexpr int NPHASE = 15;
#ifndef REP_MASK
#define REP_MASK 0u
#endif
#define NREP(k) ((((REP_MASK) >> (k)) & 1u) ? 2 : 1)
#ifndef MK_LAUNCH_PER_PHASE
#define MK_LAUNCH_PER_PHASE 0
#endif
__global__ void __launch_bounds__(512) hyena_hgrn2_moe_fwd(Params p) {
    extern __shared__ __attribute__((aligned(16))) unsigned char lds_[];
    cg::grid_group grid = cg::this_grid();
    Frame F; F.lds = (LAS unsigned char*)lds_; F.p = &p; F.ws = p.ws; F.tid = threadIdx.x; F.lane = F.tid & 63; F.wave = __builtin_amdgcn_readfirstlane(F.tid >> 6); F.G = gridDim.x; F.bx = blockIdx.x;
    if (F.tid < 16) ((LAS unsigned*)(F.lds + LDS_BARST))[F.tid] = 0u;
    __syncthreads();
    XcdBarrier bar = xcd_barrier_post((unsigned*)(p.ws + WS_CTL) + CW_BAR, (volatile LAS unsigned*)(F.lds + LDS_BARST));
#ifdef ONLY_PHASE
#define IN(k) ((k) == ONLY_PHASE && p.ph_lo <= (k) && (k) < p.ph_hi)
#else
#define IN(k) (p.ph_lo <= (k) && (k) < p.ph_hi)
#endif
#define SEAM(k) do { if (IN(k) && IN((k) + 1)) xcd_barrier(bar); } while (0)
    if (p.ph_lo < 0) grid.sync();
    if (IN(0)) _Pragma("unroll 1") for (int rp = 0; rp < NREP(0); ++rp) { asm volatile("" : "+v"(F.tid)); if (rp) xcd_barrier(bar); phase0(F); }
    SEAM(0);
    if (IN(1)) _Pragma("unroll 1") for (int rp = 0; rp < NREP(1); ++rp) { asm volatile("" : "+v"(F.tid)); if (rp) xcd_barrier(bar); phase1(F); }
    SEAM(1);
    if (IN(2)) _Pragma("unroll 1") for (int rp = 0; rp < NREP(2); ++rp) { asm volatile("" : "+v"(F.tid)); if (rp) xcd_barrier(bar);
        __syncthreads();
        { pg8::Gemm g{WSP(bf16_t, WS_WINT), WSP(bf16_t, WS_WINT), D, nullptr, 2 * D, 128}; InOrder S{F.G, F.bx};
          EpiIn E{EpiInT{WSP(bf16_t, WS_PHYT), WSP(bf16_t, WS_VT)}, EpiInN{WSP(bf16_t, WS_Q), WSP(bf16_t, WS_G), WSP(bf16_t, WS_SG1), WSP(bf16_t, WS_SG2), WSP(bf16_t, WS_LF), WSP(bf16_t, WS_LB), WSP(float, WS_LBS)}};
          pg8::gemm_phase<EpiIn, InOrder, false>(F.lds, g, S, E); }
    }
    SEAM(2);
    if (IN(3)) _Pragma("unroll 1") for (int rp = 0; rp < NREP(3); ++rp) { asm volatile("" : "+v"(F.tid)); if (rp) xcd_barrier(bar);
        _Pragma("unroll 1") for (int r2 = 0; r2 < NREP(16); ++r2) { asm volatile("" : "+v"(F.tid));
            XpState xp; xp.it = F.bx; xp.stride = F.G; xp.end = (XP_BG * F.G < NE * 48) ? XP_BG * F.G : NE * 48; xp.live = false;
            for (int c = F.bx; c < HYW; c += F.G) hyena_item(F, c, xp);
            { int tid = F.tid; xp_finish(xp, p.in, F.ws, tid); while (xp.it < xp.end) { xp_issue(xp, p.in, F.ws, tid); xp_finish(xp, p.in, F.ws, tid); } } }
        _Pragma("unroll 1") for (int r2 = 0; r2 < NREP(17); ++r2) { asm volatile("" : "+v"(F.tid)); for (int it = F.bx; it < NAITEM; it += F.G) hg_delta_item(F, it); }
    }
    SEAM(3);
    if (IN(4)) _Pragma("unroll 1") for (int rp = 0; rp < NREP(4); ++rp) { asm volatile("" : "+v"(F.tid)); if (rp) xcd_barrier(bar);
        _Pragma("unroll 1") for (int r2 = 0; r2 < NREP(18); ++r2) { asm volatile("" : "+v"(F.tid)); hg_scan(F); }
        _Pragma("unroll 1") for (int r2 = 0; r2 < NREP(19); ++r2) { asm volatile("" : "+v"(F.tid)); for (int it = F.bx; it < NB * 128; it += F.G) yhy_transpose_item(F, it); }
    }
    SEAM(4);
    if (IN(5)) _Pragma("unroll 1") for (int rp = 0; rp < NREP(5); ++rp) { asm volatile("" : "+v"(F.tid)); if (rp) xcd_barrier(bar); for (int it = F.bx; it < NB * 4 * NCH_LAT; it += F.G) hg_out_item(F, it); }
    SEAM(5);
    if (IN(6)) _Pragma("unroll 1") for (int rp = 0; rp < NREP(6); ++rp) { asm volatile("" : "+v"(F.tid)); if (rp) xcd_barrier(bar);
        __syncthreads();
        { pg8::Gemm g{WSP(bf16_t, WS_YHY), WSP(bf16_t, WS_WHYT), HYW, nullptr, 2 * HYW, 128}; pg8::StaticOrder S; S.init(T, D, HYW, F.G, F.bx); EpiMerge1 E{WSP(bf16_t, WS_SG1), WSP(float, WS_T1)};
          pg8::gemm_phase<EpiMerge1, pg8::StaticOrder, false>(F.lds, g, S, E); }
        { pg8::Gemm g{WSP(bf16_t, WS_YHG), WSP(bf16_t, WS_WHGT), HGW, nullptr, 2 * HGW, 128}; pg8::StaticOrder S; S.init(T, D, HGW, F.G, F.bx); EpiMerge2 E{WSP(bf16_t, WS_SG2), WSP(float, WS_T1), WSP(bf16_t, WS_MB)};
          pg8::gemm_phase<EpiMerge2, pg8::StaticOrder, false>(F.lds, g, S, E); }
    }
    SEAM(6);
    if (IN(7)) _Pragma("unroll 1") for (int rp = 0; rp < NREP(7); ++rp) { asm volatile("" : "+v"(F.tid)); if (rp) xcd_barrier(bar);
        __syncthreads();
        pg8::Gemm g{WSP(bf16_t, WS_MB), WSP(bf16_t, WS_WOUTT), D, nullptr, 2 * D, 128}; pg8::StaticOrder S; S.init(T, D, D, F.G, F.bx);
        EpiWout E{p.in[I_X], WSP(float, WS_POSR), WSP(float, WS_POSC), WSP(float, WS_ADA), p.out};
        pg8::gemm_phase<EpiWout, pg8::StaticOrder, false>(F.lds, g, S, E);
    }
    SEAM(7);
    if (IN(8)) _Pragma("unroll 1") for (int rp = 0; rp < NREP(8); ++rp) { asm volatile("" : "+v"(F.tid)); if (rp) xcd_barrier(bar); phase_h2(F); }
    SEAM(8);
    if (IN(9)) _Pragma("unroll 1") for (int rp = 0; rp < NREP(9); ++rp) { asm volatile("" : "+v"(F.tid)); if (rp) xcd_barrier(bar);
        __syncthreads();
        { pg8::Gemm g{WSP(bf16_t, WS_H2), WSP(bf16_t, WS_ROUT), D, nullptr, 2 * D, 128}; P9Order S{F.G, F.bx}; EpiP9 E{EpiLogit{WSP(float, WS_LOGIT)}, EpiGU{WSP(bf16_t, WS_HSH)}};
          pg8::gemm_phase<EpiP9, P9Order, false>(F.lds, g, S, E); }
    }
    SEAM(9);
    if (IN(10)) _Pragma("unroll 1") for (int rp = 0; rp < NREP(10); ++rp) { asm volatile("" : "+v"(F.tid)); if (rp) xcd_barrier(bar); phase_route(F); }
    SEAM(10);
    if (IN(11)) _Pragma("unroll 1") for (int rp = 0; rp < NREP(11); ++rp) { asm volatile("" : "+v"(F.tid)); if (rp) xcd_barrier(bar); phase_scatter(F); }
    SEAM(11);
    if (IN(12)) _Pragma("unroll 1") for (int rp = 0; rp < NREP(12); ++rp) { asm volatile("" : "+v"(F.tid)); if (rp) xcd_barrier(bar);
        __syncthreads();
        pg8::Gemm g{WSP(bf16_t, WS_H2), WSP(bf16_t, WS_EGUT), D, WSP(int, WS_SLOT_TOK), 128, 512 * 128}; MoeOrder S{WSP(unsigned, WS_CTL) + CW_UNITS, (int)WSP(unsigned, WS_CTL)[CW_TOFF + NE], 2, F.G, F.bx, 1048576u}; EpiGU E{WSP(bf16_t, WS_HBUF)};
        pg8::gemm_phase<EpiGU, MoeOrder, true>(F.lds, g, S, E);
    }
    SEAM(12);
    if (IN(13)) _Pragma("unroll 1") for (int rp = 0; rp < NREP(13); ++rp) { asm volatile("" : "+v"(F.tid)); if (rp) xcd_barrier(bar);
        __syncthreads();
        { pg8::Gemm g{WSP(bf16_t, WS_HBUF), WSP(bf16_t, WS_EDT), EH, nullptr, 128, 1024 * 128}; MoeOrder S{WSP(unsigned, WS_CTL) + CW_UNITS, (int)WSP(unsigned, WS_CTL)[CW_TOFF + NE], 4, F.G, F.bx, 524288u}; EpiDown<true, true> E{WSP(bf16_t, WS_YBUF), WSP(float, WS_SLOT_W)};
          pg8::gemm_phase<EpiDown<true, true>, MoeOrder, false>(F.lds, g, S, E); }
        { pg8::Gemm g{WSP(bf16_t, WS_HSH), WSP(bf16_t, WS_SHDT), EH, nullptr, 2 * EH, 128}; pg8::StaticOrder S; S.init(T, D, EH, F.G, F.bx); EpiDown<false> E{WSP(bf16_t, WS_YSH), nullptr};
          pg8::gemm_phase<EpiDown<false>, pg8::StaticOrder, false>(F.lds, g, S, E); }
    }
    SEAM(13);
    if (IN(14)) _Pragma("unroll 1") for (int rp = 0; rp < NREP(14); ++rp) { asm volatile("" : "+v"(F.tid)); if (rp) xcd_barrier(bar); phase_final(F); }
#undef IN
#undef SEAM
}

extern "C" void kernel_launch(void* const* d_in, const int* in_sizes, int n_in, void* d_out, int out_size, void* d_ws, size_t ws_size, hipStream_t stream) {
    static int grid = 0;
    if (grid == 0) {
        if (n_in != 34 || out_size != T * D || ws_size < WS_END) { fprintf(stderr, "kernel_launch: unexpected shapes (n_in %d, out %d, ws %zu < %zu)\n", n_in, out_size, ws_size, (size_t)WS_END); grid = -1; return; }
        int dev = 0, cus = 0, per_cu = 0;
        if (hipGetDevice(&dev) != hipSuccess || hipDeviceGetAttribute(&cus, hipDeviceAttributeMultiprocessorCount, dev) != hipSuccess) { grid = -1; return; }
        if (hipFuncSetAttribute((const void*)hyena_hgrn2_moe_fwd, hipFuncAttributeMaxDynamicSharedMemorySize, LDS_BYTES) != hipSuccess) { fprintf(stderr, "kernel_launch: hipFuncSetAttribute failed\n"); grid = -1; return; }
        if (hipOccupancyMaxActiveBlocksPerMultiprocessor(&per_cu, (const void*)hyena_hgrn2_moe_fwd, 512, LDS_BYTES) != hipSuccess || per_cu < 1) { fprintf(stderr, "kernel_launch: occupancy query failed (%d)\n", per_cu); (void)hipGetLastError(); per_cu = 1; }
        grid = cus * per_cu; if (grid > 256) grid = 256;
    }
    if (grid < 0) return;
    if (hipMemsetAsync((char*)d_ws + WS_CTL, 0, CTL_BYTES, stream) != hipSuccess) { fprintf(stderr, "kernel_launch: memset failed\n"); return; }
    Params p{};
    for (int i = 0; i < 34; ++i) p.in[i] = (const float*)d_in[i];
    p.out = (float*)d_out; p.ws = (unsigned char*)d_ws;
#if MK_LAUNCH_PER_PHASE
    for (int k = 0; k < NPHASE; ++k) { p.ph_lo = k; p.ph_hi = k + 1; void* args[] = {&p};
        hipError_t e = hipLaunchCooperativeKernel((const void*)hyena_hgrn2_moe_fwd, dim3(grid), dim3(512), args, LDS_BYTES, stream);
        if (e != hipSuccess) { fprintf(stderr, "kernel_launch: launch %d failed: %s\n", k, hipGetErrorString(e)); break; } }
#else
    p.ph_lo = 0; p.ph_hi = NPHASE; void* args[] = {&p};
    hipError_t e = hipLaunchCooperativeKernel((const void*)hyena_hgrn2_moe_fwd, dim3(grid), dim3(512), args, LDS_BYTES, stream);
    if (e != hipSuccess) fprintf(stderr, "kernel_launch: cooperative launch failed: %s (grid %d)\n", hipGetErrorString(e), grid);
#endif
}
```

```cpp
#include <hip/hip_runtime.h>
#include <hip/hip_cooperative_groups.h>
#include <cstdio>
#include <cstdint>
namespace cg = cooperative_groups;

#define LAS __attribute__((address_space(3)))
typedef unsigned short bf16_t;
typedef short bf16x8 __attribute__((ext_vector_type(8)));
typedef float f32x4 __attribute__((ext_vector_type(4)));
typedef float f32x2 __attribute__((ext_vector_type(2)));
typedef unsigned u32x4 __attribute__((ext_vector_type(4)));
typedef unsigned u32x2 __attribute__((ext_vector_type(2)));

constexpr int D = 1024, NB = 2, SEQ = 8192, T = NB * SEQ, CTXL = 256, TC = NB * CTXL, MA = T + TC, NEXT = CTXL + SEQ;
constexpr int HYW = 512, HYP = 1536, HGW = 512, INC = 6144;
constexpr int NE = 256, TOPK = 8, EH = 256, NASG = T * TOPK;
constexpr int NCH_EXT = NEXT / 64  , NCH_LAT = SEQ / 64  , NCHAIN = 16, NAITEM = NCHAIN * NCH_EXT  ;
constexpr int FFTN = 16384;
constexpr float EPS = 1e-6f;

constexpr size_t al256(size_t x) { return (x + 255) & ~(size_t)255; }
constexpr size_t WS_CTL = 0, CTL_BYTES = 65536;
constexpr size_t WS_WINT = WS_CTL + CTL_BYTES;
constexpr size_t WS_WHYT = WS_WINT + (size_t)INC * D * 2;
constexpr size_t WS_WHGT = WS_WHYT + (size_t)D * HYW * 2;
constexpr size_t WS_WOUTT = WS_WHGT + (size_t)D * HGW * 2;
constexpr size_t WS_ROUT = WS_WOUTT + (size_t)D * D * 2;
constexpr size_t WS_SHGUT = WS_ROUT + (size_t)NE * D * 2;
constexpr size_t WS_SHDT = WS_SHGUT + (size_t)512 * D * 2;
constexpr size_t WS_ADAP = WS_SHDT + (size_t)D * 256 * 2;
constexpr size_t WS_ADA = WS_ADAP + (size_t)32 * 3 * 6144 * 4;
constexpr size_t WS_POSR = WS_ADA + (size_t)3 * 6144 * 4;
constexpr size_t WS_POSC = WS_POSR + (size_t)128 * 512 * 4;
constexpr size_t WS_LBS = WS_POSC + (size_t)64 * 512 * 4;
constexpr size_t WS_ROUTE_E = WS_LBS + 4096;
constexpr size_t WS_ROUTE_W = WS_ROUTE_E + (size_t)NASG * 4;
constexpr size_t WS_ROUTE_P = WS_ROUTE_W + (size_t)NASG * 4;
constexpr size_t WS_SLOTOF = WS_ROUTE_P + (size_t)NASG * 4;
constexpr size_t WS_SLOT_TOK = WS_SLOTOF + (size_t)NASG * 4;
constexpr size_t WS_SLOT_W = WS_SLOT_TOK + (size_t)(NASG + 256) * 4;
constexpr size_t WS_EGUT = al256(WS_SLOT_W + (size_t)(NASG + 256) * 4);
constexpr size_t WS_EDT = WS_EGUT + (size_t)NE * 512 * D * 2;
constexpr size_t WS_RA = WS_EDT + (size_t)NE * D * EH * 2;
constexpr size_t RA_BYTES = (size_t)NASG * D * 2;
constexpr size_t WS_HF = WS_RA;
constexpr size_t WS_KS = WS_HF + (size_t)2048 * SEQ * 4;
constexpr size_t WS_DELTA = WS_KS + (size_t)256 * 2 * FFTN * 8;
constexpr size_t WS_DECAY = WS_DELTA + (size_t)NAITEM * 16384 * 2;
constexpr size_t WS_PHYT = WS_DECAY + (size_t)NAITEM * 128 * 4;
static_assert(WS_PHYT + (size_t)NB * HYP * SEQ * 2 <= WS_RA + RA_BYTES, "region A overflow");
constexpr size_t WS_YBUF = WS_RA;
constexpr size_t WS_RB = WS_RA + RA_BYTES;
constexpr size_t WS_VT = WS_RB;
constexpr size_t WS_Q = WS_VT + (size_t)NB * HGW * NEXT * 2;
constexpr size_t WS_LF = WS_Q + (size_t)T * HGW * 2;
constexpr size_t WS_LB = WS_LF + (size_t)NB * NEXT * HGW * 4;
constexpr size_t WS_G = WS_LB + (size_t)NB * NEXT * HGW * 4;
constexpr size_t WS_SG1 = WS_G + (size_t)T * HGW * 2;
constexpr size_t WS_SG2 = WS_SG1 + (size_t)T * D * 2;
constexpr size_t WS_A1 = WS_SG2 + (size_t)T * D * 2;
constexpr size_t WS_SST = WS_A1 + (size_t)MA * D * 2;
constexpr size_t WS_YHG = WS_SST + (size_t)NCHAIN * NCH_LAT * 16384 * 2 + 256 * 512;
constexpr size_t WS_T1 = WS_YHG + (size_t)T * HGW * 2;
constexpr size_t WS_END = WS_T1 + (size_t)T * D * 4;
constexpr size_t WS_LOGIT = WS_VT, WS_HSH = WS_Q, WS_MB = WS_LF, WS_H2 = WS_LB, WS_YSH = WS_SG1, WS_YHYT = WS_A1, WS_YHY = WS_A1 + (size_t)NB * HYW * SEQ * 2, WS_HBUF = WS_SST;
static_assert((size_t)T * 256 * 4 <= (size_t)NB * HGW * NEXT * 2, "LOGIT fits VT");
static_assert(WS_YHY + (size_t)T * HYW * 2 <= WS_SST, "YHY fits A1");
static_assert((size_t)(NASG + 256) * EH * 2 <= (size_t)NCHAIN * NCH_LAT * 16384 * 2 + 256 * 512, "HBUF fits SST");
static_assert(WS_END <= (size_t)1073741824, "workspace map exceeds 1 GiB");
constexpr int CW_CNT = 0;
constexpr int CW_START = 512;
constexpr int CW_TOFF = 1024;
constexpr int CW_BAR = 4096;
constexpr int CW_UNITS = 8192;

constexpr int LDS_BYTES = 147456;
constexpr int LDS_BARST = LDS_BYTES - 64;

__device__ __forceinline__ unsigned f2bf(float f) { unsigned u = __float_as_uint(f); return (u + 0x7fffu + ((u >> 16) & 1u)) >> 16; }
__device__ __forceinline__ unsigned pk2(float lo, float hi) { return f2bf(lo) | (f2bf(hi) << 16); }
__device__ __forceinline__ float bf2f(unsigned b) { return __uint_as_float(b << 16); }
__device__ __forceinline__ float bflo(unsigned w) { return __uint_as_float(w << 16); }
__device__ __forceinline__ float bfhi(unsigned w) { return __uint_as_float(w & 0xffff0000u); }
__device__ __forceinline__ float sigmoidf_(float x) { return __builtin_amdgcn_rcpf(1.0f + __expf(-x)); }
__device__ __forceinline__ float siluf_(float x) { return x * __builtin_amdgcn_rcpf(1.0f + __expf(-x)); }
__device__ __forceinline__ unsigned f2h(float f) { return (unsigned)__builtin_bit_cast(unsigned short, (_Float16)f); }
__device__ __forceinline__ unsigned pkh2(float lo, float hi) { return f2h(lo) | (f2h(hi) << 16); }
__device__ __forceinline__ float h2f(unsigned short b) { return (float)__builtin_bit_cast(_Float16, b); }
__device__ __forceinline__ float wave_sum(float v) {
#pragma unroll
    for (int o = 1; o < 64; o <<= 1) v += __shfl_xor(v, o);
    return v;
}
#define LDS_WAIT() asm volatile("s_waitcnt lgkmcnt(0)" ::: "memory")

struct Params {
    const float* in[34];
    float* out;
    unsigned char* ws;
    int ph_lo, ph_hi;
};
enum { I_X = 0, I_C, I_CTX, I_CCTX, I_N1G, I_N2G, I_ADAW, I_ADAB, I_WIN, I_HCW, I_HCB, I_FW1, I_FB1, I_FW2, I_FB2, I_FW3, I_FB3, I_FW4, I_FFREQ, I_HSKIP,
       I_LBL, I_HGNG, I_WHY, I_WHG, I_WOUT, I_RW, I_RB, I_EG, I_EU, I_ED, I_SG, I_SU, I_SD, I_FG };
namespace pg8 {
constexpr int BM = 256, BK = 64, HALF = 128, HTB = HALF * BK * 2, STAGE_BYTES = 8 * HTB;
__host__ __device__ __forceinline__ int lds_byte(int r, int c) { const int st = (r >> 4) * 2 + (c >> 5), rr = r & 15, cc = c & 31, ob = rr * 64 + cc * 2; return st * 1024 + (ob ^ (((ob >> 9) & 1) << 5)); }
__host__ __device__ __forceinline__ void stage_rc(int b, int& R, int& C) { const int st = b / 1024, sb = b % 1024, swz = sb ^ (((sb >> 9) & 1) << 5); R = (st >> 1) * 16 + swz / 64; C = (st & 1) * 32 + (swz % 64) / 2; }
__host__ __device__ __forceinline__ int perm32(int rho) { const int n = rho >> 4, i = rho & 15; return 8 * (i >> 2) + 4 * n + (i & 3); }

struct Unit { int row0, lrow, pn, nvalid, aux, kind; unsigned boff; };
struct Gemm { const bf16_t* A; const bf16_t* Bt; int K; const int* rows; int ldb, kstepB; };

__device__ __forceinline__ unsigned cvt_pk_bf16(float lo, float hi) { unsigned r; asm volatile("v_cvt_pk_bf16_f32 %0, %1, %2" : "=v"(r) : "v"(lo), "v"(hi)); return r; }

template <class Epi, class Sched, bool GATHER>
__device__ __forceinline__ void gemm_phase(LAS unsigned char* lds, const Gemm g, const Sched& S, const Epi& E) {
    const int tid = threadIdx.x, wid = __builtin_amdgcn_readfirstlane(tid >> 6), lane = tid & 63, wr = wid >> 2, wc = wid & 3, fr = lane & 15, fq = lane >> 4;
    int K_ = g.K; asm volatile("" : "+s"(K_));
    const int K = K_, nt = K / BK; int ldb_ = g.ldb, ksb_ = g.kstepB; asm volatile("" : "+s"(ldb_), "+s"(ksb_));
    unsigned voffA[2], voffB[2]; int RA[2], CA[2];
#pragma unroll
    for (int i = 0; i < 2; ++i) { int R, C; stage_rc(tid * 16 + i * 8192, R, C); const int Rb = Epi::PERM ? ((R & ~31) + perm32(R & 31)) : R;
        voffA[i] = (unsigned)(R * K + C) * 2u; voffB[i] = (unsigned)(Rb * ldb_ + C * 2); RA[i] = R; CA[i] = C; }
    const size_t kstep = (size_t)(BK * 2);
    const size_t hstep = (size_t)HALF * K * 2;
    const size_t kstepB = (size_t)ksb_, hstepB = (size_t)HALF * ldb_;
    const unsigned ldsw = (unsigned)wid * 1024u;
    const int aoff = lds_byte(wr * 64 + fr, fq * 8), boff = lds_byte(wc * 32 + fr, fq * 8);
    unsigned vg0[2][2], vg1[2][2];
#define PG8_SA(b, h) (((b) * 2 + (h)) * HTB)
#define PG8_SB(b, h) ((4 + (b) * 2 + (h)) * HTB)
#define PG8_STAGE(bufoff, gbase, voff) do { _Pragma("unroll") for (int _i = 0; _i < 2; ++_i) \
        __builtin_amdgcn_global_load_lds((const unsigned*)((const char*)(gbase) + (voff)[_i]), (LAS unsigned*)(lds + (bufoff) + ldsw + _i * 8192), 16, 0, 0); } while (0)
#define PG8_STAGE_A(bufoff, gbase, h, w) do { _Pragma("unroll") for (int _i = 0; _i < 2; ++_i) { \
        const unsigned _o = GATHER ? ((w) ? vg1[h][_i] : vg0[h][_i]) : (voffA[_i] + (unsigned)((h) * hstep)); \
        __builtin_amdgcn_global_load_lds((const unsigned*)((const char*)(gbase) + _o), (LAS unsigned*)(lds + (bufoff) + ldsw + _i * 8192), 16, 0, 0); } } while (0)
#define PG8_LDA(dst, b, h) do { _Pragma("unroll") for (int m = 0; m < 4; ++m) _Pragma("unroll") for (int k = 0; k < 2; ++k) dst[m][k] = *(const LAS bf16x8*)(lds + PG8_SA(b, h) + aoff + m * 2048 + k * 1024); } while (0)
#define PG8_LDB(dst, b, h) do { _Pragma("unroll") for (int n = 0; n < 2; ++n) _Pragma("unroll") for (int k = 0; k < 2; ++k) dst[n][k] = *(const LAS bf16x8*)(lds + PG8_SB(b, h) + boff + n * 2048 + k * 1024); } while (0)
#define PG8_MMA(ai, bj, At, Bt) do { __builtin_amdgcn_s_setprio(1); _Pragma("unroll") for (int m = 0; m < 4; ++m) _Pragma("unroll") for (int n = 0; n < 2; ++n) _Pragma("unroll") for (int k = 0; k < 2; ++k) \
        acc[ai][bj][m][n] = __builtin_amdgcn_mfma_f32_16x16x32_bf16(Bt[n][k], At[m][k], acc[ai][bj][m][n], 0, 0, 0); __builtin_amdgcn_s_setprio(0); } while (0)
#define PG8_WAIT_V(n) asm volatile("s_waitcnt vmcnt(" #n ")" ::: "memory")
#define PG8_WAIT_L(n) asm volatile("s_waitcnt lgkmcnt(" #n ")" ::: "memory")
#define PG8_BAR __builtin_amdgcn_s_barrier()
#define PG8_SCHED __builtin_amdgcn_sched_barrier(0)
#define PG8_GOFF(dst, u) do { if (GATHER) { _Pragma("unroll") for (int _h = 0; _h < 2; ++_h) _Pragma("unroll") for (int _i = 0; _i < 2; ++_i) \
        dst[_h][_i] = (unsigned)(g.rows[(u).row0 + _h * HALF + RA[_i]] * K + CA[_i]) * 2u; } } while (0)
    Unit cur, nxt; int ui = 0;
    if (!S.next(0, cur)) return;
    f32x4 acc[2][2][4][2];
#pragma unroll
    for (int a = 0; a < 2; ++a)
#pragma unroll
        for (int b = 0; b < 2; ++b)
#pragma unroll
            for (int m = 0; m < 4; ++m)
#pragma unroll
                for (int n = 0; n < 2; ++n) acc[a][b][m][n] = (f32x4){0.f, 0.f, 0.f, 0.f};
    bf16x8 At[4][2], B0[2][2], B1[2][2];
    const char* cA = (const char*)g.A + (GATHER ? (size_t)0 : (size_t)cur.row0 * K * 2); const char* cB = (const char*)g.Bt + cur.boff;
    PG8_GOFF(vg0, cur);
#pragma unroll
    for (int _h = 0; _h < 2; ++_h)
#pragma unroll
        for (int _i = 0; _i < 2; ++_i) vg1[_h][_i] = vg0[_h][_i];
    PG8_STAGE(PG8_SB(0, 0), cB, voffB); PG8_STAGE_A(PG8_SA(0, 0), cA, 0, false); PG8_STAGE(PG8_SB(0, 1), cB + hstepB, voffB); PG8_STAGE_A(PG8_SA(0, 1), cA, 1, false);
    if (wr == 1) PG8_BAR;
    PG8_WAIT_V(4); PG8_BAR;
    PG8_STAGE(PG8_SB(1, 0), cB + kstepB, voffB); PG8_STAGE_A(PG8_SA(1, 0), cA + kstep, 0, false); PG8_STAGE(PG8_SB(1, 1), cB + hstepB + kstepB, voffB);
    PG8_WAIT_V(6); PG8_BAR;
    for (;;) {
        const bool has_next = S.next(ui + 1, nxt);
        if (has_next) PG8_GOFF(vg1, nxt);
        const char* nA = has_next ? (const char*)g.A + (GATHER ? (size_t)0 : (size_t)nxt.row0 * K * 2) : cA; const char* nB = has_next ? (const char*)g.Bt + nxt.boff : cB;
        const bool full = cur.nvalid > HALF;
        for (int t = 0; t < nt; t += 2) {
            const bool last = (t == nt - 2);
            const bool wn = last && has_next;
            const char* a1 = cA + (size_t)(t + 1) * kstep;
            const char* a2 = last ? nA : cA + (size_t)(t + 2) * kstep; const char* b2 = last ? nB : cB + (size_t)(t + 2) * kstepB;
            const char* a3 = a2 + kstep; const char* b3 = b2 + kstepB;
            PG8_LDB(B0, 0, 0); PG8_SCHED; PG8_LDA(At, 0, 0); PG8_STAGE_A(PG8_SA(1, 1), a1, 1, false);
            PG8_WAIT_L(8); PG8_BAR; PG8_WAIT_L(0); PG8_MMA(0, 0, At, B0); PG8_BAR; PG8_SCHED;
            PG8_LDB(B1, 0, 1); PG8_STAGE(PG8_SB(0, 0), b2, voffB);
            PG8_BAR; PG8_WAIT_L(0); PG8_MMA(0, 1, At, B1); PG8_BAR;
            if (full) PG8_LDA(At, 0, 1); PG8_STAGE_A(PG8_SA(0, 0), a2, 0, wn);
            PG8_BAR; PG8_WAIT_L(0); if (full) PG8_MMA(1, 0, At, B0); PG8_BAR; PG8_SCHED;
            PG8_STAGE(PG8_SB(0, 1), b2 + hstepB, voffB);
            PG8_WAIT_V(6); PG8_BAR; if (full) PG8_MMA(1, 1, At, B1); PG8_BAR;
            PG8_LDB(B0, 1, 0); PG8_SCHED; PG8_LDA(At, 1, 0); PG8_STAGE_A(PG8_SA(0, 1), a2, 1, wn);
            PG8_WAIT_L(8); PG8_BAR; PG8_WAIT_L(0); PG8_MMA(0, 0, At, B0); PG8_BAR; PG8_SCHED;
            PG8_LDB(B1, 1, 1); PG8_STAGE(PG8_SB(1, 0), b3, voffB);
            PG8_BAR; PG8_WAIT_L(0); PG8_MMA(0, 1, At, B1); PG8_BAR;
            if (full) PG8_LDA(At, 1, 1); PG8_STAGE_A(PG8_SA(1, 0), a3, 0, wn);
            PG8_BAR; PG8_WAIT_L(0); if (full) PG8_MMA(1, 0, At, B0); PG8_BAR; PG8_SCHED;
            PG8_STAGE(PG8_SB(1, 1), b3 + hstepB, voffB);
            PG8_WAIT_V(6); PG8_BAR; if (full) PG8_MMA(1, 1, At, B1); PG8_BAR;
        }
        { int fr_ = fr, fq_ = fq; asm volatile("" : "+v"(fr_), "+v"(fq_)); E(acc, cur, wr, wc, fr_, fq_); }
        if (!has_next) break;
#pragma unroll
        for (int a = 0; a < 2; ++a)
#pragma unroll
            for (int b = 0; b < 2; ++b)
#pragma unroll
                for (int m = 0; m < 4; ++m)
#pragma unroll
                    for (int n = 0; n < 2; ++n) acc[a][b][m][n] = (f32x4){0.f, 0.f, 0.f, 0.f};
        cur = nxt; cA = nA; cB = nB; ++ui;
#pragma unroll
        for (int _h = 0; _h < 2; ++_h)
#pragma unroll
            for (int _i = 0; _i < 2; ++_i) vg0[_h][_i] = vg1[_h][_i];
    }
    PG8_WAIT_V(0);
    if (wr == 0) PG8_BAR;
    PG8_BAR;
#undef PG8_SA
#undef PG8_SB
#undef PG8_STAGE
#undef PG8_STAGE_A
#undef PG8_LDA
#undef PG8_LDB
#undef PG8_MMA
#undef PG8_WAIT_V
#undef PG8_WAIT_L
#undef PG8_BAR
#undef PG8_SCHED
#undef PG8_GOFF
}

struct StaticOrder {
    int nM, nN, nwg, G, c, Kb;
    __device__ void init(int M, int N, int K, int G_, int c_) { nM = M / BM; nN = N / BM; nwg = nM * nN; G = G_; c = c_; Kb = K; }
    __device__ bool next(int i, Unit& u) const {
        const long L = (long)i * G + c; if (L >= nwg) return false;
        int wgid = (int)L; { const int NXCD = 8; const int q = nwg / NXCD, r = nwg % NXCD, xcd = wgid % NXCD, off = wgid / NXCD; wgid = (xcd < r ? xcd * (q + 1) : r * (q + 1) + (xcd - r) * q) + off; }
        const int WGM = 8; const int nig = WGM * nN, gid = wgid / nig, fm = gid * WGM, gsz = (nM - fm) < WGM ? (nM - fm) : WGM;
        u.row0 = (fm + ((wgid % nig) % gsz)) * BM; u.lrow = u.row0; u.pn = (wgid % nig) / gsz; u.nvalid = BM; u.aux = u.pn; u.kind = 0; u.boff = (unsigned)u.pn * (unsigned)(BM * 2) * (unsigned)Kb; return true;
    }
};
}
using pg8::Unit; using pg8::cvt_pk_bf16;
typedef const f32x4 (&AccRef)[2][2][4][2];

struct MoeOrder {
    const unsigned* units; int ntile, nsub, G, c; unsigned ebytes;
    __device__ bool next(int i, Unit& u) const {
        const long L = (long)i * G + c; const int nun = ntile * nsub; if (L >= nun) return false;
        int idx = (int)L; { const int q = nun / 8, r = nun % 8, xcd = idx % 8, off = idx / 8; idx = (xcd < r ? xcd * (q + 1) : r * (q + 1) + (xcd - r) * q) + off; }
        const int tile = idx / nsub, sub = idx % nsub;
        const u32x4 d = *(const u32x4*)(units + 4 * tile);
        u.row0 = (int)d.x; u.lrow = u.row0; u.pn = (int)d.y * nsub + sub; u.nvalid = (int)d.z; u.aux = sub; u.kind = 0; u.boff = d.y * ebytes + (unsigned)sub * 32768u; return true;
    }
};

struct EpiInT {
    static constexpr bool PERM = true;
    bf16_t* phyt; bf16_t* vt;
    __device__ __forceinline__ void operator()(AccRef acc, const Unit& u, int wr, int wc, int fr, int fq) const {
        const int pm = u.lrow >> 8, tb = u.pn * 256; const bool isctx = tb >= T;
        int b, nbase; if (!isctx) { b = tb >> 13; nbase = tb & (SEQ - 1); } else { b = (tb - T) >> 8; nbase = 0; }
        if (pm < 6 && isctx) return;
#pragma unroll
        for (int ai = 0; ai < 2; ++ai)
#pragma unroll
            for (int m = 0; m < 4; ++m) {
                const int f = u.lrow + ai * 128 + wr * 64 + m * 16 + fr;
                bf16_t* rowp = (pm < 6) ? phyt + ((size_t)(b * HYP + f) * SEQ + nbase) : vt + ((size_t)(b * HGW + (f - HYP)) * NEXT + (isctx ? 0 : CTXL) + nbase);
#pragma unroll
                for (int bj = 0; bj < 2; ++bj) { const int cu = bj * 128 + wc * 32 + 8 * fq; const f32x4 v0 = acc[ai][bj][m][0], v1 = acc[ai][bj][m][1];
                    u32x4 w; w.x = cvt_pk_bf16(v0[0], v0[1]); w.y = cvt_pk_bf16(v0[2], v0[3]); w.z = cvt_pk_bf16(v1[0], v1[1]); w.w = cvt_pk_bf16(v1[2], v1[3]);
                    *(u32x4*)(rowp + cu) = w; }
            }
    }
};
struct EpiInN {
    static constexpr bool PERM = true;
    bf16_t *q, *g, *sg1, *sg2; float *lf, *lb; const float* lbs;
    __device__ __forceinline__ void operator()(AccRef acc, const Unit& u, int wr, int wc, int fr, int fq) const {
        const int pn = u.pn; const bool isctx = u.lrow >= T;
        if (isctx && (pn < 2 || pn > 5)) return;
        float lbu[2][8];
        if (pn >= 2 && pn < 6) {
#pragma unroll
            for (int bj = 0; bj < 2; ++bj) { const float* lbp = lbs + (pn >= 4) * 512 + (pn & 1) * 256 + bj * 128 + wc * 32 + 8 * fq; const f32x4 l0 = *(const f32x4*)lbp, l1 = *(const f32x4*)(lbp + 4);
                lbu[bj][0] = l0[0]; lbu[bj][1] = l0[1]; lbu[bj][2] = l0[2]; lbu[bj][3] = l0[3]; lbu[bj][4] = l1[0]; lbu[bj][5] = l1[1]; lbu[bj][6] = l1[2]; lbu[bj][7] = l1[3]; } }
#pragma unroll
        for (int ai = 0; ai < 2; ++ai)
#pragma unroll
            for (int m = 0; m < 4; ++m) {
                const int r = u.lrow + ai * 128 + wr * 64 + m * 16 + fr;
                int b, nx; if (!isctx) { b = r >> 13; nx = CTXL + (r & (SEQ - 1)); } else { const int rr = r - T; b = rr >> 8; nx = rr & 255; }
#pragma unroll
                for (int bj = 0; bj < 2; ++bj) { const int cu = bj * 128 + wc * 32 + 8 * fq; const f32x4 v0 = acc[ai][bj][m][0], v1 = acc[ai][bj][m][1];
                    float x[8] = {v0[0], v0[1], v0[2], v0[3], v1[0], v1[1], v1[2], v1[3]};
                    if (pn >= 2 && pn < 6) {
                        const int dir = pn >= 4, col = (pn & 1) * 256 + cu;
                        float o[8];
#pragma unroll
                        for (int j = 0; j < 8; ++j) o[j] = __logf(lbu[bj][j] + (1.0f - lbu[bj][j]) * sigmoidf_(x[j]));
                        float* dst = (dir ? lb : lf) + ((size_t)(b * NEXT + nx) * HGW + col);
                        *(f32x4*)dst = (f32x4){o[0], o[1], o[2], o[3]}; *(f32x4*)(dst + 4) = (f32x4){o[4], o[5], o[6], o[7]};
                    } else {
                        bf16_t* dst;
                        if (pn < 2) { dst = q + (size_t)r * HGW + pn * 256 + cu;
#pragma unroll
                            for (int j = 0; j < 8; ++j) x[j] = siluf_(x[j]); }
                        else if (pn < 8) { dst = g + (size_t)r * HGW + (pn - 6) * 256 + cu;
#pragma unroll
                            for (int j = 0; j < 8; ++j) x[j] = siluf_(x[j]); }
                        else { dst = (pn < 12 ? sg1 + (size_t)r * D + (pn - 8) * 256 : sg2 + (size_t)r * D + (pn - 12) * 256) + cu;
#pragma unroll
                            for (int j = 0; j < 8; ++j) x[j] = sigmoidf_(x[j]); }
                        u32x4 w; w.x = cvt_pk_bf16(x[0], x[1]); w.y = cvt_pk_bf16(x[2], x[3]); w.z = cvt_pk_bf16(x[4], x[5]); w.w = cvt_pk_bf16(x[6], x[7]);
                        *(u32x4*)dst = w;
                    }
                }
            }
    }
};
struct EpiMerge1 {
    static constexpr bool PERM = false;
    const bf16_t* sg1; float* t1;
    __device__ __forceinline__ void operator()(AccRef acc, const Unit& u, int wr, int wc, int fr, int fq) const {
#pragma unroll
        for (int ai = 0; ai < 2; ++ai) { u32x2 s[4][2][2];
#pragma unroll
            for (int m = 0; m < 4; ++m) { const size_t ro = (size_t)(u.lrow + ai * 128 + wr * 64 + m * 16 + fr) * D + u.pn * 256 + wc * 32 + 4 * fq;
#pragma unroll
                for (int bj = 0; bj < 2; ++bj)
#pragma unroll
                    for (int n = 0; n < 2; ++n) s[m][bj][n] = *(const u32x2*)(sg1 + ro + bj * 128 + n * 16); }
#pragma unroll
            for (int m = 0; m < 4; ++m) { const size_t ro = (size_t)(u.lrow + ai * 128 + wr * 64 + m * 16 + fr) * D + u.pn * 256 + wc * 32 + 4 * fq;
#pragma unroll
                for (int bj = 0; bj < 2; ++bj)
#pragma unroll
                    for (int n = 0; n < 2; ++n) { const f32x4 a = acc[ai][bj][m][n]; const u32x2 sv = s[m][bj][n];
                        *(f32x4*)(t1 + ro + bj * 128 + n * 16) = (f32x4){a[0] * bflo(sv.x), a[1] * bfhi(sv.x), a[2] * bflo(sv.y), a[3] * bfhi(sv.y)}; } } }
    }
};
struct EpiMerge2 {
    static constexpr bool PERM = false;
    const bf16_t* sg2; const float* t1; bf16_t* mb;
    __device__ __forceinline__ void operator()(AccRef acc, const Unit& u, int wr, int wc, int fr, int fq) const {
#pragma unroll
        for (int ai = 0; ai < 2; ++ai)
#pragma unroll
            for (int m = 0; m < 4; ++m) { u32x2 s[2][2]; f32x4 p[2][2];
                const size_t ro = (size_t)(u.lrow + ai * 128 + wr * 64 + m * 16 + fr) * D + u.pn * 256 + wc * 32 + 4 * fq;
#pragma unroll
                for (int bj = 0; bj < 2; ++bj)
#pragma unroll
                    for (int n = 0; n < 2; ++n) { s[bj][n] = *(const u32x2*)(sg2 + ro + bj * 128 + n * 16); p[bj][n] = *(const f32x4*)(t1 + ro + bj * 128 + n * 16); }
#pragma unroll
                for (int bj = 0; bj < 2; ++bj)
#pragma unroll
                    for (int n = 0; n < 2; ++n) { const f32x4 a = acc[ai][bj][m][n], pv = p[bj][n]; const u32x2 sv = s[bj][n];
                        u32x2 w; w.x = cvt_pk_bf16(pv[0] + a[0] * bflo(sv.x), pv[1] + a[1] * bfhi(sv.x)); w.y = cvt_pk_bf16(pv[2] + a[2] * bflo(sv.y), pv[3] + a[3] * bfhi(sv.y));
                        *(u32x2*)(mb + ro + bj * 128 + n * 16) = w; } }
    }
};
struct EpiWout {
    static constexpr bool PERM = false;
    const float* x; const float* posr; const float* posc; const float* ada; float* x1;
    __device__ __forceinline__ void operator()(AccRef acc, const Unit& u, int wr, int wc, int fr, int fq) const {
        const int b = u.lrow >> 13, cb = u.pn * 256 + wc * 32 + 4 * fq;
        f32x4 g1[2][2];
#pragma unroll
        for (int bj = 0; bj < 2; ++bj)
#pragma unroll
            for (int nn = 0; nn < 2; ++nn) g1[bj][nn] = *(const f32x4*)(ada + b * 6144 + 2 * D + cb + bj * 128 + nn * 16);
#pragma unroll
        for (int ai = 0; ai < 2; ++ai)
#pragma unroll
            for (int m = 0; m < 4; ++m) { f32x4 xv[2][2], pe[2][2];
                const int r = u.lrow + ai * 128 + wr * 64 + m * 16 + fr, n = r & (SEQ - 1);
#pragma unroll
                for (int bj = 0; bj < 2; ++bj)
#pragma unroll
                    for (int nn = 0; nn < 2; ++nn) { const int c = cb + bj * 128 + nn * 16; xv[bj][nn] = *(const f32x4*)(x + (size_t)r * D + c);
                        pe[bj][nn] = (c < 512) ? *(const f32x4*)(posr + (n >> 6) * 512 + c) : *(const f32x4*)(posc + (n & 63) * 512 + (c - 512)); }
#pragma unroll
                for (int bj = 0; bj < 2; ++bj)
#pragma unroll
                    for (int nn = 0; nn < 2; ++nn) *(f32x4*)(x1 + (size_t)r * D + cb + bj * 128 + nn * 16) = xv[bj][nn] + pe[bj][nn] + g1[bj][nn] * acc[ai][bj][m][nn]; }
    }
};
struct EpiLogit {
    static constexpr bool PERM = true;
    float* lg;
    __device__ __forceinline__ void operator()(AccRef acc, const Unit& u, int wr, int wc, int fr, int fq) const {
#pragma unroll
        for (int ai = 0; ai < 2; ++ai)
#pragma unroll
            for (int m = 0; m < 4; ++m) { float* rp = lg + (size_t)(u.lrow + ai * 128 + wr * 64 + m * 16 + fr) * NE + wc * 32 + 8 * fq;
#pragma unroll
                for (int bj = 0; bj < 2; ++bj) { *(f32x4*)(rp + bj * 128) = acc[ai][bj][m][0]; *(f32x4*)(rp + bj * 128 + 4) = acc[ai][bj][m][1]; } }
    }
};
struct EpiGU {
    static constexpr bool PERM = true;
    bf16_t* hout;
    __device__ __forceinline__ void operator()(AccRef acc, const Unit& u, int wr, int wc, int fr, int fq) const {
#pragma unroll
        for (int ai = 0; ai < 2; ++ai)
#pragma unroll
            for (int m = 0; m < 4; ++m) { const int rl = ai * 128 + wr * 64 + m * 16 + fr;
                if (rl < u.nvalid) { const f32x4 g0 = acc[ai][0][m][0], g1 = acc[ai][0][m][1], u0 = acc[ai][1][m][0], u1 = acc[ai][1][m][1];
                    u32x4 w; w.x = cvt_pk_bf16(siluf_(g0[0]) * u0[0], siluf_(g0[1]) * u0[1]); w.y = cvt_pk_bf16(siluf_(g0[2]) * u0[2], siluf_(g0[3]) * u0[3]);
                    w.z = cvt_pk_bf16(siluf_(g1[0]) * u1[0], siluf_(g1[1]) * u1[1]); w.w = cvt_pk_bf16(siluf_(g1[2]) * u1[2], siluf_(g1[3]) * u1[3]);
                    *(u32x4*)(hout + (size_t)(u.lrow + rl) * EH + u.aux * 128 + wc * 32 + 8 * fq) = w; } }
    }
};
template <bool HASW, bool FP8 = false> struct EpiDown {
    static constexpr bool PERM = true;
    bf16_t* yout; const float* wrow;
    __device__ __forceinline__ void operator()(AccRef acc, const Unit& u, int wr, int wc, int fr, int fq) const {
        char* base = (char*)yout + ((size_t)u.lrow * D + u.aux * 256 + wc * 32) * (FP8 ? 1 : 2);
        float wv[2][4];
#pragma unroll
        for (int ai = 0; ai < 2; ++ai)
#pragma unroll
            for (int m = 0; m < 4; ++m) { const int rl = ai * 128 + wr * 64 + m * 16 + fr; wv[ai][m] = (HASW && rl < u.nvalid) ? wrow[u.lrow + rl] : 1.0f; }
#pragma unroll
        for (int ai = 0; ai < 2; ++ai)
#pragma unroll
            for (int m = 0; m < 4; ++m) { const int rl = ai * 128 + wr * 64 + m * 16 + fr;
                if (rl < u.nvalid) { const float w_ = wv[ai][m];
                    const unsigned off = (unsigned)(rl * D + 8 * fq) * (FP8 ? 1u : 2u);
#pragma unroll
                    for (int bj = 0; bj < 2; ++bj) { const f32x4 v0 = acc[ai][bj][m][0] * w_, v1 = acc[ai][bj][m][1] * w_;
                        if (FP8) { int a = __builtin_amdgcn_cvt_pk_fp8_f32(v0[0], v0[1], 0, false); a = __builtin_amdgcn_cvt_pk_fp8_f32(v0[2], v0[3], a, true);
                            int c = __builtin_amdgcn_cvt_pk_fp8_f32(v1[0], v1[1], 0, false); c = __builtin_amdgcn_cvt_pk_fp8_f32(v1[2], v1[3], c, true);
                            *(u32x2*)(base + off + bj * 128) = (u32x2){(unsigned)a, (unsigned)c}; }
                        else { u32x4 w; w.x = cvt_pk_bf16(v0[0], v0[1]); w.y = cvt_pk_bf16(v0[2], v0[3]); w.z = cvt_pk_bf16(v1[0], v1[1]); w.w = cvt_pk_bf16(v1[2], v1[3]);
                            *(u32x4*)(base + off + bj * 256) = w; } } } }
    }
};

constexpr int RA1 = (int)((WS_A1 - WS_WINT) / (D * 2));
static_assert((WS_A1 - WS_WINT) % (D * 2) == 0, "A1 must sit a whole number of rows above WINT");
struct InOrder {
    int G, c;
    static constexpr int N0 = 6 * 64, N1 = 2 * 64, N2 = 64 * 16, NU = N0 + N1 + N2;
    __device__ bool next(int i, Unit& u) const {
        const long L = (long)i * G + c; if (L >= NU) return false;
        int idx = (int)L; { const int q = NU / 8, r = NU % 8, xcd = idx % 8, off = idx / 8; idx = (xcd < r ? xcd * (q + 1) : r * (q + 1) + (xcd - r) * q) + off; }
        int pm, pn, kind;
        if (idx < N0 + N1) { const int g = idx >> 5, jj = idx & 31; kind = 0; pm = 4 * (g & 1) + (jj & 3); pn = 8 * (g >> 1) + (jj >> 2); }
        else { const int j = idx - N0 - N1, g = j >> 7, jj = j & 127; kind = 1; pm = 8 * g + (jj & 7); pn = jj >> 3; }
        fill(u, kind, pm, pn); return true;
    }
    __device__ static void fill(Unit& u, int kind, int pm, int pn) {
        u.kind = kind; u.pn = pn; u.lrow = pm * 256; u.nvalid = 256; u.aux = pn;
        if (kind == 0) { u.row0 = pm * 256; u.boff = (unsigned)(RA1 + pn * 256) * (unsigned)(D * 2); }
        else { u.row0 = RA1 + pm * 256; u.boff = (unsigned)(2048 + pn * 256) * (unsigned)(D * 2); }
    }
};
struct CtxUnit {
    int idx;
    __device__ static int tile(int idx) { return idx < 4 ? (idx & 1) : ((idx - 4) >> 2); }
    __device__ bool next(int i, Unit& u) const { if (i) return false;
        if (idx < 4) InOrder::fill(u, 0, 6 + (idx >> 1), 64 + (idx & 1)); else InOrder::fill(u, 1, 64 + ((idx - 4) >> 2), 2 + ((idx - 4) & 3)); return true; }
};
struct EpiIn {
    static constexpr bool PERM = true;
    EpiInT t; EpiInN n;
    __device__ __forceinline__ void operator()(AccRef acc, const Unit& u, int wr, int wc, int fr, int fq) const { if (u.kind == 0) t(acc, u, wr, wc, fr, fq); else n(acc, u, wr, wc, fr, fq); }
};
struct P9Order {
    int G, c;
    __device__ bool next(int i, Unit& u) const {
        const long L = (long)i * G + c; if (L >= 192) return false; int idx = (int)L;
        { const int xcd = idx % 8, off = idx / 8; idx = xcd * 24 + off; }
        const int pm = idx / 3, k3 = idx % 3;
        u.row0 = pm * 256;
        if (k3 == 0) { u.kind = 0; u.pn = 0; u.aux = 0; u.boff = 0u; }
        else { u.kind = 1; u.pn = k3 - 1; u.aux = k3 - 1; u.boff = (unsigned)(WS_SHGUT - WS_ROUT) + (unsigned)(k3 - 1) * (unsigned)(256 * D * 2); }
        u.lrow = u.row0; u.nvalid = 256; return true;
    }
};
struct EpiP9 {
    static constexpr bool PERM = true;
    EpiLogit l; EpiGU g;
    __device__ __forceinline__ void operator()(AccRef acc, const Unit& u, int wr, int wc, int fr, int fq) const { if (u.kind == 0) l(acc, u, wr, wc, fr, fq); else g(acc, u, wr, wc, fr, fq); }
};
#define XB_TMO      128
#define XB_XCNT(j)  (256  + 64 * (j))
#define XB_XSUB(j)  (1280 + 64 * (j))
#define XB_XGEN(j)  (2304 + 64 * (j))
#define XB_TOP      3328
#define XB_TOPGEN   3392
#define XCD_BAR_WORDS 3456
#define XB_SPIN_CAP (1u << 18)

__device__ __forceinline__ unsigned xb_ld(unsigned* p)              { return __hip_atomic_load(p, __ATOMIC_RELAXED, __HIP_MEMORY_SCOPE_AGENT); }
__device__ __forceinline__ unsigned xb_add(unsigned* p, unsigned v) { return __hip_atomic_fetch_add(p, v, __ATOMIC_RELAXED, __HIP_MEMORY_SCOPE_AGENT); }
__device__ __forceinline__ unsigned xb_xcc_id() { return (unsigned)__builtin_amdgcn_s_getreg((3 << 11) | 20) & 0xFu; }
#define XB_SPIN(cond, bar) do { unsigned _sp = 0; while (cond) { __builtin_amdgcn_s_sleep(1); \
    if ((++_sp & 255u) == 0u) { if (xb_ld(&(bar)[XB_TMO])) break; if (_sp > XB_SPIN_CAP) { atomicAdd(&(bar)[XB_TMO], 1u); break; } } } } while (0)

struct XcdBarrier {
    unsigned* bar; unsigned x;
    volatile LAS unsigned* st;
};

__device__ __forceinline__ XcdBarrier xcd_barrier_post(unsigned* bar, volatile LAS unsigned* st) {
    XcdBarrier b; b.bar = bar; b.x = xb_xcc_id(); b.st = st;
    if (threadIdx.x == 0) (void)xb_add(&bar[XB_XCNT(b.x)], 1u);
    return b;
}
__device__ __forceinline__ void xcd_barrier_complete(unsigned* bar, unsigned x, unsigned& nloc, unsigned& nx) {
    const unsigned G = gridDim.x * gridDim.y * gridDim.z;
    unsigned sum, cnt, mine, sp = 0u;
    for (;;) {
        sum = 0u; cnt = 0u; mine = 0u;
#pragma unroll
        for (unsigned j = 0; j < 16; ++j) { const unsigned c = xb_ld(&bar[XB_XCNT(j)]); sum += c; cnt += (c > 0u) ? 1u : 0u; mine = (j == x) ? c : mine; }
        if (sum == G) break;
        __builtin_amdgcn_s_sleep(1);
        if ((++sp & 255u) == 0u) { if (xb_ld(&bar[XB_TMO])) break; if (sp > XB_SPIN_CAP) { atomicAdd(&bar[XB_TMO], 1u); break; } }
    }
    nloc = mine > 0u ? mine : 1u; nx = cnt > 0u ? cnt : 1u;
}

__device__ __forceinline__ void xcd_barrier(const XcdBarrier& b) {
    asm volatile("s_waitcnt vmcnt(0)" ::: "memory");
    __syncthreads();
    if (threadIdx.x == 0) {
        unsigned* bar = b.bar;
        __builtin_amdgcn_s_waitcnt(0);
        unsigned nloc = b.st[0], nx = b.st[1];
        if (nloc == 0u) { xcd_barrier_complete(bar, b.x, nloc, nx); b.st[0] = nloc; b.st[1] = nx; }
        const unsigned old = xb_add(&bar[XB_XSUB(b.x)], 1u);
        const unsigned gen = old / nloc;
        if (old + 1u == (gen + 1u) * nloc) {
            __builtin_amdgcn_fence(__ATOMIC_RELEASE, "agent");
            asm volatile("s_waitcnt vmcnt(0)" ::: "memory");
            const unsigned og = xb_add(&bar[XB_TOP], 1u);
            const unsigned tg = og / nx;
            if (og + 1u == (tg + 1u) * nx) xb_add(&bar[XB_TOPGEN], 1u);
            else XB_SPIN(xb_ld(&bar[XB_TOPGEN]) == tg, bar);
            __builtin_amdgcn_fence(__ATOMIC_ACQUIRE, "agent");
            xb_add(&bar[XB_XGEN(b.x)], 1u);
            asm volatile("s_waitcnt vmcnt(0)" ::: "memory");
        } else {
            XB_SPIN(xb_ld(&bar[XB_XGEN(b.x)]) == gen, bar);
            __builtin_amdgcn_fence(__ATOMIC_ACQUIRE, "agent");
            asm volatile("s_waitcnt vmcnt(0)" ::: "memory");
        }
    }
    __syncthreads();
}


struct Frame {
    LAS unsigned char* lds;
    const Params* p;
    unsigned char* ws;
    int tid, lane, wave, G, bx;
};
#define WSP(T_, off) ((T_*)(F.ws + (off)))

__device__ __forceinline__ void p0_transpose_item(const float* W, int N, bf16_t* WT, int K, int k0, int n0, int row0, LAS float* scr, int lane) {
#pragma unroll 8
    for (int i = 0; i < 32; ++i) { const int kk = 2 * i + (lane >> 5); scr[kk * 33 + (lane & 31)] = W[(size_t)(k0 + kk) * N + n0 + (lane & 31)]; }
    LDS_WAIT(); asm volatile("" ::: "memory");
    const int c = lane & 7;
#pragma unroll
    for (int j = 0; j < 4; ++j) { const int n = (lane >> 3) + 8 * j; const LAS float* s = scr + (8 * c) * 33 + n;
        u32x4 o; o.x = pk2(s[0 * 33], s[1 * 33]); o.y = pk2(s[2 * 33], s[3 * 33]); o.z = pk2(s[4 * 33], s[5 * 33]); o.w = pk2(s[6 * 33], s[7 * 33]);
        *(u32x4*)(WT + (size_t)(row0 + n) * K + k0 + 8 * c) = o; }
    LDS_WAIT(); asm volatile("" ::: "memory");
}
__device__ __forceinline__ int gu_row(int n0, int up) { return (n0 >> 7) * 256 + up * 128 + (n0 & 127); }

__device__ __forceinline__ void p0_transposes(Frame& F) {
    LAS float* scr = (LAS float*)(F.lds + F.wave * 16384);
    const int gw = F.bx * 8 + F.wave, NGW = F.G * 8;
    const float* const* in = F.p->in;
    constexpr int I_WIN_ = 16 * 192, I_WHY_ = 8 * 32, I_WHG_ = 8 * 32, I_WOUT_ = 16 * 32, I_R_ = 16 * 8, I_SG_ = 16 * 8, I_SU_ = 16 * 8, I_SD_ = 4 * 32;
    constexpr int NSMALL = I_WIN_ + I_WHY_ + I_WHG_ + I_WOUT_ + I_R_ + I_SG_ + I_SU_ + I_SD_;
    for (int it = gw; it < NSMALL; it += NGW) {
        int r = it;
        {
            if (r < I_WIN_) { const int kb = r / 192, nb = r % 192, n0 = nb * 32; const int f0 = (n0 >= 1536 && n0 < 2048) ? n0 + 512 : ((n0 >= 2048 && n0 < 2560) ? n0 - 512 : n0);
                p0_transpose_item(in[I_WIN], INC, WSP(bf16_t, WS_WINT), D, kb * 64, n0, f0, scr, F.lane); continue; } r -= I_WIN_;
            if (r < I_WHY_) { p0_transpose_item(in[I_WHY], D, WSP(bf16_t, WS_WHYT), HYW, (r / 32) * 64, (r % 32) * 32, (r % 32) * 32, scr, F.lane); continue; } r -= I_WHY_;
            if (r < I_WHG_) { p0_transpose_item(in[I_WHG], D, WSP(bf16_t, WS_WHGT), HGW, (r / 32) * 64, (r % 32) * 32, (r % 32) * 32, scr, F.lane); continue; } r -= I_WHG_;
            if (r < I_WOUT_) { p0_transpose_item(in[I_WOUT], D, WSP(bf16_t, WS_WOUTT), D, (r / 32) * 64, (r % 32) * 32, (r % 32) * 32, scr, F.lane); continue; } r -= I_WOUT_;
            if (r < I_R_) { p0_transpose_item(in[I_RW], NE, WSP(bf16_t, WS_ROUT), D, (r / 8) * 64, (r % 8) * 32, (r % 8) * 32, scr, F.lane); continue; } r -= I_R_;
            if (r < I_SG_) { p0_transpose_item(in[I_SG], EH, WSP(bf16_t, WS_SHGUT), D, (r / 8) * 64, (r % 8) * 32, gu_row((r % 8) * 32, 0), scr, F.lane); continue; } r -= I_SG_;
            if (r < I_SU_) { p0_transpose_item(in[I_SU], EH, WSP(bf16_t, WS_SHGUT), D, (r / 8) * 64, (r % 8) * 32, gu_row((r % 8) * 32, 1), scr, F.lane); continue; } r -= I_SU_;
            p0_transpose_item(in[I_SD], D, WSP(bf16_t, WS_SHDT), EH, (r / 32) * 64, (r % 32) * 32, (r % 32) * 32, scr, F.lane); continue;
        }
    }
}

template <int MODE  >
__device__ __forceinline__ void p0_x256_load(const float* W, int N, int k0, int n0, int tid, f32x4 (&v)[8]) {
    const int n4 = MODE ? ((tid >> 6) * 8 + (tid & 7)) : (tid & 63), kq = MODE ? ((tid >> 3) & 7) : (tid >> 6); const float* src = W + (size_t)(k0 + 8 * kq) * N + n0 + 4 * n4;
#pragma unroll
    for (int r = 0; r < 8; ++r) v[r] = __builtin_nontemporal_load((const f32x4*)(src + (size_t)r * N));
}
__device__ __forceinline__ void p0_x256_store(LAS unsigned char* ts, bf16_t* WT, int K, int k0, int row0, int mode, int tid, const f32x4 (&v)[8]) {
    const int n4 = tid & 63, kq = tid >> 6;
    __syncthreads();
#pragma unroll
    for (int i = 0; i < 4; ++i) { const int n = 4 * n4 + i;
        u32x4 o; o.x = pk2(v[0][i], v[1][i]); o.y = pk2(v[2][i], v[3][i]); o.z = pk2(v[4][i], v[5][i]); o.w = pk2(v[6][i], v[7][i]);
        *(LAS u32x4*)(ts + n * 128 + ((kq ^ (n4 & 7)) << 4)) = o; }
    __syncthreads();
#pragma unroll
    for (int q = 0; q < 4; ++q) { const int task = tid + 512 * q, n = task >> 3, part = task & 7;
        const u32x4 o = *(const LAS u32x4*)(ts + n * 128 + ((part ^ ((n >> 2) & 7)) << 4));
        const int row = mode == 0 ? row0 + n : ((n >> 7) * 256 + (mode - 1) * 128 + (n & 127));
        *(u32x4*)(WT + (size_t)(k0 >> 6) * K + row * 64 + 8 * part) = o; }
}
__device__ __forceinline__ void p0_x256_decode(const float* const* in, unsigned char* ws, int item, const float*& W, int& N, bf16_t*& WT, int& K, int& k0, int& n0, int& mode) {
    const int e = item / 48, r = item % 48;
    if (r < 16) { W = in[I_EG] + (size_t)e * D * EH; N = EH; WT = (bf16_t*)(ws + WS_EGUT) + (size_t)e * 512 * D; K = 512 * 64; k0 = r * 64; n0 = 0; mode = 1; }
    else if (r < 32) { W = in[I_EU] + (size_t)e * D * EH; N = EH; WT = (bf16_t*)(ws + WS_EGUT) + (size_t)e * 512 * D; K = 512 * 64; k0 = (r - 16) * 64; n0 = 0; mode = 2; }
    else { const int q = r - 32; W = in[I_ED] + (size_t)e * EH * D; N = D; WT = (bf16_t*)(ws + WS_EDT) + (size_t)e * D * EH; K = D * 64; k0 = (q >> 2) * 64; n0 = (q & 3) * 256; mode = 0; }
}
struct XpState { f32x4 v[8]; int it, end, stride; bool live; };
__device__ __forceinline__ void xp_issue(XpState& s, const float* const* in, unsigned char* ws, int tid) {
    s.live = s.it < s.end;
    if (s.live) { const float* W; int N, K, k0, n0, mode; bf16_t* WT; p0_x256_decode(in, ws, s.it, W, N, WT, K, k0, n0, mode); p0_x256_load<1>(W, N, k0, n0, tid, s.v); }
}
__device__ __forceinline__ void xp_finish(XpState& s, const float* const* in, unsigned char* ws, int tid) {
    if (s.live) { const float* W; int N, K, k0, n0, mode; bf16_t* WT; p0_x256_decode(in, ws, s.it, W, N, WT, K, k0, n0, mode);
        const int n4 = (tid >> 6) * 8 + (tid & 7), kq = (tid >> 3) & 7;
#pragma unroll
        for (int i = 0; i < 4; ++i) { const int n = 4 * n4 + i; const int row = mode == 0 ? n0 + n : ((n >> 7) * 256 + (mode - 1) * 128 + (n & 127));
            u32x4 o; o.x = pk2(s.v[0][i], s.v[1][i]); o.y = pk2(s.v[2][i], s.v[3][i]); o.z = pk2(s.v[4][i], s.v[5][i]); o.w = pk2(s.v[6][i], s.v[7][i]);
            *(u32x4*)(WT + (size_t)(k0 >> 6) * K + row * 64 + 8 * kq) = o; }
        s.it += s.stride; s.live = false; }
}
__device__ __forceinline__ void xp_step(XpState& s, const float* const* in, unsigned char* ws, int tid) { xp_finish(s, in, ws, tid); xp_issue(s, in, ws, tid); }
constexpr int XP_BG = 30;

__device__ __forceinline__ void p0_expert_transposes(Frame& F) {
    int tid = F.tid; asm volatile("" : "+v"(tid));
    constexpr int NIT = NE * 48;
    int it = F.bx + XP_BG * F.G; if (it >= NIT) return;
    const float* W; int N, K, k0, n0, mode; bf16_t* WT;
    const float* W2; int N2, K2, k2, n2, mode2; bf16_t* WT2;
    f32x4 va[8], vb[8];
    p0_x256_decode(F.p->in, F.ws, it, W, N, WT, K, k0, n0, mode);
    p0_x256_load<0>(W, N, k0, n0, tid, va);
    for (;;) {
        __builtin_amdgcn_s_waitcnt(0);
        int nx = it + F.G; bool has = nx < NIT;
        if (has) { p0_x256_decode(F.p->in, F.ws, nx, W2, N2, WT2, K2, k2, n2, mode2); p0_x256_load<0>(W2, N2, k2, n2, tid, vb); }
        p0_x256_store(F.lds, WT, K, k0, n0, mode, tid, va);
        if (!has) break;
        it = nx;
        __builtin_amdgcn_s_waitcnt(0);
        nx = it + F.G; has = nx < NIT;
        if (has) { p0_x256_decode(F.p->in, F.ws, nx, W, N, WT, K, k0, n0, mode); p0_x256_load<0>(W, N, k0, n0, tid, va); }
        p0_x256_store(F.lds, WT2, K2, k2, n2, mode2, tid, vb);
        if (!has) break;
        it = nx;
    }
}

constexpr int ADA_KC = 4;
__device__ __forceinline__ void p0_ada_item(Frame& F, int item) {
    const int kc = item / 12, cb = item % 12, col = cb * 512 + F.tid;
    const float* in_c = F.p->in[I_C]; const float* in_cc = F.p->in[I_CCTX]; const float* w = F.p->in[I_ADAW];
    LAS float* sv = (LAS float*)F.lds;
    __syncthreads();
    for (int i = F.tid; i < 768; i += 512) { const int wh = i >> 8, k = kc * 256 + (i & 255); sv[i] = siluf_(wh == 0 ? in_c[k] : (wh == 1 ? in_c[D + k] : in_cc[k])); }
    __syncthreads();
    float a0 = 0.f, a1 = 0.f, a2 = 0.f;
    const float* wp = w + (size_t)(kc * 256) * 6144 + col;
#pragma unroll 16
    for (int k = 0; k < 256; ++k) { const float wv = wp[(size_t)k * 6144]; a0 += sv[k] * wv; a1 += sv[256 + k] * wv; a2 += sv[512 + k] * wv; }
    float* o = WSP(float, WS_ADAP) + (size_t)kc * 3 * 6144 + col;
    o[0] = a0; o[6144] = a1; o[2 * 6144] = a2;
}

__device__ __forceinline__ void p0_filter_item(Frame& F, int item) {
    LAS float* zb = (LAS float*)F.lds;
    LAS float* ab1 = zb + 32 * 36;
    LAS float* ab2 = ab1 + 32 * 64;
    const float* const* in = F.p->in; const int t0 = item * 32; int tid = F.tid; asm volatile("" : "+v"(tid));
    __syncthreads();
    for (int idx = tid; idx < 32 * 33; idx += 512) { const int t = idx / 33, e = idx % 33; const float tf = (float)(t0 + t); float v;
        if (e == 0) v = tf / (float)(SEQ - 1);
        else { const int k = (e - 1) & 15; const float band = 1e-4f + (float)k * ((15.0f - 1e-4f) / 15.0f); float sn, cs; sincospif(2.0f * tf * band / (float)SEQ, &sn, &cs); v = (e <= 16) ? cs : -sn; }
        zb[t * 36 + e] = v; }
    __syncthreads();
    {
        const int t = tid >> 4, jj = tid & 15;
#pragma unroll 1
        for (int q = 0; q < 4; ++q) { const int j = jj + 16 * q; float s = in[I_FB1][j];
#pragma unroll 3
            for (int e = 0; e < 33; ++e) s += zb[t * 36 + e] * in[I_FW1][e * 64 + j];
            ab1[t * 64 + j] = sinf(in[I_FFREQ][j] * s); }
    }
    __syncthreads();
    { const int t = tid >> 4, jj = tid & 15;
#pragma unroll 1
        for (int q = 0; q < 4; ++q) { const int j = jj + 16 * q; float s = in[I_FB2][j];
#pragma unroll 4
            for (int e = 0; e < 64; ++e) s += ab1[t * 64 + e] * in[I_FW2][e * 64 + j];
            ab2[t * 64 + j] = sinf(in[I_FFREQ][j] * s); }
    }
    __syncthreads();
    { const int t = tid >> 4, jj = tid & 15;
#pragma unroll 1
        for (int q = 0; q < 4; ++q) { const int j = jj + 16 * q; float s = in[I_FB3][j];
#pragma unroll 4
            for (int e = 0; e < 64; ++e) s += ab2[t * 64 + e] * in[I_FW3][e * 64 + j];
            ab1[t * 64 + j] = sinf(in[I_FFREQ][j] * s); }
    }
    __syncthreads();
    const float* w4 = in[I_FW4];
    const float MIND = -3.0701134573253945f, MAXD = -15.350567286626973f;
    const float delta = fabsf(MIND + (MAXD - MIND) * ((float)tid / 511.0f));
    bf16_t* hf = WSP(bf16_t, WS_HF);
#pragma unroll 1
    for (int half = 0; half < 4; ++half) {
        f32x2 acc[8][2];
#pragma unroll
        for (int t = 0; t < 8; ++t) { acc[t][0] = (f32x2){0.f, 0.f}; acc[t][1] = (f32x2){0.f, 0.f}; }
        f32x2 wa[4][2], wb[4][2];
#pragma unroll
        for (int jj = 0; jj < 4; ++jj) { wa[jj][0] = (f32x2){w4[(size_t)jj * 2048 + tid], w4[(size_t)jj * 2048 + tid + 512]}; wa[jj][1] = (f32x2){w4[(size_t)jj * 2048 + tid + 1024], w4[(size_t)jj * 2048 + tid + 1536]}; }
#pragma unroll 1
        for (int j4 = 0; j4 < 16; j4 += 2) {
#pragma unroll
            for (int jj = 0; jj < 4; ++jj) { const size_t o = (size_t)(4 * (j4 + 1) + jj) * 2048 + tid; wb[jj][0] = (f32x2){w4[o], w4[o + 512]}; wb[jj][1] = (f32x2){w4[o + 1024], w4[o + 1536]}; }
#pragma unroll
            for (int t = 0; t < 8; ++t) { const f32x4 a = *(const LAS f32x4*)(ab1 + (8 * half + t) * 64 + 4 * j4);
#pragma unroll
                for (int jj = 0; jj < 4; ++jj) { const f32x2 aa = (f32x2){a[jj], a[jj]}; acc[t][0] += aa * wa[jj][0]; acc[t][1] += aa * wa[jj][1]; } }
            if (j4 + 2 < 16) {
#pragma unroll
                for (int jj = 0; jj < 4; ++jj) { const size_t o = (size_t)(4 * (j4 + 2) + jj) * 2048 + tid; wa[jj][0] = (f32x2){w4[o], w4[o + 512]}; wa[jj][1] = (f32x2){w4[o + 1024], w4[o + 1536]}; } }
#pragma unroll
            for (int t = 0; t < 8; ++t) { const f32x4 a = *(const LAS f32x4*)(ab1 + (8 * half + t) * 64 + 4 * (j4 + 1));
#pragma unroll
                for (int jj = 0; jj < 4; ++jj) { const f32x2 aa = (f32x2){a[jj], a[jj]}; acc[t][0] += aa * wb[jj][0]; acc[t][1] += aa * wb[jj][1]; } }
        }
#pragma unroll
        for (int t4 = 0; t4 < 2; ++t4) { const int tb = t0 + 8 * half + 4 * t4;
            float dc[4];
#pragma unroll
            for (int k = 0; k < 4; ++k) dc[k] = expf(-((float)(tb + k) / (float)(SEQ - 1)) * delta);
#pragma unroll
            for (int i = 0; i < 4; ++i)
                *(u32x2*)(hf + (size_t)(tid + 512 * i) * SEQ + tb) = (u32x2){pk2(acc[4 * t4][i >> 1][i & 1] * dc[0], acc[4 * t4 + 1][i >> 1][i & 1] * dc[1]), pk2(acc[4 * t4 + 2][i >> 1][i & 1] * dc[2], acc[4 * t4 + 3][i >> 1][i & 1] * dc[3])};
        }
    }
}

__device__ __forceinline__ void p0_tables(Frame& F, int item) {
    if (item < 6) {
        const int idx = item * 16384 + F.tid * 32;
        for (int k = 0; k < 32; ++k) { const int id = idx + k; if (id >= 192 * 512) break;
            const int row = id >> 9, col = id & 511, i = col & 255; const float omega = 1.0f / powf(10000.0f, (float)i / 256.0f);
            const float pos = (float)(row < 128 ? row : row - 128); const float ang = pos * omega;
            const float v = (col < 256) ? sinf(ang) : cosf(ang);
            if (row < 128) WSP(float, WS_POSR)[row * 512 + col] = v; else WSP(float, WS_POSC)[(row - 128) * 512 + col] = v; }
    } else {
        for (int id = F.tid; id < 1024; id += 512) { const float l0 = F.p->in[I_LBL][id], l1 = F.p->in[I_LBL][1024 + id];
            WSP(float, WS_LBS)[id] = 1.0f / (1.0f + expf(l1 - l0)); }
    }
}

__device__ __forceinline__ void phase0(Frame& F) {
    for (int it = F.bx; it < 311; it += F.G) {
        if (it < 48) p0_ada_item(F, it);
        else if (it < 304) p0_filter_item(F, it - 48);
        else p0_tables(F, it - 304);
    }
    __syncthreads();
    p0_transposes(F);
    __syncthreads();
    p0_expert_transposes(F);
}

__device__ __forceinline__ void phase1(Frame& F) {
    const float* adap = WSP(float, WS_ADAP); const float* adab = F.p->in[I_ADAB];
    { const int gid = F.bx * 512 + F.tid; if (gid < 3 * 6144) { const int wh = gid / 6144, col = gid % 6144; float s = adab[col];
#pragma unroll
        for (int kc = 0; kc < ADA_KC; ++kc) s += adap[(size_t)(kc * 3 + wh) * 6144 + col]; WSP(float, WS_ADA)[gid] = s; } }
    LAS float* md = (LAS float*)F.lds;
    __syncthreads();
    for (int id = F.tid; id < 3 * 2048; id += 512) { const int wh = id >> 11, col = id & 2047; float s = adab[col];
#pragma unroll
        for (int kc = 0; kc < ADA_KC; ++kc) s += adap[(size_t)(kc * 3 + wh) * 6144 + col]; md[id] = s; }
    __syncthreads();
    const float* x = F.p->in[I_X]; const float* ctx = F.p->in[I_CTX]; const float* g1 = F.p->in[I_N1G];
    const float* posr = WSP(float, WS_POSR); const float* posc = WSP(float, WS_POSC); bf16_t* a1 = WSP(bf16_t, WS_A1);
    const int lane = F.lane;
#define P1_GG() f32x4 ggv[4]; _Pragma("unroll") for (int j = 0; j < 4; ++j) ggv[j] = *(const f32x4*)(g1 + 256 * j + 4 * lane)
#define P1_ROWS4(r0) do { f32x4 v[4][4]; const int wh = (r0) < T ? ((r0) >> 13) : 2; \
        _Pragma("unroll") for (int q = 0; q < 4; ++q) { const int r = (r0) + q; \
            if ((r0) < T) { const int n = r & (SEQ - 1); const f32x4* xr = (const f32x4*)(x + (size_t)r * D) + lane; \
                _Pragma("unroll") for (int j = 0; j < 4; ++j) { const int c = 256 * j + 4 * lane; const f32x4 pe = (c < 512) ? *(const f32x4*)(posr + (n >> 6) * 512 + c) : *(const f32x4*)(posc + (n & 63) * 512 + c - 512); v[q][j] = xr[64 * j] + pe; } \
            } else { const f32x4* xr = (const f32x4*)(ctx + (size_t)(r - T) * D) + lane; \
                _Pragma("unroll") for (int j = 0; j < 4; ++j) v[q][j] = xr[64 * j]; } } \
        _Pragma("unroll") for (int q = 0; q < 4; ++q) { float ss = 0.f; \
            _Pragma("unroll") for (int j = 0; j < 4; ++j) ss += (v[q][j][0] * v[q][j][0] + v[q][j][1] * v[q][j][1]) + (v[q][j][2] * v[q][j][2] + v[q][j][3] * v[q][j][3]); \
            const float rs = rsqrtf(wave_sum(ss) * (1.0f / D) + EPS); \
            u32x2* o8 = (u32x2*)(a1 + (size_t)((r0) + q) * D) + lane; \
            _Pragma("unroll") for (int j = 0; j < 4; ++j) { const int c = 256 * j + 4 * lane; const f32x4 gg = ggv[j]; \
                const f32x4 sh = *(const LAS f32x4*)(md + wh * 2048 + c), sc = *(const LAS f32x4*)(md + wh * 2048 + 1024 + c); \
                const f32x4 y = v[q][j] * rs * gg * (sc + 1.0f) + sh; \
                u32x2 w; w.x = pk2(y[0], y[1]); w.y = pk2(y[2], y[3]); o8[64 * j] = w; } } } while (0)
    const int nded = F.G > 24 ? 12 : 0;
    if (F.bx >= nded) { const int gw = (F.bx - nded) * 8 + F.wave, NGW = (F.G - nded) * 8; P1_GG();
        for (int r0 = gw * 4; r0 < T; r0 += NGW * 4) P1_ROWS4(r0); }
    for (int idx = F.bx; idx < 12; idx += (nded ? 12 : F.G)) {
        if (nded && F.bx >= 12) break;
        const int rbase = T + CtxUnit::tile(idx) * 256 + F.wave * 32;
        { P1_GG(); for (int i = 0; i < 32; i += 4) P1_ROWS4(rbase + i); }
        asm volatile("s_waitcnt vmcnt(0)" ::: "memory"); __syncthreads();
        { pg8::Gemm g{WSP(bf16_t, WS_WINT), WSP(bf16_t, WS_WINT), D, nullptr, 2 * D, 128}; CtxUnit S{idx};
          EpiIn E{EpiInT{WSP(bf16_t, WS_PHYT), WSP(bf16_t, WS_VT)}, EpiInN{WSP(bf16_t, WS_Q), WSP(bf16_t, WS_G), WSP(bf16_t, WS_SG1), WSP(bf16_t, WS_SG2), WSP(float, WS_LF), WSP(float, WS_LB), WSP(float, WS_LBS)}};
          pg8::gemm_phase<EpiIn, CtxUnit, false>(F.lds, g, S, E); }
        if (!nded) { __syncthreads(); for (int id = F.tid; id < 3 * 2048; id += 512) { const int wh = id >> 11, col = id & 2047; float s = adab[col];
            for (int kc = 0; kc < ADA_KC; ++kc) s += adap[(size_t)(kc * 3 + wh) * 6144 + col]; md[id] = s; } __syncthreads(); }
    }
#undef P1_ROWS4
#undef P1_GG
}

__device__ __forceinline__ void phase_h2(Frame& F) {
    const float* x1 = F.p->out; const float* g2 = F.p->in[I_N2G]; const float* ada = WSP(float, WS_ADA); bf16_t* h2 = WSP(bf16_t, WS_H2);
    const int gw = F.bx * 8 + F.wave, NGW = F.G * 8, lane = F.lane;
    f32x4 ggv[4];
#pragma unroll
    for (int j = 0; j < 4; ++j) ggv[j] = *(const f32x4*)(g2 + 256 * j + 4 * lane);
    const bool al = (F.G == 256); const int vw = ((F.bx & 7) * 32 + (F.bx >> 3)) * 8 + F.wave;
    for (int r0 = al ? vw * 8 : gw * 4, it_ = 0; al ? it_ < 2 : r0 < T; r0 += al ? 4 : NGW * 4, ++it_) { const int b = r0 >> 13;
        f32x4 v[4][4], shv[4], scv[4];
#pragma unroll
        for (int j = 0; j < 4; ++j) { const int c = 256 * j + 4 * lane; shv[j] = *(const f32x4*)(ada + b * 6144 + 3 * D + c); scv[j] = *(const f32x4*)(ada + b * 6144 + 4 * D + c); }
#pragma unroll
        for (int q = 0; q < 4; ++q) { const f32x4* xr = (const f32x4*)(x1 + (size_t)(r0 + q) * D) + lane;
#pragma unroll
            for (int j = 0; j < 4; ++j) v[q][j] = xr[64 * j]; }
#pragma unroll
        for (int q = 0; q < 4; ++q) { float ss = 0.f;
#pragma unroll
            for (int j = 0; j < 4; ++j) ss += (v[q][j][0] * v[q][j][0] + v[q][j][1] * v[q][j][1]) + (v[q][j][2] * v[q][j][2] + v[q][j][3] * v[q][j][3]);
            const float rs = rsqrtf(wave_sum(ss) * (1.0f / D) + EPS);
            u32x2* o8 = (u32x2*)(h2 + (size_t)(r0 + q) * D) + lane;
#pragma unroll
            for (int j = 0; j < 4; ++j) { const f32x4 gg = ggv[j], sh = shv[j], sc = scv[j];
                const f32x4 y = v[q][j] * rs * gg * (sc + 1.0f) + sh;
                u32x2 w; w.x = pk2(y[0], y[1]); w.y = pk2(y[2], y[3]); o8[64 * j] = w; } }
    }
}
constexpr int FPAD = 17920;
__device__ __forceinline__ int fphys(int i) { return i + (i >> 4) + ((i >> 9) << 4); }
__device__ constexpr float TWC[16] = {1.0f, 0.98078528040323044913f, 0.92387953251128675613f, 0.83146961230254523708f, 0.70710678118654752440f, 0.55557023301960222474f, 0.38268343236508977173f, 0.19509032201612826785f,
                                      0.0f, -0.19509032201612826785f, -0.38268343236508977173f, -0.55557023301960222474f, -0.70710678118654752440f, -0.83146961230254523708f, -0.92387953251128675613f, -0.98078528040323044913f};
__device__ constexpr float TWS[16] = {0.0f, 0.19509032201612826785f, 0.38268343236508977173f, 0.55557023301960222474f, 0.70710678118654752440f, 0.83146961230254523708f, 0.92387953251128675613f, 0.98078528040323044913f,
                                      1.0f, 0.98078528040323044913f, 0.92387953251128675613f, 0.83146961230254523708f, 0.70710678118654752440f, 0.55557023301960222474f, 0.38268343236508977173f, 0.19509032201612826785f};
__host__ __device__ constexpr int brev_c(int x, int bits) { int r = 0; for (int i = 0; i < bits; ++i) r = (r << 1) | ((x >> i) & 1); return r; }

typedef f32x2 cpx;
__device__ __forceinline__ cpx cmul(cpx a, cpx w) { return (cpx){a.x, a.x} * w + (cpx){a.y, a.y} * (cpx){-w.y, w.x}; }
template <int S0, int R, bool INV, bool ZHI = false, bool OLO = false>
__device__ __forceinline__ void fft_pass(LAS cpx* X, int tid) {
    constexpr int LOW = 14 - S0 - R, NR = 1 << R, NTASK = (1 << (14 - R)) / 512;
    asm volatile("" : "+v"(tid));
#pragma unroll 1
    for (int task = 0; task < NTASK; ++task) {
        const int g = tid + 512 * task;
        const int blo = g & ((1 << LOW) - 1), bhi = g >> LOW;
        const int base = (bhi << (LOW + R)) | blo;
        cpx v[NR];
#pragma unroll
        for (int j = 0; j < NR; ++j) { if (ZHI && j >= NR / 2) v[j] = (cpx){0.f, 0.f}; else v[j] = X[fphys(base | (j << LOW))]; }
        cpx w0 = (cpx){1.f, 0.f};
        if (LOW > 0) { float s, c; sincospif(-(float)blo * (1.0f / (float)(1 << (13 - S0))), &s, &c); w0 = (cpx){c, INV ? -s : s}; }
        if (INV && LOW > 0) {
            cpx cw = w0;
#pragma unroll
            for (int m = 1; m < NR; ++m) { const int j = brev_c(m, R); v[j] = cmul(v[j], cw); if (m + 1 < NR) cw = cmul(cw, w0); }
        }
        if (!INV) {
#pragma unroll
            for (int q = 0; q < R; ++q) { const int hj = 1 << (R - 1 - q);
#pragma unroll
                for (int j = 0; j < NR; ++j) { if (j & hj) continue; const int k32 = (j & (hj - 1)) << (5 - R + q);
                    cpx d;
                    if (ZHI && q == 0) d = v[j];
                    else { const cpx a = v[j], bb = v[j + hj]; v[j] = a + bb; d = a - bb; }
                    if (k32 == 0) v[j + hj] = d;
                    else if (k32 == 8) v[j + hj] = (cpx){d.y, -d.x};
                    else v[j + hj] = cmul(d, (cpx){TWC[k32], -TWS[k32]}); } }
        } else {
#pragma unroll
            for (int q = R - 1; q >= 0; --q) { const int hj = 1 << (R - 1 - q);
#pragma unroll
                for (int j = 0; j < NR; ++j) { if (j & hj) continue; const int k32 = (j & (hj - 1)) << (5 - R + q);
                    const cpx p = v[j], bb = v[j + hj]; cpx t;
                    if (k32 == 0) t = bb;
                    else if (k32 == 8) t = (cpx){-bb.y, bb.x};
                    else t = cmul(bb, (cpx){TWC[k32], TWS[k32]});
                    v[j] = p + t; if (!(OLO && q == 0)) v[j + hj] = p - t; } }
        }
        if (!INV && LOW > 0) {
            cpx cw = w0;
#pragma unroll
            for (int m = 1; m < NR; ++m) { const int j = brev_c(m, R); v[j] = cmul(v[j], cw); if (m + 1 < NR) cw = cmul(cw, w0); }
        }
#pragma unroll
        for (int j = 0; j < NR; ++j) { if (OLO && j >= NR / 2) continue; X[fphys(base | (j << LOW))] = v[j]; }
    }
}
#define XP_HOOK() xp_step(xp, F.p->in, F.ws, tid)
template <bool ZHI> __device__ __forceinline__ void fft_fwd(Frame& F, XpState& xp, LAS cpx* X, int tid) {
    fft_pass<0, 5, false, ZHI>(X, tid); __syncthreads(); XP_HOOK(); fft_pass<5, 5, false>(X, tid); __syncthreads(); XP_HOOK(); fft_pass<10, 4, false>(X, tid); __syncthreads(); XP_HOOK();
}
__device__ __forceinline__ void fft_inv(Frame& F, XpState& xp, LAS cpx* X, int tid) {
    fft_pass<10, 4, true>(X, tid); __syncthreads(); XP_HOOK(); fft_pass<5, 5, true>(X, tid); __syncthreads(); XP_HOOK(); fft_pass<0, 5, true, false, true>(X, tid); __syncthreads(); XP_HOOK();
}
struct SC8 { u32x4 c; unsigned l, r; };
__device__ __forceinline__ SC8 sconv8_load(const bf16_t* p, int n) {
    SC8 s; s.c = *(const u32x4*)(p + n); s.l = n > 0 ? (unsigned)p[n - 1] : 0u; s.r = n + 8 < SEQ ? (unsigned)p[n + 8] : 0u; return s;
}
__device__ __forceinline__ void sconv8_eval(const SC8& s, float w0, float w1, float w2, float bias, float (&o)[8]) {
    float v[10]; v[0] = bf2f(s.l); v[1] = bflo(s.c.x); v[2] = bfhi(s.c.x); v[3] = bflo(s.c.y); v[4] = bfhi(s.c.y); v[5] = bflo(s.c.z); v[6] = bfhi(s.c.z); v[7] = bflo(s.c.w); v[8] = bfhi(s.c.w); v[9] = bf2f(s.r);
#pragma unroll
    for (int i = 0; i < 8; ++i) o[i] = w0 * v[i] + w1 * v[i + 1] + w2 * v[i + 2] + bias;
}
__device__ __forceinline__ void hyena_item(Frame& F, int c, XpState& xp) {
    LAS cpx* X = (LAS cpx*)F.lds; LAS float* red = (LAS float*)(F.lds + (size_t)FPAD * 8);
    int tid = F.tid; asm volatile("" : "+v"(tid));
    const bf16_t* hf = WSP(bf16_t, WS_HF);
    __syncthreads();
    float s0 = 0.f, s1 = 0.f;
    {
        f32x4 fa[4], fb[4], ba[4], bb[4];
#pragma unroll
        for (int it = 0; it < 4; ++it) { const int j = 4 * (tid + 512 * it);
            const u32x2 w0 = *(const u32x2*)(hf + (size_t)c * SEQ + j), w1 = *(const u32x2*)(hf + (size_t)(1024 + c) * SEQ + j), w2 = *(const u32x2*)(hf + (size_t)(512 + c) * SEQ + j), w3 = *(const u32x2*)(hf + (size_t)(1536 + c) * SEQ + j);
            fa[it] = (f32x4){bflo(w0.x), bfhi(w0.x), bflo(w0.y), bfhi(w0.y)}; fb[it] = (f32x4){bflo(w1.x), bfhi(w1.x), bflo(w1.y), bfhi(w1.y)};
            ba[it] = (f32x4){bflo(w2.x), bfhi(w2.x), bflo(w2.y), bfhi(w2.y)}; bb[it] = (f32x4){bflo(w3.x), bfhi(w3.x), bflo(w3.y), bfhi(w3.y)}; }
#pragma unroll
        for (int it = 0; it < 4; ++it) { const int j = 4 * (tid + 512 * it);
#pragma unroll
            for (int i = 0; i < 4; ++i) { X[fphys(j + i)] = (cpx){fa[it][i], fb[it][i]}; s0 += fabsf(fa[it][i]); s1 += fabsf(fb[it][i]);
                const int m = j + i; if (m > 0) { X[fphys(FFTN - m)] = (cpx){ba[it][i], bb[it][i]}; s0 += fabsf(ba[it][i]); s1 += fabsf(bb[it][i]); } } }
        if (tid == 0) X[fphys(SEQ)] = (cpx){0.f, 0.f};
    }
    s0 = wave_sum(s0); s1 = wave_sum(s1);
    if (F.lane == 0) { red[F.wave] = s0; red[8 + F.wave] = s1; }
    __syncthreads();
    float S0 = 0.f, S1 = 0.f;
#pragma unroll
    for (int w = 0; w < 8; ++w) { S0 += red[w]; S1 += red[8 + w]; }
    fft_fwd<false>(F, xp, X, tid);
    unsigned* ks = WSP(unsigned, WS_KS) + (size_t)F.bx * 2 * FFTN;
    { const float i0 = 1.0f / S0, i1 = 1.0f / S1, sk0 = F.p->in[I_HSKIP][c], sk1 = F.p->in[I_HSKIP][512 + c];
#pragma unroll 8
        for (int it = 0; it < 32; ++it) { const int p = tid + 512 * it; const int k = (int)(__brev((unsigned)p) >> 18); const int pp = (int)(__brev((unsigned)((FFTN - k) & (FFTN - 1))) >> 18);
            const cpx A = X[fphys(p)], B = X[fphys(pp)];
            const float k1r = 0.5f * (A.x + B.x), k1i = 0.5f * (A.y - B.y), k2r = 0.5f * (A.y + B.y), k2i = -0.5f * (A.x - B.x);
            ks[p] = pkh2(k1r * i0 + sk0, k1i * i0); ks[FFTN + p] = pkh2(k2r * i1 + sk1, k2i * i1); } }
    __syncthreads();
    const bf16_t* ph = WSP(bf16_t, WS_PHYT); const float* cw = F.p->in[I_HCW]; const float* cb = F.p->in[I_HCB];
    { const float w0 = cw[c], w1 = cw[HYP + c], w2 = cw[2 * HYP + c], bs = cb[c];
        SC8 sa[2], sb[2];
#pragma unroll
        for (int it = 0; it < 2; ++it) { const int n = 8 * (tid + 512 * it); sa[it] = sconv8_load(ph + (size_t)c * SEQ, n); sb[it] = sconv8_load(ph + (size_t)(HYP + c) * SEQ, n); }
#pragma unroll
        for (int it = 0; it < 2; ++it) { const int n = 8 * (tid + 512 * it); float a[8], b[8]; sconv8_eval(sa[it], w0, w1, w2, bs, a); sconv8_eval(sb[it], w0, w1, w2, bs, b);
#pragma unroll
            for (int i = 0; i < 8; ++i) X[fphys(n + i)] = (cpx){a[i], b[i]}; } }
    __syncthreads();
    fft_fwd<true>(F, xp, X, tid);
    { unsigned kk[32]; const float invN = 1.0f / (float)FFTN;
#pragma unroll
        for (int it = 0; it < 32; ++it) kk[it] = ks[tid + 512 * it];
#pragma unroll
        for (int it = 0; it < 32; ++it) { const int q = fphys(tid + 512 * it); X[q] = cmul(X[q], (cpx){h2f((unsigned short)(kk[it] & 0xffffu)) * invN, h2f((unsigned short)(kk[it] >> 16)) * invN}); } }
    __syncthreads();
    fft_inv(F, xp, X, tid);
    { const int col = HYW + c; const float w0 = cw[col], w1 = cw[HYP + col], w2 = cw[2 * HYP + col], bs = cb[col];
        SC8 sa[2], sb[2];
#pragma unroll
        for (int it = 0; it < 2; ++it) { const int n = 8 * (tid + 512 * it); sa[it] = sconv8_load(ph + (size_t)col * SEQ, n); sb[it] = sconv8_load(ph + (size_t)(HYP + col) * SEQ, n); }
#pragma unroll
        for (int it = 0; it < 2; ++it) { const int n = 8 * (tid + 512 * it); float a[8], b[8]; sconv8_eval(sa[it], w0, w1, w2, bs, a); sconv8_eval(sb[it], w0, w1, w2, bs, b);
#pragma unroll
            for (int i = 0; i < 8; ++i) { const int q = fphys(n + i); X[q] = X[q] * (cpx){a[i], b[i]}; } } }
    __syncthreads();
    fft_fwd<true>(F, xp, X, tid);
    { unsigned kk[32]; const float invN = 1.0f / (float)FFTN;
#pragma unroll
        for (int it = 0; it < 32; ++it) kk[it] = ks[FFTN + tid + 512 * it];
#pragma unroll
        for (int it = 0; it < 32; ++it) { const int q = fphys(tid + 512 * it); X[q] = cmul(X[q], (cpx){h2f((unsigned short)(kk[it] & 0xffffu)) * invN, h2f((unsigned short)(kk[it] >> 16)) * invN}); } }
    __syncthreads();
    fft_inv(F, xp, X, tid);
    { const int col = 2 * HYW + c; const float w0 = cw[col], w1 = cw[HYP + col], w2 = cw[2 * HYP + col], bs = cb[col];
        bf16_t* yt = WSP(bf16_t, WS_YHYT);
        SC8 sa[2], sb[2]; u32x4 oa[2], ob[2];
#pragma unroll
        for (int it = 0; it < 2; ++it) { const int n = 8 * (tid + 512 * it); sa[it] = sconv8_load(ph + (size_t)col * SEQ, n); sb[it] = sconv8_load(ph + (size_t)(HYP + col) * SEQ, n); }
#pragma unroll
        for (int it = 0; it < 2; ++it) { const int n = 8 * (tid + 512 * it); float a[8], b[8]; sconv8_eval(sa[it], w0, w1, w2, bs, a); sconv8_eval(sb[it], w0, w1, w2, bs, b);
            cpx y[8];
#pragma unroll
            for (int i = 0; i < 8; ++i) y[i] = X[fphys(n + i)];
            oa[it] = (u32x4){pk2(y[0].x * a[0], y[1].x * a[1]), pk2(y[2].x * a[2], y[3].x * a[3]), pk2(y[4].x * a[4], y[5].x * a[5]), pk2(y[6].x * a[6], y[7].x * a[7])};
            ob[it] = (u32x4){pk2(y[0].y * b[0], y[1].y * b[1]), pk2(y[2].y * b[2], y[3].y * b[3]), pk2(y[4].y * b[4], y[5].y * b[5]), pk2(y[6].y * b[6], y[7].y * b[7])}; }
#pragma unroll
        for (int it = 0; it < 2; ++it) { const int n = 8 * (tid + 512 * it);
            *(u32x4*)(yt + (size_t)c * SEQ + n) = oa[it]; *(u32x4*)(yt + (size_t)(HYW + c) * SEQ + n) = ob[it]; } }
}

__device__ __forceinline__ bf16x8 lds_frag(const LAS bf16_t* base, int row, int stride, int k) { return *(const LAS bf16x8*)(base + row * stride + k); }
#define MFMA16(a, b, c) __builtin_amdgcn_mfma_f32_16x16x32_bf16(a, b, c, 0, 0, 0)

__device__ __forceinline__ void hg_delta_item(Frame& F, int item) {
    const int chain = item / NCH_EXT, j = item % NCH_EXT, dir = chain & 1, h = (chain >> 1) & 3, b = chain >> 3;
    const int cj = dir == 0 ? j : (j < 4 ? 3 - j : 135 - j), n0 = cj * 64;
    LAS float* segtot = (LAS float*)F.lds;
    LAS bf16_t* Kt = (LAS bf16_t*)(F.lds + 4096);
    LAS bf16_t* VTs = (LAS bf16_t*)(F.lds + 4096 + 18432);
    const int tid = F.tid, d = 2 * (tid & 63), seg = tid >> 6, lane = F.lane;
    const float* lfp = (dir ? WSP(float, WS_LB) : WSP(float, WS_LF)) + ((size_t)(b * NEXT + n0) * HGW + h * 128 + d);
    f32x2 lf[8], tot = (f32x2){0.f, 0.f};
#pragma unroll
    for (int i = 0; i < 8; ++i) { lf[i] = *(const f32x2*)(lfp + (size_t)(8 * seg + i) * HGW); tot += lf[i]; }
    __syncthreads();
    *(LAS f32x2*)(segtot + seg * 128 + d) = tot;
    { const bf16_t* vt = WSP(bf16_t, WS_VT) + ((size_t)(b * HGW + h * 128) * NEXT + n0);
        u32x4 tv[2];
#pragma unroll
        for (int q = 0; q < 2; ++q) { const int piece = tid + 512 * q, e = piece >> 3, part = piece & 7; tv[q] = *(const u32x4*)(vt + (size_t)e * NEXT + part * 8); }
#pragma unroll
        for (int q = 0; q < 2; ++q) { const int piece = tid + 512 * q, e = piece >> 3, part = piece & 7; *(LAS u32x4*)(VTs + e * 72 + part * 8) = tv[q]; } }
    __syncthreads();
    f32x2 later = (f32x2){0.f, 0.f}, total = later;
#pragma unroll
    for (int s = 0; s < 8; ++s) { const f32x2 v = *(const LAS f32x2*)(segtot + s * 128 + d); total += v; if (dir == 0 ? (s > seg) : (s < seg)) later += v; }
    f32x2 E[8];
    if (dir == 0) { f32x2 run = later;
#pragma unroll
        for (int i = 7; i >= 0; --i) { E[i] = run; run += lf[i]; } }
    else { f32x2 run = later;
#pragma unroll
        for (int i = 0; i < 8; ++i) { E[i] = run; run += lf[i]; } }
    float k0[8], k1[8];
#pragma unroll
    for (int i = 0; i < 8; ++i) { k0[i] = (1.0f - __expf(lf[i].x)) * __expf(E[i].x); k1[i] = (1.0f - __expf(lf[i].y)) * __expf(E[i].y); }
    *(LAS u32x4*)(Kt + d * 72 + 8 * seg) = (u32x4){pk2(k0[0], k0[1]), pk2(k0[2], k0[3]), pk2(k0[4], k0[5]), pk2(k0[6], k0[7])};
    *(LAS u32x4*)(Kt + (d + 1) * 72 + 8 * seg) = (u32x4){pk2(k1[0], k1[1]), pk2(k1[2], k1[3]), pk2(k1[4], k1[5]), pk2(k1[6], k1[7])};
    if (seg == 0) *(f32x2*)(WSP(float, WS_DECAY) + (size_t)item * 128 + d) = (f32x2){__expf(total.x), __expf(total.y)};
    __syncthreads();
    const int w = F.wave, lr = lane & 15, lq = lane >> 4;
    f32x4 acc[8];
#pragma unroll
    for (int et = 0; et < 8; ++et) acc[et] = (f32x4){0.f, 0.f, 0.f, 0.f};
#pragma unroll
    for (int ksi = 0; ksi < 2; ++ksi) { const bf16x8 a = lds_frag(Kt, 16 * w + lr, 72, 32 * ksi + 8 * lq);
#pragma unroll
        for (int et = 0; et < 8; ++et) acc[et] = MFMA16(a, lds_frag(VTs, 16 * et + lr, 72, 32 * ksi + 8 * lq), acc[et]); }
    bf16_t* dl = WSP(bf16_t, WS_DELTA) + (size_t)item * 16384;
#pragma unroll
    for (int et = 0; et < 8; ++et) { const int e = 16 * et + lr, d0 = 16 * w + 4 * lq;
        u32x2 o; o.x = pk2(acc[et][0], acc[et][1]); o.y = pk2(acc[et][2], acc[et][3]); *(u32x2*)(dl + e * 128 + d0) = o; }
}

__device__ __forceinline__ void hg_scan(Frame& F) {
    for (int gid = F.bx * 512 + F.tid; gid < NCHAIN * 8192; gid += F.G * 512) {
        const int chain = gid >> 13, idx = gid & 8191, dd = (2 * idx) & 127;
        const unsigned* dl = WSP(unsigned, WS_DELTA) + (size_t)chain * NCH_EXT * 8192 + idx;
        const float* dc = WSP(float, WS_DECAY) + (size_t)chain * NCH_EXT * 128 + dd;
        unsigned* ss = WSP(unsigned, WS_SST) + (size_t)chain * NCH_LAT * 8192 + idx;
        float s0 = 0.f, s1 = 0.f;
        unsigned dv[12], dw[12]; f32x2 cv[12], cw[12];
#pragma unroll
        for (int u = 0; u < 12; ++u) { dv[u] = dl[(size_t)u * 8192]; cv[u] = *(const f32x2*)(dc + (size_t)u * 128); }
#pragma unroll 1
        for (int j0 = 0; j0 < NCH_EXT; j0 += 12) {
            const bool more = j0 + 12 < NCH_EXT;
            if (more) {
#pragma unroll
                for (int u = 0; u < 12; ++u) { dw[u] = dl[(size_t)(j0 + 12 + u) * 8192]; cw[u] = *(const f32x2*)(dc + (size_t)(j0 + 12 + u) * 128); } }
#pragma unroll
            for (int u = 0; u < 12; ++u) { const int j = j0 + u;
                if (j >= 4) ss[(size_t)(j - 4) * 8192] = pk2(s0, s1);
                s0 = cv[u].x * s0 + bflo(dv[u]); s1 = cv[u].y * s1 + bfhi(dv[u]); }
#pragma unroll
            for (int u = 0; u < 12; ++u) { dv[u] = dw[u]; cv[u] = cw[u]; }
        }
    }
}

__device__ __forceinline__ void yhy_transpose_item(Frame& F, int item) {
    const int b = item >> 7, nb = item & 127, tid = F.tid;
    LAS bf16_t* ts = (LAS bf16_t*)F.lds;
    const bf16_t* src = WSP(bf16_t, WS_YHYT) + (size_t)b * HYW * SEQ + nb * 64;
    __syncthreads();
    { u32x4 tv[8];
#pragma unroll
    for (int q = 0; q < 8; ++q) { const int piece = tid + 512 * q, c = piece >> 3, part = piece & 7; tv[q] = *(const u32x4*)(src + (size_t)c * SEQ + part * 8); }
#pragma unroll
    for (int q = 0; q < 8; ++q) { const int piece = tid + 512 * q, c = piece >> 3, part = piece & 7; *(LAS u32x4*)(ts + c * 72 + part * 8) = tv[q]; } }
    __syncthreads();
    bf16_t* dst = WSP(bf16_t, WS_YHY) + (size_t)(b * SEQ + nb * 64) * HYW;
#pragma unroll
    for (int q = 0; q < 8; ++q) { const int task = tid + 512 * q, n = task & 63, cg = task >> 6;
        unsigned v[8];
#pragma unroll
        for (int i = 0; i < 8; ++i) v[i] = ts[(8 * cg + i) * 72 + n];
        *(u32x4*)(dst + (size_t)n * HYW + 8 * cg) = (u32x4){v[0] | (v[1] << 16), v[2] | (v[3] << 16), v[4] | (v[5] << 16), v[6] | (v[7] << 16)}; }
}

__device__ __forceinline__ void hg_out_item(Frame& F, int item) {
    const int b = item >> 9, h = (item >> 7) & 3, nc = item & 127;
    LAS float* segtot = (LAS float*)F.lds;
    LAS float* bref = (LAS float*)(F.lds + 4096);
    LAS float* red = (LAS float*)(F.lds + 4608);
    LAS bf16_t* Qd = (LAS bf16_t*)(F.lds + 5120);
    LAS bf16_t* Kd = (LAS bf16_t*)(F.lds + 22528);
    LAS bf16_t* Qb = (LAS bf16_t*)(F.lds + 39936);
    LAS bf16_t* VTs = (LAS bf16_t*)(F.lds + 57344);
    LAS bf16_t* Ss = (LAS bf16_t*)(F.lds + 75776);
    LAS bf16_t* att = (LAS bf16_t*)(F.lds + 110592);
    const int tid = F.tid, d = 2 * (tid & 63), seg = tid >> 6, lane = F.lane, w = F.wave, lr = lane & 15, lq = lane >> 4;
    const int nx0 = CTXL + nc * 64, r0 = b * SEQ + nc * 64;
    __syncthreads();
    { const bf16_t* vt = WSP(bf16_t, WS_VT) + ((size_t)(b * HGW + h * 128) * NEXT + nx0);
        u32x4 tv[2];
#pragma unroll
        for (int q = 0; q < 2; ++q) { const int piece = tid + 512 * q, e = piece >> 3, part = piece & 7; tv[q] = *(const u32x4*)(vt + (size_t)e * NEXT + part * 8); }
#pragma unroll
        for (int q = 0; q < 2; ++q) { const int piece = tid + 512 * q, e = piece >> 3, part = piece & 7; *(LAS u32x4*)(VTs + e * 72 + part * 8) = tv[q]; } }
    f32x4 acc[4];
#pragma unroll
    for (int i = 0; i < 4; ++i) acc[i] = (f32x4){0.f, 0.f, 0.f, 0.f};
    const bf16_t* qp = WSP(bf16_t, WS_Q) + ((size_t)r0 * HGW + h * 128 + d);
#pragma unroll 1
    for (int dir = 0; dir < 2; ++dir) {
        const int chain = (b * 4 + h) * 2 + dir, jlat = dir == 0 ? nc : 127 - nc;
        __syncthreads();
        { const bf16_t* sp = WSP(bf16_t, WS_SST) + (size_t)(chain * NCH_LAT + jlat) * 16384;
            u32x4 sv[4];
#pragma unroll
            for (int q = 0; q < 4; ++q) { const int piece = tid + 512 * q, e = piece >> 4, part = piece & 15; sv[q] = *(const u32x4*)(sp + e * 128 + part * 8); }
#pragma unroll
            for (int q = 0; q < 4; ++q) { const int piece = tid + 512 * q, e = piece >> 4, part = piece & 15; *(LAS u32x4*)(Ss + e * 136 + part * 8) = sv[q]; } }
        const float* lfp = (dir ? WSP(float, WS_LB) : WSP(float, WS_LF)) + ((size_t)(b * NEXT + nx0) * HGW + h * 128 + d);
        f32x2 lf[8], qv[8], tot = (f32x2){0.f, 0.f};
#pragma unroll
        for (int i = 0; i < 8; ++i) { lf[i] = *(const f32x2*)(lfp + (size_t)(8 * seg + i) * HGW); const unsigned qw = *(const unsigned*)(qp + (size_t)(8 * seg + i) * HGW); qv[i] = (f32x2){bflo(qw), bfhi(qw)}; tot += lf[i]; }
        *(LAS f32x2*)(segtot + seg * 128 + d) = tot;
        __syncthreads();
        f32x2 off = (f32x2){0.f, 0.f};
#pragma unroll
        for (int s = 0; s < 8; ++s) { const f32x2 v = *(const LAS f32x2*)(segtot + s * 128 + d); if (dir == 0 ? (s < seg) : (s > seg)) off += v; }
        f32x2 bb[8];
        if (dir == 0) { f32x2 run = off;
#pragma unroll
            for (int i = 0; i < 8; ++i) { run += lf[i]; bb[i] = run; } if (seg == 3) *(LAS f32x2*)(bref + d) = bb[7]; }
        else { f32x2 run = off;
#pragma unroll
            for (int i = 7; i >= 0; --i) { run += lf[i]; bb[i] = run; } if (seg == 4) *(LAS f32x2*)(bref + d) = bb[0]; }
        __syncthreads();
        { const f32x2 br = *(const LAS f32x2*)(bref + d); const f32x2 em = (f32x2){__expf(-br.x), __expf(-br.y)}, ep = (f32x2){__expf(br.x), __expf(br.y)};
#pragma unroll
            for (int i = 0; i < 8; ++i) { const int t = 8 * seg + i;
                const f32x2 eb = (f32x2){__expf(bb[i].x), __expf(bb[i].y)}, kk = (f32x2){1.0f - __expf(lf[i].x), 1.0f - __expf(lf[i].y)};
                const f32x2 qb = qv[i] * eb, qd = qb * em, kd = kk * ep * (f32x2){__builtin_amdgcn_rcpf(eb.x), __builtin_amdgcn_rcpf(eb.y)};
                *(LAS unsigned*)(Qd + t * 136 + d) = pk2(qd.x, qd.y); *(LAS unsigned*)(Kd + t * 136 + d) = pk2(kd.x, kd.y); *(LAS unsigned*)(Qb + t * 136 + d) = pk2(qb.x, qb.y); } }
        __syncthreads();
        {
            const int st = w & 3; f32x4 a2[2] = {(f32x4){0.f, 0.f, 0.f, 0.f}, (f32x4){0.f, 0.f, 0.f, 0.f}};
#pragma unroll
            for (int ksi = 0; ksi < 4; ++ksi) { const bf16x8 a = lds_frag(Kd, 16 * st + lr, 136, 32 * ksi + 8 * lq);
#pragma unroll
                for (int q = 0; q < 2; ++q) a2[q] = MFMA16(a, lds_frag(Qd, 16 * (2 * (w >> 2) + q) + lr, 136, 32 * ksi + 8 * lq), a2[q]); }
#pragma unroll
            for (int q = 0; q < 2; ++q) { const int t = 16 * (2 * (w >> 2) + q) + lr, s0 = 16 * st + 4 * lq; float v[4];
#pragma unroll
                for (int r = 0; r < 4; ++r) { const int s = s0 + r; v[r] = (dir == 0 ? (s <= t) : (s >= t)) ? a2[q][r] : 0.f; }
                u32x2 o; o.x = pk2(v[0], v[1]); o.y = pk2(v[2], v[3]); *(LAS u32x2*)(att + t * 72 + s0) = o; }
        }
        __syncthreads();
        { const int tt = w & 3;
#pragma unroll
            for (int ksi = 0; ksi < 2; ++ksi) { const bf16x8 a = lds_frag(att, 16 * tt + lr, 72, 32 * ksi + 8 * lq);
#pragma unroll
                for (int i = 0; i < 4; ++i) acc[i] = MFMA16(a, lds_frag(VTs, 16 * (4 * (w >> 2) + i) + lr, 72, 32 * ksi + 8 * lq), acc[i]); }
#pragma unroll
            for (int ksi = 0; ksi < 4; ++ksi) { const bf16x8 a = lds_frag(Qb, 16 * tt + lr, 136, 32 * ksi + 8 * lq);
#pragma unroll
                for (int i = 0; i < 4; ++i) acc[i] = MFMA16(a, lds_frag(Ss, 16 * (4 * (w >> 2) + i) + lr, 136, 32 * ksi + 8 * lq), acc[i]); }
        }
    }
    const int tt = w & 3, eh = w >> 2;
    float ssq[4];
#pragma unroll
    for (int r = 0; r < 4; ++r) { float s = 0.f;
#pragma unroll
        for (int i = 0; i < 4; ++i) s += acc[i][r] * acc[i][r];
        s += __shfl_xor(s, 1); s += __shfl_xor(s, 2); s += __shfl_xor(s, 4); s += __shfl_xor(s, 8); ssq[r] = s; }
    if (lr == 0) {
#pragma unroll
        for (int r = 0; r < 4; ++r) red[eh * 64 + 16 * tt + 4 * lq + r] = ssq[r]; }
    __syncthreads();
    const float* ng = F.p->in[I_HGNG]; const bf16_t* gp = WSP(bf16_t, WS_G); bf16_t* yo = WSP(bf16_t, WS_YHG);
    float ngv[4], gv[4][4];
#pragma unroll
    for (int i = 0; i < 4; ++i) ngv[i] = ng[16 * (4 * eh + i) + lr];
#pragma unroll
    for (int r = 0; r < 4; ++r)
#pragma unroll
        for (int i = 0; i < 4; ++i) gv[r][i] = bf2f(gp[(size_t)(r0 + 16 * tt + 4 * lq + r) * HGW + h * 128 + 16 * (4 * eh + i) + lr]);
#pragma unroll
    for (int r = 0; r < 4; ++r) { const int t = 16 * tt + 4 * lq + r; const float rs = rsqrtf((red[t] + red[64 + t]) * (1.0f / 128.0f) + EPS);
#pragma unroll
        for (int i = 0; i < 4; ++i) { const int e = 16 * (4 * eh + i) + lr; const size_t o = (size_t)(r0 + t) * HGW + h * 128 + e;
            yo[o] = (bf16_t)f2bf(acc[i][r] * rs * ngv[i] * gv[r][i]); } }
}
__device__ __forceinline__ void phase_route(Frame& F) {
    const float* lg = WSP(float, WS_LOGIT); const float* rb = F.p->in[I_RB];
    unsigned* cnt = WSP(unsigned, WS_CTL) + CW_CNT;
    int* re_ = WSP(int, WS_ROUTE_E); float* rw_ = WSP(float, WS_ROUTE_W); int* rp_ = WSP(int, WS_ROUTE_P);
    const int gw = F.bx * 8 + F.wave, NGW = F.G * 8, lane = F.lane;
    const f32x4 bias = *(const f32x4*)(rb + 4 * lane);
    const float NINF = -__builtin_inff();
    const bool al = (F.G == 256); const int tbase = al ? (((F.bx & 7) * 32 + (F.bx >> 3)) * 8 + F.wave) * 8 : gw, tstr = al ? 1 : NGW;
    f32x4 lpre[8];
#pragma unroll
    for (int i = 0; i < 8; ++i) { const int t = tbase + i * tstr; lpre[i] = t < T ? *(const f32x4*)(lg + (size_t)t * NE + 4 * lane) : (f32x4){0.f, 0.f, 0.f, 0.f}; }
    int ti = 0;
    for (int t = tbase; al ? ti < 8 : t < T; t += tstr, ++ti) {
        f32x4 l4 = lpre[0];
#pragma unroll
        for (int i = 1; i < 8; ++i) if (ti == i) l4 = lpre[i];
        if (ti >= 8) l4 = *(const f32x4*)(lg + (size_t)t * NE + 4 * lane);
        float sc[4], bs[4];
#pragma unroll
        for (int i = 0; i < 4; ++i) { sc[i] = sigmoidf_(l4[i]); bs[i] = sc[i] + bias[i]; }
        float m1 = fmaxf(bs[0], bs[1]), m2 = fminf(bs[0], bs[1]);
#pragma unroll
        for (int i = 2; i < 4; ++i) { const float v = bs[i]; m2 = fmaxf(m2, fminf(m1, v)); m1 = fmaxf(m1, v); }
#pragma unroll
        for (int o = 1; o < 8; o <<= 1) { const float o1 = __shfl_xor(m1, o), o2 = __shfl_xor(m2, o); const float n1 = fmaxf(m1, o1), n2 = fmaxf(fminf(m1, o1), fmaxf(m2, o2)); m1 = n1; m2 = n2; }
        const float gs = m1 + m2; const int mg = lane >> 3; int rank = 0;
#pragma unroll
        for (int g = 0; g < 8; ++g) { const float v = __shfl(gs, g * 8); rank += (v > gs || (v == gs && g < mg)) ? 1 : 0; }
        const bool sel = rank < 4;
        float cd[4];
#pragma unroll
        for (int i = 0; i < 4; ++i) cd[i] = sel ? bs[i] : NINF;
        int ek[8]; float sk[8]; float ssum = 0.f;
#pragma unroll
        for (int k = 0; k < 8; ++k) {
            float bv = cd[0]; int bi = 4 * lane;
#pragma unroll
            for (int i = 1; i < 4; ++i) if (cd[i] > bv) { bv = cd[i]; bi = 4 * lane + i; }
#pragma unroll
            for (int o = 32; o >= 1; o >>= 1) { const float ov = __shfl_xor(bv, o); const int oi = __shfl_xor(bi, o); if (ov > bv || (ov == bv && oi < bi)) { bv = ov; bi = oi; } }
            const int sub = bi & 3; const float mysc = sub == 0 ? sc[0] : (sub == 1 ? sc[1] : (sub == 2 ? sc[2] : sc[3]));
            const float s = __shfl(mysc, bi >> 2);
            if ((bi >> 2) == lane) {
#pragma unroll
                for (int i = 0; i < 4; ++i) if (i == sub) cd[i] = NINF; }
            ek[k] = bi; sk[k] = s; ssum += s;
        }
        const float scale = 2.5f / ssum;
        int me = ek[0]; float mw = sk[0];
#pragma unroll
        for (int k = 1; k < 8; ++k) if (lane == k) { me = ek[k]; mw = sk[k]; }
        if (lane < 8) { const int pos = (int)atomicAdd(cnt + me, 1u); re_[t * 8 + lane] = me; rw_[t * 8 + lane] = mw * scale; rp_[t * 8 + lane] = pos; }
    }
}
__device__ __forceinline__ void phase_scatter(Frame& F) {
    LAS int* st = (LAS int*)F.lds; LAS int* cn = st + 512;
    const unsigned* cnt = WSP(unsigned, WS_CTL) + CW_CNT;
    __syncthreads();
    if (F.tid < NE) cn[F.tid] = (int)cnt[F.tid];
    __syncthreads();
    if (F.tid <= NE) { int s = 0, tl = 0; for (int e = 0; e < F.tid; ++e) { s += cn[e]; tl += (cn[e] + 255) >> 8; } st[F.tid] = s;
        if (F.bx == 0) { unsigned* ctl = WSP(unsigned, WS_CTL); ctl[CW_START + F.tid] = (unsigned)s; ctl[CW_TOFF + F.tid] = (unsigned)tl;
            if (F.tid < NE) { const int c_ = cn[F.tid]; for (int j = 0; j * 256 < c_; ++j) { unsigned* up = ctl + CW_UNITS + 4 * (tl + j); up[0] = (unsigned)(s + 256 * j); up[1] = (unsigned)F.tid; up[2] = (unsigned)(c_ - 256 * j < 256 ? c_ - 256 * j : 256); up[3] = 0u; } } } }
    __syncthreads();
    const int* re_ = WSP(int, WS_ROUTE_E); const float* rw_ = WSP(float, WS_ROUTE_W); const int* rp_ = WSP(int, WS_ROUTE_P);
    int* stok = WSP(int, WS_SLOT_TOK); float* sw = WSP(float, WS_SLOT_W); int* sof = WSP(int, WS_SLOTOF);
    for (int a = F.bx * 512 + F.tid; a < NASG; a += F.G * 512) { const int slot = st[re_[a]] + rp_[a]; stok[slot] = a >> 3; sw[slot] = rw_[a]; sof[a] = slot; }
    if (F.bx == 0 && F.tid < 256) { stok[NASG + F.tid] = 0; sw[NASG + F.tid] = 0.f; }
}
__device__ __forceinline__ void phase_final(Frame& F) {
    float* out = F.p->out; const float* x1 = F.p->out;     const float* fg = F.p->in[I_FG]; const float* ada = WSP(float, WS_ADA);
    const unsigned char* yb8 = WSP(unsigned char, WS_YBUF); const bf16_t* ysh = WSP(bf16_t, WS_YSH); const int* sof = WSP(int, WS_SLOTOF);
    const int lane = F.lane, NGW = F.G * 8;
    const bool al = (F.G == 256); const int tbase = al ? (((F.bx & 7) * 32 + (F.bx >> 3)) * 8 + F.wave) * 8 : F.bx * 8 + F.wave, tstr = al ? 1 : NGW;
    f32x4 fgv[2][2];
#pragma unroll
    for (int j = 0; j < 2; ++j) { fgv[j][0] = *(const f32x4*)(fg + 512 * j + 8 * lane); fgv[j][1] = *(const f32x4*)(fg + 512 * j + 8 * lane + 4); }
    int it_ = 0;
    for (int t = tbase; al ? it_ < 8 : t < T; t += tstr, ++it_) { const int b = t >> 13;
        int sl[8];
#pragma unroll
        for (int k = 0; k < 8; ++k) sl[k] = sof[t * 8 + k];
        u32x4 ys[2]; u32x2 y[8][2]; f32x4 xv[2][2], g2[2][2];
#pragma unroll
        for (int j = 0; j < 2; ++j) { const int c = 512 * j + 8 * lane;
            ys[j] = *(const u32x4*)(ysh + (size_t)t * D + c); xv[j][0] = *(const f32x4*)(x1 + (size_t)t * D + c); xv[j][1] = *(const f32x4*)(x1 + (size_t)t * D + c + 4);
            g2[j][0] = *(const f32x4*)(ada + b * 6144 + 5 * D + c); g2[j][1] = *(const f32x4*)(ada + b * 6144 + 5 * D + c + 4);
#pragma unroll
            for (int k = 0; k < 8; ++k) y[k][j] = *(const u32x2*)(yb8 + (size_t)sl[k] * D + c); }
        f32x4 v[2][2]; float ss = 0.f;
#pragma unroll
        for (int j = 0; j < 2; ++j) { f32x4 m0 = (f32x4){bflo(ys[j].x), bfhi(ys[j].x), bflo(ys[j].y), bfhi(ys[j].y)}, m1 = (f32x4){bflo(ys[j].z), bfhi(ys[j].z), bflo(ys[j].w), bfhi(ys[j].w)};
#pragma unroll
            for (int k = 0; k < 8; ++k) { const f32x2 a0 = __builtin_amdgcn_cvt_pk_f32_fp8((int)y[k][j].x, false), a1 = __builtin_amdgcn_cvt_pk_f32_fp8((int)y[k][j].x, true), b0 = __builtin_amdgcn_cvt_pk_f32_fp8((int)y[k][j].y, false), b1 = __builtin_amdgcn_cvt_pk_f32_fp8((int)y[k][j].y, true);
                m0 += (f32x4){a0.x, a0.y, a1.x, a1.y}; m1 += (f32x4){b0.x, b0.y, b1.x, b1.y}; }
            v[j][0] = xv[j][0] + g2[j][0] * m0; v[j][1] = xv[j][1] + g2[j][1] * m1;
#pragma unroll
            for (int h = 0; h < 2; ++h) ss += (v[j][h][0] * v[j][h][0] + v[j][h][1] * v[j][h][1]) + (v[j][h][2] * v[j][h][2] + v[j][h][3] * v[j][h][3]); }
        const float rs = rsqrtf(wave_sum(ss) * (1.0f / D) + EPS);
#pragma unroll
        for (int j = 0; j < 2; ++j) { const int c = 512 * j + 8 * lane; *(f32x4*)(out + (size_t)t * D + c) = v[j][0] * rs * fgv[j][0]; *(f32x4*)(out + (size_t)t * D + c + 4) = v[j][1] * rs * fgv[j][1]; }
    }
}

constexpr int NPHASE = 15;
#ifndef REP_MASK
#define REP_MASK 0u
#endif
#define NREP(k) ((((REP_MASK) >> (k)) & 1u) ? 2 : 1)
#ifndef MK_LAUNCH_PER_PHASE
#define MK_LAUNCH_PER_PHASE 0
#endif
__global__ void __launch_bounds__(512) hyena_hgrn2_moe_fwd(Params p) {
    extern __shared__ __attribute__((aligned(16))) unsigned char lds_[];
    cg::grid_group grid = cg::this_grid();
    Frame F; F.lds = (LAS unsigned char*)lds_; F.p = &p; F.ws = p.ws; F.tid = threadIdx.x; F.lane = F.tid & 63; F.wave = __builtin_amdgcn_readfirstlane(F.tid >> 6); F.G = gridDim.x; F.bx = blockIdx.x;
    if (F.tid < 16) ((LAS unsigned*)(F.lds + LDS_BARST))[F.tid] = 0u;
    __syncthreads();
    XcdBarrier bar = xcd_barrier_post((unsigned*)(p.ws + WS_CTL) + CW_BAR, (volatile LAS unsigned*)(F.lds + LDS_BARST));
#ifdef ONLY_PHASE
#define IN(k) ((k) == ONLY_PHASE && p.ph_lo <= (k) && (k) < p.ph_hi)
#else
#define IN(k) (p.ph_lo <= (k) && (k) < p.ph_hi)
#endif
#define SEAM(k) do { if (IN(k) && IN((k) + 1)) xcd_barrier(bar); } while (0)
    if (p.ph_lo < 0) grid.sync();
    if (IN(0)) _Pragma("unroll 1") for (int rp = 0; rp < NREP(0); ++rp) { asm volatile("" : "+v"(F.tid)); if (rp) xcd_barrier(bar); phase0(F); }
    SEAM(0);
    if (IN(1)) _Pragma("unroll 1") for (int rp = 0; rp < NREP(1); ++rp) { asm volatile("" : "+v"(F.tid)); if (rp) xcd_barrier(bar); phase1(F); }
    SEAM(1);
    if (IN(2)) _Pragma("unroll 1") for (int rp = 0; rp < NREP(2); ++rp) { asm volatile("" : "+v"(F.tid)); if (rp) xcd_barrier(bar);
        __syncthreads();
        { pg8::Gemm g{WSP(bf16_t, WS_WINT), WSP(bf16_t, WS_WINT), D, nullptr, 2 * D, 128}; InOrder S{F.G, F.bx};
          EpiIn E{EpiInT{WSP(bf16_t, WS_PHYT), WSP(bf16_t, WS_VT)}, EpiInN{WSP(bf16_t, WS_Q), WSP(bf16_t, WS_G), WSP(bf16_t, WS_SG1), WSP(bf16_t, WS_SG2), WSP(float, WS_LF), WSP(float, WS_LB), WSP(float, WS_LBS)}};
          pg8::gemm_phase<EpiIn, InOrder, false>(F.lds, g, S, E); }
    }
    SEAM(2);
    if (IN(3)) _Pragma("unroll 1") for (int rp = 0; rp < NREP(3); ++rp) { asm volatile("" : "+v"(F.tid)); if (rp) xcd_barrier(bar);
        _Pragma("unroll 1") for (int r2 = 0; r2 < NREP(16); ++r2) { asm volatile("" : "+v"(F.tid));
            XpState xp; xp.it = F.bx; xp.stride = F.G; xp.end = (XP_BG * F.G < NE * 48) ? XP_BG * F.G : NE * 48; xp.live = false;
            for (int c = F.bx; c < HYW; c += F.G) hyena_item(F, c, xp);
            { int tid = F.tid; xp_finish(xp, p.in, F.ws, tid); while (xp.it < xp.end) { xp_issue(xp, p.in, F.ws, tid); xp_finish(xp, p.in, F.ws, tid); } } }
        _Pragma("unroll 1") for (int r2 = 0; r2 < NREP(17); ++r2) { asm volatile("" : "+v"(F.tid)); for (int it = F.bx; it < NAITEM; it += F.G) hg_delta_item(F, it); }
    }
    SEAM(3);
    if (IN(4)) _Pragma("unroll 1") for (int rp = 0; rp < NREP(4); ++rp) { asm volatile("" : "+v"(F.tid)); if (rp) xcd_barrier(bar);
        _Pragma("unroll 1") for (int r2 = 0; r2 < NREP(18); ++r2) { asm volatile("" : "+v"(F.tid)); hg_scan(F); }
        _Pragma("unroll 1") for (int r2 = 0; r2 < NREP(19); ++r2) { asm volatile("" : "+v"(F.tid)); for (int it = F.bx; it < NB * 128; it += F.G) yhy_transpose_item(F, it); }
    }
    SEAM(4);
    if (IN(5)) _Pragma("unroll 1") for (int rp = 0; rp < NREP(5); ++rp) { asm volatile("" : "+v"(F.tid)); if (rp) xcd_barrier(bar); for (int it = F.bx; it < NB * 4 * NCH_LAT; it += F.G) hg_out_item(F, it); }
    SEAM(5);
    if (IN(6)) _Pragma("unroll 1") for (int rp = 0; rp < NREP(6); ++rp) { asm volatile("" : "+v"(F.tid)); if (rp) xcd_barrier(bar);
        __syncthreads();
        { pg8::Gemm g{WSP(bf16_t, WS_YHY), WSP(bf16_t, WS_WHYT), HYW, nullptr, 2 * HYW, 128}; pg8::StaticOrder S; S.init(T, D, HYW, F.G, F.bx); EpiMerge1 E{WSP(bf16_t, WS_SG1), WSP(float, WS_T1)};
          pg8::gemm_phase<EpiMerge1, pg8::StaticOrder, false>(F.lds, g, S, E); }
        { pg8::Gemm g{WSP(bf16_t, WS_YHG), WSP(bf16_t, WS_WHGT), HGW, nullptr, 2 * HGW, 128}; pg8::StaticOrder S; S.init(T, D, HGW, F.G, F.bx); EpiMerge2 E{WSP(bf16_t, WS_SG2), WSP(float, WS_T1), WSP(bf16_t, WS_MB)};
          pg8::gemm_phase<EpiMerge2, pg8::StaticOrder, false>(F.lds, g, S, E); }
    }
    SEAM(6);
    if (IN(7)) _Pragma("unroll 1") for (int rp = 0; rp < NREP(7); ++rp) { asm volatile("" : "+v"(F.tid)); if (rp) xcd_barrier(bar);
        __syncthreads();
        pg8::Gemm g{WSP(bf16_t, WS_MB), WSP(bf16_t, WS_WOUTT), D, nullptr, 2 * D, 128}; pg8::StaticOrder S; S.init(T, D, D, F.G, F.bx);
        EpiWout E{p.in[I_X], WSP(float, WS_POSR), WSP(float, WS_POSC), WSP(float, WS_ADA), p.out};
        pg8::gemm_phase<EpiWout, pg8::StaticOrder, false>(F.lds, g, S, E);
    }
    SEAM(7);
    if (IN(8)) _Pragma("unroll 1") for (int rp = 0; rp < NREP(8); ++rp) { asm volatile("" : "+v"(F.tid)); if (rp) xcd_barrier(bar); phase_h2(F); }
    SEAM(8);
    if (IN(9)) _Pragma("unroll 1") for (int rp = 0; rp < NREP(9); ++rp) { asm volatile("" : "+v"(F.tid)); if (rp) xcd_barrier(bar);
        __syncthreads();
        { pg8::Gemm g{WSP(bf16_t, WS_H2), WSP(bf16_t, WS_ROUT), D, nullptr, 2 * D, 128}; P9Order S{F.G, F.bx}; EpiP9 E{EpiLogit{WSP(float, WS_LOGIT)}, EpiGU{WSP(bf16_t, WS_HSH)}};
          pg8::gemm_phase<EpiP9, P9Order, false>(F.lds, g, S, E); }
    }
    SEAM(9);
    if (IN(10)) _Pragma("unroll 1") for (int rp = 0; rp < NREP(10); ++rp) { asm volatile("" : "+v"(F.tid)); if (rp) xcd_barrier(bar); phase_route(F); }
    SEAM(10);
    if (IN(11)) _Pragma("unroll 1") for (int rp = 0; rp < NREP(11); ++rp) { asm volatile("" : "+v"(F.tid)); if (rp) xcd_barrier(bar); phase_scatter(F); }
    SEAM(11);
    if (IN(12)) _Pragma("unroll 1") for (int rp = 0; rp < NREP(12); ++rp) { asm volatile("" : "+v"(F.tid)); if (rp) xcd_barrier(bar);
        __syncthreads();
        pg8::Gemm g{WSP(bf16_t, WS_H2), WSP(bf16_t, WS_EGUT), D, WSP(int, WS_SLOT_TOK), 128, 512 * 128}; MoeOrder S{WSP(unsigned, WS_CTL) + CW_UNITS, (int)WSP(unsigned, WS_CTL)[CW_TOFF + NE], 2, F.G, F.bx, 1048576u}; EpiGU E{WSP(bf16_t, WS_HBUF)};
        pg8::gemm_phase<EpiGU, MoeOrder, true>(F.lds, g, S, E);
    }
    SEAM(12);
    if (IN(13)) _Pragma("unroll 1") for (int rp = 0; rp < NREP(13); ++rp) { asm volatile("" : "+v"(F.tid)); if (rp) xcd_barrier(bar);
        __syncthreads();
        { pg8::Gemm g{WSP(bf16_t, WS_HBUF), WSP(bf16_t, WS_EDT), EH, nullptr, 128, 1024 * 128}; MoeOrder S{WSP(unsigned, WS_CTL) + CW_UNITS, (int)WSP(unsigned, WS_CTL)[CW_TOFF + NE], 4, F.G, F.bx, 524288u}; EpiDown<true, true> E{WSP(bf16_t, WS_YBUF), WSP(float, WS_SLOT_W)};
          pg8::gemm_phase<EpiDown<true, true>, MoeOrder, false>(F.lds, g, S, E); }
        { pg8::Gemm g{WSP(bf16_t, WS_HSH), WSP(bf16_t, WS_SHDT), EH, nullptr, 2 * EH, 128}; pg8::StaticOrder S; S.init(T, D, EH, F.G, F.bx); EpiDown<false> E{WSP(bf16_t, WS_YSH), nullptr};
          pg8::gemm_phase<EpiDown<false>, pg8::StaticOrder, false>(F.lds, g, S, E); }
    }
    SEAM(13);
    if (IN(14)) _Pragma("unroll 1") for (int rp = 0; rp < NREP(14); ++rp) { asm volatile("" : "+v"(F.tid)); if (rp) xcd_barrier(bar); phase_final(F); }
#undef IN
#undef SEAM
}

extern "C" void kernel_launch(void* const* d_in, const int* in_sizes, int n_in, void* d_out, int out_size, void* d_ws, size_t ws_size, hipStream_t stream) {
    static int grid = 0;
    if (grid == 0) {
        if (n_in != 34 || out_size != T * D || ws_size < WS_END) { fprintf(stderr, "kernel_launch: unexpected shapes (n_in %d, out %d, ws %zu < %zu)\n", n_in, out_size, ws_size, (size_t)WS_END); grid = -1; return; }
        int dev = 0, cus = 0, per_cu = 0;
        if (hipGetDevice(&dev) != hipSuccess || hipDeviceGetAttribute(&cus, hipDeviceAttributeMultiprocessorCount, dev) != hipSuccess) { grid = -1; return; }
        if (hipFuncSetAttribute((const void*)hyena_hgrn2_moe_fwd, hipFuncAttributeMaxDynamicSharedMemorySize, LDS_BYTES) != hipSuccess) { fprintf(stderr, "kernel_launch: hipFuncSetAttribute failed\n"); grid = -1; return; }
        if (hipOccupancyMaxActiveBlocksPerMultiprocessor(&per_cu, (const void*)hyena_hgrn2_moe_fwd, 512, LDS_BYTES) != hipSuccess || per_cu < 1) { fprintf(stderr, "kernel_launch: occupancy query failed (%d)\n", per_cu); (void)hipGetLastError(); per_cu = 1; }
        grid = cus * per_cu; if (grid > 256) grid = 256;
    }
    if (grid < 0) return;
    if (hipMemsetAsync((char*)d_ws + WS_CTL, 0, CTL_BYTES, stream) != hipSuccess) { fprintf(stderr, "kernel_launch: memset failed\n"); return; }
    Params p{};
    for (int i = 0; i < 34; ++i) p.in[i] = (const float*)d_in[i];
    p.out = (float*)d_out; p.ws = (unsigned char*)d_ws;
#if MK_LAUNCH_PER_PHASE
    for (int k = 0; k < NPHASE; ++k) { p.ph_lo = k; p.ph_hi = k + 1; void* args[] = {&p};
        hipError_t e = hipLaunchCooperativeKernel((const void*)hyena_hgrn2_moe_fwd, dim3(grid), dim3(512), args, LDS_BYTES, stream);
        if (e != hipSuccess) { fprintf(stderr, "kernel_launch: launch %d failed: %s\n", k, hipGetErrorString(e)); break; } }
#else
    p.ph_lo = 0; p.ph_hi = NPHASE; void* args[] = {&p};
    hipError_t e = hipLaunchCooperativeKernel((const void*)hyena_hgrn2_moe_fwd, dim3(grid), dim3(512), args, LDS_BYTES, stream);
    if (e != hipSuccess) fprintf(stderr, "kernel_launch: cooperative launch failed: %s (grid %d)\n", hipGetErrorString(e), grid);
#endif
}
```

```cpp
#include <hip/hip_runtime.h>
#include <hip/hip_cooperative_groups.h>
#include <cstdio>
#include <cstdint>
namespace cg = cooperative_groups;

#define LAS __attribute__((address_space(3)))
typedef unsigned short bf16_t;
typedef short bf16x8 __attribute__((ext_vector_type(8)));
typedef float f32x4 __attribute__((ext_vector_type(4)));
typedef float f32x2 __attribute__((ext_vector_type(2)));
typedef unsigned u32x4 __attribute__((ext_vector_type(4)));
typedef unsigned u32x2 __attribute__((ext_vector_type(2)));

constexpr int D = 1024, NB = 2, SEQ = 8192, T = NB * SEQ, CTXL = 256, TC = NB * CTXL, MA = T + TC, NEXT = CTXL + SEQ;
constexpr int HYW = 512, HYP = 1536, HGW = 512, INC = 6144;
constexpr int NE = 256, TOPK = 8, EH = 256, NASG = T * TOPK;
constexpr int NCH_EXT = NEXT / 64  , NCH_LAT = SEQ / 64  , NCHAIN = 16, NAITEM = NCHAIN * NCH_EXT  ;
constexpr int FFTN = 16384;
constexpr float EPS = 1e-6f;

constexpr size_t al256(size_t x) { return (x + 255) & ~(size_t)255; }
constexpr size_t WS_CTL = 0, CTL_BYTES = 65536;
constexpr size_t WS_WINT = WS_CTL + CTL_BYTES;
constexpr size_t WS_WHYT = WS_WINT + (size_t)INC * D * 2;
constexpr size_t WS_WHGT = WS_WHYT + (size_t)D * HYW * 2;
constexpr size_t WS_WOUTT = WS_WHGT + (size_t)D * HGW * 2;
constexpr size_t WS_ROUT = WS_WOUTT + (size_t)D * D * 2;
constexpr size_t WS_SHGUT = WS_ROUT + (size_t)NE * D * 2;
constexpr size_t WS_SHDT = WS_SHGUT + (size_t)512 * D * 2;
constexpr size_t WS_ADAP = WS_SHDT + (size_t)D * 256 * 2;
constexpr size_t WS_ADA = WS_ADAP + (size_t)32 * 3 * 6144 * 4;
constexpr size_t WS_POSR = WS_ADA + (size_t)3 * 6144 * 4;
constexpr size_t WS_POSC = WS_POSR + (size_t)128 * 512 * 4;
constexpr size_t WS_LBS = WS_POSC + (size_t)64 * 512 * 4;
constexpr size_t WS_ROUTE_E = WS_LBS + 4096;
constexpr size_t WS_ROUTE_W = WS_ROUTE_E + (size_t)NASG * 4;
constexpr size_t WS_ROUTE_P = WS_ROUTE_W + (size_t)NASG * 4;
constexpr size_t WS_SLOTOF = WS_ROUTE_P + (size_t)NASG * 4;
constexpr size_t WS_SLOT_TOK = WS_SLOTOF + (size_t)NASG * 4;
constexpr size_t WS_SLOT_W = WS_SLOT_TOK + (size_t)(NASG + 256) * 4;
constexpr size_t WS_EGUT = al256(WS_SLOT_W + (size_t)(NASG + 256) * 4);
constexpr size_t WS_EDT = WS_EGUT + (size_t)NE * 512 * D * 2;
constexpr size_t WS_RA = WS_EDT + (size_t)NE * D * EH * 2;
constexpr size_t RA_BYTES = (size_t)NASG * D * 2;
constexpr size_t WS_HF = WS_RA;
constexpr size_t WS_KS = WS_HF + (size_t)2048 * SEQ * 4;
constexpr size_t WS_DELTA = WS_KS + (size_t)256 * 2 * FFTN * 8;
constexpr size_t WS_DECAY = WS_DELTA + (size_t)NAITEM * 16384 * 2;
constexpr size_t WS_PHYT = WS_DECAY + (size_t)NAITEM * 128 * 4;
static_assert(WS_PHYT + (size_t)NB * HYP * SEQ * 2 <= WS_RA + RA_BYTES, "region A overflow");
constexpr size_t WS_YBUF = WS_RA;
constexpr size_t WS_RB = WS_RA + RA_BYTES;
constexpr size_t WS_VT = WS_RB;
constexpr size_t WS_Q = WS_VT + (size_t)NB * HGW * NEXT * 2;
constexpr size_t WS_LF = WS_Q + (size_t)T * HGW * 2;
constexpr size_t WS_LB = WS_LF + (size_t)NB * NEXT * HGW * 4;
constexpr size_t WS_G = WS_LB + (size_t)NB * NEXT * HGW * 4;
constexpr size_t WS_SG1 = WS_G + (size_t)T * HGW * 2;
constexpr size_t WS_SG2 = WS_SG1 + (size_t)T * D * 2;
constexpr size_t WS_A1 = WS_SG2 + (size_t)T * D * 2;
constexpr size_t WS_SST = WS_A1 + (size_t)MA * D * 2;
constexpr size_t WS_YHG = WS_SST + (size_t)NCHAIN * NCH_LAT * 16384 * 2 + 256 * 512;
constexpr size_t WS_T1 = WS_YHG + (size_t)T * HGW * 2;
constexpr size_t WS_END = WS_T1 + (size_t)T * D * 4;
constexpr size_t WS_LOGIT = WS_VT, WS_HSH = WS_Q, WS_MB = WS_LF, WS_H2 = WS_LB, WS_YSH = WS_SG1, WS_YHYT = WS_A1, WS_YHY = WS_A1 + (size_t)NB * HYW * SEQ * 2, WS_HBUF = WS_SST;
static_assert((size_t)T * 256 * 4 <= (size_t)NB * HGW * NEXT * 2, "LOGIT fits VT");
static_assert(WS_YHY + (size_t)T * HYW * 2 <= WS_SST, "YHY fits A1");
static_assert((size_t)(NASG + 256) * EH * 2 <= (size_t)NCHAIN * NCH_LAT * 16384 * 2 + 256 * 512, "HBUF fits SST");
static_assert(WS_END <= (size_t)1073741824, "workspace map exceeds 1 GiB");
constexpr int CW_CNT = 0;
constexpr int CW_START = 512;
constexpr int CW_TOFF = 1024;
constexpr int CW_BAR = 4096;
constexpr int CW_UNITS = 8192;

constexpr int LDS_BYTES = 147456;
constexpr int LDS_BARST = LDS_BYTES - 64;

__device__ __forceinline__ unsigned f2bf(float f) { unsigned u = __float_as_uint(f); return (u + 0x7fffu + ((u >> 16) & 1u)) >> 16; }
__device__ __forceinline__ unsigned pk2(float lo, float hi) { return f2bf(lo) | (f2bf(hi) << 16); }
__device__ __forceinline__ float bf2f(unsigned b) { return __uint_as_float(b << 16); }
__device__ __forceinline__ float bflo(unsigned w) { return __uint_as_float(w << 16); }
__device__ __forceinline__ float bfhi(unsigned w) { return __uint_as_float(w & 0xffff0000u); }
__device__ __forceinline__ float sigmoidf_(float x) { return __builtin_amdgcn_rcpf(1.0f + __expf(-x)); }
__device__ __forceinline__ float siluf_(float x) { return x * __builtin_amdgcn_rcpf(1.0f + __expf(-x)); }
__device__ __forceinline__ unsigned f2h(float f) { return (unsigned)__builtin_bit_cast(unsigned short, (_Float16)f); }
__device__ __forceinline__ unsigned pkh2(float lo, float hi) { return f2h(lo) | (f2h(hi) << 16); }
__device__ __forceinline__ float h2f(unsigned short b) { return (float)__builtin_bit_cast(_Float16, b); }
__device__ __forceinline__ float wave_sum(float v) {
#pragma unroll
    for (int o = 1; o < 64; o <<= 1) v += __shfl_xor(v, o);
    return v;
}
#define LDS_WAIT() asm volatile("s_waitcnt lgkmcnt(0)" ::: "memory")

struct Params {
    const float* in[34];
    float* out;
    unsigned char* ws;
    int ph_lo, ph_hi;
};
enum { I_X = 0, I_C, I_CTX, I_CCTX, I_N1G, I_N2G, I_ADAW, I_ADAB, I_WIN, I_HCW, I_HCB, I_FW1, I_FB1, I_FW2, I_FB2, I_FW3, I_FB3, I_FW4, I_FFREQ, I_HSKIP,
       I_LBL, I_HGNG, I_WHY, I_WHG, I_WOUT, I_RW, I_RB, I_EG, I_EU, I_ED, I_SG, I_SU, I_SD, I_FG };
namespace pg8 {
constexpr int BM = 256, BK = 64, HALF = 128, HTB = HALF * BK * 2, STAGE_BYTES = 8 * HTB;
__host__ __device__ __forceinline__ int lds_byte(int r, int c) { const int st = (r >> 4) * 2 + (c >> 5), rr = r & 15, cc = c & 31, ob = rr * 64 + cc * 2; return st * 1024 + (ob ^ (((ob >> 9) & 1) << 5)); }
__host__ __device__ __forceinline__ void stage_rc(int b, int& R, int& C) { const int st = b / 1024, sb = b % 1024, swz = sb ^ (((sb >> 9) & 1) << 5); R = (st >> 1) * 16 + swz / 64; C = (st & 1) * 32 + (swz % 64) / 2; }
__host__ __device__ __forceinline__ int perm32(int rho) { const int n = rho >> 4, i = rho & 15; return 8 * (i >> 2) + 4 * n + (i & 3); }

struct Unit { int row0, lrow, pn, nvalid, aux, kind; unsigned boff; };
struct Gemm { const bf16_t* A; const bf16_t* Bt; int K; const int* rows; int ldb, kstepB; };

__device__ __forceinline__ unsigned cvt_pk_bf16(float lo, float hi) { unsigned r; asm volatile("v_cvt_pk_bf16_f32 %0, %1, %2" : "=v"(r) : "v"(lo), "v"(hi)); return r; }

template <class Epi, class Sched, bool GATHER>
__device__ __forceinline__ void gemm_phase(LAS unsigned char* lds, const Gemm g, const Sched& S, const Epi& E) {
    const int tid = threadIdx.x, wid = __builtin_amdgcn_readfirstlane(tid >> 6), lane = tid & 63, wr = wid >> 2, wc = wid & 3, fr = lane & 15, fq = lane >> 4;
    int K_ = g.K; asm volatile("" : "+s"(K_));
    const int K = K_, nt = K / BK; int ldb_ = g.ldb, ksb_ = g.kstepB; asm volatile("" : "+s"(ldb_), "+s"(ksb_));
    unsigned voffA[2], voffB[2]; int RA[2], CA[2];
#pragma unroll
    for (int i = 0; i < 2; ++i) { int R, C; stage_rc(tid * 16 + i * 8192, R, C); const int Rb = Epi::PERM ? ((R & ~31) + perm32(R & 31)) : R;
        voffA[i] = (unsigned)(R * K + C) * 2u; voffB[i] = (unsigned)(Rb * ldb_ + C * 2); RA[i] = R; CA[i] = C; }
    const size_t kstep = (size_t)(BK * 2);
    const size_t hstep = (size_t)HALF * K * 2;
    const size_t kstepB = (size_t)ksb_, hstepB = (size_t)HALF * ldb_;
    const unsigned ldsw = (unsigned)wid * 1024u;
    const int aoff = lds_byte(wr * 64 + fr, fq * 8), boff = lds_byte(wc * 32 + fr, fq * 8);
    unsigned vg0[2][2], vg1[2][2];
#define PG8_SA(b, h) (((b) * 2 + (h)) * HTB)
#define PG8_SB(b, h) ((4 + (b) * 2 + (h)) * HTB)
#define PG8_STAGE(bufoff, gbase, voff) do { _Pragma("unroll") for (int _i = 0; _i < 2; ++_i) \
        __builtin_amdgcn_global_load_lds((const unsigned*)((const char*)(gbase) + (voff)[_i]), (LAS unsigned*)(lds + (bufoff) + ldsw + _i * 8192), 16, 0, 0); } while (0)
#define PG8_STAGE_A(bufoff, gbase, h, w) do { _Pragma("unroll") for (int _i = 0; _i < 2; ++_i) { \
        const unsigned _o = GATHER ? ((w) ? vg1[h][_i] : vg0[h][_i]) : (voffA[_i] + (unsigned)((h) * hstep)); \
        __builtin_amdgcn_global_load_lds((const unsigned*)((const char*)(gbase) + _o), (LAS unsigned*)(lds + (bufoff) + ldsw + _i * 8192), 16, 0, 0); } } while (0)
#define PG8_LDA(dst, b, h) do { _Pragma("unroll") for (int m = 0; m < 4; ++m) _Pragma("unroll") for (int k = 0; k < 2; ++k) dst[m][k] = *(const LAS bf16x8*)(lds + PG8_SA(b, h) + aoff + m * 2048 + k * 1024); } while (0)
#define PG8_LDB(dst, b, h) do { _Pragma("unroll") for (int n = 0; n < 2; ++n) _Pragma("unroll") for (int k = 0; k < 2; ++k) dst[n][k] = *(const LAS bf16x8*)(lds + PG8_SB(b, h) + boff + n * 2048 + k * 1024); } while (0)
#define PG8_MMA(ai, bj, At, Bt) do { __builtin_amdgcn_s_setprio(1); _Pragma("unroll") for (int m = 0; m < 4; ++m) _Pragma("unroll") for (int n = 0; n < 2; ++n) _Pragma("unroll") for (int k = 0; k < 2; ++k) \
        acc[ai][bj][m][n] = __builtin_amdgcn_mfma_f32_16x16x32_bf16(Bt[n][k], At[m][k], acc[ai][bj][m][n], 0, 0, 0); __builtin_amdgcn_s_setprio(0); } while (0)
#define PG8_WAIT_V(n) asm volatile("s_waitcnt vmcnt(" #n ")" ::: "memory")
#define PG8_WAIT_L(n) asm volatile("s_waitcnt lgkmcnt(" #n ")" ::: "memory")
#define PG8_BAR __builtin_amdgcn_s_barrier()
#define PG8_SCHED __builtin_amdgcn_sched_barrier(0)
#define PG8_GOFF(dst, u) do { if (GATHER) { _Pragma("unroll") for (int _h = 0; _h < 2; ++_h) _Pragma("unroll") for (int _i = 0; _i < 2; ++_i) \
        dst[_h][_i] = (unsigned)(g.rows[(u).row0 + _h * HALF + RA[_i]] * K + CA[_i]) * 2u; } } while (0)
    Unit cur, nxt; int ui = 0;
    if (!S.next(0, cur)) return;
    f32x4 acc[2][2][4][2];
#pragma unroll
    for (int a = 0; a < 2; ++a)
#pragma unroll
        for (int b = 0; b < 2; ++b)
#pragma unroll
            for (int m = 0; m < 4; ++m)
#pragma unroll
                for (int n = 0; n < 2; ++n) acc[a][b][m][n] = (f32x4){0.f, 0.f, 0.f, 0.f};
    bf16x8 At[4][2], B0[2][2], B1[2][2];
    const char* cA = (const char*)g.A + (GATHER ? (size_t)0 : (size_t)cur.row0 * K * 2); const char* cB = (const char*)g.Bt + cur.boff;
    PG8_GOFF(vg0, cur);
#pragma unroll
    for (int _h = 0; _h < 2; ++_h)
#pragma unroll
        for (int _i = 0; _i < 2; ++_i) vg1[_h][_i] = vg0[_h][_i];
    PG8_STAGE(PG8_SB(0, 0), cB, voffB); PG8_STAGE_A(PG8_SA(0, 0), cA, 0, false); PG8_STAGE(PG8_SB(0, 1), cB + hstepB, voffB); PG8_STAGE_A(PG8_SA(0, 1), cA, 1, false);
    if (wr == 1) PG8_BAR;
    PG8_WAIT_V(4); PG8_BAR;
    PG8_STAGE(PG8_SB(1, 0), cB + kstepB, voffB); PG8_STAGE_A(PG8_SA(1, 0), cA + kstep, 0, false); PG8_STAGE(PG8_SB(1, 1), cB + hstepB + kstepB, voffB);
    PG8_WAIT_V(6); PG8_BAR;
    for (;;) {
        const bool has_next = S.next(ui + 1, nxt);
        if (has_next) PG8_GOFF(vg1, nxt);
        const char* nA = has_next ? (const char*)g.A + (GATHER ? (size_t)0 : (size_t)nxt.row0 * K * 2) : cA; const char* nB = has_next ? (const char*)g.Bt + nxt.boff : cB;
        const bool full = cur.nvalid > HALF;
        for (int t = 0; t < nt; t += 2) {
            const bool last = (t == nt - 2);
            const bool wn = last && has_next;
            const char* a1 = cA + (size_t)(t + 1) * kstep;
            const char* a2 = last ? nA : cA + (size_t)(t + 2) * kstep; const char* b2 = last ? nB : cB + (size_t)(t + 2) * kstepB;
            const char* a3 = a2 + kstep; const char* b3 = b2 + kstepB;
            PG8_LDB(B0, 0, 0); PG8_SCHED; PG8_LDA(At, 0, 0); PG8_STAGE_A(PG8_SA(1, 1), a1, 1, false);
            PG8_WAIT_L(8); PG8_BAR; PG8_WAIT_L(0); PG8_MMA(0, 0, At, B0); PG8_BAR; PG8_SCHED;
            PG8_LDB(B1, 0, 1); PG8_STAGE(PG8_SB(0, 0), b2, voffB);
            PG8_BAR; PG8_WAIT_L(0); PG8_MMA(0, 1, At, B1); PG8_BAR;
            if (full) PG8_LDA(At, 0, 1); PG8_STAGE_A(PG8_SA(0, 0), a2, 0, wn);
            PG8_BAR; PG8_WAIT_L(0); if (full) PG8_MMA(1, 0, At, B0); PG8_BAR; PG8_SCHED;
            PG8_STAGE(PG8_SB(0, 1), b2 + hstepB, voffB);
            PG8_WAIT_V(6); PG8_BAR; if (full) PG8_MMA(1, 1, At, B1); PG8_BAR;
            PG8_LDB(B0, 1, 0); PG8_SCHED; PG8_LDA(At, 1, 0); PG8_STAGE_A(PG8_SA(0, 1), a2, 1, wn);
            PG8_WAIT_L(8); PG8_BAR; PG8_WAIT_L(0); PG8_MMA(0, 0, At, B0); PG8_BAR; PG8_SCHED;
            PG8_LDB(B1, 1, 1); PG8_STAGE(PG8_SB(1, 0), b3, voffB);
            PG8_BAR; PG8_WAIT_L(0); PG8_MMA(0, 1, At, B1); PG8_BAR;
            if (full) PG8_LDA(At, 1, 1); PG8_STAGE_A(PG8_SA(1, 0), a3, 0, wn);
            PG8_BAR; PG8_WAIT_L(0); if (full) PG8_MMA(1, 0, At, B0); PG8_BAR; PG8_SCHED;
            PG8_STAGE(PG8_SB(1, 1), b3 + hstepB, voffB);
            PG8_WAIT_V(6); PG8_BAR; if (full) PG8_MMA(1, 1, At, B1); PG8_BAR;
        }
        { int fr_ = fr, fq_ = fq; asm volatile("" : "+v"(fr_), "+v"(fq_)); E(acc, cur, wr, wc, fr_, fq_); }
        if (!has_next) break;
#pragma unroll
        for (int a = 0; a < 2; ++a)
#pragma unroll
            for (int b = 0; b < 2; ++b)
#pragma unroll
                for (int m = 0; m < 4; ++m)
#pragma unroll
                    for (int n = 0; n < 2; ++n) acc[a][b][m][n] = (f32x4){0.f, 0.f, 0.f, 0.f};
        cur = nxt; cA = nA; cB = nB; ++ui;
#pragma unroll
        for (int _h = 0; _h < 2; ++_h)
#pragma unroll
            for (int _i = 0; _i < 2; ++_i) vg0[_h][_i] = vg1[_h][_i];
    }
    PG8_WAIT_V(0);
    if (wr == 0) PG8_BAR;
    PG8_BAR;
#undef PG8_SA
#undef PG8_SB
#undef PG8_STAGE
#undef PG8_STAGE_A
#undef PG8_LDA
#undef PG8_LDB
#undef PG8_MMA
#undef PG8_WAIT_V
#undef PG8_WAIT_L
#undef PG8_BAR
#undef PG8_SCHED
#undef PG8_GOFF
}

struct StaticOrder {
    int nM, nN, nwg, G, c, Kb;
    __device__ void init(int M, int N, int K, int G_, int c_) { nM = M / BM; nN = N / BM; nwg = nM * nN; G = G_; c = c_; Kb = K; }
    __device__ bool next(int i, Unit& u) const {
        const long L = (long)i * G + c; if (L >= nwg) return false;
        int wgid = (int)L; { const int NXCD = 8; const int q = nwg / NXCD, r = nwg % NXCD, xcd = wgid % NXCD, off = wgid / NXCD; wgid = (xcd < r ? xcd * (q + 1) : r * (q + 1) + (xcd - r) * q) + off; }
        const int WGM = 8; const int nig = WGM * nN, gid = wgid / nig, fm = gid * WGM, gsz = (nM - fm) < WGM ? (nM - fm) : WGM;
        u.row0 = (fm + ((wgid % nig) % gsz)) * BM; u.lrow = u.row0; u.pn = (wgid % nig) / gsz; u.nvalid = BM; u.aux = u.pn; u.kind = 0; u.boff = (unsigned)u.pn * (unsigned)(BM * 2) * (unsigned)Kb; return true;
    }
};
}
using pg8::Unit; using pg8::cvt_pk_bf16;
typedef const f32x4 (&AccRef)[2][2][4][2];

struct MoeOrder {
    const unsigned* units; int ntile, nsub, G, c; unsigned ebytes;
    __device__ bool next(int i, Unit& u) const {
        const long L = (long)i * G + c; const int nun = ntile * nsub; if (L >= nun) return false;
        int idx = (int)L; { const int q = nun / 8, r = nun % 8, xcd = idx % 8, off = idx / 8; idx = (xcd < r ? xcd * (q + 1) : r * (q + 1) + (xcd - r) * q) + off; }
        const int tile = idx / nsub, sub = idx % nsub;
        const u32x4 d = *(const u32x4*)(units + 4 * tile);
        u.row0 = (int)d.x; u.lrow = u.row0; u.pn = (int)d.y * nsub + sub; u.nvalid = (int)d.z; u.aux = sub; u.kind = 0; u.boff = d.y * ebytes + (unsigned)sub * 32768u; return true;
    }
};

struct EpiInT {
    static constexpr bool PERM = true;
    bf16_t* phyt; bf16_t* vt;
    __device__ __forceinline__ void operator()(AccRef acc, const Unit& u, int wr, int wc, int fr, int fq) const {
        const int pm = u.lrow >> 8, tb = u.pn * 256; const bool isctx = tb >= T;
        int b, nbase; if (!isctx) { b = tb >> 13; nbase = tb & (SEQ - 1); } else { b = (tb - T) >> 8; nbase = 0; }
        if (pm < 6 && isctx) return;
#pragma unroll
        for (int ai = 0; ai < 2; ++ai)
#pragma unroll
            for (int m = 0; m < 4; ++m) {
                const int f = u.lrow + ai * 128 + wr * 64 + m * 16 + fr;
                bf16_t* rowp = (pm < 6) ? phyt + ((size_t)(b * HYP + f) * SEQ + nbase) : vt + ((size_t)(b * HGW + (f - HYP)) * NEXT + (isctx ? 0 : CTXL) + nbase);
#pragma unroll
                for (int bj = 0; bj < 2; ++bj) { const int cu = bj * 128 + wc * 32 + 8 * fq; const f32x4 v0 = acc[ai][bj][m][0], v1 = acc[ai][bj][m][1];
                    u32x4 w; w.x = cvt_pk_bf16(v0[0], v0[1]); w.y = cvt_pk_bf16(v0[2], v0[3]); w.z = cvt_pk_bf16(v1[0], v1[1]); w.w = cvt_pk_bf16(v1[2], v1[3]);
                    *(u32x4*)(rowp + cu) = w; }
            }
    }
};
struct EpiInN {
    static constexpr bool PERM = true;
    bf16_t *q, *g, *sg1, *sg2; float *lf, *lb; const float* lbs;
    __device__ __forceinline__ void operator()(AccRef acc, const Unit& u, int wr, int wc, int fr, int fq) const {
        const int pn = u.pn; const bool isctx = u.lrow >= T;
        if (isctx && (pn < 2 || pn > 5)) return;
        float lbu[2][8];
        if (pn >= 2 && pn < 6) {
#pragma unroll
            for (int bj = 0; bj < 2; ++bj) { const float* lbp = lbs + (pn >= 4) * 512 + (pn & 1) * 256 + bj * 128 + wc * 32 + 8 * fq; const f32x4 l0 = *(const f32x4*)lbp, l1 = *(const f32x4*)(lbp + 4);
                lbu[bj][0] = l0[0]; lbu[bj][1] = l0[1]; lbu[bj][2] = l0[2]; lbu[bj][3] = l0[3]; lbu[bj][4] = l1[0]; lbu[bj][5] = l1[1]; lbu[bj][6] = l1[2]; lbu[bj][7] = l1[3]; } }
#pragma unroll
        for (int ai = 0; ai < 2; ++ai)
#pragma unroll
            for (int m = 0; m < 4; ++m) {
                const int r = u.lrow + ai * 128 + wr * 64 + m * 16 + fr;
                int b, nx; if (!isctx) { b = r >> 13; nx = CTXL + (r & (SEQ - 1)); } else { const int rr = r - T; b = rr >> 8; nx = rr & 255; }
#pragma unroll
                for (int bj = 0; bj < 2; ++bj) { const int cu = bj * 128 + wc * 32 + 8 * fq; const f32x4 v0 = acc[ai][bj][m][0], v1 = acc[ai][bj][m][1];
                    float x[8] = {v0[0], v0[1], v0[2], v0[3], v1[0], v1[1], v1[2], v1[3]};
                    if (pn >= 2 && pn < 6) {
                        const int dir = pn >= 4, col = (pn & 1) * 256 + cu;
                        float o[8];
#pragma unroll
                        for (int j = 0; j < 8; ++j) o[j] = __logf(lbu[bj][j] + (1.0f - lbu[bj][j]) * sigmoidf_(x[j]));
                        float* dst = (dir ? lb : lf) + ((size_t)(b * NEXT + nx) * HGW + col);
                        *(f32x4*)dst = (f32x4){o[0], o[1], o[2], o[3]}; *(f32x4*)(dst + 4) = (f32x4){o[4], o[5], o[6], o[7]};
                    } else {
                        bf16_t* dst;
                        if (pn < 2) { dst = q + (size_t)r * HGW + pn * 256 + cu;
#pragma unroll
                            for (int j = 0; j < 8; ++j) x[j] = siluf_(x[j]); }
                        else if (pn < 8) { dst = g + (size_t)r * HGW + (pn - 6) * 256 + cu;
#pragma unroll
                            for (int j = 0; j < 8; ++j) x[j] = siluf_(x[j]); }
                        else { dst = (pn < 12 ? sg1 + (size_t)r * D + (pn - 8) * 256 : sg2 + (size_t)r * D + (pn - 12) * 256) + cu;
#pragma unroll
                            for (int j = 0; j < 8; ++j) x[j] = sigmoidf_(x[j]); }
                        u32x4 w; w.x = cvt_pk_bf16(x[0], x[1]); w.y = cvt_pk_bf16(x[2], x[3]); w.z = cvt_pk_bf16(x[4], x[5]); w.w = cvt_pk_bf16(x[6], x[7]);
                        *(u32x4*)dst = w;
                    }
                }
            }
    }
};
struct EpiMerge1 {
    static constexpr bool PERM = false;
    const bf16_t* sg1; float* t1;
    __device__ __forceinline__ void operator()(AccRef acc, const Unit& u, int wr, int wc, int fr, int fq) const {
#pragma unroll
        for (int ai = 0; ai < 2; ++ai) { u32x2 s[4][2][2];
#pragma unroll
            for (int m = 0; m < 4; ++m) { const size_t ro = (size_t)(u.lrow + ai * 128 + wr * 64 + m * 16 + fr) * D + u.pn * 256 + wc * 32 + 4 * fq;
#pragma unroll
                for (int bj = 0; bj < 2; ++bj)
#pragma unroll
                    for (int n = 0; n < 2; ++n) s[m][bj][n] = *(const u32x2*)(sg1 + ro + bj * 128 + n * 16); }
#pragma unroll
            for (int m = 0; m < 4; ++m) { const size_t ro = (size_t)(u.lrow + ai * 128 + wr * 64 + m * 16 + fr) * D + u.pn * 256 + wc * 32 + 4 * fq;
#pragma unroll
                for (int bj = 0; bj < 2; ++bj)
#pragma unroll
                    for (int n = 0; n < 2; ++n) { const f32x4 a = acc[ai][bj][m][n]; const u32x2 sv = s[m][bj][n];
                        *(f32x4*)(t1 + ro + bj * 128 + n * 16) = (f32x4){a[0] * bflo(sv.x), a[1] * bfhi(sv.x), a[2] * bflo(sv.y), a[3] * bfhi(sv.y)}; } } }
    }
};
struct EpiMerge2 {
    static constexpr bool PERM = false;
    const bf16_t* sg2; const float* t1; bf16_t* mb;
    __device__ __forceinline__ void operator()(AccRef acc, const Unit& u, int wr, int wc, int fr, int fq) const {
#pragma unroll
        for (int ai = 0; ai < 2; ++ai)
#pragma unroll
            for (int m = 0; m < 4; ++m) { u32x2 s[2][2]; f32x4 p[2][2];
                const size_t ro = (size_t)(u.lrow + ai * 128 + wr * 64 + m * 16 + fr) * D + u.pn * 256 + wc * 32 + 4 * fq;
#pragma unroll
                for (int bj = 0; bj < 2; ++bj)
#pragma unroll
                    for (int n = 0; n < 2; ++n) { s[bj][n] = *(const u32x2*)(sg2 + ro + bj * 128 + n * 16); p[bj][n] = *(const f32x4*)(t1 + ro + bj * 128 + n * 16); }
#pragma unroll
                for (int bj = 0; bj < 2; ++bj)
#pragma unroll
                    for (int n = 0; n < 2; ++n) { const f32x4 a = acc[ai][bj][m][n], pv = p[bj][n]; const u32x2 sv = s[bj][n];
                        u32x2 w; w.x = cvt_pk_bf16(pv[0] + a[0] * bflo(sv.x), pv[1] + a[1] * bfhi(sv.x)); w.y = cvt_pk_bf16(pv[2] + a[2] * bflo(sv.y), pv[3] + a[3] * bfhi(sv.y));
                        *(u32x2*)(mb + ro + bj * 128 + n * 16) = w; } }
    }
};
struct EpiWout {
    static constexpr bool PERM = false;
    const float* x; const float* posr; const float* posc; const float* ada; float* x1;
    __device__ __forceinline__ void operator()(AccRef acc, const Unit& u, int wr, int wc, int fr, int fq) const {
        const int b = u.lrow >> 13, cb = u.pn * 256 + wc * 32 + 4 * fq;
        f32x4 g1[2][2];
#pragma unroll
        for (int bj = 0; bj < 2; ++bj)
#pragma unroll
            for (int nn = 0; nn < 2; ++nn) g1[bj][nn] = *(const f32x4*)(ada + b * 6144 + 2 * D + cb + bj * 128 + nn * 16);
#pragma unroll
        for (int ai = 0; ai < 2; ++ai)
#pragma unroll
            for (int m = 0; m < 4; ++m) { f32x4 xv[2][2], pe[2][2];
                const int r = u.lrow + ai * 128 + wr * 64 + m * 16 + fr, n = r & (SEQ - 1);
#pragma unroll
                for (int bj = 0; bj < 2; ++bj)
#pragma unroll
                    for (int nn = 0; nn < 2; ++nn) { const int c = cb + bj * 128 + nn * 16; xv[bj][nn] = *(const f32x4*)(x + (size_t)r * D + c);
                        pe[bj][nn] = (c < 512) ? *(const f32x4*)(posr + (n >> 6) * 512 + c) : *(const f32x4*)(posc + (n & 63) * 512 + (c - 512)); }
#pragma unroll
                for (int bj = 0; bj < 2; ++bj)
#pragma unroll
                    for (int nn = 0; nn < 2; ++nn) *(f32x4*)(x1 + (size_t)r * D + cb + bj * 128 + nn * 16) = xv[bj][nn] + pe[bj][nn] + g1[bj][nn] * acc[ai][bj][m][nn]; }
    }
};
struct EpiLogit {
    static constexpr bool PERM = true;
    float* lg;
    __device__ __forceinline__ void operator()(AccRef acc, const Unit& u, int wr, int wc, int fr, int fq) const {
#pragma unroll
        for (int ai = 0; ai < 2; ++ai)
#pragma unroll
            for (int m = 0; m < 4; ++m) { float* rp = lg + (size_t)(u.lrow + ai * 128 + wr * 64 + m * 16 + fr) * NE + wc * 32 + 8 * fq;
#pragma unroll
                for (int bj = 0; bj < 2; ++bj) { *(f32x4*)(rp + bj * 128) = acc[ai][bj][m][0]; *(f32x4*)(rp + bj * 128 + 4) = acc[ai][bj][m][1]; } }
    }
};
struct EpiGU {
    static constexpr bool PERM = true;
    bf16_t* hout;
    __device__ __forceinline__ void operator()(AccRef acc, const Unit& u, int wr, int wc, int fr, int fq) const {
#pragma unroll
        for (int ai = 0; ai < 2; ++ai)
#pragma unroll
            for (int m = 0; m < 4; ++m) { const int rl = ai * 128 + wr * 64 + m * 16 + fr;
                if (rl < u.nvalid) { const f32x4 g0 = acc[ai][0][m][0], g1 = acc[ai][0][m][1], u0 = acc[ai][1][m][0], u1 = acc[ai][1][m][1];
                    u32x4 w; w.x = cvt_pk_bf16(siluf_(g0[0]) * u0[0], siluf_(g0[1]) * u0[1]); w.y = cvt_pk_bf16(siluf_(g0[2]) * u0[2], siluf_(g0[3]) * u0[3]);
                    w.z = cvt_pk_bf16(siluf_(g1[0]) * u1[0], siluf_(g1[1]) * u1[1]); w.w = cvt_pk_bf16(siluf_(g1[2]) * u1[2], siluf_(g1[3]) * u1[3]);
                    *(u32x4*)(hout + (size_t)(u.lrow + rl) * EH + u.aux * 128 + wc * 32 + 8 * fq) = w; } }
    }
};
template <bool HASW, bool FP8 = false> struct EpiDown {
    static constexpr bool PERM = true;
    bf16_t* yout; const float* wrow;
    __device__ __forceinline__ void operator()(AccRef acc, const Unit& u, int wr, int wc, int fr, int fq) const {
        char* base = (char*)yout + ((size_t)u.lrow * D + u.aux * 256 + wc * 32) * (FP8 ? 1 : 2);
        float wv[2][4];
#pragma unroll
        for (int ai = 0; ai < 2; ++ai)
#pragma unroll
            for (int m = 0; m < 4; ++m) { const int rl = ai * 128 + wr * 64 + m * 16 + fr; wv[ai][m] = (HASW && rl < u.nvalid) ? wrow[u.lrow + rl] : 1.0f; }
#pragma unroll
        for (int ai = 0; ai < 2; ++ai)
#pragma unroll
            for (int m = 0; m < 4; ++m) { const int rl = ai * 128 + wr * 64 + m * 16 + fr;
                if (rl < u.nvalid) { const float w_ = wv[ai][m];
                    const unsigned off = (unsigned)(rl * D + 8 * fq) * (FP8 ? 1u : 2u);
#pragma unroll
                    for (int bj = 0; bj < 2; ++bj) { const f32x4 v0 = acc[ai][bj][m][0] * w_, v1 = acc[ai][bj][m][1] * w_;
                        if (FP8) { int a = __builtin_amdgcn_cvt_pk_fp8_f32(v0[0], v0[1], 0, false); a = __builtin_amdgcn_cvt_pk_fp8_f32(v0[2], v0[3], a, true);
                            int c = __builtin_amdgcn_cvt_pk_fp8_f32(v1[0], v1[1], 0, false); c = __builtin_amdgcn_cvt_pk_fp8_f32(v1[2], v1[3], c, true);
                            *(u32x2*)(base + off + bj * 128) = (u32x2){(unsigned)a, (unsigned)c}; }
                        else { u32x4 w; w.x = cvt_pk_bf16(v0[0], v0[1]); w.y = cvt_pk_bf16(v0[2], v0[3]); w.z = cvt_pk_bf16(v1[0], v1[1]); w.w = cvt_pk_bf16(v1[2], v1[3]);
                            *(u32x4*)(base + off + bj * 256) = w; } } } }
    }
};

constexpr int RA1 = (int)((WS_A1 - WS_WINT) / (D * 2));
static_assert((WS_A1 - WS_WINT) % (D * 2) == 0, "A1 must sit a whole number of rows above WINT");
struct InOrder {
    int G, c;
    static constexpr int N0 = 6 * 64, N1 = 2 * 64, N2 = 64 * 16, NU = N0 + N1 + N2;
    __device__ bool next(int i, Unit& u) const {
        const long L = (long)i * G + c; if (L >= NU) return false;
        int idx = (int)L; { const int q = NU / 8, r = NU % 8, xcd = idx % 8, off = idx / 8; idx = (xcd < r ? xcd * (q + 1) : r * (q + 1) + (xcd - r) * q) + off; }
        int pm, pn, kind;
        if (idx < N0 + N1) { const int g = idx >> 5, jj = idx & 31; kind = 0; pm = 4 * (g & 1) + (jj & 3); pn = 8 * (g >> 1) + (jj >> 2); }
        else { const int j = idx - N0 - N1, g = j >> 7, jj = j & 127; kind = 1; pm = 8 * g + (jj & 7); pn = jj >> 3; }
        fill(u, kind, pm, pn); return true;
    }
    __device__ static void fill(Unit& u, int kind, int pm, int pn) {
        u.kind = kind; u.pn = pn; u.lrow = pm * 256; u.nvalid = 256; u.aux = pn;
        if (kind == 0) { u.row0 = pm * 256; u.boff = (unsigned)(RA1 + pn * 256) * (unsigned)(D * 2); }
        else { u.row0 = RA1 + pm * 256; u.boff = (unsigned)(2048 + pn * 256) * (unsigned)(D * 2); }
    }
};
struct CtxUnit {
    int idx;
    __device__ static int tile(int idx) { return idx < 4 ? (idx & 1) : ((idx - 4) >> 2); }
    __device__ bool next(int i, Unit& u) const { if (i) return false;
        if (idx < 4) InOrder::fill(u, 0, 6 + (idx >> 1), 64 + (idx & 1)); else InOrder::fill(u, 1, 64 + ((idx - 4) >> 2), 2 + ((idx - 4) & 3)); return true; }
};
struct EpiIn {
    static constexpr bool PERM = true;
    EpiInT t; EpiInN n;
    __device__ __forceinline__ void operator()(AccRef acc, const Unit& u, int wr, int wc, int fr, int fq) const { if (u.kind == 0) t(acc, u, wr, wc, fr, fq); else n(acc, u, wr, wc, fr, fq); }
};
struct P9Order {
    int G, c;
    __device__ bool next(int i, Unit& u) const {
        const long L = (long)i * G + c; if (L >= 192) return false; int idx = (int)L;
        { const int xcd = idx % 8, off = idx / 8; idx = xcd * 24 + off; }
        const int pm = idx / 3, k3 = idx % 3;
        u.row0 = pm * 256;
        if (k3 == 0) { u.kind = 0; u.pn = 0; u.aux = 0; u.boff = 0u; }
        else { u.kind = 1; u.pn = k3 - 1; u.aux = k3 - 1; u.boff = (unsigned)(WS_SHGUT - WS_ROUT) + (unsigned)(k3 - 1) * (unsigned)(256 * D * 2); }
        u.lrow = u.row0; u.nvalid = 256; return true;
    }
};
struct EpiP9 {
    static constexpr bool PERM = true;
    EpiLogit l; EpiGU g;
    __device__ __forceinline__ void operator()(AccRef acc, const Unit& u, int wr, int wc, int fr, int fq) const { if (u.kind == 0) l(acc, u, wr, wc, fr, fq); else g(acc, u, wr, wc, fr, fq); }
};
#define XB_TMO      128
#define XB_XCNT(j)  (256  + 64 * (j))
#define XB_XSUB(j)  (1280 + 64 * (j))
#define XB_XGEN(j)  (2304 + 64 * (j))
#define XB_TOP      3328
#define XB_TOPGEN   3392
#define XCD_BAR_WORDS 3456
#define XB_SPIN_CAP (1u << 18)

__device__ __forceinline__ unsigned xb_ld(unsigned* p)              { return __hip_atomic_load(p, __ATOMIC_RELAXED, __HIP_MEMORY_SCOPE_AGENT); }
__device__ __forceinline__ unsigned xb_add(unsigned* p, unsigned v) { return __hip_atomic_fetch_add(p, v, __ATOMIC_RELAXED, __HIP_MEMORY_SCOPE_AGENT); }
__device__ __forceinline__ unsigned xb_xcc_id() { return (unsigned)__builtin_amdgcn_s_getreg((3 << 11) | 20) & 0xFu; }
#define XB_SPIN(cond, bar) do { unsigned _sp = 0; while (cond) { __builtin_amdgcn_s_sleep(1); \
    if ((++_sp & 255u) == 0u) { if (xb_ld(&(bar)[XB_TMO])) break; if (_sp > XB_SPIN_CAP) { atomicAdd(&(bar)[XB_TMO], 1u); break; } } } } while (0)

struct XcdBarrier {
    unsigned* bar; unsigned x;
    volatile LAS unsigned* st;
};

__device__ __forceinline__ XcdBarrier xcd_barrier_post(unsigned* bar, volatile LAS unsigned* st) {
    XcdBarrier b; b.bar = bar; b.x = xb_xcc_id(); b.st = st;
    if (threadIdx.x == 0) (void)xb_add(&bar[XB_XCNT(b.x)], 1u);
    return b;
}
__device__ __forceinline__ void xcd_barrier_complete(unsigned* bar, unsigned x, unsigned& nloc, unsigned& nx) {
    const unsigned G = gridDim.x * gridDim.y * gridDim.z;
    unsigned sum, cnt, mine, sp = 0u;
    for (;;) {
        sum = 0u; cnt = 0u; mine = 0u;
#pragma unroll
        for (unsigned j = 0; j < 16; ++j) { const unsigned c = xb_ld(&bar[XB_XCNT(j)]); sum += c; cnt += (c > 0u) ? 1u : 0u; mine = (j == x) ? c : mine; }
        if (sum == G) break;
        __builtin_amdgcn_s_sleep(1);
        if ((++sp & 255u) == 0u) { if (xb_ld(&bar[XB_TMO])) break; if (sp > XB_SPIN_CAP) { atomicAdd(&bar[XB_TMO], 1u); break; } }
    }
    nloc = mine > 0u ? mine : 1u; nx = cnt > 0u ? cnt : 1u;
}

__device__ __forceinline__ void xcd_barrier(const XcdBarrier& b) {
    asm volatile("s_waitcnt vmcnt(0)" ::: "memory");
    __syncthreads();
    if (threadIdx.x == 0) {
        unsigned* bar = b.bar;
        __builtin_amdgcn_s_waitcnt(0);
        unsigned nloc = b.st[0], nx = b.st[1];
        if (nloc == 0u) { xcd_barrier_complete(bar, b.x, nloc, nx); b.st[0] = nloc; b.st[1] = nx; }
        const unsigned old = xb_add(&bar[XB_XSUB(b.x)], 1u);
        const unsigned gen = old / nloc;
        if (old + 1u == (gen + 1u) * nloc) {
            __builtin_amdgcn_fence(__ATOMIC_RELEASE, "agent");
            asm volatile("s_waitcnt vmcnt(0)" ::: "memory");
            const unsigned og = xb_add(&bar[XB_TOP], 1u);
            const unsigned tg = og / nx;
            if (og + 1u == (tg + 1u) * nx) xb_add(&bar[XB_TOPGEN], 1u);
            else XB_SPIN(xb_ld(&bar[XB_TOPGEN]) == tg, bar);
            __builtin_amdgcn_fence(__ATOMIC_ACQUIRE, "agent");
            xb_add(&bar[XB_XGEN(b.x)], 1u);
            asm volatile("s_waitcnt vmcnt(0)" ::: "memory");
        } else {
            XB_SPIN(xb_ld(&bar[XB_XGEN(b.x)]) == gen, bar);
            __builtin_amdgcn_fence(__ATOMIC_ACQUIRE, "agent");
            asm volatile("s_waitcnt vmcnt(0)" ::: "memory");
        }
    }
    __syncthreads();
}


struct Frame {
    LAS unsigned char* lds;
    const Params* p;
    unsigned char* ws;
    int tid, lane, wave, G, bx;
};
#define WSP(T_, off) ((T_*)(F.ws + (off)))

__device__ __forceinline__ void p0_transpose_item(const float* W, int N, bf16_t* WT, int K, int k0, int n0, int row0, LAS float* scr, int lane) {
#pragma unroll 8
    for (int i = 0; i < 32; ++i) { const int kk = 2 * i + (lane >> 5); scr[kk * 33 + (lane & 31)] = W[(size_t)(k0 + kk) * N + n0 + (lane & 31)]; }
    LDS_WAIT(); asm volatile("" ::: "memory");
    const int c = lane & 7;
#pragma unroll
    for (int j = 0; j < 4; ++j) { const int n = (lane >> 3) + 8 * j; const LAS float* s = scr + (8 * c) * 33 + n;
        u32x4 o; o.x = pk2(s[0 * 33], s[1 * 33]); o.y = pk2(s[2 * 33], s[3 * 33]); o.z = pk2(s[4 * 33], s[5 * 33]); o.w = pk2(s[6 * 33], s[7 * 33]);
        *(u32x4*)(WT + (size_t)(row0 + n) * K + k0 + 8 * c) = o; }
    LDS_WAIT(); asm volatile("" ::: "memory");
}
__device__ __forceinline__ int gu_row(int n0, int up) { return (n0 >> 7) * 256 + up * 128 + (n0 & 127); }

__device__ __forceinline__ void p0_transposes(Frame& F) {
    LAS float* scr = (LAS float*)(F.lds + F.wave * 16384);
    const int gw = F.bx * 8 + F.wave, NGW = F.G * 8;
    const float* const* in = F.p->in;
    constexpr int I_WIN_ = 16 * 192, I_WHY_ = 8 * 32, I_WHG_ = 8 * 32, I_WOUT_ = 16 * 32, I_R_ = 16 * 8, I_SG_ = 16 * 8, I_SU_ = 16 * 8, I_SD_ = 4 * 32;
    constexpr int NSMALL = I_WIN_ + I_WHY_ + I_WHG_ + I_WOUT_ + I_R_ + I_SG_ + I_SU_ + I_SD_;
    for (int it = gw; it < NSMALL; it += NGW) {
        int r = it;
        {
            if (r < I_WIN_) { const int kb = r / 192, nb = r % 192, n0 = nb * 32; const int f0 = (n0 >= 1536 && n0 < 2048) ? n0 + 512 : ((n0 >= 2048 && n0 < 2560) ? n0 - 512 : n0);
                p0_transpose_item(in[I_WIN], INC, WSP(bf16_t, WS_WINT), D, kb * 64, n0, f0, scr, F.lane); continue; } r -= I_WIN_;
            if (r < I_WHY_) { p0_transpose_item(in[I_WHY], D, WSP(bf16_t, WS_WHYT), HYW, (r / 32) * 64, (r % 32) * 32, (r % 32) * 32, scr, F.lane); continue; } r -= I_WHY_;
            if (r < I_WHG_) { p0_transpose_item(in[I_WHG], D, WSP(bf16_t, WS_WHGT), HGW, (r / 32) * 64, (r % 32) * 32, (r % 32) * 32, scr, F.lane); continue; } r -= I_WHG_;
            if (r < I_WOUT_) { p0_transpose_item(in[I_WOUT], D, WSP(bf16_t, WS_WOUTT), D, (r / 32) * 64, (r % 32) * 32, (r % 32) * 32, scr, F.lane); continue; } r -= I_WOUT_;
            if (r < I_R_) { p0_transpose_item(in[I_RW], NE, WSP(bf16_t, WS_ROUT), D, (r / 8) * 64, (r % 8) * 32, (r % 8) * 32, scr, F.lane); continue; } r -= I_R_;
            if (r < I_SG_) { p0_transpose_item(in[I_SG], EH, WSP(bf16_t, WS_SHGUT), D, (r / 8) * 64, (r % 8) * 32, gu_row((r % 8) * 32, 0), scr, F.lane); continue; } r -= I_SG_;
            if (r < I_SU_) { p0_transpose_item(in[I_SU], EH, WSP(bf16_t, WS_SHGUT), D, (r / 8) * 64, (r % 8) * 32, gu_row((r % 8) * 32, 1), scr, F.lane); continue; } r -= I_SU_;
            p0_transpose_item(in[I_SD], D, WSP(bf16_t, WS_SHDT), EH, (r / 32) * 64, (r % 32) * 32, (r % 32) * 32, scr, F.lane); continue;
        }
    }
}

template <int MODE  >
__device__ __forceinline__ void p0_x256_load(const float* W, int N, int k0, int n0, int tid, f32x4 (&v)[8]) {
    const int n4 = MODE ? ((tid >> 6) * 8 + (tid & 7)) : (tid & 63), kq = MODE ? ((tid >> 3) & 7) : (tid >> 6); const float* src = W + (size_t)(k0 + 8 * kq) * N + n0 + 4 * n4;
#pragma unroll
    for (int r = 0; r < 8; ++r) v[r] = __builtin_nontemporal_load((const f32x4*)(src + (size_t)r * N));
}
__device__ __forceinline__ void p0_x256_store(LAS unsigned char* ts, bf16_t* WT, int K, int k0, int row0, int mode, int tid, const f32x4 (&v)[8]) {
    const int n4 = tid & 63, kq = tid >> 6;
    __syncthreads();
#pragma unroll
    for (int i = 0; i < 4; ++i) { const int n = 4 * n4 + i;
        u32x4 o; o.x = pk2(v[0][i], v[1][i]); o.y = pk2(v[2][i], v[3][i]); o.z = pk2(v[4][i], v[5][i]); o.w = pk2(v[6][i], v[7][i]);
        *(LAS u32x4*)(ts + n * 128 + ((kq ^ (n4 & 7)) << 4)) = o; }
    __syncthreads();
#pragma unroll
    for (int q = 0; q < 4; ++q) { const int task = tid + 512 * q, n = task >> 3, part = task & 7;
        const u32x4 o = *(const LAS u32x4*)(ts + n * 128 + ((part ^ ((n >> 2) & 7)) << 4));
        const int row = mode == 0 ? row0 + n : ((n >> 7) * 256 + (mode - 1) * 128 + (n & 127));
        *(u32x4*)(WT + (size_t)(k0 >> 6) * K + row * 64 + 8 * part) = o; }
}
__device__ __forceinline__ void p0_x256_decode(const float* const* in, unsigned char* ws, int item, const float*& W, int& N, bf16_t*& WT, int& K, int& k0, int& n0, int& mode) {
    const int e = item / 48, r = item % 48;
    if (r < 16) { W = in[I_EG] + (size_t)e * D * EH; N = EH; WT = (bf16_t*)(ws + WS_EGUT) + (size_t)e * 512 * D; K = 512 * 64; k0 = r * 64; n0 = 0; mode = 1; }
    else if (r < 32) { W = in[I_EU] + (size_t)e * D * EH; N = EH; WT = (bf16_t*)(ws + WS_EGUT) + (size_t)e * 512 * D; K = 512 * 64; k0 = (r - 16) * 64; n0 = 0; mode = 2; }
    else { const int q = r - 32; W = in[I_ED] + (size_t)e * EH * D; N = D; WT = (bf16_t*)(ws + WS_EDT) + (size_t)e * D * EH; K = D * 64; k0 = (q >> 2) * 64; n0 = (q & 3) * 256; mode = 0; }
}
struct XpState { f32x4 v[8]; int it, end, stride; bool live; };
__device__ __forceinline__ void xp_issue(XpState& s, const float* const* in, unsigned char* ws, int tid) {
    s.live = s.it < s.end;
    if (s.live) { const float* W; int N, K, k0, n0, mode; bf16_t* WT; p0_x256_decode(in, ws, s.it, W, N, WT, K, k0, n0, mode); p0_x256_load<1>(W, N, k0, n0, tid, s.v); }
}
__device__ __forceinline__ void xp_finish(XpState& s, const float* const* in, unsigned char* ws, int tid) {
    if (s.live) { const float* W; int N, K, k0, n0, mode; bf16_t* WT; p0_x256_decode(in, ws, s.it, W, N, WT, K, k0, n0, mode);
        const int n4 = (tid >> 6) * 8 + (tid & 7), kq = (tid >> 3) & 7;
#pragma unroll
        for (int i = 0; i < 4; ++i) { const int n = 4 * n4 + i; const int row = mode == 0 ? n0 + n : ((n >> 7) * 256 + (mode - 1) * 128 + (n & 127));
            u32x4 o; o.x = pk2(s.v[0][i], s.v[1][i]); o.y = pk2(s.v[2][i], s.v[3][i]); o.z = pk2(s.v[4][i], s.v[5][i]); o.w = pk2(s.v[6][i], s.v[7][i]);
            *(u32x4*)(WT + (size_t)(k0 >> 6) * K + row * 64 + 8 * kq) = o; }
        s.it += s.stride; s.live = false; }
}
__device__ __forceinline__ void xp_step(XpState& s, const float* const* in, unsigned char* ws, int tid) { xp_finish(s, in, ws, tid); xp_issue(s, in, ws, tid); }
constexpr int XP_BG = 30;
constexpr int XP_K0 = 6;
constexpr int NCONV = 36;
__device__ __forceinline__ void conv_loop(const float* const* in, unsigned char* ws, int first, int stride, int end, int tid) {
    XpState a, b, c, d; a.stride = b.stride = c.stride = d.stride = 4 * stride; a.end = b.end = c.end = d.end = end; a.live = b.live = c.live = d.live = false;
    a.it = first; b.it = first + stride; c.it = first + 2 * stride; d.it = first + 3 * stride;
    xp_issue(a, in, ws, tid); xp_issue(b, in, ws, tid); xp_issue(c, in, ws, tid);
    while (a.live) {
        xp_issue(d, in, ws, tid); xp_finish(a, in, ws, tid);
        if (!b.live) break; xp_issue(a, in, ws, tid); xp_finish(b, in, ws, tid);
        if (!c.live) break; xp_issue(b, in, ws, tid); xp_finish(c, in, ws, tid);
        if (!d.live) break; xp_issue(c, in, ws, tid); xp_finish(d, in, ws, tid);
    }
}

__device__ __forceinline__ void p0_expert_transposes(Frame& F) {
    int tid = F.tid; asm volatile("" : "+v"(tid));
    constexpr int NIT = NE * 48;
    int it = F.bx + XP_BG * F.G; if (it >= NIT) return;
    const int p0end = (F.G == 256) ? 256 * (XP_BG + XP_K0) : NIT;
    const float* W; int N, K, k0, n0, mode; bf16_t* WT;
    const float* W2; int N2, K2, k2, n2, mode2; bf16_t* WT2;
    f32x4 va[8], vb[8];
    p0_x256_decode(F.p->in, F.ws, it, W, N, WT, K, k0, n0, mode);
    p0_x256_load<0>(W, N, k0, n0, tid, va);
    for (;;) {
        __builtin_amdgcn_s_waitcnt(0);
        int nx = it + F.G; bool has = nx < p0end;
        if (has) { p0_x256_decode(F.p->in, F.ws, nx, W2, N2, WT2, K2, k2, n2, mode2); p0_x256_load<0>(W2, N2, k2, n2, tid, vb); }
        p0_x256_store(F.lds, WT, K, k0, n0, mode, tid, va);
        if (!has) break;
        it = nx;
        __builtin_amdgcn_s_waitcnt(0);
        nx = it + F.G; has = nx < p0end;
        if (has) { p0_x256_decode(F.p->in, F.ws, nx, W, N, WT, K, k0, n0, mode); p0_x256_load<0>(W, N, k0, n0, tid, va); }
        p0_x256_store(F.lds, WT2, K2, k2, n2, mode2, tid, vb);
        if (!has) break;
        it = nx;
    }
}

constexpr int ADA_KC = 4;
__device__ __forceinline__ void p0_ada_item(Frame& F, int item) {
    const int kc = item / 12, cb = item % 12, col = cb * 512 + F.tid;
    const float* in_c = F.p->in[I_C]; const float* in_cc = F.p->in[I_CCTX]; const float* w = F.p->in[I_ADAW];
    LAS float* sv = (LAS float*)F.lds;
    __syncthreads();
    for (int i = F.tid; i < 768; i += 512) { const int wh = i >> 8, k = kc * 256 + (i & 255); sv[i] = siluf_(wh == 0 ? in_c[k] : (wh == 1 ? in_c[D + k] : in_cc[k])); }
    __syncthreads();
    float a0 = 0.f, a1 = 0.f, a2 = 0.f;
    const float* wp = w + (size_t)(kc * 256) * 6144 + col;
#pragma unroll 16
    for (int k = 0; k < 256; ++k) { const float wv = wp[(size_t)k * 6144]; a0 += sv[k] * wv; a1 += sv[256 + k] * wv; a2 += sv[512 + k] * wv; }
    float* o = WSP(float, WS_ADAP) + (size_t)kc * 3 * 6144 + col;
    o[0] = a0; o[6144] = a1; o[2 * 6144] = a2;
}

__device__ __forceinline__ void p0_filter_item(Frame& F, int item) {
    LAS float* zb = (LAS float*)F.lds;
    LAS float* ab1 = zb + 32 * 36;
    LAS float* ab2 = ab1 + 32 * 64;
    const float* const* in = F.p->in; const int t0 = item * 32; int tid = F.tid; asm volatile("" : "+v"(tid));
    __syncthreads();
    for (int idx = tid; idx < 32 * 33; idx += 512) { const int t = idx / 33, e = idx % 33; const float tf = (float)(t0 + t); float v;
        if (e == 0) v = tf / (float)(SEQ - 1);
        else { const int k = (e - 1) & 15; const float band = 1e-4f + (float)k * ((15.0f - 1e-4f) / 15.0f); float sn, cs; sincospif(2.0f * tf * band / (float)SEQ, &sn, &cs); v = (e <= 16) ? cs : -sn; }
        zb[t * 36 + e] = v; }
    __syncthreads();
    {
        const int t = tid >> 4, jj = tid & 15;
#pragma unroll 1
        for (int q = 0; q < 4; ++q) { const int j = jj + 16 * q; float s = in[I_FB1][j];
#pragma unroll 3
            for (int e = 0; e < 33; ++e) s += zb[t * 36 + e] * in[I_FW1][e * 64 + j];
            ab1[t * 64 + j] = sinf(in[I_FFREQ][j] * s); }
    }
    __syncthreads();
    { const int t = tid >> 4, jj = tid & 15;
#pragma unroll 1
        for (int q = 0; q < 4; ++q) { const int j = jj + 16 * q; float s = in[I_FB2][j];
#pragma unroll 4
            for (int e = 0; e < 64; ++e) s += ab1[t * 64 + e] * in[I_FW2][e * 64 + j];
            ab2[t * 64 + j] = sinf(in[I_FFREQ][j] * s); }
    }
    __syncthreads();
    { const int t = tid >> 4, jj = tid & 15;
#pragma unroll 1
        for (int q = 0; q < 4; ++q) { const int j = jj + 16 * q; float s = in[I_FB3][j];
#pragma unroll 4
            for (int e = 0; e < 64; ++e) s += ab2[t * 64 + e] * in[I_FW3][e * 64 + j];
            ab1[t * 64 + j] = sinf(in[I_FFREQ][j] * s); }
    }
    __syncthreads();
    const float* w4 = in[I_FW4];
    const float MIND = -3.0701134573253945f, MAXD = -15.350567286626973f;
    const float delta = fabsf(MIND + (MAXD - MIND) * ((float)tid / 511.0f));
    bf16_t* hf = WSP(bf16_t, WS_HF);
#pragma unroll 1
    for (int half = 0; half < 4; ++half) {
        f32x2 acc[8][2];
#pragma unroll
        for (int t = 0; t < 8; ++t) { acc[t][0] = (f32x2){0.f, 0.f}; acc[t][1] = (f32x2){0.f, 0.f}; }
        f32x2 wa[4][2], wb[4][2];
#pragma unroll
        for (int jj = 0; jj < 4; ++jj) { wa[jj][0] = (f32x2){w4[(size_t)jj * 2048 + tid], w4[(size_t)jj * 2048 + tid + 512]}; wa[jj][1] = (f32x2){w4[(size_t)jj * 2048 + tid + 1024], w4[(size_t)jj * 2048 + tid + 1536]}; }
#pragma unroll 1
        for (int j4 = 0; j4 < 16; j4 += 2) {
#pragma unroll
            for (int jj = 0; jj < 4; ++jj) { const size_t o = (size_t)(4 * (j4 + 1) + jj) * 2048 + tid; wb[jj][0] = (f32x2){w4[o], w4[o + 512]}; wb[jj][1] = (f32x2){w4[o + 1024], w4[o + 1536]}; }
#pragma unroll
            for (int t = 0; t < 8; ++t) { const f32x4 a = *(const LAS f32x4*)(ab1 + (8 * half + t) * 64 + 4 * j4);
#pragma unroll
                for (int jj = 0; jj < 4; ++jj) { const f32x2 aa = (f32x2){a[jj], a[jj]}; acc[t][0] += aa * wa[jj][0]; acc[t][1] += aa * wa[jj][1]; } }
            if (j4 + 2 < 16) {
#pragma unroll
                for (int jj = 0; jj < 4; ++jj) { const size_t o = (size_t)(4 * (j4 + 2) + jj) * 2048 + tid; wa[jj][0] = (f32x2){w4[o], w4[o + 512]}; wa[jj][1] = (f32x2){w4[o + 1024], w4[o + 1536]}; } }
#pragma unroll
            for (int t = 0; t < 8; ++t) { const f32x4 a = *(const LAS f32x4*)(ab1 + (8 * half + t) * 64 + 4 * (j4 + 1));
#pragma unroll
                for (int jj = 0; jj < 4; ++jj) { const f32x2 aa = (f32x2){a[jj], a[jj]}; acc[t][0] += aa * wb[jj][0]; acc[t][1] += aa * wb[jj][1]; } }
        }
#pragma unroll
        for (int t4 = 0; t4 < 2; ++t4) { const int tb = t0 + 8 * half + 4 * t4;
            float dc[4];
#pragma unroll
            for (int k = 0; k < 4; ++k) dc[k] = expf(-((float)(tb + k) / (float)(SEQ - 1)) * delta);
#pragma unroll
            for (int i = 0; i < 4; ++i)
                *(u32x2*)(hf + (size_t)(tid + 512 * i) * SEQ + tb) = (u32x2){pk2(acc[4 * t4][i >> 1][i & 1] * dc[0], acc[4 * t4 + 1][i >> 1][i & 1] * dc[1]), pk2(acc[4 * t4 + 2][i >> 1][i & 1] * dc[2], acc[4 * t4 + 3][i >> 1][i & 1] * dc[3])};
        }
    }
}

__device__ __forceinline__ void p0_tables(Frame& F, int item) {
    if (item < 6) {
        const int idx = item * 16384 + F.tid * 32;
        for (int k = 0; k < 32; ++k) { const int id = idx + k; if (id >= 192 * 512) break;
            const int row = id >> 9, col = id & 511, i = col & 255; const float omega = 1.0f / powf(10000.0f, (float)i / 256.0f);
            const float pos = (float)(row < 128 ? row : row - 128); const float ang = pos * omega;
            const float v = (col < 256) ? sinf(ang) : cosf(ang);
            if (row < 128) WSP(float, WS_POSR)[row * 512 + col] = v; else WSP(float, WS_POSC)[(row - 128) * 512 + col] = v; }
    } else {
        for (int id = F.tid; id < 1024; id += 512) { const float l0 = F.p->in[I_LBL][id], l1 = F.p->in[I_LBL][1024 + id];
            WSP(float, WS_LBS)[id] = 1.0f / (1.0f + expf(l1 - l0)); }
    }
}

__device__ __forceinline__ void phase0(Frame& F) {
    for (int it = F.bx; it < 311; it += F.G) {
        if (it < 48) p0_ada_item(F, it);
        else if (it < 304) p0_filter_item(F, it - 48);
        else p0_tables(F, it - 304);
    }
    __syncthreads();
    p0_transposes(F);
    __syncthreads();
    p0_expert_transposes(F);
}

__device__ __forceinline__ void phase1(Frame& F) {
    const float* adap = WSP(float, WS_ADAP); const float* adab = F.p->in[I_ADAB];
    { const int gid = F.bx * 512 + F.tid; if (gid < 3 * 6144) { const int wh = gid / 6144, col = gid % 6144; float s = adab[col];
#pragma unroll
        for (int kc = 0; kc < ADA_KC; ++kc) s += adap[(size_t)(kc * 3 + wh) * 6144 + col]; WSP(float, WS_ADA)[gid] = s; } }
    LAS float* md = (LAS float*)F.lds;
    __syncthreads();
    for (int id = F.tid; id < 3 * 2048; id += 512) { const int wh = id >> 11, col = id & 2047; float s = adab[col];
#pragma unroll
        for (int kc = 0; kc < ADA_KC; ++kc) s += adap[(size_t)(kc * 3 + wh) * 6144 + col]; md[id] = s; }
    __syncthreads();
    const float* x = F.p->in[I_X]; const float* ctx = F.p->in[I_CTX]; const float* g1 = F.p->in[I_N1G];
    const float* posr = WSP(float, WS_POSR); const float* posc = WSP(float, WS_POSC); bf16_t* a1 = WSP(bf16_t, WS_A1);
    const int lane = F.lane;
#define P1_GG() f32x4 ggv[4]; _Pragma("unroll") for (int j = 0; j < 4; ++j) ggv[j] = *(const f32x4*)(g1 + 256 * j + 4 * lane)
#define P1_ROWS4(r0) do { f32x4 v[4][4]; const int wh = (r0) < T ? ((r0) >> 13) : 2; \
        _Pragma("unroll") for (int q = 0; q < 4; ++q) { const int r = (r0) + q; \
            if ((r0) < T) { const int n = r & (SEQ - 1); const f32x4* xr = (const f32x4*)(x + (size_t)r * D) + lane; \
                _Pragma("unroll") for (int j = 0; j < 4; ++j) { const int c = 256 * j + 4 * lane; const f32x4 pe = (c < 512) ? *(const f32x4*)(posr + (n >> 6) * 512 + c) : *(const f32x4*)(posc + (n & 63) * 512 + c - 512); v[q][j] = xr[64 * j] + pe; } \
            } else { const f32x4* xr = (const f32x4*)(ctx + (size_t)(r - T) * D) + lane; \
                _Pragma("unroll") for (int j = 0; j < 4; ++j) v[q][j] = xr[64 * j]; } } \
        _Pragma("unroll") for (int q = 0; q < 4; ++q) { float ss = 0.f; \
            _Pragma("unroll") for (int j = 0; j < 4; ++j) ss += (v[q][j][0] * v[q][j][0] + v[q][j][1] * v[q][j][1]) + (v[q][j][2] * v[q][j][2] + v[q][j][3] * v[q][j][3]); \
            const float rs = rsqrtf(wave_sum(ss) * (1.0f / D) + EPS); \
            u32x2* o8 = (u32x2*)(a1 + (size_t)((r0) + q) * D) + lane; \
            _Pragma("unroll") for (int j = 0; j < 4; ++j) { const int c = 256 * j + 4 * lane; const f32x4 gg = ggv[j]; \
                const f32x4 sh = *(const LAS f32x4*)(md + wh * 2048 + c), sc = *(const LAS f32x4*)(md + wh * 2048 + 1024 + c); \
                const f32x4 y = v[q][j] * rs * gg * (sc + 1.0f) + sh; \
                u32x2 w; w.x = pk2(y[0], y[1]); w.y = pk2(y[2], y[3]); o8[64 * j] = w; } } } while (0)
    const int nded = F.G > 24 ? 12 : 0;
    if (F.bx >= nded) { const int gw = (F.bx - nded) * 8 + F.wave, NGW = (F.G - nded) * 8; P1_GG();
        for (int r0 = gw * 4; r0 < T; r0 += NGW * 4) P1_ROWS4(r0); }
    for (int idx = F.bx; idx < 12; idx += (nded ? 12 : F.G)) {
        if (nded && F.bx >= 12) break;
        const int rbase = T + CtxUnit::tile(idx) * 256 + F.wave * 32;
        { P1_GG(); for (int i = 0; i < 32; i += 4) P1_ROWS4(rbase + i); }
        asm volatile("s_waitcnt vmcnt(0)" ::: "memory"); __syncthreads();
        { pg8::Gemm g{WSP(bf16_t, WS_WINT), WSP(bf16_t, WS_WINT), D, nullptr, 2 * D, 128}; CtxUnit S{idx};
          EpiIn E{EpiInT{WSP(bf16_t, WS_PHYT), WSP(bf16_t, WS_VT)}, EpiInN{WSP(bf16_t, WS_Q), WSP(bf16_t, WS_G), WSP(bf16_t, WS_SG1), WSP(bf16_t, WS_SG2), WSP(float, WS_LF), WSP(float, WS_LB), WSP(float, WS_LBS)}};
          pg8::gemm_phase<EpiIn, CtxUnit, false>(F.lds, g, S, E); }
        if (!nded) { __syncthreads(); for (int id = F.tid; id < 3 * 2048; id += 512) { const int wh = id >> 11, col = id & 2047; float s = adab[col];
            for (int kc = 0; kc < ADA_KC; ++kc) s += adap[(size_t)(kc * 3 + wh) * 6144 + col]; md[id] = s; } __syncthreads(); }
    }
#undef P1_ROWS4
#undef P1_GG
}

__device__ __forceinline__ void phase_h2(Frame& F) {
    const float* x1 = F.p->out; const float* g2 = F.p->in[I_N2G]; const float* ada = WSP(float, WS_ADA); bf16_t* h2 = WSP(bf16_t, WS_H2);
    const int gw = F.bx * 8 + F.wave, NGW = F.G * 8, lane = F.lane;
    f32x4 ggv[4];
#pragma unroll
    for (int j = 0; j < 4; ++j) ggv[j] = *(const f32x4*)(g2 + 256 * j + 4 * lane);
    const bool al = (F.G == 256); const int vw = ((F.bx & 7) * 32 + (F.bx >> 3)) * 8 + F.wave;
    for (int r0 = al ? vw * 8 : gw * 4, it_ = 0; al ? it_ < 2 : r0 < T; r0 += al ? 4 : NGW * 4, ++it_) { const int b = r0 >> 13;
        f32x4 v[4][4], shv[4], scv[4];
#pragma unroll
        for (int j = 0; j < 4; ++j) { const int c = 256 * j + 4 * lane; shv[j] = *(const f32x4*)(ada + b * 6144 + 3 * D + c); scv[j] = *(const f32x4*)(ada + b * 6144 + 4 * D + c); }
#pragma unroll
        for (int q = 0; q < 4; ++q) { const f32x4* xr = (const f32x4*)(x1 + (size_t)(r0 + q) * D) + lane;
#pragma unroll
            for (int j = 0; j < 4; ++j) v[q][j] = xr[64 * j]; }
#pragma unroll
        for (int q = 0; q < 4; ++q) { float ss = 0.f;
#pragma unroll
            for (int j = 0; j < 4; ++j) ss += (v[q][j][0] * v[q][j][0] + v[q][j][1] * v[q][j][1]) + (v[q][j][2] * v[q][j][2] + v[q][j][3] * v[q][j][3]);
            const float rs = rsqrtf(wave_sum(ss) * (1.0f / D) + EPS);
            u32x2* o8 = (u32x2*)(h2 + (size_t)(r0 + q) * D) + lane;
#pragma unroll
            for (int j = 0; j < 4; ++j) { const f32x4 gg = ggv[j], sh = shv[j], sc = scv[j];
                const f32x4 y = v[q][j] * rs * gg * (sc + 1.0f) + sh;
                u32x2 w; w.x = pk2(y[0], y[1]); w.y = pk2(y[2], y[3]); o8[64 * j] = w; } }
    }
}
constexpr int FPAD = 17920;
__device__ __forceinline__ int fphys(int i) { return i + (i >> 4) + ((i >> 9) << 4); }
__device__ constexpr float TWC[16] = {1.0f, 0.98078528040323044913f, 0.92387953251128675613f, 0.83146961230254523708f, 0.70710678118654752440f, 0.55557023301960222474f, 0.38268343236508977173f, 0.19509032201612826785f,
                                      0.0f, -0.19509032201612826785f, -0.38268343236508977173f, -0.55557023301960222474f, -0.70710678118654752440f, -0.83146961230254523708f, -0.92387953251128675613f, -0.98078528040323044913f};
__device__ constexpr float TWS[16] = {0.0f, 0.19509032201612826785f, 0.38268343236508977173f, 0.55557023301960222474f, 0.70710678118654752440f, 0.83146961230254523708f, 0.92387953251128675613f, 0.98078528040323044913f,
                                      1.0f, 0.98078528040323044913f, 0.92387953251128675613f, 0.83146961230254523708f, 0.70710678118654752440f, 0.55557023301960222474f, 0.38268343236508977173f, 0.19509032201612826785f};
__host__ __device__ constexpr int brev_c(int x, int bits) { int r = 0; for (int i = 0; i < bits; ++i) r = (r << 1) | ((x >> i) & 1); return r; }

typedef f32x2 cpx;
__device__ __forceinline__ cpx cmul(cpx a, cpx w) { return (cpx){a.x, a.x} * w + (cpx){a.y, a.y} * (cpx){-w.y, w.x}; }
template <int S0, int R, bool INV, bool ZHI = false, bool OLO = false>
__device__ __forceinline__ void fft_pass(LAS cpx* X, int tid) {
    constexpr int LOW = 14 - S0 - R, NR = 1 << R, NTASK = (1 << (14 - R)) / 512;
    asm volatile("" : "+v"(tid));
#pragma unroll 1
    for (int task = 0; task < NTASK; ++task) {
        const int g = tid + 512 * task;
        const int blo = g & ((1 << LOW) - 1), bhi = g >> LOW;
        const int base = (bhi << (LOW + R)) | blo;
        cpx v[NR];
#pragma unroll
        for (int j = 0; j < NR; ++j) { if (ZHI && j >= NR / 2) v[j] = (cpx){0.f, 0.f}; else v[j] = X[fphys(base | (j << LOW))]; }
        cpx w0 = (cpx){1.f, 0.f};
        if (LOW > 0) { float s, c; sincospif(-(float)blo * (1.0f / (float)(1 << (13 - S0))), &s, &c); w0 = (cpx){c, INV ? -s : s}; }
        if (INV && LOW > 0) {
            cpx cw = w0;
#pragma unroll
            for (int m = 1; m < NR; ++m) { const int j = brev_c(m, R); v[j] = cmul(v[j], cw); if (m + 1 < NR) cw = cmul(cw, w0); }
        }
        if (!INV) {
#pragma unroll
            for (int q = 0; q < R; ++q) { const int hj = 1 << (R - 1 - q);
#pragma unroll
                for (int j = 0; j < NR; ++j) { if (j & hj) continue; const int k32 = (j & (hj - 1)) << (5 - R + q);
                    cpx d;
                    if (ZHI && q == 0) d = v[j];
                    else { const cpx a = v[j], bb = v[j + hj]; v[j] = a + bb; d = a - bb; }
                    if (k32 == 0) v[j + hj] = d;
                    else if (k32 == 8) v[j + hj] = (cpx){d.y, -d.x};
                    else v[j + hj] = cmul(d, (cpx){TWC[k32], -TWS[k32]}); } }
        } else {
#pragma unroll
            for (int q = R - 1; q >= 0; --q) { const int hj = 1 << (R - 1 - q);
#pragma unroll
                for (int j = 0; j < NR; ++j) { if (j & hj) continue; const int k32 = (j & (hj - 1)) << (5 - R + q);
                    const cpx p = v[j], bb = v[j + hj]; cpx t;
                    if (k32 == 0) t = bb;
                    else if (k32 == 8) t = (cpx){-bb.y, bb.x};
                    else t = cmul(bb, (cpx){TWC[k32], TWS[k32]});
                    v[j] = p + t; if (!(OLO && q == 0)) v[j + hj] = p - t; } }
        }
        if (!INV && LOW > 0) {
            cpx cw = w0;
#pragma unroll
            for (int m = 1; m < NR; ++m) { const int j = brev_c(m, R); v[j] = cmul(v[j], cw); if (m + 1 < NR) cw = cmul(cw, w0); }
        }
#pragma unroll
        for (int j = 0; j < NR; ++j) { if (OLO && j >= NR / 2) continue; X[fphys(base | (j << LOW))] = v[j]; }
    }
}
#define XP_HOOK() xp_step(xp, F.p->in, F.ws, tid)
template <bool ZHI> __device__ __forceinline__ void fft_fwd(Frame& F, XpState& xp, LAS cpx* X, int tid) {
    fft_pass<0, 5, false, ZHI>(X, tid); __syncthreads(); XP_HOOK(); fft_pass<5, 5, false>(X, tid); __syncthreads(); XP_HOOK(); fft_pass<10, 4, false>(X, tid); __syncthreads(); XP_HOOK();
}
__device__ __forceinline__ void fft_inv(Frame& F, XpState& xp, LAS cpx* X, int tid) {
    fft_pass<10, 4, true>(X, tid); __syncthreads(); XP_HOOK(); fft_pass<5, 5, true>(X, tid); __syncthreads(); XP_HOOK(); fft_pass<0, 5, true, false, true>(X, tid); __syncthreads(); XP_HOOK();
}
struct SC8 { u32x4 c; unsigned l, r; };
__device__ __forceinline__ SC8 sconv8_load(const bf16_t* p, int n) {
    SC8 s; s.c = *(const u32x4*)(p + n); s.l = n > 0 ? (unsigned)p[n - 1] : 0u; s.r = n + 8 < SEQ ? (unsigned)p[n + 8] : 0u; return s;
}
__device__ __forceinline__ void sconv8_eval(const SC8& s, float w0, float w1, float w2, float bias, float (&o)[8]) {
    float v[10]; v[0] = bf2f(s.l); v[1] = bflo(s.c.x); v[2] = bfhi(s.c.x); v[3] = bflo(s.c.y); v[4] = bfhi(s.c.y); v[5] = bflo(s.c.z); v[6] = bfhi(s.c.z); v[7] = bflo(s.c.w); v[8] = bfhi(s.c.w); v[9] = bf2f(s.r);
#pragma unroll
    for (int i = 0; i < 8; ++i) o[i] = w0 * v[i] + w1 * v[i + 1] + w2 * v[i + 2] + bias;
}
__device__ __forceinline__ void hyena_item(Frame& F, int c, XpState& xp) {
    LAS cpx* X = (LAS cpx*)F.lds; LAS float* red = (LAS float*)(F.lds + (size_t)FPAD * 8);
    int tid = F.tid; asm volatile("" : "+v"(tid));
    const bf16_t* hf = WSP(bf16_t, WS_HF);
    __syncthreads();
    float s0 = 0.f, s1 = 0.f;
    {
        f32x4 fa[4], fb[4], ba[4], bb[4];
#pragma unroll
        for (int it = 0; it < 4; ++it) { const int j = 4 * (tid + 512 * it);
            const u32x2 w0 = *(const u32x2*)(hf + (size_t)c * SEQ + j), w1 = *(const u32x2*)(hf + (size_t)(1024 + c) * SEQ + j), w2 = *(const u32x2*)(hf + (size_t)(512 + c) * SEQ + j), w3 = *(const u32x2*)(hf + (size_t)(1536 + c) * SEQ + j);
            fa[it] = (f32x4){bflo(w0.x), bfhi(w0.x), bflo(w0.y), bfhi(w0.y)}; fb[it] = (f32x4){bflo(w1.x), bfhi(w1.x), bflo(w1.y), bfhi(w1.y)};
            ba[it] = (f32x4){bflo(w2.x), bfhi(w2.x), bflo(w2.y), bfhi(w2.y)}; bb[it] = (f32x4){bflo(w3.x), bfhi(w3.x), bflo(w3.y), bfhi(w3.y)}; }
#pragma unroll
        for (int it = 0; it < 4; ++it) { const int j = 4 * (tid + 512 * it);
#pragma unroll
            for (int i = 0; i < 4; ++i) { X[fphys(j + i)] = (cpx){fa[it][i], fb[it][i]}; s0 += fabsf(fa[it][i]); s1 += fabsf(fb[it][i]);
                const int m = j + i; if (m > 0) { X[fphys(FFTN - m)] = (cpx){ba[it][i], bb[it][i]}; s0 += fabsf(ba[it][i]); s1 += fabsf(bb[it][i]); } } }
        if (tid == 0) X[fphys(SEQ)] = (cpx){0.f, 0.f};
    }
    s0 = wave_sum(s0); s1 = wave_sum(s1);
    if (F.lane == 0) { red[F.wave] = s0; red[8 + F.wave] = s1; }
    __syncthreads();
    float S0 = 0.f, S1 = 0.f;
#pragma unroll
    for (int w = 0; w < 8; ++w) { S0 += red[w]; S1 += red[8 + w]; }
    fft_fwd<false>(F, xp, X, tid);
    unsigned* ks = WSP(unsigned, WS_KS) + (size_t)F.bx * 2 * FFTN;
    { const float i0 = 1.0f / S0, i1 = 1.0f / S1, sk0 = F.p->in[I_HSKIP][c], sk1 = F.p->in[I_HSKIP][512 + c];
#pragma unroll 8
        for (int it = 0; it < 32; ++it) { const int p = tid + 512 * it; const int k = (int)(__brev((unsigned)p) >> 18); const int pp = (int)(__brev((unsigned)((FFTN - k) & (FFTN - 1))) >> 18);
            const cpx A = X[fphys(p)], B = X[fphys(pp)];
            const float k1r = 0.5f * (A.x + B.x), k1i = 0.5f * (A.y - B.y), k2r = 0.5f * (A.y + B.y), k2i = -0.5f * (A.x - B.x);
            ks[p] = pkh2(k1r * i0 + sk0, k1i * i0); ks[FFTN + p] = pkh2(k2r * i1 + sk1, k2i * i1); } }
    __syncthreads();
    const bf16_t* ph = WSP(bf16_t, WS_PHYT); const float* cw = F.p->in[I_HCW]; const float* cb = F.p->in[I_HCB];
    { const float w0 = cw[c], w1 = cw[HYP + c], w2 = cw[2 * HYP + c], bs = cb[c];
        SC8 sa[2], sb[2];
#pragma unroll
        for (int it = 0; it < 2; ++it) { const int n = 8 * (tid + 512 * it); sa[it] = sconv8_load(ph + (size_t)c * SEQ, n); sb[it] = sconv8_load(ph + (size_t)(HYP + c) * SEQ, n); }
#pragma unroll
        for (int it = 0; it < 2; ++it) { const int n = 8 * (tid + 512 * it); float a[8], b[8]; sconv8_eval(sa[it], w0, w1, w2, bs, a); sconv8_eval(sb[it], w0, w1, w2, bs, b);
#pragma unroll
            for (int i = 0; i < 8; ++i) X[fphys(n + i)] = (cpx){a[i], b[i]}; } }
    __syncthreads();
    fft_fwd<true>(F, xp, X, tid);
    { unsigned kk[32]; const float invN = 1.0f / (float)FFTN;
#pragma unroll
        for (int it = 0; it < 32; ++it) kk[it] = ks[tid + 512 * it];
#pragma unroll
        for (int it = 0; it < 32; ++it) { const int q = fphys(tid + 512 * it); X[q] = cmul(X[q], (cpx){h2f((unsigned short)(kk[it] & 0xffffu)) * invN, h2f((unsigned short)(kk[it] >> 16)) * invN}); } }
    __syncthreads();
    fft_inv(F, xp, X, tid);
    { const int col = HYW + c; const float w0 = cw[col], w1 = cw[HYP + col], w2 = cw[2 * HYP + col], bs = cb[col];
        SC8 sa[2], sb[2];
#pragma unroll
        for (int it = 0; it < 2; ++it) { const int n = 8 * (tid + 512 * it); sa[it] = sconv8_load(ph + (size_t)col * SEQ, n); sb[it] = sconv8_load(ph + (size_t)(HYP + col) * SEQ, n); }
#pragma unroll
        for (int it = 0; it < 2; ++it) { const int n = 8 * (tid + 512 * it); float a[8], b[8]; sconv8_eval(sa[it], w0, w1, w2, bs, a); sconv8_eval(sb[it], w0, w1, w2, bs, b);
#pragma unroll
            for (int i = 0; i < 8; ++i) { const int q = fphys(n + i); X[q] = X[q] * (cpx){a[i], b[i]}; } } }
    __syncthreads();
    fft_fwd<true>(F, xp, X, tid);
    { unsigned kk[32]; const float invN = 1.0f / (float)FFTN;
#pragma unroll
        for (int it = 0; it < 32; ++it) kk[it] = ks[FFTN + tid + 512 * it];
#pragma unroll
        for (int it = 0; it < 32; ++it) { const int q = fphys(tid + 512 * it); X[q] = cmul(X[q], (cpx){h2f((unsigned short)(kk[it] & 0xffffu)) * invN, h2f((unsigned short)(kk[it] >> 16)) * invN}); } }
    __syncthreads();
    fft_inv(F, xp, X, tid);
    { const int col = 2 * HYW + c; const float w0 = cw[col], w1 = cw[HYP + col], w2 = cw[2 * HYP + col], bs = cb[col];
        bf16_t* yt = WSP(bf16_t, WS_YHYT);
        SC8 sa[2], sb[2]; u32x4 oa[2], ob[2];
#pragma unroll
        for (int it = 0; it < 2; ++it) { const int n = 8 * (tid + 512 * it); sa[it] = sconv8_load(ph + (size_t)col * SEQ, n); sb[it] = sconv8_load(ph + (size_t)(HYP + col) * SEQ, n); }
#pragma unroll
        for (int it = 0; it < 2; ++it) { const int n = 8 * (tid + 512 * it); float a[8], b[8]; sconv8_eval(sa[it], w0, w1, w2, bs, a); sconv8_eval(sb[it], w0, w1, w2, bs, b);
            cpx y[8];
#pragma unroll
            for (int i = 0; i < 8; ++i) y[i] = X[fphys(n + i)];
            oa[it] = (u32x4){pk2(y[0].x * a[0], y[1].x * a[1]), pk2(y[2].x * a[2], y[3].x * a[3]), pk2(y[4].x * a[4], y[5].x * a[5]), pk2(y[6].x * a[6], y[7].x * a[7])};
            ob[it] = (u32x4){pk2(y[0].y * b[0], y[1].y * b[1]), pk2(y[2].y * b[2], y[3].y * b[3]), pk2(y[4].y * b[4], y[5].y * b[5]), pk2(y[6].y * b[6], y[7].y * b[7])}; }
#pragma unroll
        for (int it = 0; it < 2; ++it) { const int n = 8 * (tid + 512 * it);
            *(u32x4*)(yt + (size_t)c * SEQ + n) = oa[it]; *(u32x4*)(yt + (size_t)(HYW + c) * SEQ + n) = ob[it]; } }
}

__device__ __forceinline__ bf16x8 lds_frag(const LAS bf16_t* base, int row, int stride, int k) { return *(const LAS bf16x8*)(base + row * stride + k); }
#define MFMA16(a, b, c) __builtin_amdgcn_mfma_f32_16x16x32_bf16(a, b, c, 0, 0, 0)

__device__ __forceinline__ void hg_delta_item(Frame& F, int item) {
    const int chain = item / NCH_EXT, j = item % NCH_EXT, dir = chain & 1, h = (chain >> 1) & 3, b = chain >> 3;
    const int cj = dir == 0 ? j : (j < 4 ? 3 - j : 135 - j), n0 = cj * 64;
    LAS float* segtot = (LAS float*)F.lds;
    LAS bf16_t* Kt = (LAS bf16_t*)(F.lds + 4096);
    LAS bf16_t* VTs = (LAS bf16_t*)(F.lds + 4096 + 18432);
    const int tid = F.tid, d = 2 * (tid & 63), seg = tid >> 6, lane = F.lane;
    const float* lfp = (dir ? WSP(float, WS_LB) : WSP(float, WS_LF)) + ((size_t)(b * NEXT + n0) * HGW + h * 128 + d);
    f32x2 lf[8], tot = (f32x2){0.f, 0.f};
#pragma unroll
    for (int i = 0; i < 8; ++i) { lf[i] = *(const f32x2*)(lfp + (size_t)(8 * seg + i) * HGW); tot += lf[i]; }
    __syncthreads();
    *(LAS f32x2*)(segtot + seg * 128 + d) = tot;
    { const bf16_t* vt = WSP(bf16_t, WS_VT) + ((size_t)(b * HGW + h * 128) * NEXT + n0);
        u32x4 tv[2];
#pragma unroll
        for (int q = 0; q < 2; ++q) { const int piece = tid + 512 * q, e = piece >> 3, part = piece & 7; tv[q] = *(const u32x4*)(vt + (size_t)e * NEXT + part * 8); }
#pragma unroll
        for (int q = 0; q < 2; ++q) { const int piece = tid + 512 * q, e = piece >> 3, part = piece & 7; *(LAS u32x4*)(VTs + e * 72 + part * 8) = tv[q]; } }
    __syncthreads();
    f32x2 later = (f32x2){0.f, 0.f}, total = later;
#pragma unroll
    for (int s = 0; s < 8; ++s) { const f32x2 v = *(const LAS f32x2*)(segtot + s * 128 + d); total += v; if (dir == 0 ? (s > seg) : (s < seg)) later += v; }
    f32x2 E[8];
    if (dir == 0) { f32x2 run = later;
#pragma unroll
        for (int i = 7; i >= 0; --i) { E[i] = run; run += lf[i]; } }
    else { f32x2 run = later;
#pragma unroll
        for (int i = 0; i < 8; ++i) { E[i] = run; run += lf[i]; } }
    float k0[8], k1[8];
#pragma unroll
    for (int i = 0; i < 8; ++i) { k0[i] = (1.0f - __expf(lf[i].x)) * __expf(E[i].x); k1[i] = (1.0f - __expf(lf[i].y)) * __expf(E[i].y); }
    *(LAS u32x4*)(Kt + d * 72 + 8 * seg) = (u32x4){pk2(k0[0], k0[1]), pk2(k0[2], k0[3]), pk2(k0[4], k0[5]), pk2(k0[6], k0[7])};
    *(LAS u32x4*)(Kt + (d + 1) * 72 + 8 * seg) = (u32x4){pk2(k1[0], k1[1]), pk2(k1[2], k1[3]), pk2(k1[4], k1[5]), pk2(k1[6], k1[7])};
    if (seg == 0) *(f32x2*)(WSP(float, WS_DECAY) + (size_t)item * 128 + d) = (f32x2){__expf(total.x), __expf(total.y)};
    __syncthreads();
    const int w = F.wave, lr = lane & 15, lq = lane >> 4;
    f32x4 acc[8];
#pragma unroll
    for (int et = 0; et < 8; ++et) acc[et] = (f32x4){0.f, 0.f, 0.f, 0.f};
#pragma unroll
    for (int ksi = 0; ksi < 2; ++ksi) { const bf16x8 a = lds_frag(Kt, 16 * w + lr, 72, 32 * ksi + 8 * lq);
#pragma unroll
        for (int et = 0; et < 8; ++et) acc[et] = MFMA16(a, lds_frag(VTs, 16 * et + lr, 72, 32 * ksi + 8 * lq), acc[et]); }
    bf16_t* dl = WSP(bf16_t, WS_DELTA) + (size_t)item * 16384;
#pragma unroll
    for (int et = 0; et < 8; ++et) { const int e = 16 * et + lr, d0 = 16 * w + 4 * lq;
        u32x2 o; o.x = pk2(acc[et][0], acc[et][1]); o.y = pk2(acc[et][2], acc[et][3]); *(u32x2*)(dl + e * 128 + d0) = o; }
}

__device__ __forceinline__ void hg_scan(Frame& F) {
    for (int gid = F.bx * 512 + F.tid; gid < NCHAIN * 8192; gid += F.G * 512) {
        const int chain = gid >> 13, idx = gid & 8191, dd = (2 * idx) & 127;
        const unsigned* dl = WSP(unsigned, WS_DELTA) + (size_t)chain * NCH_EXT * 8192 + idx;
        const float* dc = WSP(float, WS_DECAY) + (size_t)chain * NCH_EXT * 128 + dd;
        unsigned* ss = WSP(unsigned, WS_SST) + (size_t)chain * NCH_LAT * 8192 + idx;
        float s0 = 0.f, s1 = 0.f;
        unsigned dv[12], dw[12]; f32x2 cv[12], cw[12];
#pragma unroll
        for (int u = 0; u < 12; ++u) { dv[u] = dl[(size_t)u * 8192]; cv[u] = *(const f32x2*)(dc + (size_t)u * 128); }
#pragma unroll 1
        for (int j0 = 0; j0 < NCH_EXT; j0 += 12) {
            const bool more = j0 + 12 < NCH_EXT;
            if (more) {
#pragma unroll
                for (int u = 0; u < 12; ++u) { dw[u] = dl[(size_t)(j0 + 12 + u) * 8192]; cw[u] = *(const f32x2*)(dc + (size_t)(j0 + 12 + u) * 128); } }
#pragma unroll
            for (int u = 0; u < 12; ++u) { const int j = j0 + u;
                if (j >= 4) ss[(size_t)(j - 4) * 8192] = pk2(s0, s1);
                s0 = cv[u].x * s0 + bflo(dv[u]); s1 = cv[u].y * s1 + bfhi(dv[u]); }
#pragma unroll
            for (int u = 0; u < 12; ++u) { dv[u] = dw[u]; cv[u] = cw[u]; }
        }
    }
}

__device__ __forceinline__ void yhy_transpose_item(Frame& F, int item) {
    const int b = item >> 7, nb = item & 127, tid = F.tid;
    LAS bf16_t* ts = (LAS bf16_t*)F.lds;
    const bf16_t* src = WSP(bf16_t, WS_YHYT) + (size_t)b * HYW * SEQ + nb * 64;
    __syncthreads();
    { u32x4 tv[8];
#pragma unroll
    for (int q = 0; q < 8; ++q) { const int piece = tid + 512 * q, c = piece >> 3, part = piece & 7; tv[q] = *(const u32x4*)(src + (size_t)c * SEQ + part * 8); }
#pragma unroll
    for (int q = 0; q < 8; ++q) { const int piece = tid + 512 * q, c = piece >> 3, part = piece & 7; *(LAS u32x4*)(ts + c * 72 + part * 8) = tv[q]; } }
    __syncthreads();
    bf16_t* dst = WSP(bf16_t, WS_YHY) + (size_t)(b * SEQ + nb * 64) * HYW;
#pragma unroll
    for (int q = 0; q < 8; ++q) { const int task = tid + 512 * q, n = task & 63, cg = task >> 6;
        unsigned v[8];
#pragma unroll
        for (int i = 0; i < 8; ++i) v[i] = ts[(8 * cg + i) * 72 + n];
        *(u32x4*)(dst + (size_t)n * HYW + 8 * cg) = (u32x4){v[0] | (v[1] << 16), v[2] | (v[3] << 16), v[4] | (v[5] << 16), v[6] | (v[7] << 16)}; }
}

__device__ __forceinline__ void hg_out_item(Frame& F, int item) {
    const int b = item >> 9, h = (item >> 7) & 3, nc = item & 127;
    LAS float* segtot = (LAS float*)F.lds;
    LAS float* bref = (LAS float*)(F.lds + 4096);
    LAS float* red = (LAS float*)(F.lds + 4608);
    LAS bf16_t* Qd = (LAS bf16_t*)(F.lds + 5120);
    LAS bf16_t* Kd = (LAS bf16_t*)(F.lds + 22528);
    LAS bf16_t* Qb = (LAS bf16_t*)(F.lds + 39936);
    LAS bf16_t* VTs = (LAS bf16_t*)(F.lds + 57344);
    LAS bf16_t* Ss = (LAS bf16_t*)(F.lds + 75776);
    LAS bf16_t* att = (LAS bf16_t*)(F.lds + 110592);
    const int tid = F.tid, d = 2 * (tid & 63), seg = tid >> 6, lane = F.lane, w = F.wave, lr = lane & 15, lq = lane >> 4;
    const int nx0 = CTXL + nc * 64, r0 = b * SEQ + nc * 64;
    __syncthreads();
    { const bf16_t* vt = WSP(bf16_t, WS_VT) + ((size_t)(b * HGW + h * 128) * NEXT + nx0);
        u32x4 tv[2];
#pragma unroll
        for (int q = 0; q < 2; ++q) { const int piece = tid + 512 * q, e = piece >> 3, part = piece & 7; tv[q] = *(const u32x4*)(vt + (size_t)e * NEXT + part * 8); }
#pragma unroll
        for (int q = 0; q < 2; ++q) { const int piece = tid + 512 * q, e = piece >> 3, part = piece & 7; *(LAS u32x4*)(VTs + e * 72 + part * 8) = tv[q]; } }
    f32x4 acc[4];
#pragma unroll
    for (int i = 0; i < 4; ++i) acc[i] = (f32x4){0.f, 0.f, 0.f, 0.f};
    const bf16_t* qp = WSP(bf16_t, WS_Q) + ((size_t)r0 * HGW + h * 128 + d);
#pragma unroll 1
    for (int dir = 0; dir < 2; ++dir) {
        const int chain = (b * 4 + h) * 2 + dir, jlat = dir == 0 ? nc : 127 - nc;
        __syncthreads();
        { const bf16_t* sp = WSP(bf16_t, WS_SST) + (size_t)(chain * NCH_LAT + jlat) * 16384;
            u32x4 sv[4];
#pragma unroll
            for (int q = 0; q < 4; ++q) { const int piece = tid + 512 * q, e = piece >> 4, part = piece & 15; sv[q] = *(const u32x4*)(sp + e * 128 + part * 8); }
#pragma unroll
            for (int q = 0; q < 4; ++q) { const int piece = tid + 512 * q, e = piece >> 4, part = piece & 15; *(LAS u32x4*)(Ss + e * 136 + part * 8) = sv[q]; } }
        const float* lfp = (dir ? WSP(float, WS_LB) : WSP(float, WS_LF)) + ((size_t)(b * NEXT + nx0) * HGW + h * 128 + d);
        f32x2 lf[8], qv[8], tot = (f32x2){0.f, 0.f};
#pragma unroll
        for (int i = 0; i < 8; ++i) { lf[i] = *(const f32x2*)(lfp + (size_t)(8 * seg + i) * HGW); const unsigned qw = *(const unsigned*)(qp + (size_t)(8 * seg + i) * HGW); qv[i] = (f32x2){bflo(qw), bfhi(qw)}; tot += lf[i]; }
        *(LAS f32x2*)(segtot + seg * 128 + d) = tot;
        __syncthreads();
        f32x2 off = (f32x2){0.f, 0.f};
#pragma unroll
        for (int s = 0; s < 8; ++s) { const f32x2 v = *(const LAS f32x2*)(segtot + s * 128 + d); if (dir == 0 ? (s < seg) : (s > seg)) off += v; }
        f32x2 bb[8];
        if (dir == 0) { f32x2 run = off;
#pragma unroll
            for (int i = 0; i < 8; ++i) { run += lf[i]; bb[i] = run; } if (seg == 3) *(LAS f32x2*)(bref + d) = bb[7]; }
        else { f32x2 run = off;
#pragma unroll
            for (int i = 7; i >= 0; --i) { run += lf[i]; bb[i] = run; } if (seg == 4) *(LAS f32x2*)(bref + d) = bb[0]; }
        __syncthreads();
        { const f32x2 br = *(const LAS f32x2*)(bref + d); const f32x2 em = (f32x2){__expf(-br.x), __expf(-br.y)}, ep = (f32x2){__expf(br.x), __expf(br.y)};
#pragma unroll
            for (int i = 0; i < 8; ++i) { const int t = 8 * seg + i;
                const f32x2 eb = (f32x2){__expf(bb[i].x), __expf(bb[i].y)}, kk = (f32x2){1.0f - __expf(lf[i].x), 1.0f - __expf(lf[i].y)};
                const f32x2 qb = qv[i] * eb, qd = qb * em, kd = kk * ep * (f32x2){__builtin_amdgcn_rcpf(eb.x), __builtin_amdgcn_rcpf(eb.y)};
                *(LAS unsigned*)(Qd + t * 136 + d) = pk2(qd.x, qd.y); *(LAS unsigned*)(Kd + t * 136 + d) = pk2(kd.x, kd.y); *(LAS unsigned*)(Qb + t * 136 + d) = pk2(qb.x, qb.y); } }
        __syncthreads();
        {
            const int st = w & 3; f32x4 a2[2] = {(f32x4){0.f, 0.f, 0.f, 0.f}, (f32x4){0.f, 0.f, 0.f, 0.f}};
#pragma unroll
            for (int ksi = 0; ksi < 4; ++ksi) { const bf16x8 a = lds_frag(Kd, 16 * st + lr, 136, 32 * ksi + 8 * lq);
#pragma unroll
                for (int q = 0; q < 2; ++q) a2[q] = MFMA16(a, lds_frag(Qd, 16 * (2 * (w >> 2) + q) + lr, 136, 32 * ksi + 8 * lq), a2[q]); }
#pragma unroll
            for (int q = 0; q < 2; ++q) { const int t = 16 * (2 * (w >> 2) + q) + lr, s0 = 16 * st + 4 * lq; float v[4];
#pragma unroll
                for (int r = 0; r < 4; ++r) { const int s = s0 + r; v[r] = (dir == 0 ? (s <= t) : (s >= t)) ? a2[q][r] : 0.f; }
                u32x2 o; o.x = pk2(v[0], v[1]); o.y = pk2(v[2], v[3]); *(LAS u32x2*)(att + t * 72 + s0) = o; }
        }
        __syncthreads();
        { const int tt = w & 3;
#pragma unroll
            for (int ksi = 0; ksi < 2; ++ksi) { const bf16x8 a = lds_frag(att, 16 * tt + lr, 72, 32 * ksi + 8 * lq);
#pragma unroll
                for (int i = 0; i < 4; ++i) acc[i] = MFMA16(a, lds_frag(VTs, 16 * (4 * (w >> 2) + i) + lr, 72, 32 * ksi + 8 * lq), acc[i]); }
#pragma unroll
            for (int ksi = 0; ksi < 4; ++ksi) { const bf16x8 a = lds_frag(Qb, 16 * tt + lr, 136, 32 * ksi + 8 * lq);
#pragma unroll
                for (int i = 0; i < 4; ++i) acc[i] = MFMA16(a, lds_frag(Ss, 16 * (4 * (w >> 2) + i) + lr, 136, 32 * ksi + 8 * lq), acc[i]); }
        }
    }
    const int tt = w & 3, eh = w >> 2;
    float ssq[4];
#pragma unroll
    for (int r = 0; r < 4; ++r) { float s = 0.f;
#pragma unroll
        for (int i = 0; i < 4; ++i) s += acc[i][r] * acc[i][r];
        s += __shfl_xor(s, 1); s += __shfl_xor(s, 2); s += __shfl_xor(s, 4); s += __shfl_xor(s, 8); ssq[r] = s; }
    if (lr == 0) {
#pragma unroll
        for (int r = 0; r < 4; ++r) red[eh * 64 + 16 * tt + 4 * lq + r] = ssq[r]; }
    __syncthreads();
    const float* ng = F.p->in[I_HGNG]; const bf16_t* gp = WSP(bf16_t, WS_G); bf16_t* yo = WSP(bf16_t, WS_YHG);
    float ngv[4], gv[4][4];
#pragma unroll
    for (int i = 0; i < 4; ++i) ngv[i] = ng[16 * (4 * eh + i) + lr];
#pragma unroll
    for (int r = 0; r < 4; ++r)
#pragma unroll
        for (int i = 0; i < 4; ++i) gv[r][i] = bf2f(gp[(size_t)(r0 + 16 * tt + 4 * lq + r) * HGW + h * 128 + 16 * (4 * eh + i) + lr]);
#pragma unroll
    for (int r = 0; r < 4; ++r) { const int t = 16 * tt + 4 * lq + r; const float rs = rsqrtf((red[t] + red[64 + t]) * (1.0f / 128.0f) + EPS);
#pragma unroll
        for (int i = 0; i < 4; ++i) { const int e = 16 * (4 * eh + i) + lr; const size_t o = (size_t)(r0 + t) * HGW + h * 128 + e;
            yo[o] = (bf16_t)f2bf(acc[i][r] * rs * ngv[i] * gv[r][i]); } }
}
__device__ __forceinline__ void phase_route(Frame& F) {
    const float* lg = WSP(float, WS_LOGIT); const float* rb = F.p->in[I_RB];
    unsigned* cnt = WSP(unsigned, WS_CTL) + CW_CNT;
    int* re_ = WSP(int, WS_ROUTE_E); float* rw_ = WSP(float, WS_ROUTE_W); int* rp_ = WSP(int, WS_ROUTE_P);
    const int gw = F.bx * 8 + F.wave, NGW = F.G * 8, lane = F.lane;
    const f32x4 bias = *(const f32x4*)(rb + 4 * lane);
    const float NINF = -__builtin_inff();
    const bool al = (F.G == 256); const int tbase = al ? (((F.bx & 7) * 32 + (F.bx >> 3)) * 8 + F.wave) * 8 : gw, tstr = al ? 1 : NGW;
    f32x4 lpre[8];
#pragma unroll
    for (int i = 0; i < 8; ++i) { const int t = tbase + i * tstr; lpre[i] = t < T ? *(const f32x4*)(lg + (size_t)t * NE + 4 * lane) : (f32x4){0.f, 0.f, 0.f, 0.f}; }
    int ti = 0;
    for (int t = tbase; al ? ti < 8 : t < T; t += tstr, ++ti) {
        f32x4 l4 = lpre[0];
#pragma unroll
        for (int i = 1; i < 8; ++i) if (ti == i) l4 = lpre[i];
        if (ti >= 8) l4 = *(const f32x4*)(lg + (size_t)t * NE + 4 * lane);
        float sc[4], bs[4];
#pragma unroll
        for (int i = 0; i < 4; ++i) { sc[i] = sigmoidf_(l4[i]); bs[i] = sc[i] + bias[i]; }
        float m1 = fmaxf(bs[0], bs[1]), m2 = fminf(bs[0], bs[1]);
#pragma unroll
        for (int i = 2; i < 4; ++i) { const float v = bs[i]; m2 = fmaxf(m2, fminf(m1, v)); m1 = fmaxf(m1, v); }
#pragma unroll
        for (int o = 1; o < 8; o <<= 1) { const float o1 = __shfl_xor(m1, o), o2 = __shfl_xor(m2, o); const float n1 = fmaxf(m1, o1), n2 = fmaxf(fminf(m1, o1), fmaxf(m2, o2)); m1 = n1; m2 = n2; }
        const float gs = m1 + m2; const int mg = lane >> 3; int rank = 0;
#pragma unroll
        for (int g = 0; g < 8; ++g) { const float v = __shfl(gs, g * 8); rank += (v > gs || (v == gs && g < mg)) ? 1 : 0; }
        const bool sel = rank < 4;
        float cd[4];
#pragma unroll
        for (int i = 0; i < 4; ++i) cd[i] = sel ? bs[i] : NINF;
        int ek[8]; float sk[8]; float ssum = 0.f;
#pragma unroll
        for (int k = 0; k < 8; ++k) {
            float bv = cd[0]; int bi = 4 * lane;
#pragma unroll
            for (int i = 1; i < 4; ++i) if (cd[i] > bv) { bv = cd[i]; bi = 4 * lane + i; }
#pragma unroll
            for (int o = 32; o >= 1; o >>= 1) { const float ov = __shfl_xor(bv, o); const int oi = __shfl_xor(bi, o); if (ov > bv || (ov == bv && oi < bi)) { bv = ov; bi = oi; } }
            const int sub = bi & 3; const float mysc = sub == 0 ? sc[0] : (sub == 1 ? sc[1] : (sub == 2 ? sc[2] : sc[3]));
            const float s = __shfl(mysc, bi >> 2);
            if ((bi >> 2) == lane) {
#pragma unroll
                for (int i = 0; i < 4; ++i) if (i == sub) cd[i] = NINF; }
            ek[k] = bi; sk[k] = s; ssum += s;
        }
        const float scale = 2.5f / ssum;
        int me = ek[0]; float mw = sk[0];
#pragma unroll
        for (int k = 1; k < 8; ++k) if (lane == k) { me = ek[k]; mw = sk[k]; }
        if (lane < 8) { const int pos = (int)atomicAdd(cnt + me, 1u); re_[t * 8 + lane] = me; rw_[t * 8 + lane] = mw * scale; rp_[t * 8 + lane] = pos; }
    }
}
__device__ __forceinline__ void phase_scatter(Frame& F) {
    LAS int* st = (LAS int*)F.lds; LAS int* cn = st + 512;
    const unsigned* cnt = WSP(unsigned, WS_CTL) + CW_CNT;
    __syncthreads();
    if (F.tid < NE) cn[F.tid] = (int)cnt[F.tid];
    __syncthreads();
    if (F.tid <= NE) { int s = 0, tl = 0; for (int e = 0; e < F.tid; ++e) { s += cn[e]; tl += (cn[e] + 255) >> 8; } st[F.tid] = s;
        if (F.bx == 0) { unsigned* ctl = WSP(unsigned, WS_CTL); ctl[CW_START + F.tid] = (unsigned)s; ctl[CW_TOFF + F.tid] = (unsigned)tl;
            if (F.tid < NE) { const int c_ = cn[F.tid]; for (int j = 0; j * 256 < c_; ++j) { unsigned* up = ctl + CW_UNITS + 4 * (tl + j); up[0] = (unsigned)(s + 256 * j); up[1] = (unsigned)F.tid; up[2] = (unsigned)(c_ - 256 * j < 256 ? c_ - 256 * j : 256); up[3] = 0u; } } } }
    __syncthreads();
    const int* re_ = WSP(int, WS_ROUTE_E); const float* rw_ = WSP(float, WS_ROUTE_W); const int* rp_ = WSP(int, WS_ROUTE_P);
    int* stok = WSP(int, WS_SLOT_TOK); float* sw = WSP(float, WS_SLOT_W); int* sof = WSP(int, WS_SLOTOF);
    for (int a = F.bx * 512 + F.tid; a < NASG; a += F.G * 512) { const int slot = st[re_[a]] + rp_[a]; stok[slot] = a >> 3; sw[slot] = rw_[a]; sof[a] = slot; }
    if (F.bx == 0 && F.tid < 256) { stok[NASG + F.tid] = 0; sw[NASG + F.tid] = 0.f; }
}
__device__ __forceinline__ void phase_final(Frame& F) {
    float* out = F.p->out; const float* x1 = F.p->out;     const float* fg = F.p->in[I_FG]; const float* ada = WSP(float, WS_ADA);
    const unsigned char* yb8 = WSP(unsigned char, WS_YBUF); const bf16_t* ysh = WSP(bf16_t, WS_YSH); const int* sof = WSP(int, WS_SLOTOF);
    const int lane = F.lane, NGW = F.G * 8;
    const bool al = (F.G == 256); const int tbase = al ? (((F.bx & 7) * 32 + (F.bx >> 3)) * 8 + F.wave) * 8 : F.bx * 8 + F.wave, tstr = al ? 1 : NGW;
    f32x4 fgv[2][2];
#pragma unroll
    for (int j = 0; j < 2; ++j) { fgv[j][0] = *(const f32x4*)(fg + 512 * j + 8 * lane); fgv[j][1] = *(const f32x4*)(fg + 512 * j + 8 * lane + 4); }
    int it_ = 0;
    for (int t = tbase; al ? it_ < 8 : t < T; t += tstr, ++it_) { const int b = t >> 13;
        int sl[8];
#pragma unroll
        for (int k = 0; k < 8; ++k) sl[k] = sof[t * 8 + k];
        u32x4 ys[2]; u32x2 y[8][2]; f32x4 xv[2][2], g2[2][2];
#pragma unroll
        for (int j = 0; j < 2; ++j) { const int c = 512 * j + 8 * lane;
            ys[j] = *(const u32x4*)(ysh + (size_t)t * D + c); xv[j][0] = *(const f32x4*)(x1 + (size_t)t * D + c); xv[j][1] = *(const f32x4*)(x1 + (size_t)t * D + c + 4);
            g2[j][0] = *(const f32x4*)(ada + b * 6144 + 5 * D + c); g2[j][1] = *(const f32x4*)(ada + b * 6144 + 5 * D + c + 4);
#pragma unroll
            for (int k = 0; k < 8; ++k) y[k][j] = *(const u32x2*)(yb8 + (size_t)sl[k] * D + c); }
        f32x4 v[2][2]; float ss = 0.f;
#pragma unroll
        for (int j = 0; j < 2; ++j) { f32x4 m0 = (f32x4){bflo(ys[j].x), bfhi(ys[j].x), bflo(ys[j].y), bfhi(ys[j].y)}, m1 = (f32x4){bflo(ys[j].z), bfhi(ys[j].z), bflo(ys[j].w), bfhi(ys[j].w)};
#pragma unroll
            for (int k = 0; k < 8; ++k) { const f32x2 a0 = __builtin_amdgcn_cvt_pk_f32_fp8((int)y[k][j].x, false), a1 = __builtin_amdgcn_cvt_pk_f32_fp8((int)y[k][j].x, true), b0 = __builtin_amdgcn_cvt_pk_f32_fp8((int)y[k][j].y, false), b1 = __builtin_amdgcn_cvt_pk_f32_fp8((int)y[k][j].y, true);
                m0 += (f32x4){a0.x, a0.y, a1.x, a1.y}; m1 += (f32x4){b0.x, b0.y, b1.x, b1.y}; }
            v[j][0] = xv[j][0] + g2[j][0] * m0; v[j][1] = xv[j][1] + g2[j][1] * m1;
#pragma unroll
            for (int h = 0; h < 2; ++h) ss += (v[j][h][0] * v[j][h][0] + v[j][h][1] * v[j][h][1]) + (v[j][h][2] * v[j][h][2] + v[j][h][3] * v[j][h][3]); }
        const float rs = rsqrtf(wave_sum(ss) * (1.0f / D) + EPS);
#pragma unroll
        for (int j = 0; j < 2; ++j) { const int c = 512 * j + 8 * lane; *(f32x4*)(out + (size_t)t * D + c) = v[j][0] * rs * fgv[j][0]; *(f32x4*)(out + (size_t)t * D + c + 4) = v[j][1] * rs * fgv[j][1]; }
    }
}

constexpr int NPHASE = 15;
#ifndef REP_MASK
#define REP_MASK 0u
#endif
#define NREP(k) ((((REP_MASK) >> (k)) & 1u) ? 2 : 1)
#ifndef MK_LAUNCH_PER_PHASE
#define MK_LAUNCH_PER_PHASE 0
#endif
__global__ void __launch_bounds__(512) hyena_hgrn2_moe_fwd(Params p) {
    extern __shared__ __attribute__((aligned(16))) unsigned char lds_[];
    cg::grid_group grid = cg::this_grid();
    Frame F; F.lds = (LAS unsigned char*)lds_; F.p = &p; F.ws = p.ws; F.tid = threadIdx.x; F.lane = F.tid & 63; F.wave = __builtin_amdgcn_readfirstlane(F.tid >> 6); F.G = gridDim.x; F.bx = blockIdx.x;
    if (F.tid < 16) ((LAS unsigned*)(F.lds + LDS_BARST))[F.tid] = 0u;
    __syncthreads();
    XcdBarrier bar = xcd_barrier_post((unsigned*)(p.ws + WS_CTL) + CW_BAR, (volatile LAS unsigned*)(F.lds + LDS_BARST));
#ifdef ONLY_PHASE
#define IN(k) ((k) == ONLY_PHASE && p.ph_lo <= (k) && (k) < p.ph_hi)
#else
#define IN(k) (p.ph_lo <= (k) && (k) < p.ph_hi)
#endif
#define SEAM(k) do { if (IN(k) && IN((k) + 1)) xcd_barrier(bar); } while (0)
    if (p.ph_lo < 0) grid.sync();
    if (IN(0)) _Pragma("unroll 1") for (int rp = 0; rp < NREP(0); ++rp) { asm volatile("" : "+v"(F.tid)); if (rp) xcd_barrier(bar); phase0(F); }
    SEAM(0);
    if (IN(1)) _Pragma("unroll 1") for (int rp = 0; rp < NREP(1); ++rp) { asm volatile("" : "+v"(F.tid)); if (rp) xcd_barrier(bar); phase1(F); }
    SEAM(1);
    if (IN(2)) _Pragma("unroll 1") for (int rp = 0; rp < NREP(2); ++rp) { asm volatile("" : "+v"(F.tid)); if (rp) xcd_barrier(bar);
        __syncthreads();
        if (F.G == 256 && F.bx >= 256 - NCONV) {
            int tid = F.tid; conv_loop(p.in, F.ws, 256 * (XP_BG + XP_K0) + (F.bx - (256 - NCONV)), NCONV, NE * 48, tid);
        } else
        { pg8::Gemm g{WSP(bf16_t, WS_WINT), WSP(bf16_t, WS_WINT), D, nullptr, 2 * D, 128}; InOrder S{F.G == 256 ? 256 - NCONV : F.G, F.bx};
          EpiIn E{EpiInT{WSP(bf16_t, WS_PHYT), WSP(bf16_t, WS_VT)}, EpiInN{WSP(bf16_t, WS_Q), WSP(bf16_t, WS_G), WSP(bf16_t, WS_SG1), WSP(bf16_t, WS_SG2), WSP(float, WS_LF), WSP(float, WS_LB), WSP(float, WS_LBS)}};
          pg8::gemm_phase<EpiIn, InOrder, false>(F.lds, g, S, E); }
    }
    SEAM(2);
    if (IN(3)) _Pragma("unroll 1") for (int rp = 0; rp < NREP(3); ++rp) { asm volatile("" : "+v"(F.tid)); if (rp) xcd_barrier(bar);
        _Pragma("unroll 1") for (int r2 = 0; r2 < NREP(16); ++r2) { asm volatile("" : "+v"(F.tid));
            XpState xp; xp.it = F.bx; xp.stride = F.G; xp.end = (XP_BG * F.G < NE * 48) ? XP_BG * F.G : NE * 48; xp.live = false;
            for (int c = F.bx; c < HYW; c += F.G) hyena_item(F, c, xp);
            { int tid = F.tid; xp_finish(xp, p.in, F.ws, tid); while (xp.it < xp.end) { xp_issue(xp, p.in, F.ws, tid); xp_finish(xp, p.in, F.ws, tid); } } }
        _Pragma("unroll 1") for (int r2 = 0; r2 < NREP(17); ++r2) { asm volatile("" : "+v"(F.tid)); for (int it = F.bx; it < NAITEM; it += F.G) hg_delta_item(F, it); }
    }
    SEAM(3);
    if (IN(4)) _Pragma("unroll 1") for (int rp = 0; rp < NREP(4); ++rp) { asm volatile("" : "+v"(F.tid)); if (rp) xcd_barrier(bar);
        _Pragma("unroll 1") for (int r2 = 0; r2 < NREP(18); ++r2) { asm volatile("" : "+v"(F.tid)); hg_scan(F); }
        _Pragma("unroll 1") for (int r2 = 0; r2 < NREP(19); ++r2) { asm volatile("" : "+v"(F.tid)); for (int it = F.bx; it < NB * 128; it += F.G) yhy_transpose_item(F, it); }
    }
    SEAM(4);
    if (IN(5)) _Pragma("unroll 1") for (int rp = 0; rp < NREP(5); ++rp) { asm volatile("" : "+v"(F.tid)); if (rp) xcd_barrier(bar); for (int it = F.bx; it < NB * 4 * NCH_LAT; it += F.G) hg_out_item(F, it); }
    SEAM(5);
    if (IN(6)) _Pragma("unroll 1") for (int rp = 0; rp < NREP(6); ++rp) { asm volatile("" : "+v"(F.tid)); if (rp) xcd_barrier(bar);
        __syncthreads();
        { pg8::Gemm g{WSP(bf16_t, WS_YHY), WSP(bf16_t, WS_WHYT), HYW, nullptr, 2 * HYW, 128}; pg8::StaticOrder S; S.init(T, D, HYW, F.G, F.bx); EpiMerge1 E{WSP(bf16_t, WS_SG1), WSP(float, WS_T1)};
          pg8::gemm_phase<EpiMerge1, pg8::StaticOrder, false>(F.lds, g, S, E); }
        { pg8::Gemm g{WSP(bf16_t, WS_YHG), WSP(bf16_t, WS_WHGT), HGW, nullptr, 2 * HGW, 128}; pg8::StaticOrder S; S.init(T, D, HGW, F.G, F.bx); EpiMerge2 E{WSP(bf16_t, WS_SG2), WSP(float, WS_T1), WSP(bf16_t, WS_MB)};
          pg8::gemm_phase<EpiMerge2, pg8::StaticOrder, false>(F.lds, g, S, E); }
    }
    SEAM(6);
    if (IN(7)) _Pragma("unroll 1") for (int rp = 0; rp < NREP(7); ++rp) { asm volatile("" : "+v"(F.tid)); if (rp) xcd_barrier(bar);
        __syncthreads();
        pg8::Gemm g{WSP(bf16_t, WS_MB), WSP(bf16_t, WS_WOUTT), D, nullptr, 2 * D, 128}; pg8::StaticOrder S; S.init(T, D, D, F.G, F.bx);
        EpiWout E{p.in[I_X], WSP(float, WS_POSR), WSP(float, WS_POSC), WSP(float, WS_ADA), p.out};
        pg8::gemm_phase<EpiWout, pg8::StaticOrder, false>(F.lds, g, S, E);
    }
    SEAM(7);
    if (IN(8)) _Pragma("unroll 1") for (int rp = 0; rp < NREP(8); ++rp) { asm volatile("" : "+v"(F.tid)); if (rp) xcd_barrier(bar); phase_h2(F); }
    SEAM(8);
    if (IN(9)) _Pragma("unroll 1") for (int rp = 0; rp < NREP(9); ++rp) { asm volatile("" : "+v"(F.tid)); if (rp) xcd_barrier(bar);
        __syncthreads();
        { pg8::Gemm g{WSP(bf16_t, WS_H2), WSP(bf16_t, WS_ROUT), D, nullptr, 2 * D, 128}; P9Order S{F.G, F.bx}; EpiP9 E{EpiLogit{WSP(float, WS_LOGIT)}, EpiGU{WSP(bf16_t, WS_HSH)}};
          pg8::gemm_phase<EpiP9, P9Order, false>(F.lds, g, S, E); }
    }
    SEAM(9);
    if (IN(10)) _Pragma("unroll 1") for (int rp = 0; rp < NREP(10); ++rp) { asm volatile("" : "+v"(F.tid)); if (rp) xcd_barrier(bar); phase_route(F); }
    SEAM(10);
    if (IN(11)) _Pragma("unroll 1") for (int rp = 0; rp < NREP(11); ++rp) { asm volatile("" : "+v"(F.tid)); if (rp) xcd_barrier(bar); phase_scatter(F); }
    SEAM(11);
    if (IN(12)) _Pragma("unroll 1") for (int rp = 0; rp < NREP(12); ++rp) { asm volatile("" : "+v"(F.tid)); if (rp) xcd_barrier(bar);
        __syncthreads();
        pg8::Gemm g{WSP(bf16_t, WS_H2), WSP(bf16_t, WS_EGUT), D, WSP(int, WS_SLOT_TOK), 128, 512 * 128}; MoeOrder S{WSP(unsigned, WS_CTL) + CW_UNITS, (int)WSP(unsigned, WS_CTL)[CW_TOFF + NE], 2, F.G, F.bx, 1048576u}; EpiGU E{WSP(bf16_t, WS_HBUF)};
        pg8::gemm_phase<EpiGU, MoeOrder, true>(F.lds, g, S, E);
    }
    SEAM(12);
    if (IN(13)) _Pragma("unroll 1") for (int rp = 0; rp < NREP(13); ++rp) { asm volatile("" : "+v"(F.tid)); if (rp) xcd_barrier(bar);
        __syncthreads();
        { pg8::Gemm g{WSP(bf16_t, WS_HBUF), WSP(bf16_t, WS_EDT), EH, nullptr, 128, 1024 * 128}; MoeOrder S{WSP(unsigned, WS_CTL) + CW_UNITS, (int)WSP(unsigned, WS_CTL)[CW_TOFF + NE], 4, F.G, F.bx, 524288u}; EpiDown<true, true> E{WSP(bf16_t, WS_YBUF), WSP(float, WS_SLOT_W)};
          pg8::gemm_phase<EpiDown<true, true>, MoeOrder, false>(F.lds, g, S, E); }
        { pg8::Gemm g{WSP(bf16_t, WS_HSH), WSP(bf16_t, WS_SHDT), EH, nullptr, 2 * EH, 128}; pg8::StaticOrder S; S.init(T, D, EH, F.G, F.bx); EpiDown<false> E{WSP(bf16_t, WS_YSH), nullptr};
          pg8::gemm_phase<EpiDown<false>, pg8::StaticOrder, false>(F.lds, g, S, E); }
    }
    SEAM(13);
    if (IN(14)) _Pragma("unroll 1") for (int rp = 0; rp < NREP(14); ++rp) { asm volatile("" : "+v"(F.tid)); if (rp) xcd_barrier(bar); phase_final(F); }
#undef IN
#undef SEAM
}

extern "C" void kernel_launch(void* const* d_in, const int* in_sizes, int n_in, void* d_out, int out_size, void* d_ws, size_t ws_size, hipStream_t stream) {
    static int grid = 0;
    if (grid == 0) {
        if (n_in != 34 || out_size != T * D || ws_size < WS_END) { fprintf(stderr, "kernel_launch: unexpected shapes (n_in %d, out %d, ws %zu < %zu)\n", n_in, out_size, ws_size, (size_t)WS_END); grid = -1; return; }
        int dev = 0, cus = 0, per_cu = 0;
        if (hipGetDevice(&dev) != hipSuccess || hipDeviceGetAttribute(&cus, hipDeviceAttributeMultiprocessorCount, dev) != hipSuccess) { grid = -1; return; }
        if (hipFuncSetAttribute((const void*)hyena_hgrn2_moe_fwd, hipFuncAttributeMaxDynamicSharedMemorySize, LDS_BYTES) != hipSuccess) { fprintf(stderr, "kernel_launch: hipFuncSetAttribute failed\n"); grid = -1; return; }
        if (hipOccupancyMaxActiveBlocksPerMultiprocessor(&per_cu, (const void*)hyena_hgrn2_moe_fwd, 512, LDS_BYTES) != hipSuccess || per_cu < 1) { fprintf(stderr, "kernel_launch: occupancy query failed (%d)\n", per_cu); (void)hipGetLastError(); per_cu = 1; }
        grid = cus * per_cu; if (grid > 256) grid = 256;
    }
    if (grid < 0) return;
    if (hipMemsetAsync((char*)d_ws + WS_CTL, 0, CTL_BYTES, stream) != hipSuccess) { fprintf(stderr, "kernel_launch: memset failed\n"); return; }
    Params p{};
    for (int i = 0; i < 34; ++i) p.in[i] = (const float*)d_in[i];
    p.out = (float*)d_out; p.ws = (unsigned char*)d_ws;
#if MK_LAUNCH_PER_PHASE
    for (int k = 0; k < NPHASE; ++k) { p.ph_lo = k; p.ph_hi = k + 1; void* args[] = {&p};
        hipError_t e = hipLaunchCooperativeKernel((const void*)hyena_hgrn2_moe_fwd, dim3(grid), dim3(512), args, LDS_BYTES, stream);
        if (e != hipSuccess) { fprintf(stderr, "kernel_launch: launch %d failed: %s\n", k, hipGetErrorString(e)); break; } }
#else
    p.ph_lo = 0; p.ph_hi = NPHASE; void* args[] = {&p};
    hipError_t e = hipLaunchCooperativeKernel((const void*)hyena_hgrn2_moe_fwd, dim3(grid), dim3(512), args, LDS_BYTES, stream);
    if (e != hipSuccess) fprintf(stderr, "kernel_launch: cooperative launch failed: %s (grid %d)\n", hipGetErrorString(e), grid);
#endif
}
```

```cpp
#include <hip/hip_runtime.h>
#include <hip/hip_cooperative_groups.h>
#include <cstdio>
#include <cstdint>
namespace cg = cooperative_groups;

#define LAS __attribute__((address_space(3)))
typedef unsigned short bf16_t;
typedef short bf16x8 __attribute__((ext_vector_type(8)));
typedef float f32x4 __attribute__((ext_vector_type(4)));
typedef float f32x2 __attribute__((ext_vector_type(2)));
typedef unsigned u32x4 __attribute__((ext_vector_type(4)));
typedef unsigned u32x2 __attribute__((ext_vector_type(2)));

constexpr int D = 1024, NB = 2, SEQ = 8192, T = NB * SEQ, CTXL = 256, TC = NB * CTXL, MA = T + TC, NEXT = CTXL + SEQ;
constexpr int HYW = 512, HYP = 1536, HGW = 512, INC = 6144;
constexpr int NE = 256, TOPK = 8, EH = 256, NASG = T * TOPK;
constexpr int NCH_EXT = NEXT / 64  , NCH_LAT = SEQ / 64  , NCHAIN = 16, NAITEM = NCHAIN * NCH_EXT  ;
constexpr int FFTN = 16384;
constexpr float EPS = 1e-6f;

constexpr size_t al256(size_t x) { return (x + 255) & ~(size_t)255; }
constexpr size_t WS_CTL = 0, CTL_BYTES = 65536;
constexpr size_t WS_WINT = WS_CTL + CTL_BYTES;
constexpr size_t WS_WHYT = WS_WINT + (size_t)INC * D * 2;
constexpr size_t WS_WHGT = WS_WHYT + (size_t)D * HYW * 2;
constexpr size_t WS_WOUTT = WS_WHGT + (size_t)D * HGW * 2;
constexpr size_t WS_ROUT = WS_WOUTT + (size_t)D * D * 2;
constexpr size_t WS_SHGUT = WS_ROUT + (size_t)NE * D * 2;
constexpr size_t WS_SHDT = WS_SHGUT + (size_t)512 * D * 2;
constexpr size_t WS_ADAP = WS_SHDT + (size_t)D * 256 * 2;
constexpr size_t WS_ADA = WS_ADAP + (size_t)32 * 3 * 6144 * 4;
constexpr size_t WS_POSR = WS_ADA + (size_t)3 * 6144 * 4;
constexpr size_t WS_POSC = WS_POSR + (size_t)128 * 512 * 4;
constexpr size_t WS_LBS = WS_POSC + (size_t)64 * 512 * 4;
constexpr size_t WS_ROUTE_E = WS_LBS + 4096;
constexpr size_t WS_ROUTE_W = WS_ROUTE_E + (size_t)NASG * 4;
constexpr size_t WS_ROUTE_P = WS_ROUTE_W + (size_t)NASG * 4;
constexpr size_t WS_SLOTOF = WS_ROUTE_P + (size_t)NASG * 4;
constexpr size_t WS_SLOT_TOK = WS_SLOTOF + (size_t)NASG * 4;
constexpr size_t WS_SLOT_W = WS_SLOT_TOK + (size_t)(NASG + 256) * 4;
constexpr size_t WS_EGUT = al256(WS_SLOT_W + (size_t)(NASG + 256) * 4);
constexpr size_t WS_EDT = WS_EGUT + (size_t)NE * 512 * D * 2;
constexpr size_t WS_RA = WS_EDT + (size_t)NE * D * EH * 2;
constexpr size_t RA_BYTES = (size_t)NASG * D * 2;
constexpr size_t WS_HF = WS_RA;
constexpr size_t WS_KS = WS_HF + (size_t)2048 * SEQ * 4;
constexpr size_t WS_DELTA = WS_KS + (size_t)256 * 2 * FFTN * 8;
constexpr size_t WS_DECAY = WS_DELTA + (size_t)NAITEM * 16384 * 2;
constexpr size_t WS_PHYT = WS_DECAY + (size_t)NAITEM * 128 * 4;
static_assert(WS_PHYT + (size_t)NB * HYP * SEQ * 2 <= WS_RA + RA_BYTES, "region A overflow");
constexpr size_t WS_YBUF = WS_RA;
constexpr size_t WS_RB = WS_RA + RA_BYTES;
constexpr size_t WS_VT = WS_RB;
constexpr size_t WS_Q = WS_VT + (size_t)NB * HGW * NEXT * 2;
constexpr size_t WS_LF = WS_Q + (size_t)T * HGW * 2;
constexpr size_t WS_LB = WS_LF + (size_t)NB * NEXT * HGW * 4;
constexpr size_t WS_G = WS_LB + (size_t)NB * NEXT * HGW * 4;
constexpr size_t WS_SG1 = WS_G + (size_t)T * HGW * 2;
constexpr size_t WS_SG2 = WS_SG1 + (size_t)T * D * 2;
constexpr size_t WS_A1 = WS_SG2 + (size_t)T * D * 2;
constexpr size_t WS_SST = WS_A1 + (size_t)MA * D * 2;
constexpr size_t WS_YHG = WS_SST + (size_t)NCHAIN * NCH_LAT * 16384 * 2 + 256 * 512;
constexpr size_t WS_T1 = WS_YHG + (size_t)T * HGW * 2;
constexpr size_t WS_END = WS_T1 + (size_t)T * D * 4;
constexpr size_t WS_LOGIT = WS_VT, WS_HSH = WS_Q, WS_MB = WS_LF, WS_H2 = WS_LB, WS_YSH = WS_SG1, WS_YHYT = WS_A1, WS_YHY = WS_A1 + (size_t)NB * HYW * SEQ * 2, WS_HBUF = WS_SST;
static_assert((size_t)T * 256 * 4 <= (size_t)NB * HGW * NEXT * 2, "LOGIT fits VT");
static_assert(WS_YHY + (size_t)T * HYW * 2 <= WS_SST, "YHY fits A1");
static_assert((size_t)(NASG + 256) * EH * 2 <= (size_t)NCHAIN * NCH_LAT * 16384 * 2 + 256 * 512, "HBUF fits SST");
static_assert(WS_END <= (size_t)1073741824, "workspace map exceeds 1 GiB");
constexpr int CW_CNT = 0;
constexpr int CW_START = 512;
constexpr int CW_TOFF = 1024;
constexpr int CW_BAR = 4096;
constexpr int CW_UNITS = 8192;

constexpr int LDS_BYTES = 147456;
constexpr int LDS_BARST = LDS_BYTES - 64;

__device__ __forceinline__ unsigned f2bf(float f) { unsigned u = __float_as_uint(f); return (u + 0x7fffu + ((u >> 16) & 1u)) >> 16; }
__device__ __forceinline__ unsigned pk2(float lo, float hi) { return f2bf(lo) | (f2bf(hi) << 16); }
__device__ __forceinline__ float bf2f(unsigned b) { return __uint_as_float(b << 16); }
__device__ __forceinline__ float bflo(unsigned w) { return __uint_as_float(w << 16); }
__device__ __forceinline__ float bfhi(unsigned w) { return __uint_as_float(w & 0xffff0000u); }
__device__ __forceinline__ float sigmoidf_(float x) { return __builtin_amdgcn_rcpf(1.0f + __expf(-x)); }
__device__ __forceinline__ float siluf_(float x) { return x * __builtin_amdgcn_rcpf(1.0f + __expf(-x)); }
__device__ __forceinline__ unsigned f2h(float f) { return (unsigned)__builtin_bit_cast(unsigned short, (_Float16)f); }
__device__ __forceinline__ unsigned pkh2(float lo, float hi) { return f2h(lo) | (f2h(hi) << 16); }
__device__ __forceinline__ float h2f(unsigned short b) { return (float)__builtin_bit_cast(_Float16, b); }
__device__ __forceinline__ float wave_sum(float v) {
#pragma unroll
    for (int o = 1; o < 64; o <<= 1) v += __shfl_xor(v, o);
    return v;
}
#define LDS_WAIT() asm volatile("s_waitcnt lgkmcnt(0)" ::: "memory")

struct Params {
    const float* in[34];
    float* out;
    unsigned char* ws;
    int ph_lo, ph_hi;
};
enum { I_X = 0, I_C, I_CTX, I_CCTX, I_N1G, I_N2G, I_ADAW, I_ADAB, I_WIN, I_HCW, I_HCB, I_FW1, I_FB1, I_FW2, I_FB2, I_FW3, I_FB3, I_FW4, I_FFREQ, I_HSKIP,
       I_LBL, I_HGNG, I_WHY, I_WHG, I_WOUT, I_RW, I_RB, I_EG, I_EU, I_ED, I_SG, I_SU, I_SD, I_FG };
namespace pg8 {
constexpr int BM = 256, BK = 64, HALF = 128, HTB = HALF * BK * 2, STAGE_BYTES = 8 * HTB;
__host__ __device__ __forceinline__ int lds_byte(int r, int c) { const int st = (r >> 4) * 2 + (c >> 5), rr = r & 15, cc = c & 31, ob = rr * 64 + cc * 2; return st * 1024 + (ob ^ (((ob >> 9) & 1) << 5)); }
__host__ __device__ __forceinline__ void stage_rc(int b, int& R, int& C) { const int st = b / 1024, sb = b % 1024, swz = sb ^ (((sb >> 9) & 1) << 5); R = (st >> 1) * 16 + swz / 64; C = (st & 1) * 32 + (swz % 64) / 2; }
__host__ __device__ __forceinline__ int perm32(int rho) { const int n = rho >> 4, i = rho & 15; return 8 * (i >> 2) + 4 * n + (i & 3); }

struct Unit { int row0, lrow, pn, nvalid, aux, kind; unsigned boff; };
struct Gemm { const bf16_t* A; const bf16_t* Bt; int K; const int* rows; int ldb, kstepB; };

__device__ __forceinline__ unsigned cvt_pk_bf16(float lo, float hi) { unsigned r; asm volatile("v_cvt_pk_bf16_f32 %0, %1, %2" : "=v"(r) : "v"(lo), "v"(hi)); return r; }

template <class Epi, class Sched, bool GATHER>
__device__ __forceinline__ void gemm_phase(LAS unsigned char* lds, const Gemm g, const Sched& S, const Epi& E) {
    const int tid = threadIdx.x, wid = __builtin_amdgcn_readfirstlane(tid >> 6), lane = tid & 63, wr = wid >> 2, wc = wid & 3, fr = lane & 15, fq = lane >> 4;
    int K_ = g.K; asm volatile("" : "+s"(K_));
    const int K = K_, nt = K / BK; int ldb_ = g.ldb, ksb_ = g.kstepB; asm volatile("" : "+s"(ldb_), "+s"(ksb_));
    unsigned voffA[2], voffB[2]; int RA[2], CA[2];
#pragma unroll
    for (int i = 0; i < 2; ++i) { int R, C; stage_rc(tid * 16 + i * 8192, R, C); const int Rb = Epi::PERM ? ((R & ~31) + perm32(R & 31)) : R;
        voffA[i] = (unsigned)(R * K + C) * 2u; voffB[i] = (unsigned)(Rb * ldb_ + C * 2); RA[i] = R; CA[i] = C; }
    const size_t kstep = (size_t)(BK * 2);
    const size_t hstep = (size_t)HALF * K * 2;
    const size_t kstepB = (size_t)ksb_, hstepB = (size_t)HALF * ldb_;
    const unsigned ldsw = (unsigned)wid * 1024u;
    const int aoff = lds_byte(wr * 64 + fr, fq * 8), boff = lds_byte(wc * 32 + fr, fq * 8);
    unsigned vg0[2][2], vg1[2][2];
#define PG8_SA(b, h) (((b) * 2 + (h)) * HTB)
#define PG8_SB(b, h) ((4 + (b) * 2 + (h)) * HTB)
#define PG8_STAGE(bufoff, gbase, voff) do { _Pragma("unroll") for (int _i = 0; _i < 2; ++_i) \
        __builtin_amdgcn_global_load_lds((const unsigned*)((const char*)(gbase) + (voff)[_i]), (LAS unsigned*)(lds + (bufoff) + ldsw + _i * 8192), 16, 0, 0); } while (0)
#define PG8_STAGE_A(bufoff, gbase, h, w) do { _Pragma("unroll") for (int _i = 0; _i < 2; ++_i) { \
        const unsigned _o = GATHER ? ((w) ? vg1[h][_i] : vg0[h][_i]) : (voffA[_i] + (unsigned)((h) * hstep)); \
        __builtin_amdgcn_global_load_lds((const unsigned*)((const char*)(gbase) + _o), (LAS unsigned*)(lds + (bufoff) + ldsw + _i * 8192), 16, 0, 0); } } while (0)
#define PG8_LDA(dst, b, h) do { _Pragma("unroll") for (int m = 0; m < 4; ++m) _Pragma("unroll") for (int k = 0; k < 2; ++k) dst[m][k] = *(const LAS bf16x8*)(lds + PG8_SA(b, h) + aoff + m * 2048 + k * 1024); } while (0)
#define PG8_LDB(dst, b, h) do { _Pragma("unroll") for (int n = 0; n < 2; ++n) _Pragma("unroll") for (int k = 0; k < 2; ++k) dst[n][k] = *(const LAS bf16x8*)(lds + PG8_SB(b, h) + boff + n * 2048 + k * 1024); } while (0)
#define PG8_MMA(ai, bj, At, Bt) do { __builtin_amdgcn_s_setprio(1); _Pragma("unroll") for (int m = 0; m < 4; ++m) _Pragma("unroll") for (int n = 0; n < 2; ++n) _Pragma("unroll") for (int k = 0; k < 2; ++k) \
        acc[ai][bj][m][n] = __builtin_amdgcn_mfma_f32_16x16x32_bf16(Bt[n][k], At[m][k], acc[ai][bj][m][n], 0, 0, 0); __builtin_amdgcn_s_setprio(0); } while (0)
#define PG8_WAIT_V(n) asm volatile("s_waitcnt vmcnt(" #n ")" ::: "memory")
#define PG8_WAIT_L(n) asm volatile("s_waitcnt lgkmcnt(" #n ")" ::: "memory")
#define PG8_BAR __builtin_amdgcn_s_barrier()
#define PG8_SCHED __builtin_amdgcn_sched_barrier(0)
#define PG8_GOFF(dst, u) do { if (GATHER) { _Pragma("unroll") for (int _h = 0; _h < 2; ++_h) _Pragma("unroll") for (int _i = 0; _i < 2; ++_i) \
        dst[_h][_i] = (unsigned)(g.rows[(u).row0 + _h * HALF + RA[_i]] * K + CA[_i]) * 2u; } } while (0)
    Unit cur, nxt; int ui = 0;
    if (!S.next(0, cur)) return;
    f32x4 acc[2][2][4][2];
#pragma unroll
    for (int a = 0; a < 2; ++a)
#pragma unroll
        for (int b = 0; b < 2; ++b)
#pragma unroll
            for (int m = 0; m < 4; ++m)
#pragma unroll
                for (int n = 0; n < 2; ++n) acc[a][b][m][n] = (f32x4){0.f, 0.f, 0.f, 0.f};
    bf16x8 At[4][2], B0[2][2], B1[2][2];
    const char* cA = (const char*)g.A + (GATHER ? (size_t)0 : (size_t)cur.row0 * K * 2); const char* cB = (const char*)g.Bt + cur.boff;
    PG8_GOFF(vg0, cur);
#pragma unroll
    for (int _h = 0; _h < 2; ++_h)
#pragma unroll
        for (int _i = 0; _i < 2; ++_i) vg1[_h][_i] = vg0[_h][_i];
    PG8_STAGE(PG8_SB(0, 0), cB, voffB); PG8_STAGE_A(PG8_SA(0, 0), cA, 0, false); PG8_STAGE(PG8_SB(0, 1), cB + hstepB, voffB); PG8_STAGE_A(PG8_SA(0, 1), cA, 1, false);
    if (wr == 1) PG8_BAR;
    PG8_WAIT_V(4); PG8_BAR;
    PG8_STAGE(PG8_SB(1, 0), cB + kstepB, voffB); PG8_STAGE_A(PG8_SA(1, 0), cA + kstep, 0, false); PG8_STAGE(PG8_SB(1, 1), cB + hstepB + kstepB, voffB);
    PG8_WAIT_V(6); PG8_BAR;
    for (;;) {
        const bool has_next = S.next(ui + 1, nxt);
        if (has_next) PG8_GOFF(vg1, nxt);
        const char* nA = has_next ? (const char*)g.A + (GATHER ? (size_t)0 : (size_t)nxt.row0 * K * 2) : cA; const char* nB = has_next ? (const char*)g.Bt + nxt.boff : cB;
        const bool full = cur.nvalid > HALF;
        for (int t = 0; t < nt; t += 2) {
            const bool last = (t == nt - 2);
            const bool wn = last && has_next;
            const char* a1 = cA + (size_t)(t + 1) * kstep;
            const char* a2 = last ? nA : cA + (size_t)(t + 2) * kstep; const char* b2 = last ? nB : cB + (size_t)(t + 2) * kstepB;
            const char* a3 = a2 + kstep; const char* b3 = b2 + kstepB;
            PG8_LDB(B0, 0, 0); PG8_SCHED; PG8_LDA(At, 0, 0); PG8_STAGE_A(PG8_SA(1, 1), a1, 1, false);
            PG8_WAIT_L(8); PG8_BAR; PG8_WAIT_L(0); PG8_MMA(0, 0, At, B0); PG8_BAR; PG8_SCHED;
            PG8_LDB(B1, 0, 1); PG8_STAGE(PG8_SB(0, 0), b2, voffB);
            PG8_BAR; PG8_WAIT_L(0); PG8_MMA(0, 1, At, B1); PG8_BAR;
            if (full) PG8_LDA(At, 0, 1); PG8_STAGE_A(PG8_SA(0, 0), a2, 0, wn);
            PG8_BAR; PG8_WAIT_L(0); if (full) PG8_MMA(1, 0, At, B0); PG8_BAR; PG8_SCHED;
            PG8_STAGE(PG8_SB(0, 1), b2 + hstepB, voffB);
            PG8_WAIT_V(6); PG8_BAR; if (full) PG8_MMA(1, 1, At, B1); PG8_BAR;
            PG8_LDB(B0, 1, 0); PG8_SCHED; PG8_LDA(At, 1, 0); PG8_STAGE_A(PG8_SA(0, 1), a2, 1, wn);
            PG8_WAIT_L(8); PG8_BAR; PG8_WAIT_L(0); PG8_MMA(0, 0, At, B0); PG8_BAR; PG8_SCHED;
            PG8_LDB(B1, 1, 1); PG8_STAGE(PG8_SB(1, 0), b3, voffB);
            PG8_BAR; PG8_WAIT_L(0); PG8_MMA(0, 1, At, B1); PG8_BAR;
            if (full) PG8_LDA(At, 1, 1); PG8_STAGE_A(PG8_SA(1, 0), a3, 0, wn);
            PG8_BAR; PG8_WAIT_L(0); if (full) PG8_MMA(1, 0, At, B0); PG8_BAR; PG8_SCHED;
            PG8_STAGE(PG8_SB(1, 1), b3 + hstepB, voffB);
            PG8_WAIT_V(6); PG8_BAR; if (full) PG8_MMA(1, 1, At, B1); PG8_BAR;
        }
        { int fr_ = fr, fq_ = fq; asm volatile("" : "+v"(fr_), "+v"(fq_)); E(acc, cur, wr, wc, fr_, fq_); }
        if (!has_next) break;
#pragma unroll
        for (int a = 0; a < 2; ++a)
#pragma unroll
            for (int b = 0; b < 2; ++b)
#pragma unroll
                for (int m = 0; m < 4; ++m)
#pragma unroll
                    for (int n = 0; n < 2; ++n) acc[a][b][m][n] = (f32x4){0.f, 0.f, 0.f, 0.f};
        cur = nxt; cA = nA; cB = nB; ++ui;
#pragma unroll
        for (int _h = 0; _h < 2; ++_h)
#pragma unroll
            for (int _i = 0; _i < 2; ++_i) vg0[_h][_i] = vg1[_h][_i];
    }
    PG8_WAIT_V(0);
    if (wr == 0) PG8_BAR;
    PG8_BAR;
#undef PG8_SA
#undef PG8_SB
#undef PG8_STAGE
#undef PG8_STAGE_A
#undef PG8_LDA
#undef PG8_LDB
#undef PG8_MMA
#undef PG8_WAIT_V
#undef PG8_WAIT_L
#undef PG8_BAR
#undef PG8_SCHED
#undef PG8_GOFF
}

struct StaticOrder {
    int nM, nN, nwg, G, c, Kb;
    __device__ void init(int M, int N, int K, int G_, int c_) { nM = M / BM; nN = N / BM; nwg = nM * nN; G = G_; c = c_; Kb = K; }
    __device__ bool next(int i, Unit& u) const {
        const long L = (long)i * G + c; if (L >= nwg) return false;
        int wgid = (int)L; { const int NXCD = 8; const int q = nwg / NXCD, r = nwg % NXCD, xcd = wgid % NXCD, off = wgid / NXCD; wgid = (xcd < r ? xcd * (q + 1) : r * (q + 1) + (xcd - r) * q) + off; }
        const int WGM = 8; const int nig = WGM * nN, gid = wgid / nig, fm = gid * WGM, gsz = (nM - fm) < WGM ? (nM - fm) : WGM;
        u.row0 = (fm + ((wgid % nig) % gsz)) * BM; u.lrow = u.row0; u.pn = (wgid % nig) / gsz; u.nvalid = BM; u.aux = u.pn; u.kind = 0; u.boff = (unsigned)u.pn * (unsigned)(BM * 2) * (unsigned)Kb; return true;
    }
};
}
using pg8::Unit; using pg8::cvt_pk_bf16;
typedef const f32x4 (&AccRef)[2][2][4][2];

struct MoeOrder {
    const unsigned* units; int ntile, nsub, G, c; unsigned ebytes;
    __device__ bool next(int i, Unit& u) const {
        const long L = (long)i * G + c; const int nun = ntile * nsub; if (L >= nun) return false;
        int idx = (int)L; { const int q = nun / 8, r = nun % 8, xcd = idx % 8, off = idx / 8; idx = (xcd < r ? xcd * (q + 1) : r * (q + 1) + (xcd - r) * q) + off; }
        const int tile = idx / nsub, sub = idx % nsub;
        const u32x4 d = *(const u32x4*)(units + 4 * tile);
        u.row0 = (int)d.x; u.lrow = u.row0; u.pn = (int)d.y * nsub + sub; u.nvalid = (int)d.z; u.aux = sub; u.kind = 0; u.boff = d.y * ebytes + (unsigned)sub * 32768u; return true;
    }
};

struct EpiInT {
    static constexpr bool PERM = true;
    bf16_t* phyt; bf16_t* vt;
    __device__ __forceinline__ void operator()(AccRef acc, const Unit& u, int wr, int wc, int fr, int fq) const {
        const int pm = u.lrow >> 8, tb = u.pn * 256; const bool isctx = tb >= T;
        int b, nbase; if (!isctx) { b = tb >> 13; nbase = tb & (SEQ - 1); } else { b = (tb - T) >> 8; nbase = 0; }
        if (pm < 6 && isctx) return;
#pragma unroll
        for (int ai = 0; ai < 2; ++ai)
#pragma unroll
            for (int m = 0; m < 4; ++m) {
                const int f = u.lrow + ai * 128 + wr * 64 + m * 16 + fr;
                bf16_t* rowp = (pm < 6) ? phyt + ((size_t)(b * HYP + f) * SEQ + nbase) : vt + ((size_t)(b * HGW + (f - HYP)) * NEXT + (isctx ? 0 : CTXL) + nbase);
#pragma unroll
                for (int bj = 0; bj < 2; ++bj) { const int cu = bj * 128 + wc * 32 + 8 * fq; const f32x4 v0 = acc[ai][bj][m][0], v1 = acc[ai][bj][m][1];
                    u32x4 w; w.x = cvt_pk_bf16(v0[0], v0[1]); w.y = cvt_pk_bf16(v0[2], v0[3]); w.z = cvt_pk_bf16(v1[0], v1[1]); w.w = cvt_pk_bf16(v1[2], v1[3]);
                    *(u32x4*)(rowp + cu) = w; }
            }
    }
};
struct EpiInN {
    static constexpr bool PERM = true;
    bf16_t *q, *g, *sg1, *sg2; float *lf, *lb; const float* lbs;
    __device__ __forceinline__ void operator()(AccRef acc, const Unit& u, int wr, int wc, int fr, int fq) const {
        const int pn = u.pn; const bool isctx = u.lrow >= T;
        if (isctx && (pn < 2 || pn > 5)) return;
        float lbu[2][8];
        if (pn >= 2 && pn < 6) {
#pragma unroll
            for (int bj = 0; bj < 2; ++bj) { const float* lbp = lbs + (pn >= 4) * 512 + (pn & 1) * 256 + bj * 128 + wc * 32 + 8 * fq; const f32x4 l0 = *(const f32x4*)lbp, l1 = *(const f32x4*)(lbp + 4);
                lbu[bj][0] = l0[0]; lbu[bj][1] = l0[1]; lbu[bj][2] = l0[2]; lbu[bj][3] = l0[3]; lbu[bj][4] = l1[0]; lbu[bj][5] = l1[1]; lbu[bj][6] = l1[2]; lbu[bj][7] = l1[3]; } }
#pragma unroll
        for (int ai = 0; ai < 2; ++ai)
#pragma unroll
            for (int m = 0; m < 4; ++m) {
                const int r = u.lrow + ai * 128 + wr * 64 + m * 16 + fr;
                int b, nx; if (!isctx) { b = r >> 13; nx = CTXL + (r & (SEQ - 1)); } else { const int rr = r - T; b = rr >> 8; nx = rr & 255; }
#pragma unroll
                for (int bj = 0; bj < 2; ++bj) { const int cu = bj * 128 + wc * 32 + 8 * fq; const f32x4 v0 = acc[ai][bj][m][0], v1 = acc[ai][bj][m][1];
                    float x[8] = {v0[0], v0[1], v0[2], v0[3], v1[0], v1[1], v1[2], v1[3]};
                    if (pn >= 2 && pn < 6) {
                        const int dir = pn >= 4, col = (pn & 1) * 256 + cu;
                        float o[8];
#pragma unroll
                        for (int j = 0; j < 8; ++j) o[j] = __logf(lbu[bj][j] + (1.0f - lbu[bj][j]) * sigmoidf_(x[j]));
                        float* dst = (dir ? lb : lf) + ((size_t)(b * NEXT + nx) * HGW + col);
                        *(f32x4*)dst = (f32x4){o[0], o[1], o[2], o[3]}; *(f32x4*)(dst + 4) = (f32x4){o[4], o[5], o[6], o[7]};
                    } else {
                        bf16_t* dst;
                        if (pn < 2) { dst = q + (size_t)r * HGW + pn * 256 + cu;
#pragma unroll
                            for (int j = 0; j < 8; ++j) x[j] = siluf_(x[j]); }
                        else if (pn < 8) { dst = g + (size_t)r * HGW + (pn - 6) * 256 + cu;
#pragma unroll
                            for (int j = 0; j < 8; ++j) x[j] = siluf_(x[j]); }
                        else { dst = (pn < 12 ? sg1 + (size_t)r * D + (pn - 8) * 256 : sg2 + (size_t)r * D + (pn - 12) * 256) + cu;
#pragma unroll
                            for (int j = 0; j < 8; ++j) x[j] = sigmoidf_(x[j]); }
                        u32x4 w; w.x = cvt_pk_bf16(x[0], x[1]); w.y = cvt_pk_bf16(x[2], x[3]); w.z = cvt_pk_bf16(x[4], x[5]); w.w = cvt_pk_bf16(x[6], x[7]);
                        *(u32x4*)dst = w;
                    }
                }
            }
    }
};
struct EpiMerge1 {
    static constexpr bool PERM = false;
    const bf16_t* sg1; float* t1;
    __device__ __forceinline__ void operator()(AccRef acc, const Unit& u, int wr, int wc, int fr, int fq) const {
#pragma unroll
        for (int ai = 0; ai < 2; ++ai) { u32x2 s[4][2][2];
#pragma unroll
            for (int m = 0; m < 4; ++m) { const size_t ro = (size_t)(u.lrow + ai * 128 + wr * 64 + m * 16 + fr) * D + u.pn * 256 + wc * 32 + 4 * fq;
#pragma unroll
                for (int bj = 0; bj < 2; ++bj)
#pragma unroll
                    for (int n = 0; n < 2; ++n) s[m][bj][n] = *(const u32x2*)(sg1 + ro + bj * 128 + n * 16); }
#pragma unroll
            for (int m = 0; m < 4; ++m) { const size_t ro = (size_t)(u.lrow + ai * 128 + wr * 64 + m * 16 + fr) * D + u.pn * 256 + wc * 32 + 4 * fq;
#pragma unroll
                for (int bj = 0; bj < 2; ++bj)
#pragma unroll
                    for (int n = 0; n < 2; ++n) { const f32x4 a = acc[ai][bj][m][n]; const u32x2 sv = s[m][bj][n];
                        *(f32x4*)(t1 + ro + bj * 128 + n * 16) = (f32x4){a[0] * bflo(sv.x), a[1] * bfhi(sv.x), a[2] * bflo(sv.y), a[3] * bfhi(sv.y)}; } } }
    }
};
struct EpiMerge2 {
    static constexpr bool PERM = false;
    const bf16_t* sg2; const float* t1; bf16_t* mb;
    __device__ __forceinline__ void operator()(AccRef acc, const Unit& u, int wr, int wc, int fr, int fq) const {
#pragma unroll
        for (int ai = 0; ai < 2; ++ai)
#pragma unroll
            for (int m = 0; m < 4; ++m) { u32x2 s[2][2]; f32x4 p[2][2];
                const size_t ro = (size_t)(u.lrow + ai * 128 + wr * 64 + m * 16 + fr) * D + u.pn * 256 + wc * 32 + 4 * fq;
#pragma unroll
                for (int bj = 0; bj < 2; ++bj)
#pragma unroll
                    for (int n = 0; n < 2; ++n) { s[bj][n] = *(const u32x2*)(sg2 + ro + bj * 128 + n * 16); p[bj][n] = *(const f32x4*)(t1 + ro + bj * 128 + n * 16); }
#pragma unroll
                for (int bj = 0; bj < 2; ++bj)
#pragma unroll
                    for (int n = 0; n < 2; ++n) { const f32x4 a = acc[ai][bj][m][n], pv = p[bj][n]; const u32x2 sv = s[bj][n];
                        u32x2 w; w.x = cvt_pk_bf16(pv[0] + a[0] * bflo(sv.x), pv[1] + a[1] * bfhi(sv.x)); w.y = cvt_pk_bf16(pv[2] + a[2] * bflo(sv.y), pv[3] + a[3] * bfhi(sv.y));
                        *(u32x2*)(mb + ro + bj * 128 + n * 16) = w; } }
    }
};
struct EpiWout {
    static constexpr bool PERM = false;
    const float* x; const float* posr; const float* posc; const float* ada; float* x1;
    __device__ __forceinline__ void operator()(AccRef acc, const Unit& u, int wr, int wc, int fr, int fq) const {
        const int b = u.lrow >> 13, cb = u.pn * 256 + wc * 32 + 4 * fq;
        f32x4 g1[2][2];
#pragma unroll
        for (int bj = 0; bj < 2; ++bj)
#pragma unroll
            for (int nn = 0; nn < 2; ++nn) g1[bj][nn] = *(const f32x4*)(ada + b * 6144 + 2 * D + cb + bj * 128 + nn * 16);
#pragma unroll
        for (int ai = 0; ai < 2; ++ai)
#pragma unroll
            for (int m = 0; m < 4; ++m) { f32x4 xv[2][2], pe[2][2];
                const int r = u.lrow + ai * 128 + wr * 64 + m * 16 + fr, n = r & (SEQ - 1);
#pragma unroll
                for (int bj = 0; bj < 2; ++bj)
#pragma unroll
                    for (int nn = 0; nn < 2; ++nn) { const int c = cb + bj * 128 + nn * 16; xv[bj][nn] = *(const f32x4*)(x + (size_t)r * D + c);
                        pe[bj][nn] = (c < 512) ? *(const f32x4*)(posr + (n >> 6) * 512 + c) : *(const f32x4*)(posc + (n & 63) * 512 + (c - 512)); }
#pragma unroll
                for (int bj = 0; bj < 2; ++bj)
#pragma unroll
                    for (int nn = 0; nn < 2; ++nn) *(f32x4*)(x1 + (size_t)r * D + cb + bj * 128 + nn * 16) = xv[bj][nn] + pe[bj][nn] + g1[bj][nn] * acc[ai][bj][m][nn]; }
    }
};
struct EpiLogit {
    static constexpr bool PERM = true;
    float* lg;
    __device__ __forceinline__ void operator()(AccRef acc, const Unit& u, int wr, int wc, int fr, int fq) const {
#pragma unroll
        for (int ai = 0; ai < 2; ++ai)
#pragma unroll
            for (int m = 0; m < 4; ++m) { float* rp = lg + (size_t)(u.lrow + ai * 128 + wr * 64 + m * 16 + fr) * NE + wc * 32 + 8 * fq;
#pragma unroll
                for (int bj = 0; bj < 2; ++bj) { *(f32x4*)(rp + bj * 128) = acc[ai][bj][m][0]; *(f32x4*)(rp + bj * 128 + 4) = acc[ai][bj][m][1]; } }
    }
};
struct EpiGU {
    static constexpr bool PERM = true;
    bf16_t* hout;
    __device__ __forceinline__ void operator()(AccRef acc, const Unit& u, int wr, int wc, int fr, int fq) const {
#pragma unroll
        for (int ai = 0; ai < 2; ++ai)
#pragma unroll
            for (int m = 0; m < 4; ++m) { const int rl = ai * 128 + wr * 64 + m * 16 + fr;
                if (rl < u.nvalid) { const f32x4 g0 = acc[ai][0][m][0], g1 = acc[ai][0][m][1], u0 = acc[ai][1][m][0], u1 = acc[ai][1][m][1];
                    u32x4 w; w.x = cvt_pk_bf16(siluf_(g0[0]) * u0[0], siluf_(g0[1]) * u0[1]); w.y = cvt_pk_bf16(siluf_(g0[2]) * u0[2], siluf_(g0[3]) * u0[3]);
                    w.z = cvt_pk_bf16(siluf_(g1[0]) * u1[0], siluf_(g1[1]) * u1[1]); w.w = cvt_pk_bf16(siluf_(g1[2]) * u1[2], siluf_(g1[3]) * u1[3]);
                    *(u32x4*)(hout + (size_t)(u.lrow + rl) * EH + u.aux * 128 + wc * 32 + 8 * fq) = w; } }
    }
};
template <bool HASW, bool FP8 = false> struct EpiDown {
    static constexpr bool PERM = true;
    bf16_t* yout; const float* wrow;
    __device__ __forceinline__ void operator()(AccRef acc, const Unit& u, int wr, int wc, int fr, int fq) const {
        char* base = (char*)yout + ((size_t)u.lrow * D + u.aux * 256 + wc * 32) * (FP8 ? 1 : 2);
        float wv[2][4];
#pragma unroll
        for (int ai = 0; ai < 2; ++ai)
#pragma unroll
            for (int m = 0; m < 4; ++m) { const int rl = ai * 128 + wr * 64 + m * 16 + fr; wv[ai][m] = (HASW && rl < u.nvalid) ? wrow[u.lrow + rl] : 1.0f; }
#pragma unroll
        for (int ai = 0; ai < 2; ++ai)
#pragma unroll
            for (int m = 0; m < 4; ++m) { const int rl = ai * 128 + wr * 64 + m * 16 + fr;
                if (rl < u.nvalid) { const float w_ = wv[ai][m];
                    const unsigned off = (unsigned)(rl * D + 8 * fq) * (FP8 ? 1u : 2u);
#pragma unroll
                    for (int bj = 0; bj < 2; ++bj) { const f32x4 v0 = acc[ai][bj][m][0] * w_, v1 = acc[ai][bj][m][1] * w_;
                        if (FP8) { int a = __builtin_amdgcn_cvt_pk_fp8_f32(v0[0], v0[1], 0, false); a = __builtin_amdgcn_cvt_pk_fp8_f32(v0[2], v0[3], a, true);
                            int c = __builtin_amdgcn_cvt_pk_fp8_f32(v1[0], v1[1], 0, false); c = __builtin_amdgcn_cvt_pk_fp8_f32(v1[2], v1[3], c, true);
                            *(u32x2*)(base + off + bj * 128) = (u32x2){(unsigned)a, (unsigned)c}; }
                        else { u32x4 w; w.x = cvt_pk_bf16(v0[0], v0[1]); w.y = cvt_pk_bf16(v0[2], v0[3]); w.z = cvt_pk_bf16(v1[0], v1[1]); w.w = cvt_pk_bf16(v1[2], v1[3]);
                            *(u32x4*)(base + off + bj * 256) = w; } } } }
    }
};

constexpr int RA1 = (int)((WS_A1 - WS_WINT) / (D * 2));
static_assert((WS_A1 - WS_WINT) % (D * 2) == 0, "A1 must sit a whole number of rows above WINT");
struct InOrder {
    int G, c;
    static constexpr int N0 = 6 * 64, N1 = 2 * 64, N2 = 64 * 16, NU = N0 + N1 + N2;
    __device__ bool next(int i, Unit& u) const {
        const long L = (long)i * G + c; if (L >= NU) return false;
        int idx = (int)L; { const int q = NU / 8, r = NU % 8, xcd = idx % 8, off = idx / 8; idx = (xcd < r ? xcd * (q + 1) : r * (q + 1) + (xcd - r) * q) + off; }
        int pm, pn, kind;
        if (idx < N0 + N1) { const int g = idx >> 5, jj = idx & 31; kind = 0; pm = 4 * (g & 1) + (jj & 3); pn = 8 * (g >> 1) + (jj >> 2); }
        else { const int j = idx - N0 - N1, g = j >> 7, jj = j & 127; kind = 1; pm = 8 * g + (jj & 7); pn = jj >> 3; }
        fill(u, kind, pm, pn); return true;
    }
    __device__ static void fill(Unit& u, int kind, int pm, int pn) {
        u.kind = kind; u.pn = pn; u.lrow = pm * 256; u.nvalid = 256; u.aux = pn;
        if (kind == 0) { u.row0 = pm * 256; u.boff = (unsigned)(RA1 + pn * 256) * (unsigned)(D * 2); }
        else { u.row0 = RA1 + pm * 256; u.boff = (unsigned)(2048 + pn * 256) * (unsigned)(D * 2); }
    }
};
struct CtxUnit {
    int idx;
    __device__ static int tile(int idx) { return idx < 4 ? (idx & 1) : ((idx - 4) >> 2); }
    __device__ bool next(int i, Unit& u) const { if (i) return false;
        if (idx < 4) InOrder::fill(u, 0, 6 + (idx >> 1), 64 + (idx & 1)); else InOrder::fill(u, 1, 64 + ((idx - 4) >> 2), 2 + ((idx - 4) & 3)); return true; }
};
struct EpiIn {
    static constexpr bool PERM = true;
    EpiInT t; EpiInN n;
    __device__ __forceinline__ void operator()(AccRef acc, const Unit& u, int wr, int wc, int fr, int fq) const { if (u.kind == 0) t(acc, u, wr, wc, fr, fq); else n(acc, u, wr, wc, fr, fq); }
};
struct P9Order {
    int G, c;
    __device__ bool next(int i, Unit& u) const {
        const long L = (long)i * G + c; if (L >= 192) return false; int idx = (int)L;
        { const int xcd = idx % 8, off = idx / 8; idx = xcd * 24 + off; }
        const int pm = idx / 3, k3 = idx % 3;
        u.row0 = pm * 256;
        if (k3 == 0) { u.kind = 0; u.pn = 0; u.aux = 0; u.boff = 0u; }
        else { u.kind = 1; u.pn = k3 - 1; u.aux = k3 - 1; u.boff = (unsigned)(WS_SHGUT - WS_ROUT) + (unsigned)(k3 - 1) * (unsigned)(256 * D * 2); }
        u.lrow = u.row0; u.nvalid = 256; return true;
    }
};
struct EpiP9 {
    static constexpr bool PERM = true;
    EpiLogit l; EpiGU g;
    __device__ __forceinline__ void operator()(AccRef acc, const Unit& u, int wr, int wc, int fr, int fq) const { if (u.kind == 0) l(acc, u, wr, wc, fr, fq); else g(acc, u, wr, wc, fr, fq); }
};
#define XB_TMO      128
#define XB_XCNT(j)  (256  + 64 * (j))
#define XB_XSUB(j)  (1280 + 64 * (j))
#define XB_XGEN(j)  (2304 + 64 * (j))
#define XB_TOP      3328
#define XB_TOPGEN   3392
#define XCD_BAR_WORDS 3456
#define XB_SPIN_CAP (1u << 18)

__device__ __forceinline__ unsigned xb_ld(unsigned* p)              { return __hip_atomic_load(p, __ATOMIC_RELAXED, __HIP_MEMORY_SCOPE_AGENT); }
__device__ __forceinline__ unsigned xb_add(unsigned* p, unsigned v) { return __hip_atomic_fetch_add(p, v, __ATOMIC_RELAXED, __HIP_MEMORY_SCOPE_AGENT); }
__device__ __forceinline__ unsigned xb_xcc_id() { return (unsigned)__builtin_amdgcn_s_getreg((3 << 11) | 20) & 0xFu; }
#define XB_SPIN(cond, bar) do { unsigned _sp = 0; while (cond) { __builtin_amdgcn_s_sleep(1); \
    if ((++_sp & 255u) == 0u) { if (xb_ld(&(bar)[XB_TMO])) break; if (_sp > XB_SPIN_CAP) { atomicAdd(&(bar)[XB_TMO], 1u); break; } } } } while (0)

struct XcdBarrier {
    unsigned* bar; unsigned x;
    volatile LAS unsigned* st;
};

__device__ __forceinline__ XcdBarrier xcd_barrier_post(unsigned* bar, volatile LAS unsigned* st) {
    XcdBarrier b; b.bar = bar; b.x = xb_xcc_id(); b.st = st;
    if (threadIdx.x == 0) (void)xb_add(&bar[XB_XCNT(b.x)], 1u);
    return b;
}
__device__ __forceinline__ void xcd_barrier_complete(unsigned* bar, unsigned x, unsigned& nloc, unsigned& nx) {
    const unsigned G = gridDim.x * gridDim.y * gridDim.z;
    unsigned sum, cnt, mine, sp = 0u;
    for (;;) {
        sum = 0u; cnt = 0u; mine = 0u;
#pragma unroll
        for (unsigned j = 0; j < 16; ++j) { const unsigned c = xb_ld(&bar[XB_XCNT(j)]); sum += c; cnt += (c > 0u) ? 1u : 0u; mine = (j == x) ? c : mine; }
        if (sum == G) break;
        __builtin_amdgcn_s_sleep(1);
        if ((++sp & 255u) == 0u) { if (xb_ld(&bar[XB_TMO])) break; if (sp > XB_SPIN_CAP) { atomicAdd(&bar[XB_TMO], 1u); break; } }
    }
    nloc = mine > 0u ? mine : 1u; nx = cnt > 0u ? cnt : 1u;
}

__device__ __forceinline__ void xcd_barrier(const XcdBarrier& b) {
    asm volatile("s_waitcnt vmcnt(0)" ::: "memory");
    __syncthreads();
    if (threadIdx.x == 0) {
        unsigned* bar = b.bar;
        __builtin_amdgcn_s_waitcnt(0);
        unsigned nloc = b.st[0], nx = b.st[1];
        if (nloc == 0u) { xcd_barrier_complete(bar, b.x, nloc, nx); b.st[0] = nloc; b.st[1] = nx; }
        const unsigned old = xb_add(&bar[XB_XSUB(b.x)], 1u);
        const unsigned gen = old / nloc;
        if (old + 1u == (gen + 1u) * nloc) {
            __builtin_amdgcn_fence(__ATOMIC_RELEASE, "agent");
            asm volatile("s_waitcnt vmcnt(0)" ::: "memory");
            const unsigned og = xb_add(&bar[XB_TOP], 1u);
            const unsigned tg = og / nx;
            if (og + 1u == (tg + 1u) * nx) xb_add(&bar[XB_TOPGEN], 1u);
            else XB_SPIN(xb_ld(&bar[XB_TOPGEN]) == tg, bar);
            __builtin_amdgcn_fence(__ATOMIC_ACQUIRE, "agent");
            xb_add(&bar[XB_XGEN(b.x)], 1u);
            asm volatile("s_waitcnt vmcnt(0)" ::: "memory");
        } else {
            XB_SPIN(xb_ld(&bar[XB_XGEN(b.x)]) == gen, bar);
            __builtin_amdgcn_fence(__ATOMIC_ACQUIRE, "agent");
            asm volatile("s_waitcnt vmcnt(0)" ::: "memory");
        }
    }
    __syncthreads();
}


struct Frame {
    LAS unsigned char* lds;
    const Params* p;
    unsigned char* ws;
    int tid, lane, wave, G, bx;
};
#define WSP(T_, off) ((T_*)(F.ws + (off)))

__device__ __forceinline__ void p0_transpose_item(const float* W, int N, bf16_t* WT, int K, int k0, int n0, int row0, LAS float* scr, int lane) {
#pragma unroll 8
    for (int i = 0; i < 32; ++i) { const int kk = 2 * i + (lane >> 5); scr[kk * 33 + (lane & 31)] = W[(size_t)(k0 + kk) * N + n0 + (lane & 31)]; }
    LDS_WAIT(); asm volatile("" ::: "memory");
    const int c = lane & 7;
#pragma unroll
    for (int j = 0; j < 4; ++j) { const int n = (lane >> 3) + 8 * j; const LAS float* s = scr + (8 * c) * 33 + n;
        u32x4 o; o.x = pk2(s[0 * 33], s[1 * 33]); o.y = pk2(s[2 * 33], s[3 * 33]); o.z = pk2(s[4 * 33], s[5 * 33]); o.w = pk2(s[6 * 33], s[7 * 33]);
        *(u32x4*)(WT + (size_t)(row0 + n) * K + k0 + 8 * c) = o; }
    LDS_WAIT(); asm volatile("" ::: "memory");
}
__device__ __forceinline__ int gu_row(int n0, int up) { return (n0 >> 7) * 256 + up * 128 + (n0 & 127); }

__device__ __forceinline__ void p0_transposes(Frame& F) {
    LAS float* scr = (LAS float*)(F.lds + F.wave * 16384);
    const int gw = F.bx * 8 + F.wave, NGW = F.G * 8;
    const float* const* in = F.p->in;
    constexpr int I_WIN_ = 16 * 192, I_WHY_ = 8 * 32, I_WHG_ = 8 * 32, I_WOUT_ = 16 * 32, I_R_ = 16 * 8, I_SG_ = 16 * 8, I_SU_ = 16 * 8, I_SD_ = 4 * 32;
    constexpr int NSMALL = I_WIN_ + I_WHY_ + I_WHG_ + I_WOUT_ + I_R_ + I_SG_ + I_SU_ + I_SD_;
    for (int it = gw; it < NSMALL; it += NGW) {
        int r = it;
        {
            if (r < I_WIN_) { const int kb = r / 192, nb = r % 192, n0 = nb * 32; const int f0 = (n0 >= 1536 && n0 < 2048) ? n0 + 512 : ((n0 >= 2048 && n0 < 2560) ? n0 - 512 : n0);
                p0_transpose_item(in[I_WIN], INC, WSP(bf16_t, WS_WINT), D, kb * 64, n0, f0, scr, F.lane); continue; } r -= I_WIN_;
            if (r < I_WHY_) { p0_transpose_item(in[I_WHY], D, WSP(bf16_t, WS_WHYT), HYW, (r / 32) * 64, (r % 32) * 32, (r % 32) * 32, scr, F.lane); continue; } r -= I_WHY_;
            if (r < I_WHG_) { p0_transpose_item(in[I_WHG], D, WSP(bf16_t, WS_WHGT), HGW, (r / 32) * 64, (r % 32) * 32, (r % 32) * 32, scr, F.lane); continue; } r -= I_WHG_;
            if (r < I_WOUT_) { p0_transpose_item(in[I_WOUT], D, WSP(bf16_t, WS_WOUTT), D, (r / 32) * 64, (r % 32) * 32, (r % 32) * 32, scr, F.lane); continue; } r -= I_WOUT_;
            if (r < I_R_) { p0_transpose_item(in[I_RW], NE, WSP(bf16_t, WS_ROUT), D, (r / 8) * 64, (r % 8) * 32, (r % 8) * 32, scr, F.lane); continue; } r -= I_R_;
            if (r < I_SG_) { p0_transpose_item(in[I_SG], EH, WSP(bf16_t, WS_SHGUT), D, (r / 8) * 64, (r % 8) * 32, gu_row((r % 8) * 32, 0), scr, F.lane); continue; } r -= I_SG_;
            if (r < I_SU_) { p0_transpose_item(in[I_SU], EH, WSP(bf16_t, WS_SHGUT), D, (r / 8) * 64, (r % 8) * 32, gu_row((r % 8) * 32, 1), scr, F.lane); continue; } r -= I_SU_;
            p0_transpose_item(in[I_SD], D, WSP(bf16_t, WS_SHDT), EH, (r / 32) * 64, (r % 32) * 32, (r % 32) * 32, scr, F.lane); continue;
        }
    }
}

template <int MODE  >
__device__ __forceinline__ void p0_x256_load(const float* W, int N, int k0, int n0, int tid, f32x4 (&v)[8]) {
    const int n4 = MODE ? ((tid >> 6) * 8 + (tid & 7)) : (tid & 63), kq = MODE ? ((tid >> 3) & 7) : (tid >> 6); const float* src = W + (size_t)(k0 + 8 * kq) * N + n0 + 4 * n4;
#pragma unroll
    for (int r = 0; r < 8; ++r) v[r] = __builtin_nontemporal_load((const f32x4*)(src + (size_t)r * N));
}
__device__ __forceinline__ void p0_x256_store(LAS unsigned char* ts, bf16_t* WT, int K, int k0, int row0, int mode, int tid, const f32x4 (&v)[8]) {
    const int n4 = tid & 63, kq = tid >> 6;
    __syncthreads();
#pragma unroll
    for (int i = 0; i < 4; ++i) { const int n = 4 * n4 + i;
        u32x4 o; o.x = pk2(v[0][i], v[1][i]); o.y = pk2(v[2][i], v[3][i]); o.z = pk2(v[4][i], v[5][i]); o.w = pk2(v[6][i], v[7][i]);
        *(LAS u32x4*)(ts + n * 128 + ((kq ^ (n4 & 7)) << 4)) = o; }
    __syncthreads();
#pragma unroll
    for (int q = 0; q < 4; ++q) { const int task = tid + 512 * q, n = task >> 3, part = task & 7;
        const u32x4 o = *(const LAS u32x4*)(ts + n * 128 + ((part ^ ((n >> 2) & 7)) << 4));
        const int row = mode == 0 ? row0 + n : ((n >> 7) * 256 + (mode - 1) * 128 + (n & 127));
        *(u32x4*)(WT + (size_t)(k0 >> 6) * K + row * 64 + 8 * part) = o; }
}
__device__ __forceinline__ void p0_x256_decode(const float* const* in, unsigned char* ws, int item, const float*& W, int& N, bf16_t*& WT, int& K, int& k0, int& n0, int& mode) {
    const int e = item / 48, r = item % 48;
    if (r < 16) { W = in[I_EG] + (size_t)e * D * EH; N = EH; WT = (bf16_t*)(ws + WS_EGUT) + (size_t)e * 512 * D; K = 512 * 64; k0 = r * 64; n0 = 0; mode = 1; }
    else if (r < 32) { W = in[I_EU] + (size_t)e * D * EH; N = EH; WT = (bf16_t*)(ws + WS_EGUT) + (size_t)e * 512 * D; K = 512 * 64; k0 = (r - 16) * 64; n0 = 0; mode = 2; }
    else { const int q = r - 32; W = in[I_ED] + (size_t)e * EH * D; N = D; WT = (bf16_t*)(ws + WS_EDT) + (size_t)e * D * EH; K = D * 64; k0 = (q >> 2) * 64; n0 = (q & 3) * 256; mode = 0; }
}
struct XpState { f32x4 v[8]; int it, end, stride; bool live; };
__device__ __forceinline__ void xp_issue(XpState& s, const float* const* in, unsigned char* ws, int tid) {
    s.live = s.it < s.end;
    if (s.live) { const float* W; int N, K, k0, n0, mode; bf16_t* WT; p0_x256_decode(in, ws, s.it, W, N, WT, K, k0, n0, mode); p0_x256_load<1>(W, N, k0, n0, tid, s.v); }
}
__device__ __forceinline__ void xp_finish(XpState& s, const float* const* in, unsigned char* ws, int tid) {
    if (s.live) { const float* W; int N, K, k0, n0, mode; bf16_t* WT; p0_x256_decode(in, ws, s.it, W, N, WT, K, k0, n0, mode);
        const int n4 = (tid >> 6) * 8 + (tid & 7), kq = (tid >> 3) & 7;
#pragma unroll
        for (int i = 0; i < 4; ++i) { const int n = 4 * n4 + i; const int row = mode == 0 ? n0 + n : ((n >> 7) * 256 + (mode - 1) * 128 + (n & 127));
            u32x4 o; o.x = pk2(s.v[0][i], s.v[1][i]); o.y = pk2(s.v[2][i], s.v[3][i]); o.z = pk2(s.v[4][i], s.v[5][i]); o.w = pk2(s.v[6][i], s.v[7][i]);
            *(u32x4*)(WT + (size_t)(k0 >> 6) * K + row * 64 + 8 * kq) = o; }
        s.it += s.stride; s.live = false; }
}
__device__ __forceinline__ void xp_step(XpState& s, const float* const* in, unsigned char* ws, int tid) { xp_finish(s, in, ws, tid); xp_issue(s, in, ws, tid); }
constexpr int XP_BG = 30;
constexpr int XP_K0 = 6;
constexpr int NCONV = 36;
__device__ __forceinline__ void conv_loop(const float* const* in, unsigned char* ws, int first, int stride, int end, int tid) {
    XpState a, b, c, d; a.stride = b.stride = c.stride = d.stride = 4 * stride; a.end = b.end = c.end = d.end = end; a.live = b.live = c.live = d.live = false;
    a.it = first; b.it = first + stride; c.it = first + 2 * stride; d.it = first + 3 * stride;
    xp_issue(a, in, ws, tid); xp_issue(b, in, ws, tid); xp_issue(c, in, ws, tid);
    while (a.live) {
        xp_issue(d, in, ws, tid); xp_finish(a, in, ws, tid);
        if (!b.live) break; xp_issue(a, in, ws, tid); xp_finish(b, in, ws, tid);
        if (!c.live) break; xp_issue(b, in, ws, tid); xp_finish(c, in, ws, tid);
        if (!d.live) break; xp_issue(c, in, ws, tid); xp_finish(d, in, ws, tid);
    }
}

__device__ __forceinline__ void p0_expert_transposes(Frame& F) {
    int tid = F.tid; asm volatile("" : "+v"(tid));
    constexpr int NIT = NE * 48;
    int it = F.bx + XP_BG * F.G; if (it >= NIT) return;
    const int p0end = (F.G == 256) ? 256 * (XP_BG + XP_K0) : NIT;
    if (it >= p0end) return;
    const float* W; int N, K, k0, n0, mode; bf16_t* WT;
    const float* W2; int N2, K2, k2, n2, mode2; bf16_t* WT2;
    f32x4 va[8], vb[8];
    p0_x256_decode(F.p->in, F.ws, it, W, N, WT, K, k0, n0, mode);
    p0_x256_load<0>(W, N, k0, n0, tid, va);
    for (;;) {
        __builtin_amdgcn_s_waitcnt(0);
        int nx = it + F.G; bool has = nx < p0end;
        if (has) { p0_x256_decode(F.p->in, F.ws, nx, W2, N2, WT2, K2, k2, n2, mode2); p0_x256_load<0>(W2, N2, k2, n2, tid, vb); }
        p0_x256_store(F.lds, WT, K, k0, n0, mode, tid, va);
        if (!has) break;
        it = nx;
        __builtin_amdgcn_s_waitcnt(0);
        nx = it + F.G; has = nx < p0end;
        if (has) { p0_x256_decode(F.p->in, F.ws, nx, W, N, WT, K, k0, n0, mode); p0_x256_load<0>(W, N, k0, n0, tid, va); }
        p0_x256_store(F.lds, WT2, K2, k2, n2, mode2, tid, vb);
        if (!has) break;
        it = nx;
    }
}

constexpr int ADA_KC = 4;
__device__ __forceinline__ void p0_ada_item(Frame& F, int item) {
    const int kc = item / 12, cb = item % 12, col = cb * 512 + F.tid;
    const float* in_c = F.p->in[I_C]; const float* in_cc = F.p->in[I_CCTX]; const float* w = F.p->in[I_ADAW];
    LAS float* sv = (LAS float*)F.lds;
    __syncthreads();
    for (int i = F.tid; i < 768; i += 512) { const int wh = i >> 8, k = kc * 256 + (i & 255); sv[i] = siluf_(wh == 0 ? in_c[k] : (wh == 1 ? in_c[D + k] : in_cc[k])); }
    __syncthreads();
    float a0 = 0.f, a1 = 0.f, a2 = 0.f;
    const float* wp = w + (size_t)(kc * 256) * 6144 + col;
#pragma unroll 16
    for (int k = 0; k < 256; ++k) { const float wv = wp[(size_t)k * 6144]; a0 += sv[k] * wv; a1 += sv[256 + k] * wv; a2 += sv[512 + k] * wv; }
    float* o = WSP(float, WS_ADAP) + (size_t)kc * 3 * 6144 + col;
    o[0] = a0; o[6144] = a1; o[2 * 6144] = a2;
}

__device__ __forceinline__ void p0_filter_item(Frame& F, int item) {
    LAS float* zb = (LAS float*)F.lds;
    LAS float* ab1 = zb + 32 * 36;
    LAS float* ab2 = ab1 + 32 * 64;
    const float* const* in = F.p->in; const int t0 = item * 32; int tid = F.tid; asm volatile("" : "+v"(tid));
    __syncthreads();
    for (int idx = tid; idx < 32 * 33; idx += 512) { const int t = idx / 33, e = idx % 33; const float tf = (float)(t0 + t); float v;
        if (e == 0) v = tf / (float)(SEQ - 1);
        else { const int k = (e - 1) & 15; const float band = 1e-4f + (float)k * ((15.0f - 1e-4f) / 15.0f); float sn, cs; sincospif(2.0f * tf * band / (float)SEQ, &sn, &cs); v = (e <= 16) ? cs : -sn; }
        zb[t * 36 + e] = v; }
    __syncthreads();
    {
        const int t = tid >> 4, jj = tid & 15;
#pragma unroll 1
        for (int q = 0; q < 4; ++q) { const int j = jj + 16 * q; float s = in[I_FB1][j];
#pragma unroll 3
            for (int e = 0; e < 33; ++e) s += zb[t * 36 + e] * in[I_FW1][e * 64 + j];
            ab1[t * 64 + j] = sinf(in[I_FFREQ][j] * s); }
    }
    __syncthreads();
    { const int t = tid >> 4, jj = tid & 15;
#pragma unroll 1
        for (int q = 0; q < 4; ++q) { const int j = jj + 16 * q; float s = in[I_FB2][j];
#pragma unroll 4
            for (int e = 0; e < 64; ++e) s += ab1[t * 64 + e] * in[I_FW2][e * 64 + j];
            ab2[t * 64 + j] = sinf(in[I_FFREQ][j] * s); }
    }
    __syncthreads();
    { const int t = tid >> 4, jj = tid & 15;
#pragma unroll 1
        for (int q = 0; q < 4; ++q) { const int j = jj + 16 * q; float s = in[I_FB3][j];
#pragma unroll 4
            for (int e = 0; e < 64; ++e) s += ab2[t * 64 + e] * in[I_FW3][e * 64 + j];
            ab1[t * 64 + j] = sinf(in[I_FFREQ][j] * s); }
    }
    __syncthreads();
    const float* w4 = in[I_FW4];
    const float MIND = -3.0701134573253945f, MAXD = -15.350567286626973f;
    const float delta = fabsf(MIND + (MAXD - MIND) * ((float)tid / 511.0f));
    bf16_t* hf = WSP(bf16_t, WS_HF);
#pragma unroll 1
    for (int half = 0; half < 4; ++half) {
        f32x2 acc[8][2];
#pragma unroll
        for (int t = 0; t < 8; ++t) { acc[t][0] = (f32x2){0.f, 0.f}; acc[t][1] = (f32x2){0.f, 0.f}; }
        f32x2 wa[4][2], wb[4][2];
#pragma unroll
        for (int jj = 0; jj < 4; ++jj) { wa[jj][0] = (f32x2){w4[(size_t)jj * 2048 + tid], w4[(size_t)jj * 2048 + tid + 512]}; wa[jj][1] = (f32x2){w4[(size_t)jj * 2048 + tid + 1024], w4[(size_t)jj * 2048 + tid + 1536]}; }
#pragma unroll 1
        for (int j4 = 0; j4 < 16; j4 += 2) {
#pragma unroll
            for (int jj = 0; jj < 4; ++jj) { const size_t o = (size_t)(4 * (j4 + 1) + jj) * 2048 + tid; wb[jj][0] = (f32x2){w4[o], w4[o + 512]}; wb[jj][1] = (f32x2){w4[o + 1024], w4[o + 1536]}; }
#pragma unroll
            for (int t = 0; t < 8; ++t) { const f32x4 a = *(const LAS f32x4*)(ab1 + (8 * half + t) * 64 + 4 * j4);
#pragma unroll
                for (int jj = 0; jj < 4; ++jj) { const f32x2 aa = (f32x2){a[jj], a[jj]}; acc[t][0] += aa * wa[jj][0]; acc[t][1] += aa * wa[jj][1]; } }
            if (j4 + 2 < 16) {
#pragma unroll
                for (int jj = 0; jj < 4; ++jj) { const size_t o = (size_t)(4 * (j4 + 2) + jj) * 2048 + tid; wa[jj][0] = (f32x2){w4[o], w4[o + 512]}; wa[jj][1] = (f32x2){w4[o + 1024], w4[o + 1536]}; } }
#pragma unroll
            for (int t = 0; t < 8; ++t) { const f32x4 a = *(const LAS f32x4*)(ab1 + (8 * half + t) * 64 + 4 * (j4 + 1));
#pragma unroll
                for (int jj = 0; jj < 4; ++jj) { const f32x2 aa = (f32x2){a[jj], a[jj]}; acc[t][0] += aa * wb[jj][0]; acc[t][1] += aa * wb[jj][1]; } }
        }
#pragma unroll
        for (int t4 = 0; t4 < 2; ++t4) { const int tb = t0 + 8 * half + 4 * t4;
            float dc[4];
#pragma unroll
            for (int k = 0; k < 4; ++k) dc[k] = expf(-((float)(tb + k) / (float)(SEQ - 1)) * delta);
#pragma unroll
            for (int i = 0; i < 4; ++i)
                *(u32x2*)(hf + (size_t)(tid + 512 * i) * SEQ + tb) = (u32x2){pk2(acc[4 * t4][i >> 1][i & 1] * dc[0], acc[4 * t4 + 1][i >> 1][i & 1] * dc[1]), pk2(acc[4 * t4 + 2][i >> 1][i & 1] * dc[2], acc[4 * t4 + 3][i >> 1][i & 1] * dc[3])};
        }
    }
}

__device__ __forceinline__ void p0_tables(Frame& F, int item) {
    if (item < 6) {
        const int idx = item * 16384 + F.tid * 32;
        for (int k = 0; k < 32; ++k) { const int id = idx + k; if (id >= 192 * 512) break;
            const int row = id >> 9, col = id & 511, i = col & 255; const float omega = 1.0f / powf(10000.0f, (float)i / 256.0f);
            const float pos = (float)(row < 128 ? row : row - 128); const float ang = pos * omega;
            const float v = (col < 256) ? sinf(ang) : cosf(ang);
            if (row < 128) WSP(float, WS_POSR)[row * 512 + col] = v; else WSP(float, WS_POSC)[(row - 128) * 512 + col] = v; }
    } else {
        for (int id = F.tid; id < 1024; id += 512) { const float l0 = F.p->in[I_LBL][id], l1 = F.p->in[I_LBL][1024 + id];
            WSP(float, WS_LBS)[id] = 1.0f / (1.0f + expf(l1 - l0)); }
    }
}

__device__ __forceinline__ void phase0(Frame& F) {
    for (int it = F.bx; it < 311; it += F.G) {
        if (it < 48) p0_ada_item(F, it);
        else if (it < 304) p0_filter_item(F, it - 48);
        else p0_tables(F, it - 304);
    }
    __syncthreads();
    p0_transposes(F);
    __syncthreads();
    p0_expert_transposes(F);
}

__device__ __forceinline__ void phase1(Frame& F) {
    const float* adap = WSP(float, WS_ADAP); const float* adab = F.p->in[I_ADAB];
    { const int gid = F.bx * 512 + F.tid; if (gid < 3 * 6144) { const int wh = gid / 6144, col = gid % 6144; float s = adab[col];
#pragma unroll
        for (int kc = 0; kc < ADA_KC; ++kc) s += adap[(size_t)(kc * 3 + wh) * 6144 + col]; WSP(float, WS_ADA)[gid] = s; } }
    LAS float* md = (LAS float*)F.lds;
    __syncthreads();
    for (int id = F.tid; id < 3 * 2048; id += 512) { const int wh = id >> 11, col = id & 2047; float s = adab[col];
#pragma unroll
        for (int kc = 0; kc < ADA_KC; ++kc) s += adap[(size_t)(kc * 3 + wh) * 6144 + col]; md[id] = s; }
    __syncthreads();
    const float* x = F.p->in[I_X]; const float* ctx = F.p->in[I_CTX]; const float* g1 = F.p->in[I_N1G];
    const float* posr = WSP(float, WS_POSR); const float* posc = WSP(float, WS_POSC); bf16_t* a1 = WSP(bf16_t, WS_A1);
    const int lane = F.lane;
#define P1_GG() f32x4 ggv[4]; _Pragma("unroll") for (int j = 0; j < 4; ++j) ggv[j] = *(const f32x4*)(g1 + 256 * j + 4 * lane)
#define P1_ROWS4(r0) do { f32x4 v[4][4]; const int wh = (r0) < T ? ((r0) >> 13) : 2; \
        _Pragma("unroll") for (int q = 0; q < 4; ++q) { const int r = (r0) + q; \
            if ((r0) < T) { const int n = r & (SEQ - 1); const f32x4* xr = (const f32x4*)(x + (size_t)r * D) + lane; \
                _Pragma("unroll") for (int j = 0; j < 4; ++j) { const int c = 256 * j + 4 * lane; const f32x4 pe = (c < 512) ? *(const f32x4*)(posr + (n >> 6) * 512 + c) : *(const f32x4*)(posc + (n & 63) * 512 + c - 512); v[q][j] = xr[64 * j] + pe; } \
            } else { const f32x4* xr = (const f32x4*)(ctx + (size_t)(r - T) * D) + lane; \
                _Pragma("unroll") for (int j = 0; j < 4; ++j) v[q][j] = xr[64 * j]; } } \
        _Pragma("unroll") for (int q = 0; q < 4; ++q) { float ss = 0.f; \
            _Pragma("unroll") for (int j = 0; j < 4; ++j) ss += (v[q][j][0] * v[q][j][0] + v[q][j][1] * v[q][j][1]) + (v[q][j][2] * v[q][j][2] + v[q][j][3] * v[q][j][3]); \
            const float rs = rsqrtf(wave_sum(ss) * (1.0f / D) + EPS); \
            u32x2* o8 = (u32x2*)(a1 + (size_t)((r0) + q) * D) + lane; \
            _Pragma("unroll") for (int j = 0; j < 4; ++j) { const int c = 256 * j + 4 * lane; const f32x4 gg = ggv[j]; \
                const f32x4 sh = *(const LAS f32x4*)(md + wh * 2048 + c), sc = *(const LAS f32x4*)(md + wh * 2048 + 1024 + c); \
                const f32x4 y = v[q][j] * rs * gg * (sc + 1.0f) + sh; \
                u32x2 w; w.x = pk2(y[0], y[1]); w.y = pk2(y[2], y[3]); o8[64 * j] = w; } } } while (0)
    const int nded = F.G > 24 ? 12 : 0;
    if (F.bx >= nded) { const int gw = (F.bx - nded) * 8 + F.wave, NGW = (F.G - nded) * 8; P1_GG();
        for (int r0 = gw * 4; r0 < T; r0 += NGW * 4) P1_ROWS4(r0); }
    for (int idx = F.bx; idx < 12; idx += (nded ? 12 : F.G)) {
        if (nded && F.bx >= 12) break;
        const int rbase = T + CtxUnit::tile(idx) * 256 + F.wave * 32;
        { P1_GG(); for (int i = 0; i < 32; i += 4) P1_ROWS4(rbase + i); }
        asm volatile("s_waitcnt vmcnt(0)" ::: "memory"); __syncthreads();
        { pg8::Gemm g{WSP(bf16_t, WS_WINT), WSP(bf16_t, WS_WINT), D, nullptr, 2 * D, 128}; CtxUnit S{idx};
          EpiIn E{EpiInT{WSP(bf16_t, WS_PHYT), WSP(bf16_t, WS_VT)}, EpiInN{WSP(bf16_t, WS_Q), WSP(bf16_t, WS_G), WSP(bf16_t, WS_SG1), WSP(bf16_t, WS_SG2), WSP(float, WS_LF), WSP(float, WS_LB), WSP(float, WS_LBS)}};
          pg8::gemm_phase<EpiIn, CtxUnit, false>(F.lds, g, S, E); }
        if (!nded) { __syncthreads(); for (int id = F.tid; id < 3 * 2048; id += 512) { const int wh = id >> 11, col = id & 2047; float s = adab[col];
            for (int kc = 0; kc < ADA_KC; ++kc) s += adap[(size_t)(kc * 3 + wh) * 6144 + col]; md[id] = s; } __syncthreads(); }
    }
#undef P1_ROWS4
#undef P1_GG
}

__device__ __forceinline__ void phase_h2(Frame& F) {
    const float* x1 = F.p->out; const float* g2 = F.p->in[I_N2G]; const float* ada = WSP(float, WS_ADA); bf16_t* h2 = WSP(bf16_t, WS_H2);
    const int gw = F.bx * 8 + F.wave, NGW = F.G * 8, lane = F.lane;
    f32x4 ggv[4];
#pragma unroll
    for (int j = 0; j < 4; ++j) ggv[j] = *(const f32x4*)(g2 + 256 * j + 4 * lane);
    const bool al = (F.G == 256); const int vw = ((F.bx & 7) * 32 + (F.bx >> 3)) * 8 + F.wave;
    for (int r0 = al ? vw * 8 : gw * 4, it_ = 0; al ? it_ < 2 : r0 < T; r0 += al ? 4 : NGW * 4, ++it_) { const int b = r0 >> 13;
        f32x4 v[4][4], shv[4], scv[4];
#pragma unroll
        for (int j = 0; j < 4; ++j) { const int c = 256 * j + 4 * lane; shv[j] = *(const f32x4*)(ada + b * 6144 + 3 * D + c); scv[j] = *(const f32x4*)(ada + b * 6144 + 4 * D + c); }
#pragma unroll
        for (int q = 0; q < 4; ++q) { const f32x4* xr = (const f32x4*)(x1 + (size_t)(r0 + q) * D) + lane;
#pragma unroll
            for (int j = 0; j < 4; ++j) v[q][j] = xr[64 * j]; }
#pragma unroll
        for (int q = 0; q < 4; ++q) { float ss = 0.f;
#pragma unroll
            for (int j = 0; j < 4; ++j) ss += (v[q][j][0] * v[q][j][0] + v[q][j][1] * v[q][j][1]) + (v[q][j][2] * v[q][j][2] + v[q][j][3] * v[q][j][3]);
            const float rs = rsqrtf(wave_sum(ss) * (1.0f / D) + EPS);
            u32x2* o8 = (u32x2*)(h2 + (size_t)(r0 + q) * D) + lane;
#pragma unroll
            for (int j = 0; j < 4; ++j) { const f32x4 gg = ggv[j], sh = shv[j], sc = scv[j];
                const f32x4 y = v[q][j] * rs * gg * (sc + 1.0f) + sh;
                u32x2 w; w.x = pk2(y[0], y[1]); w.y = pk2(y[2], y[3]); o8[64 * j] = w; } }
    }
}
constexpr int FPAD = 17920;
__device__ __forceinline__ int fphys(int i) { return i + (i >> 4) + ((i >> 9) << 4); }
__device__ constexpr float TWC[16] = {1.0f, 0.98078528040323044913f, 0.92387953251128675613f, 0.83146961230254523708f, 0.70710678118654752440f, 0.55557023301960222474f, 0.38268343236508977173f, 0.19509032201612826785f,
                                      0.0f, -0.19509032201612826785f, -0.38268343236508977173f, -0.55557023301960222474f, -0.70710678118654752440f, -0.83146961230254523708f, -0.92387953251128675613f, -0.98078528040323044913f};
__device__ constexpr float TWS[16] = {0.0f, 0.19509032201612826785f, 0.38268343236508977173f, 0.55557023301960222474f, 0.70710678118654752440f, 0.83146961230254523708f, 0.92387953251128675613f, 0.98078528040323044913f,
                                      1.0f, 0.98078528040323044913f, 0.92387953251128675613f, 0.83146961230254523708f, 0.70710678118654752440f, 0.55557023301960222474f, 0.38268343236508977173f, 0.19509032201612826785f};
__host__ __device__ constexpr int brev_c(int x, int bits) { int r = 0; for (int i = 0; i < bits; ++i) r = (r << 1) | ((x >> i) & 1); return r; }

typedef f32x2 cpx;
__device__ __forceinline__ cpx cmul(cpx a, cpx w) { return (cpx){a.x, a.x} * w + (cpx){a.y, a.y} * (cpx){-w.y, w.x}; }
template <int S0, int R, bool INV, bool ZHI = false, bool OLO = false>
__device__ __forceinline__ void fft_pass(LAS cpx* X, int tid) {
    constexpr int LOW = 14 - S0 - R, NR = 1 << R, NTASK = (1 << (14 - R)) / 512;
    asm volatile("" : "+v"(tid));
#pragma unroll 1
    for (int task = 0; task < NTASK; ++task) {
        const int g = tid + 512 * task;
        const int blo = g & ((1 << LOW) - 1), bhi = g >> LOW;
        const int base = (bhi << (LOW + R)) | blo;
        cpx v[NR];
#pragma unroll
        for (int j = 0; j < NR; ++j) { if (ZHI && j >= NR / 2) v[j] = (cpx){0.f, 0.f}; else v[j] = X[fphys(base | (j << LOW))]; }
        cpx w0 = (cpx){1.f, 0.f};
        if (LOW > 0) { float s, c; sincospif(-(float)blo * (1.0f / (float)(1 << (13 - S0))), &s, &c); w0 = (cpx){c, INV ? -s : s}; }
        if (INV && LOW > 0) {
            cpx cw = w0;
#pragma unroll
            for (int m = 1; m < NR; ++m) { const int j = brev_c(m, R); v[j] = cmul(v[j], cw); if (m + 1 < NR) cw = cmul(cw, w0); }
        }
        if (!INV) {
#pragma unroll
            for (int q = 0; q < R; ++q) { const int hj = 1 << (R - 1 - q);
#pragma unroll
                for (int j = 0; j < NR; ++j) { if (j & hj) continue; const int k32 = (j & (hj - 1)) << (5 - R + q);
                    cpx d;
                    if (ZHI && q == 0) d = v[j];
                    else { const cpx a = v[j], bb = v[j + hj]; v[j] = a + bb; d = a - bb; }
                    if (k32 == 0) v[j + hj] = d;
                    else if (k32 == 8) v[j + hj] = (cpx){d.y, -d.x};
                    else v[j + hj] = cmul(d, (cpx){TWC[k32], -TWS[k32]}); } }
        } else {
#pragma unroll
            for (int q = R - 1; q >= 0; --q) { const int hj = 1 << (R - 1 - q);
#pragma unroll
                for (int j = 0; j < NR; ++j) { if (j & hj) continue; const int k32 = (j & (hj - 1)) << (5 - R + q);
                    const cpx p = v[j], bb = v[j + hj]; cpx t;
                    if (k32 == 0) t = bb;
                    else if (k32 == 8) t = (cpx){-bb.y, bb.x};
                    else t = cmul(bb, (cpx){TWC[k32], TWS[k32]});
                    v[j] = p + t; if (!(OLO && q == 0)) v[j + hj] = p - t; } }
        }
        if (!INV && LOW > 0) {
            cpx cw = w0;
#pragma unroll
            for (int m = 1; m < NR; ++m) { const int j = brev_c(m, R); v[j] = cmul(v[j], cw); if (m + 1 < NR) cw = cmul(cw, w0); }
        }
#pragma unroll
        for (int j = 0; j < NR; ++j) { if (OLO && j >= NR / 2) continue; X[fphys(base | (j << LOW))] = v[j]; }
    }
}
#define XP_HOOK() xp_step(xp, F.p->in, F.ws, tid)
template <bool ZHI> __device__ __forceinline__ void fft_fwd(Frame& F, XpState& xp, LAS cpx* X, int tid) {
    fft_pass<0, 5, false, ZHI>(X, tid); __syncthreads(); XP_HOOK(); fft_pass<5, 5, false>(X, tid); __syncthreads(); XP_HOOK(); fft_pass<10, 4, false>(X, tid); __syncthreads(); XP_HOOK();
}
__device__ __forceinline__ void fft_inv(Frame& F, XpState& xp, LAS cpx* X, int tid) {
    fft_pass<10, 4, true>(X, tid); __syncthreads(); XP_HOOK(); fft_pass<5, 5, true>(X, tid); __syncthreads(); XP_HOOK(); fft_pass<0, 5, true, false, true>(X, tid); __syncthreads(); XP_HOOK();
}
struct SC8 { u32x4 c; unsigned l, r; };
__device__ __forceinline__ SC8 sconv8_load(const bf16_t* p, int n) {
    SC8 s; s.c = *(const u32x4*)(p + n); s.l = n > 0 ? (unsigned)p[n - 1] : 0u; s.r = n + 8 < SEQ ? (unsigned)p[n + 8] : 0u; return s;
}
__device__ __forceinline__ void sconv8_eval(const SC8& s, float w0, float w1, float w2, float bias, float (&o)[8]) {
    float v[10]; v[0] = bf2f(s.l); v[1] = bflo(s.c.x); v[2] = bfhi(s.c.x); v[3] = bflo(s.c.y); v[4] = bfhi(s.c.y); v[5] = bflo(s.c.z); v[6] = bfhi(s.c.z); v[7] = bflo(s.c.w); v[8] = bfhi(s.c.w); v[9] = bf2f(s.r);
#pragma unroll
    for (int i = 0; i < 8; ++i) o[i] = w0 * v[i] + w1 * v[i + 1] + w2 * v[i + 2] + bias;
}
__device__ __forceinline__ void hyena_item(Frame& F, int c, XpState& xp) {
    LAS cpx* X = (LAS cpx*)F.lds; LAS float* red = (LAS float*)(F.lds + (size_t)FPAD * 8);
    int tid = F.tid; asm volatile("" : "+v"(tid));
    const bf16_t* hf = WSP(bf16_t, WS_HF);
    __syncthreads();
    float s0 = 0.f, s1 = 0.f;
    {
        f32x4 fa[4], fb[4], ba[4], bb[4];
#pragma unroll
        for (int it = 0; it < 4; ++it) { const int j = 4 * (tid + 512 * it);
            const u32x2 w0 = *(const u32x2*)(hf + (size_t)c * SEQ + j), w1 = *(const u32x2*)(hf + (size_t)(1024 + c) * SEQ + j), w2 = *(const u32x2*)(hf + (size_t)(512 + c) * SEQ + j), w3 = *(const u32x2*)(hf + (size_t)(1536 + c) * SEQ + j);
            fa[it] = (f32x4){bflo(w0.x), bfhi(w0.x), bflo(w0.y), bfhi(w0.y)}; fb[it] = (f32x4){bflo(w1.x), bfhi(w1.x), bflo(w1.y), bfhi(w1.y)};
            ba[it] = (f32x4){bflo(w2.x), bfhi(w2.x), bflo(w2.y), bfhi(w2.y)}; bb[it] = (f32x4){bflo(w3.x), bfhi(w3.x), bflo(w3.y), bfhi(w3.y)}; }
#pragma unroll
        for (int it = 0; it < 4; ++it) { const int j = 4 * (tid + 512 * it);
#pragma unroll
            for (int i = 0; i < 4; ++i) { X[fphys(j + i)] = (cpx){fa[it][i], fb[it][i]}; s0 += fabsf(fa[it][i]); s1 += fabsf(fb[it][i]);
                const int m = j + i; if (m > 0) { X[fphys(FFTN - m)] = (cpx){ba[it][i], bb[it][i]}; s0 += fabsf(ba[it][i]); s1 += fabsf(bb[it][i]); } } }
        if (tid == 0) X[fphys(SEQ)] = (cpx){0.f, 0.f};
    }
    s0 = wave_sum(s0); s1 = wave_sum(s1);
    if (F.lane == 0) { red[F.wave] = s0; red[8 + F.wave] = s1; }
    __syncthreads();
    float S0 = 0.f, S1 = 0.f;
#pragma unroll
    for (int w = 0; w < 8; ++w) { S0 += red[w]; S1 += red[8 + w]; }
    fft_fwd<false>(F, xp, X, tid);
    unsigned* ks = WSP(unsigned, WS_KS) + (size_t)F.bx * 2 * FFTN;
    { const float i0 = 1.0f / S0, i1 = 1.0f / S1, sk0 = F.p->in[I_HSKIP][c], sk1 = F.p->in[I_HSKIP][512 + c];
#pragma unroll 8
        for (int it = 0; it < 32; ++it) { const int p = tid + 512 * it; const int k = (int)(__brev((unsigned)p) >> 18); const int pp = (int)(__brev((unsigned)((FFTN - k) & (FFTN - 1))) >> 18);
            const cpx A = X[fphys(p)], B = X[fphys(pp)];
            const float k1r = 0.5f * (A.x + B.x), k1i = 0.5f * (A.y - B.y), k2r = 0.5f * (A.y + B.y), k2i = -0.5f * (A.x - B.x);
            ks[p] = pkh2(k1r * i0 + sk0, k1i * i0); ks[FFTN + p] = pkh2(k2r * i1 + sk1, k2i * i1); } }
    __syncthreads();
    const bf16_t* ph = WSP(bf16_t, WS_PHYT); const float* cw = F.p->in[I_HCW]; const float* cb = F.p->in[I_HCB];
    { const float w0 = cw[c], w1 = cw[HYP + c], w2 = cw[2 * HYP + c], bs = cb[c];
        SC8 sa[2], sb[2];
#pragma unroll
        for (int it = 0; it < 2; ++it) { const int n = 8 * (tid + 512 * it); sa[it] = sconv8_load(ph + (size_t)c * SEQ, n); sb[it] = sconv8_load(ph + (size_t)(HYP + c) * SEQ, n); }
#pragma unroll
        for (int it = 0; it < 2; ++it) { const int n = 8 * (tid + 512 * it); float a[8], b[8]; sconv8_eval(sa[it], w0, w1, w2, bs, a); sconv8_eval(sb[it], w0, w1, w2, bs, b);
#pragma unroll
            for (int i = 0; i < 8; ++i) X[fphys(n + i)] = (cpx){a[i], b[i]}; } }
    __syncthreads();
    fft_fwd<true>(F, xp, X, tid);
    { unsigned kk[32]; const float invN = 1.0f / (float)FFTN;
#pragma unroll
        for (int it = 0; it < 32; ++it) kk[it] = ks[tid + 512 * it];
#pragma unroll
        for (int it = 0; it < 32; ++it) { const int q = fphys(tid + 512 * it); X[q] = cmul(X[q], (cpx){h2f((unsigned short)(kk[it] & 0xffffu)) * invN, h2f((unsigned short)(kk[it] >> 16)) * invN}); } }
    __syncthreads();
    fft_inv(F, xp, X, tid);
    { const int col = HYW + c; const float w0 = cw[col], w1 = cw[HYP + col], w2 = cw[2 * HYP + col], bs = cb[col];
        SC8 sa[2], sb[2];
#pragma unroll
        for (int it = 0; it < 2; ++it) { const int n = 8 * (tid + 512 * it); sa[it] = sconv8_load(ph + (size_t)col * SEQ, n); sb[it] = sconv8_load(ph + (size_t)(HYP + col) * SEQ, n); }
#pragma unroll
        for (int it = 0; it < 2; ++it) { const int n = 8 * (tid + 512 * it); float a[8], b[8]; sconv8_eval(sa[it], w0, w1, w2, bs, a); sconv8_eval(sb[it], w0, w1, w2, bs, b);
#pragma unroll
            for (int i = 0; i < 8; ++i) { const int q = fphys(n + i); X[q] = X[q] * (cpx){a[i], b[i]}; } } }
    __syncthreads();
    fft_fwd<true>(F, xp, X, tid);
    { unsigned kk[32]; const float invN = 1.0f / (float)FFTN;
#pragma unroll
        for (int it = 0; it < 32; ++it) kk[it] = ks[FFTN + tid + 512 * it];
#pragma unroll
        for (int it = 0; it < 32; ++it) { const int q = fphys(tid + 512 * it); X[q] = cmul(X[q], (cpx){h2f((unsigned short)(kk[it] & 0xffffu)) * invN, h2f((unsigned short)(kk[it] >> 16)) * invN}); } }
    __syncthreads();
    fft_inv(F, xp, X, tid);
    { const int col = 2 * HYW + c; const float w0 = cw[col], w1 = cw[HYP + col], w2 = cw[2 * HYP + col], bs = cb[col];
        bf16_t* yt = WSP(bf16_t, WS_YHYT);
        SC8 sa[2], sb[2]; u32x4 oa[2], ob[2];
#pragma unroll
        for (int it = 0; it < 2; ++it) { const int n = 8 * (tid + 512 * it); sa[it] = sconv8_load(ph + (size_t)col * SEQ, n); sb[it] = sconv8_load(ph + (size_t)(HYP + col) * SEQ, n); }
#pragma unroll
        for (int it = 0; it < 2; ++it) { const int n = 8 * (tid + 512 * it); float a[8], b[8]; sconv8_eval(sa[it], w0, w1, w2, bs, a); sconv8_eval(sb[it], w0, w1, w2, bs, b);
            cpx y[8];
#pragma unroll
            for (int i = 0; i < 8; ++i) y[i] = X[fphys(n + i)];
            oa[it] = (u32x4){pk2(y[0].x * a[0], y[1].x * a[1]), pk2(y[2].x * a[2], y[3].x * a[3]), pk2(y[4].x * a[4], y[5].x * a[5]), pk2(y[6].x * a[6], y[7].x * a[7])};
            ob[it] = (u32x4){pk2(y[0].y * b[0], y[1].y * b[1]), pk2(y[2].y * b[2], y[3].y * b[3]), pk2(y[4].y * b[4], y[5].y * b[5]), pk2(y[6].y * b[6], y[7].y * b[7])}; }
#pragma unroll
        for (int it = 0; it < 2; ++it) { const int n = 8 * (tid + 512 * it);
            *(u32x4*)(yt + (size_t)c * SEQ + n) = oa[it]; *(u32x4*)(yt + (size_t)(HYW + c) * SEQ + n) = ob[it]; } }
}

__device__ __forceinline__ bf16x8 lds_frag(const LAS bf16_t* base, int row, int stride, int k) { return *(const LAS bf16x8*)(base + row * stride + k); }
#define MFMA16(a, b, c) __builtin_amdgcn_mfma_f32_16x16x32_bf16(a, b, c, 0, 0, 0)

__device__ __forceinline__ void hg_delta_item(Frame& F, int item) {
    const int chain = item / NCH_EXT, j = item % NCH_EXT, dir = chain & 1, h = (chain >> 1) & 3, b = chain >> 3;
    const int cj = dir == 0 ? j : (j < 4 ? 3 - j : 135 - j), n0 = cj * 64;
    LAS float* segtot = (LAS float*)F.lds;
    LAS bf16_t* Kt = (LAS bf16_t*)(F.lds + 4096);
    LAS bf16_t* VTs = (LAS bf16_t*)(F.lds + 4096 + 18432);
    const int tid = F.tid, d = 2 * (tid & 63), seg = tid >> 6, lane = F.lane;
    const float* lfp = (dir ? WSP(float, WS_LB) : WSP(float, WS_LF)) + ((size_t)(b * NEXT + n0) * HGW + h * 128 + d);
    f32x2 lf[8], tot = (f32x2){0.f, 0.f};
#pragma unroll
    for (int i = 0; i < 8; ++i) { lf[i] = *(const f32x2*)(lfp + (size_t)(8 * seg + i) * HGW); tot += lf[i]; }
    __syncthreads();
    *(LAS f32x2*)(segtot + seg * 128 + d) = tot;
    { const bf16_t* vt = WSP(bf16_t, WS_VT) + ((size_t)(b * HGW + h * 128) * NEXT + n0);
        u32x4 tv[2];
#pragma unroll
        for (int q = 0; q < 2; ++q) { const int piece = tid + 512 * q, e = piece >> 3, part = piece & 7; tv[q] = *(const u32x4*)(vt + (size_t)e * NEXT + part * 8); }
#pragma unroll
        for (int q = 0; q < 2; ++q) { const int piece = tid + 512 * q, e = piece >> 3, part = piece & 7; *(LAS u32x4*)(VTs + e * 72 + part * 8) = tv[q]; } }
    __syncthreads();
    f32x2 later = (f32x2){0.f, 0.f}, total = later;
#pragma unroll
    for (int s = 0; s < 8; ++s) { const f32x2 v = *(const LAS f32x2*)(segtot + s * 128 + d); total += v; if (dir == 0 ? (s > seg) : (s < seg)) later += v; }
    f32x2 E[8];
    if (dir == 0) { f32x2 run = later;
#pragma unroll
        for (int i = 7; i >= 0; --i) { E[i] = run; run += lf[i]; } }
    else { f32x2 run = later;
#pragma unroll
        for (int i = 0; i < 8; ++i) { E[i] = run; run += lf[i]; } }
    float k0[8], k1[8];
#pragma unroll
    for (int i = 0; i < 8; ++i) { k0[i] = (1.0f - __expf(lf[i].x)) * __expf(E[i].x); k1[i] = (1.0f - __expf(lf[i].y)) * __expf(E[i].y); }
    *(LAS u32x4*)(Kt + d * 72 + 8 * seg) = (u32x4){pk2(k0[0], k0[1]), pk2(k0[2], k0[3]), pk2(k0[4], k0[5]), pk2(k0[6], k0[7])};
    *(LAS u32x4*)(Kt + (d + 1) * 72 + 8 * seg) = (u32x4){pk2(k1[0], k1[1]), pk2(k1[2], k1[3]), pk2(k1[4], k1[5]), pk2(k1[6], k1[7])};
    if (seg == 0) *(f32x2*)(WSP(float, WS_DECAY) + (size_t)item * 128 + d) = (f32x2){__expf(total.x), __expf(total.y)};
    __syncthreads();
    const int w = F.wave, lr = lane & 15, lq = lane >> 4;
    f32x4 acc[8];
#pragma unroll
    for (int et = 0; et < 8; ++et) acc[et] = (f32x4){0.f, 0.f, 0.f, 0.f};
#pragma unroll
    for (int ksi = 0; ksi < 2; ++ksi) { const bf16x8 a = lds_frag(Kt, 16 * w + lr, 72, 32 * ksi + 8 * lq);
#pragma unroll
        for (int et = 0; et < 8; ++et) acc[et] = MFMA16(a, lds_frag(VTs, 16 * et + lr, 72, 32 * ksi + 8 * lq), acc[et]); }
    bf16_t* dl = WSP(bf16_t, WS_DELTA) + (size_t)item * 16384;
#pragma unroll
    for (int et = 0; et < 8; ++et) { const int e = 16 * et + lr, d0 = 16 * w + 4 * lq;
        u32x2 o; o.x = pk2(acc[et][0], acc[et][1]); o.y = pk2(acc[et][2], acc[et][3]); *(u32x2*)(dl + e * 128 + d0) = o; }
}

__device__ __forceinline__ void hg_scan(Frame& F) {
    for (int gid = F.bx * 512 + F.tid; gid < NCHAIN * 8192; gid += F.G * 512) {
        const int chain = gid >> 13, idx = gid & 8191, dd = (2 * idx) & 127;
        const unsigned* dl = WSP(unsigned, WS_DELTA) + (size_t)chain * NCH_EXT * 8192 + idx;
        const float* dc = WSP(float, WS_DECAY) + (size_t)chain * NCH_EXT * 128 + dd;
        unsigned* ss = WSP(unsigned, WS_SST) + (size_t)chain * NCH_LAT * 8192 + idx;
        float s0 = 0.f, s1 = 0.f;
        unsigned dv[12], dw[12]; f32x2 cv[12], cw[12];
#pragma unroll
        for (int u = 0; u < 12; ++u) { dv[u] = dl[(size_t)u * 8192]; cv[u] = *(const f32x2*)(dc + (size_t)u * 128); }
#pragma unroll 1
        for (int j0 = 0; j0 < NCH_EXT; j0 += 12) {
            const bool more = j0 + 12 < NCH_EXT;
            if (more) {
#pragma unroll
                for (int u = 0; u < 12; ++u) { dw[u] = dl[(size_t)(j0 + 12 + u) * 8192]; cw[u] = *(const f32x2*)(dc + (size_t)(j0 + 12 + u) * 128); } }
#pragma unroll
            for (int u = 0; u < 12; ++u) { const int j = j0 + u;
                if (j >= 4) ss[(size_t)(j - 4) * 8192] = pk2(s0, s1);
                s0 = cv[u].x * s0 + bflo(dv[u]); s1 = cv[u].y * s1 + bfhi(dv[u]); }
#pragma unroll
            for (int u = 0; u < 12; ++u) { dv[u] = dw[u]; cv[u] = cw[u]; }
        }
    }
}

__device__ __forceinline__ void yhy_transpose_item(Frame& F, int item) {
    const int b = item >> 7, nb = item & 127, tid = F.tid;
    LAS bf16_t* ts = (LAS bf16_t*)F.lds;
    const bf16_t* src = WSP(bf16_t, WS_YHYT) + (size_t)b * HYW * SEQ + nb * 64;
    __syncthreads();
    { u32x4 tv[8];
#pragma unroll
    for (int q = 0; q < 8; ++q) { const int piece = tid + 512 * q, c = piece >> 3, part = piece & 7; tv[q] = *(const u32x4*)(src + (size_t)c * SEQ + part * 8); }
#pragma unroll
    for (int q = 0; q < 8; ++q) { const int piece = tid + 512 * q, c = piece >> 3, part = piece & 7; *(LAS u32x4*)(ts + c * 72 + part * 8) = tv[q]; } }
    __syncthreads();
    bf16_t* dst = WSP(bf16_t, WS_YHY) + (size_t)(b * SEQ + nb * 64) * HYW;
#pragma unroll
    for (int q = 0; q < 8; ++q) { const int task = tid + 512 * q, n = task & 63, cg = task >> 6;
        unsigned v[8];
#pragma unroll
        for (int i = 0; i < 8; ++i) v[i] = ts[(8 * cg + i) * 72 + n];
        *(u32x4*)(dst + (size_t)n * HYW + 8 * cg) = (u32x4){v[0] | (v[1] << 16), v[2] | (v[3] << 16), v[4] | (v[5] << 16), v[6] | (v[7] << 16)}; }
}

__device__ __forceinline__ void hg_out_item(Frame& F, int item) {
    const int b = item >> 9, h = (item >> 7) & 3, nc = item & 127;
    LAS float* segtot = (LAS float*)F.lds;
    LAS float* bref = (LAS float*)(F.lds + 4096);
    LAS float* red = (LAS float*)(F.lds + 4608);
    LAS bf16_t* Qd = (LAS bf16_t*)(F.lds + 5120);
    LAS bf16_t* Kd = (LAS bf16_t*)(F.lds + 22528);
    LAS bf16_t* Qb = (LAS bf16_t*)(F.lds + 39936);
    LAS bf16_t* VTs = (LAS bf16_t*)(F.lds + 57344);
    LAS bf16_t* Ss = (LAS bf16_t*)(F.lds + 75776);
    LAS bf16_t* att = (LAS bf16_t*)(F.lds + 110592);
    const int tid = F.tid, d = 2 * (tid & 63), seg = tid >> 6, lane = F.lane, w = F.wave, lr = lane & 15, lq = lane >> 4;
    const int nx0 = CTXL + nc * 64, r0 = b * SEQ + nc * 64;
    __syncthreads();
    { const bf16_t* vt = WSP(bf16_t, WS_VT) + ((size_t)(b * HGW + h * 128) * NEXT + nx0);
        u32x4 tv[2];
#pragma unroll
        for (int q = 0; q < 2; ++q) { const int piece = tid + 512 * q, e = piece >> 3, part = piece & 7; tv[q] = *(const u32x4*)(vt + (size_t)e * NEXT + part * 8); }
#pragma unroll
        for (int q = 0; q < 2; ++q) { const int piece = tid + 512 * q, e = piece >> 3, part = piece & 7; *(LAS u32x4*)(VTs + e * 72 + part * 8) = tv[q]; } }
    f32x4 acc[4];
#pragma unroll
    for (int i = 0; i < 4; ++i) acc[i] = (f32x4){0.f, 0.f, 0.f, 0.f};
    const bf16_t* qp = WSP(bf16_t, WS_Q) + ((size_t)r0 * HGW + h * 128 + d);
#pragma unroll 1
    for (int dir = 0; dir < 2; ++dir) {
        const int chain = (b * 4 + h) * 2 + dir, jlat = dir == 0 ? nc : 127 - nc;
        __syncthreads();
        { const bf16_t* sp = WSP(bf16_t, WS_SST) + (size_t)(chain * NCH_LAT + jlat) * 16384;
            u32x4 sv[4];
#pragma unroll
            for (int q = 0; q < 4; ++q) { const int piece = tid + 512 * q, e = piece >> 4, part = piece & 15; sv[q] = *(const u32x4*)(sp + e * 128 + part * 8); }
#pragma unroll
            for (int q = 0; q < 4; ++q) { const int piece = tid + 512 * q, e = piece >> 4, part = piece & 15; *(LAS u32x4*)(Ss + e * 136 + part * 8) = sv[q]; } }
        const float* lfp = (dir ? WSP(float, WS_LB) : WSP(float, WS_LF)) + ((size_t)(b * NEXT + nx0) * HGW + h * 128 + d);
        f32x2 lf[8], qv[8], tot = (f32x2){0.f, 0.f};
#pragma unroll
        for (int i = 0; i < 8; ++i) { lf[i] = *(const f32x2*)(lfp + (size_t)(8 * seg + i) * HGW); const unsigned qw = *(const unsigned*)(qp + (size_t)(8 * seg + i) * HGW); qv[i] = (f32x2){bflo(qw), bfhi(qw)}; tot += lf[i]; }
        *(LAS f32x2*)(segtot + seg * 128 + d) = tot;
        __syncthreads();
        f32x2 off = (f32x2){0.f, 0.f};
#pragma unroll
        for (int s = 0; s < 8; ++s) { const f32x2 v = *(const LAS f32x2*)(segtot + s * 128 + d); if (dir == 0 ? (s < seg) : (s > seg)) off += v; }
        f32x2 bb[8];
        if (dir == 0) { f32x2 run = off;
#pragma unroll
            for (int i = 0; i < 8; ++i) { run += lf[i]; bb[i] = run; } if (seg == 3) *(LAS f32x2*)(bref + d) = bb[7]; }
        else { f32x2 run = off;
#pragma unroll
            for (int i = 7; i >= 0; --i) { run += lf[i]; bb[i] = run; } if (seg == 4) *(LAS f32x2*)(bref + d) = bb[0]; }
        __syncthreads();
        { const f32x2 br = *(const LAS f32x2*)(bref + d); const f32x2 em = (f32x2){__expf(-br.x), __expf(-br.y)}, ep = (f32x2){__expf(br.x), __expf(br.y)};
#pragma unroll
            for (int i = 0; i < 8; ++i) { const int t = 8 * seg + i;
                const f32x2 eb = (f32x2){__expf(bb[i].x), __expf(bb[i].y)}, kk = (f32x2){1.0f - __expf(lf[i].x), 1.0f - __expf(lf[i].y)};
                const f32x2 qb = qv[i] * eb, qd = qb * em, kd = kk * ep * (f32x2){__builtin_amdgcn_rcpf(eb.x), __builtin_amdgcn_rcpf(eb.y)};
                *(LAS unsigned*)(Qd + t * 136 + d) = pk2(qd.x, qd.y); *(LAS unsigned*)(Kd + t * 136 + d) = pk2(kd.x, kd.y); *(LAS unsigned*)(Qb + t * 136 + d) = pk2(qb.x, qb.y); } }
        __syncthreads();
        {
            const int st = w & 3; f32x4 a2[2] = {(f32x4){0.f, 0.f, 0.f, 0.f}, (f32x4){0.f, 0.f, 0.f, 0.f}};
#pragma unroll
            for (int ksi = 0; ksi < 4; ++ksi) { const bf16x8 a = lds_frag(Kd, 16 * st + lr, 136, 32 * ksi + 8 * lq);
#pragma unroll
                for (int q = 0; q < 2; ++q) a2[q] = MFMA16(a, lds_frag(Qd, 16 * (2 * (w >> 2) + q) + lr, 136, 32 * ksi + 8 * lq), a2[q]); }
#pragma unroll
            for (int q = 0; q < 2; ++q) { const int t = 16 * (2 * (w >> 2) + q) + lr, s0 = 16 * st + 4 * lq; float v[4];
#pragma unroll
                for (int r = 0; r < 4; ++r) { const int s = s0 + r; v[r] = (dir == 0 ? (s <= t) : (s >= t)) ? a2[q][r] : 0.f; }
                u32x2 o; o.x = pk2(v[0], v[1]); o.y = pk2(v[2], v[3]); *(LAS u32x2*)(att + t * 72 + s0) = o; }
        }
        __syncthreads();
        { const int tt = w & 3;
#pragma unroll
            for (int ksi = 0; ksi < 2; ++ksi) { const bf16x8 a = lds_frag(att, 16 * tt + lr, 72, 32 * ksi + 8 * lq);
#pragma unroll
                for (int i = 0; i < 4; ++i) acc[i] = MFMA16(a, lds_frag(VTs, 16 * (4 * (w >> 2) + i) + lr, 72, 32 * ksi + 8 * lq), acc[i]); }
#pragma unroll
            for (int ksi = 0; ksi < 4; ++ksi) { const bf16x8 a = lds_frag(Qb, 16 * tt + lr, 136, 32 * ksi + 8 * lq);
#pragma unroll
                for (int i = 0; i < 4; ++i) acc[i] = MFMA16(a, lds_frag(Ss, 16 * (4 * (w >> 2) + i) + lr, 136, 32 * ksi + 8 * lq), acc[i]); }
        }
    }
    const int tt = w & 3, eh = w >> 2;
    float ssq[4];
#pragma unroll
    for (int r = 0; r < 4; ++r) { float s = 0.f;
#pragma unroll
        for (int i = 0; i < 4; ++i) s += acc[i][r] * acc[i][r];
        s += __shfl_xor(s, 1); s += __shfl_xor(s, 2); s += __shfl_xor(s, 4); s += __shfl_xor(s, 8); ssq[r] = s; }
    if (lr == 0) {
#pragma unroll
        for (int r = 0; r < 4; ++r) red[eh * 64 + 16 * tt + 4 * lq + r] = ssq[r]; }
    __syncthreads();
    const float* ng = F.p->in[I_HGNG]; const bf16_t* gp = WSP(bf16_t, WS_G); bf16_t* yo = WSP(bf16_t, WS_YHG);
    float ngv[4], gv[4][4];
#pragma unroll
    for (int i = 0; i < 4; ++i) ngv[i] = ng[16 * (4 * eh + i) + lr];
#pragma unroll
    for (int r = 0; r < 4; ++r)
#pragma unroll
        for (int i = 0; i < 4; ++i) gv[r][i] = bf2f(gp[(size_t)(r0 + 16 * tt + 4 * lq + r) * HGW + h * 128 + 16 * (4 * eh + i) + lr]);
#pragma unroll
    for (int r = 0; r < 4; ++r) { const int t = 16 * tt + 4 * lq + r; const float rs = rsqrtf((red[t] + red[64 + t]) * (1.0f / 128.0f) + EPS);
#pragma unroll
        for (int i = 0; i < 4; ++i) { const int e = 16 * (4 * eh + i) + lr; const size_t o = (size_t)(r0 + t) * HGW + h * 128 + e;
            yo[o] = (bf16_t)f2bf(acc[i][r] * rs * ngv[i] * gv[r][i]); } }
}
__device__ __forceinline__ void phase_route(Frame& F) {
    const float* lg = WSP(float, WS_LOGIT); const float* rb = F.p->in[I_RB];
    unsigned* cnt = WSP(unsigned, WS_CTL) + CW_CNT;
    int* re_ = WSP(int, WS_ROUTE_E); float* rw_ = WSP(float, WS_ROUTE_W); int* rp_ = WSP(int, WS_ROUTE_P);
    const int gw = F.bx * 8 + F.wave, NGW = F.G * 8, lane = F.lane;
    const f32x4 bias = *(const f32x4*)(rb + 4 * lane);
    const float NINF = -__builtin_inff();
    const bool al = (F.G == 256); const int tbase = al ? (((F.bx & 7) * 32 + (F.bx >> 3)) * 8 + F.wave) * 8 : gw, tstr = al ? 1 : NGW;
    f32x4 lpre[8];
#pragma unroll
    for (int i = 0; i < 8; ++i) { const int t = tbase + i * tstr; lpre[i] = t < T ? *(const f32x4*)(lg + (size_t)t * NE + 4 * lane) : (f32x4){0.f, 0.f, 0.f, 0.f}; }
    int ti = 0;
    for (int t = tbase; al ? ti < 8 : t < T; t += tstr, ++ti) {
        f32x4 l4 = lpre[0];
#pragma unroll
        for (int i = 1; i < 8; ++i) if (ti == i) l4 = lpre[i];
        if (ti >= 8) l4 = *(const f32x4*)(lg + (size_t)t * NE + 4 * lane);
        float sc[4], bs[4];
#pragma unroll
        for (int i = 0; i < 4; ++i) { sc[i] = sigmoidf_(l4[i]); bs[i] = sc[i] + bias[i]; }
        float m1 = fmaxf(bs[0], bs[1]), m2 = fminf(bs[0], bs[1]);
#pragma unroll
        for (int i = 2; i < 4; ++i) { const float v = bs[i]; m2 = fmaxf(m2, fminf(m1, v)); m1 = fmaxf(m1, v); }
#pragma unroll
        for (int o = 1; o < 8; o <<= 1) { const float o1 = __shfl_xor(m1, o), o2 = __shfl_xor(m2, o); const float n1 = fmaxf(m1, o1), n2 = fmaxf(fminf(m1, o1), fmaxf(m2, o2)); m1 = n1; m2 = n2; }
        const float gs = m1 + m2; const int mg = lane >> 3; int rank = 0;
#pragma unroll
        for (int g = 0; g < 8; ++g) { const float v = __shfl(gs, g * 8); rank += (v > gs || (v == gs && g < mg)) ? 1 : 0; }
        const bool sel = rank < 4;
        float cd[4];
#pragma unroll
        for (int i = 0; i < 4; ++i) cd[i] = sel ? bs[i] : NINF;
        int ek[8]; float sk[8]; float ssum = 0.f;
#pragma unroll
        for (int k = 0; k < 8; ++k) {
            float bv = cd[0]; int bi = 4 * lane;
#pragma unroll
            for (int i = 1; i < 4; ++i) if (cd[i] > bv) { bv = cd[i]; bi = 4 * lane + i; }
#pragma unroll
            for (int o = 32; o >= 1; o >>= 1) { const float ov = __shfl_xor(bv, o); const int oi = __shfl_xor(bi, o); if (ov > bv || (ov == bv && oi < bi)) { bv = ov; bi = oi; } }
            const int sub = bi & 3; const float mysc = sub == 0 ? sc[0] : (sub == 1 ? sc[1] : (sub == 2 ? sc[2] : sc[3]));
            const float s = __shfl(mysc, bi >> 2);
            if ((bi >> 2) == lane) {
#pragma unroll
                for (int i = 0; i < 4; ++i) if (i == sub) cd[i] = NINF; }
            ek[k] = bi; sk[k] = s; ssum += s;
        }
        const float scale = 2.5f / ssum;
        int me = ek[0]; float mw = sk[0];
#pragma unroll
        for (int k = 1; k < 8; ++k) if (lane == k) { me = ek[k]; mw = sk[k]; }
        if (lane < 8) { const int pos = (int)atomicAdd(cnt + me, 1u); re_[t * 8 + lane] = me; rw_[t * 8 + lane] = mw * scale; rp_[t * 8 + lane] = pos; }
    }
}
__device__ __forceinline__ void phase_scatter(Frame& F) {
    LAS int* st = (LAS int*)F.lds; LAS int* cn = st + 512;
    const unsigned* cnt = WSP(unsigned, WS_CTL) + CW_CNT;
    __syncthreads();
    if (F.tid < NE) cn[F.tid] = (int)cnt[F.tid];
    __syncthreads();
    if (F.tid <= NE) { int s = 0, tl = 0; for (int e = 0; e < F.tid; ++e) { s += cn[e]; tl += (cn[e] + 255) >> 8; } st[F.tid] = s;
        if (F.bx == 0) { unsigned* ctl = WSP(unsigned, WS_CTL); ctl[CW_START + F.tid] = (unsigned)s; ctl[CW_TOFF + F.tid] = (unsigned)tl;
            if (F.tid < NE) { const int c_ = cn[F.tid]; for (int j = 0; j * 256 < c_; ++j) { unsigned* up = ctl + CW_UNITS + 4 * (tl + j); up[0] = (unsigned)(s + 256 * j); up[1] = (unsigned)F.tid; up[2] = (unsigned)(c_ - 256 * j < 256 ? c_ - 256 * j : 256); up[3] = 0u; } } } }
    __syncthreads();
    const int* re_ = WSP(int, WS_ROUTE_E); const float* rw_ = WSP(float, WS_ROUTE_W); const int* rp_ = WSP(int, WS_ROUTE_P);
    int* stok = WSP(int, WS_SLOT_TOK); float* sw = WSP(float, WS_SLOT_W); int* sof = WSP(int, WS_SLOTOF);
    for (int a = F.bx * 512 + F.tid; a < NASG; a += F.G * 512) { const int slot = st[re_[a]] + rp_[a]; stok[slot] = a >> 3; sw[slot] = rw_[a]; sof[a] = slot; }
    if (F.bx == 0 && F.tid < 256) { stok[NASG + F.tid] = 0; sw[NASG + F.tid] = 0.f; }
}
__device__ __forceinline__ void phase_final(Frame& F) {
    float* out = F.p->out; const float* x1 = F.p->out;     const float* fg = F.p->in[I_FG]; const float* ada = WSP(float, WS_ADA);
    const unsigned char* yb8 = WSP(unsigned char, WS_YBUF); const bf16_t* ysh = WSP(bf16_t, WS_YSH); const int* sof = WSP(int, WS_SLOTOF);
    const int lane = F.lane, NGW = F.G * 8;
    const bool al = (F.G == 256); const int tbase = al ? (((F.bx & 7) * 32 + (F.bx >> 3)) * 8 + F.wave) * 8 : F.bx * 8 + F.wave, tstr = al ? 1 : NGW;
    f32x4 fgv[2][2];
#pragma unroll
    for (int j = 0; j < 2; ++j) { fgv[j][0] = *(const f32x4*)(fg + 512 * j + 8 * lane); fgv[j][1] = *(const f32x4*)(fg + 512 * j + 8 * lane + 4); }
    int it_ = 0;
    for (int t = tbase; al ? it_ < 8 : t < T; t += tstr, ++it_) { const int b = t >> 13;
        int sl[8];
#pragma unroll
        for (int k = 0; k < 8; ++k) sl[k] = sof[t * 8 + k];
        u32x4 ys[2]; u32x2 y[8][2]; f32x4 xv[2][2], g2[2][2];
#pragma unroll
        for (int j = 0; j < 2; ++j) { const int c = 512 * j + 8 * lane;
            ys[j] = *(const u32x4*)(ysh + (size_t)t * D + c); xv[j][0] = *(const f32x4*)(x1 + (size_t)t * D + c); xv[j][1] = *(const f32x4*)(x1 + (size_t)t * D + c + 4);
            g2[j][0] = *(const f32x4*)(ada + b * 6144 + 5 * D + c); g2[j][1] = *(const f32x4*)(ada + b * 6144 + 5 * D + c + 4);
#pragma unroll
            for (int k = 0; k < 8; ++k) y[k][j] = *(const u32x2*)(yb8 + (size_t)sl[k] * D + c); }
        f32x4 v[2][2]; float ss = 0.f;
#pragma unroll
        for (int j = 0; j < 2; ++j) { f32x4 m0 = (f32x4){bflo(ys[j].x), bfhi(ys[j].x), bflo(ys[j].y), bfhi(ys[j].y)}, m1 = (f32x4){bflo(ys[j].z), bfhi(ys[j].z), bflo(ys[j].w), bfhi(ys[j].w)};
#pragma unroll
            for (int k = 0; k < 8; ++k) { const f32x2 a0 = __builtin_amdgcn_cvt_pk_f32_fp8((int)y[k][j].x, false), a1 = __builtin_amdgcn_cvt_pk_f32_fp8((int)y[k][j].x, true), b0 = __builtin_amdgcn_cvt_pk_f32_fp8((int)y[k][j].y, false), b1 = __builtin_amdgcn_cvt_pk_f32_fp8((int)y[k][j].y, true);
                m0 += (f32x4){a0.x, a0.y, a1.x, a1.y}; m1 += (f32x4){b0.x, b0.y, b1.x, b1.y}; }
            v[j][0] = xv[j][0] + g2[j][0] * m0; v[j][1] = xv[j][1] + g2[j][1] * m1;
#pragma unroll
            for (int h = 0; h < 2; ++h) ss += (v[j][h][0] * v[j][h][0] + v[j][h][1] * v[j][h][1]) + (v[j][h][2] * v[j][h][2] + v[j][h][3] * v[j][h][3]); }
        const float rs = rsqrtf(wave_sum(ss) * (1.0f / D) + EPS);
#pragma unroll
        for (int j = 0; j < 2; ++j) { const int c = 512 * j + 8 * lane; *(f32x4*)(out + (size_t)t * D + c) = v[j][0] * rs * fgv[j][0]; *(f32x4*)(out + (size_t)t * D + c + 4) = v[j][1] * rs * fgv[j][1]; }
    }
}

constexpr int NPHASE = 15;
#ifndef REP_MASK
#define REP_MASK 0u
#endif
#define NREP(k) ((((REP_MASK) >> (k)) & 1u) ? 2 : 1)
#ifndef MK_LAUNCH_PER_PHASE
#define MK_LAUNCH_PER_PHASE 0
#endif
__global__ void __launch_bounds__(512) hyena_hgrn2_moe_fwd(Params p) {
    extern __shared__ __attribute__((aligned(16))) unsigned char lds_[];
    cg::grid_group grid = cg::this_grid();
    Frame F; F.lds = (LAS unsigned char*)lds_; F.p = &p; F.ws = p.ws; F.tid = threadIdx.x; F.lane = F.tid & 63; F.wave = __builtin_amdgcn_readfirstlane(F.tid >> 6); F.G = gridDim.x; F.bx = blockIdx.x;
    if (F.tid < 16) ((LAS unsigned*)(F.lds + LDS_BARST))[F.tid] = 0u;
    __syncthreads();
    XcdBarrier bar = xcd_barrier_post((unsigned*)(p.ws + WS_CTL) + CW_BAR, (volatile LAS unsigned*)(F.lds + LDS_BARST));
#ifdef ONLY_PHASE
#define IN(k) ((k) == ONLY_PHASE && p.ph_lo <= (k) && (k) < p.ph_hi)
#else
#define IN(k) (p.ph_lo <= (k) && (k) < p.ph_hi)
#endif
#define SEAM(k) do { if (IN(k) && IN((k) + 1)) xcd_barrier(bar); } while (0)
    if (p.ph_lo < 0) grid.sync();
    if (IN(0)) _Pragma("unroll 1") for (int rp = 0; rp < NREP(0); ++rp) { asm volatile("" : "+v"(F.tid)); if (rp) xcd_barrier(bar); phase0(F); }
    SEAM(0);
    if (IN(1)) _Pragma("unroll 1") for (int rp = 0; rp < NREP(1); ++rp) { asm volatile("" : "+v"(F.tid)); if (rp) xcd_barrier(bar); phase1(F); }
    SEAM(1);
    if (IN(2)) _Pragma("unroll 1") for (int rp = 0; rp < NREP(2); ++rp) { asm volatile("" : "+v"(F.tid)); if (rp) xcd_barrier(bar);
        __syncthreads();
        if (F.G == 256 && F.bx >= 256 - NCONV) {
            int tid = F.tid; conv_loop(p.in, F.ws, 256 * (XP_BG + XP_K0) + (F.bx - (256 - NCONV)), NCONV, NE * 48, tid);
        } else
        { pg8::Gemm g{WSP(bf16_t, WS_WINT), WSP(bf16_t, WS_WINT), D, nullptr, 2 * D, 128}; InOrder S{F.G == 256 ? 256 - NCONV : F.G, F.bx};
          EpiIn E{EpiInT{WSP(bf16_t, WS_PHYT), WSP(bf16_t, WS_VT)}, EpiInN{WSP(bf16_t, WS_Q), WSP(bf16_t, WS_G), WSP(bf16_t, WS_SG1), WSP(bf16_t, WS_SG2), WSP(float, WS_LF), WSP(float, WS_LB), WSP(float, WS_LBS)}};
          pg8::gemm_phase<EpiIn, InOrder, false>(F.lds, g, S, E); }
    }
    SEAM(2);
    if (IN(3)) _Pragma("unroll 1") for (int rp = 0; rp < NREP(3); ++rp) { asm volatile("" : "+v"(F.tid)); if (rp) xcd_barrier(bar);
        _Pragma("unroll 1") for (int r2 = 0; r2 < NREP(16); ++r2) { asm volatile("" : "+v"(F.tid));
            XpState xp; xp.it = F.bx; xp.stride = F.G; xp.end = (XP_BG * F.G < NE * 48) ? XP_BG * F.G : NE * 48; xp.live = false;
            for (int c = F.bx; c < HYW; c += F.G) hyena_item(F, c, xp);
            { int tid = F.tid; xp_finish(xp, p.in, F.ws, tid); while (xp.it < xp.end) { xp_issue(xp, p.in, F.ws, tid); xp_finish(xp, p.in, F.ws, tid); } } }
        _Pragma("unroll 1") for (int r2 = 0; r2 < NREP(17); ++r2) { asm volatile("" : "+v"(F.tid)); for (int it = F.bx; it < NAITEM; it += F.G) hg_delta_item(F, it); }
    }
    SEAM(3);
    if (IN(4)) _Pragma("unroll 1") for (int rp = 0; rp < NREP(4); ++rp) { asm volatile("" : "+v"(F.tid)); if (rp) xcd_barrier(bar);
        _Pragma("unroll 1") for (int r2 = 0; r2 < NREP(18); ++r2) { asm volatile("" : "+v"(F.tid)); hg_scan(F); }
        _Pragma("unroll 1") for (int r2 = 0; r2 < NREP(19); ++r2) { asm volatile("" : "+v"(F.tid)); for (int it = F.bx; it < NB * 128; it += F.G) yhy_transpose_item(F, it); }
    }
    SEAM(4);
    if (IN(5)) _Pragma("unroll 1") for (int rp = 0; rp < NREP(5); ++rp) { asm volatile("" : "+v"(F.tid)); if (rp) xcd_barrier(bar); for (int it = F.bx; it < NB * 4 * NCH_LAT; it += F.G) hg_out_item(F, it); }
    SEAM(5);
    if (IN(6)) _Pragma("unroll 1") for (int rp = 0; rp < NREP(6); ++rp) { asm volatile("" : "+v"(F.tid)); if (rp) xcd_barrier(bar);
        __syncthreads();
        { pg8::Gemm g{WSP(bf16_t, WS_YHY), WSP(bf16_t, WS_WHYT), HYW, nullptr, 2 * HYW, 128}; pg8::StaticOrder S; S.init(T, D, HYW, F.G, F.bx); EpiMerge1 E{WSP(bf16_t, WS_SG1), WSP(float, WS_T1)};
          pg8::gemm_phase<EpiMerge1, pg8::StaticOrder, false>(F.lds, g, S, E); }
        { pg8::Gemm g{WSP(bf16_t, WS_YHG), WSP(bf16_t, WS_WHGT), HGW, nullptr, 2 * HGW, 128}; pg8::StaticOrder S; S.init(T, D, HGW, F.G, F.bx); EpiMerge2 E{WSP(bf16_t, WS_SG2), WSP(float, WS_T1), WSP(bf16_t, WS_MB)};
          pg8::gemm_phase<EpiMerge2, pg8::StaticOrder, false>(F.lds, g, S, E); }
    }
    SEAM(6);
    if (IN(7)) _Pragma("unroll 1") for (int rp = 0; rp < NREP(7); ++rp) { asm volatile("" : "+v"(F.tid)); if (rp) xcd_barrier(bar);
        __syncthreads();
        pg8::Gemm g{WSP(bf16_t, WS_MB), WSP(bf16_t, WS_WOUTT), D, nullptr, 2 * D, 128}; pg8::StaticOrder S; S.init(T, D, D, F.G, F.bx);
        EpiWout E{p.in[I_X], WSP(float, WS_POSR), WSP(float, WS_POSC), WSP(float, WS_ADA), p.out};
        pg8::gemm_phase<EpiWout, pg8::StaticOrder, false>(F.lds, g, S, E);
    }
    SEAM(7);
    if (IN(8)) _Pragma("unroll 1") for (int rp = 0; rp < NREP(8); ++rp) { asm volatile("" : "+v"(F.tid)); if (rp) xcd_barrier(bar); phase_h2(F); }
    SEAM(8);
    if (IN(9)) _Pragma("unroll 1") for (int rp = 0; rp < NREP(9); ++rp) { asm volatile("" : "+v"(F.tid)); if (rp) xcd_barrier(bar);
        __syncthreads();
        { pg8::Gemm g{WSP(bf16_t, WS_H2), WSP(bf16_t, WS_ROUT), D, nullptr, 2 * D, 128}; P9Order S{F.G, F.bx}; EpiP9 E{EpiLogit{WSP(float, WS_LOGIT)}, EpiGU{WSP(bf16_t, WS_HSH)}};
          pg8::gemm_phase<EpiP9, P9Order, false>(F.lds, g, S, E); }
    }
    SEAM(9);
    if (IN(10)) _Pragma("unroll 1") for (int rp = 0; rp < NREP(10); ++rp) { asm volatile("" : "+v"(F.tid)); if (rp) xcd_barrier(bar); phase_route(F); }
    SEAM(10);
    if (IN(11)) _Pragma("unroll 1") for (int rp = 0; rp < NREP(11); ++rp) { asm volatile("" : "+v"(F.tid)); if (rp) xcd_barrier(bar); phase_scatter(F); }
    SEAM(11);
    if (IN(12)) _Pragma("unroll 1") for (int rp = 0; rp < NREP(12); ++rp) { asm volatile("" : "+v"(F.tid)); if (rp) xcd_barrier(bar);
        __syncthreads();
        pg8::Gemm g{WSP(bf16_t, WS_H2), WSP(bf16_t, WS_EGUT), D, WSP(int, WS_SLOT_TOK), 128, 512 * 128}; MoeOrder S{WSP(unsigned, WS_CTL) + CW_UNITS, (int)WSP(unsigned, WS_CTL)[CW_TOFF + NE], 2, F.G, F.bx, 1048576u}; EpiGU E{WSP(bf16_t, WS_HBUF)};
        pg8::gemm_phase<EpiGU, MoeOrder, true>(F.lds, g, S, E);
    }
    SEAM(12);
    if (IN(13)) _Pragma("unroll 1") for (int rp = 0; rp < NREP(13); ++rp) { asm volatile("" : "+v"(F.tid)); if (rp) xcd_barrier(bar);
        __syncthreads();
        { pg8::Gemm g{WSP(bf16_t, WS_HBUF), WSP(bf16_t, WS_EDT), EH, nullptr, 128, 1024 * 128}; MoeOrder S{WSP(unsigned, WS_CTL) + CW_UNITS, (int)WSP(unsigned, WS_CTL)[CW_TOFF + NE], 4, F.G, F.bx, 524288u}; EpiDown<true, true> E{WSP(bf16_t, WS_YBUF), WSP(float, WS_SLOT_W)};
          pg8::gemm_phase<EpiDown<true, true>, MoeOrder, false>(F.lds, g, S, E); }
        { pg8::Gemm g{WSP(bf16_t, WS_HSH), WSP(bf16_t, WS_SHDT), EH, nullptr, 2 * EH, 128}; pg8::StaticOrder S; S.init(T, D, EH, F.G, F.bx); EpiDown<false> E{WSP(bf16_t, WS_YSH), nullptr};
          pg8::gemm_phase<EpiDown<false>, pg8::StaticOrder, false>(F.lds, g, S, E); }
    }
    SEAM(13);
    if (IN(14)) _Pragma("unroll 1") for (int rp = 0; rp < NREP(14); ++rp) { asm volatile("" : "+v"(F.tid)); if (rp) xcd_barrier(bar); phase_final(F); }
#undef IN
#undef SEAM
}

extern "C" void kernel_launch(void* const* d_in, const int* in_sizes, int n_in, void* d_out, int out_size, void* d_ws, size_t ws_size, hipStream_t stream) {
    static int grid = 0;
    if (grid == 0) {
        if (n_in != 34 || out_size != T * D || ws_size < WS_END) { fprintf(stderr, "kernel_launch: unexpected shapes (n_in %d, out %d, ws %zu < %zu)\n", n_in, out_size, ws_size, (size_t)WS_END); grid = -1; return; }
        int dev = 0, cus = 0, per_cu = 0;
        if (hipGetDevice(&dev) != hipSuccess || hipDeviceGetAttribute(&cus, hipDeviceAttributeMultiprocessorCount, dev) != hipSuccess) { grid = -1; return; }
        if (hipFuncSetAttribute((const void*)hyena_hgrn2_moe_fwd, hipFuncAttributeMaxDynamicSharedMemorySize, LDS_BYTES) != hipSuccess) { fprintf(stderr, "kernel_launch: hipFuncSetAttribute failed\n"); grid = -1; return; }
        if (hipOccupancyMaxActiveBlocksPerMultiprocessor(&per_cu, (const void*)hyena_hgrn2_moe_fwd, 512, LDS_BYTES) != hipSuccess || per_cu < 1) { fprintf(stderr, "kernel_launch: occupancy query failed (%d)\n", per_cu); (void)hipGetLastError(); per_cu = 1; }
        grid = cus * per_cu; if (grid > 256) grid = 256;
    }
    if (grid < 0) return;
    if (hipMemsetAsync((char*)d_ws + WS_CTL, 0, CTL_BYTES, stream) != hipSuccess) { fprintf(stderr, "kernel_launch: memset failed\n"); return; }
    Params p{};
    for (int i = 0; i < 34; ++i) p.in[i] = (const float*)d_in[i];
    p.out = (float*)d_out; p.ws = (unsigned char*)d_ws;
#if MK_LAUNCH_PER_PHASE
    for (int k = 0; k < NPHASE; ++k) { p.ph_lo = k; p.ph_hi = k + 1; void* args[] = {&p};
        hipError_t e = hipLaunchCooperativeKernel((const void*)hyena_hgrn2_moe_fwd, dim3(grid), dim3(512), args, LDS_BYTES, stream);
        if (e != hipSuccess) { fprintf(stderr, "kernel_launch: launch %d failed: %s\n", k, hipGetErrorString(e)); break; } }
#else
    p.ph_lo = 0; p.ph_hi = NPHASE; void* args[] = {&p};
    hipError_t e = hipLaunchCooperativeKernel((const void*)hyena_hgrn2_moe_fwd, dim3(grid), dim3(512), args, LDS_BYTES, stream);
    if (e != hipSuccess) fprintf(stderr, "kernel_launch: cooperative launch failed: %s (grid %d)\n", hipGetErrorString(e), grid);
#endif
}
```

```cpp
#include <hip/hip_runtime.h>
#include <hip/hip_cooperative_groups.h>
#include <cstdio>
#include <cstdint>
namespace cg = cooperative_groups;

#define LAS __attribute__((address_space(3)))
typedef unsigned short bf16_t;
typedef short bf16x8 __attribute__((ext_vector_type(8)));
typedef float f32x4 __attribute__((ext_vector_type(4)));
typedef float f32x2 __attribute__((ext_vector_type(2)));
typedef unsigned u32x4 __attribute__((ext_vector_type(4)));
typedef unsigned u32x2 __attribute__((ext_vector_type(2)));

constexpr int D = 1024, NB = 2, SEQ = 8192, T = NB * SEQ, CTXL = 256, TC = NB * CTXL, MA = T + TC, NEXT = CTXL + SEQ;
constexpr int HYW = 512, HYP = 1536, HGW = 512, INC = 6144;
constexpr int NE = 256, TOPK = 8, EH = 256, NASG = T * TOPK;
constexpr int NCH_EXT = NEXT / 64  , NCH_LAT = SEQ / 64  , NCHAIN = 16, NAITEM = NCHAIN * NCH_EXT  ;
constexpr int FFTN = 16384;
constexpr float EPS = 1e-6f;

constexpr size_t al256(size_t x) { return (x + 255) & ~(size_t)255; }
constexpr size_t WS_CTL = 0, CTL_BYTES = 65536;
constexpr size_t WS_WINT = WS_CTL + CTL_BYTES;
constexpr size_t WS_WHYT = WS_WINT + (size_t)INC * D * 2;
constexpr size_t WS_WHGT = WS_WHYT + (size_t)D * HYW * 2;
constexpr size_t WS_WOUTT = WS_WHGT + (size_t)D * HGW * 2;
constexpr size_t WS_ROUT = WS_WOUTT + (size_t)D * D * 2;
constexpr size_t WS_SHGUT = WS_ROUT + (size_t)NE * D * 2;
constexpr size_t WS_SHDT = WS_SHGUT + (size_t)512 * D * 2;
constexpr size_t WS_ADAP = WS_SHDT + (size_t)D * 256 * 2;
constexpr size_t WS_ADA = WS_ADAP + (size_t)32 * 3 * 6144 * 4;
constexpr size_t WS_POSR = WS_ADA + (size_t)3 * 6144 * 4;
constexpr size_t WS_POSC = WS_POSR + (size_t)128 * 512 * 4;
constexpr size_t WS_LBS = WS_POSC + (size_t)64 * 512 * 4;
constexpr size_t WS_ROUTE_E = WS_LBS + 4096;
constexpr size_t WS_ROUTE_W = WS_ROUTE_E + (size_t)NASG * 4;
constexpr size_t WS_ROUTE_P = WS_ROUTE_W + (size_t)NASG * 4;
constexpr size_t WS_SLOTOF = WS_ROUTE_P + (size_t)NASG * 4;
constexpr size_t WS_SLOT_TOK = WS_SLOTOF + (size_t)NASG * 4;
constexpr size_t WS_SLOT_W = WS_SLOT_TOK + (size_t)(NASG + 256) * 4;
constexpr size_t WS_EGUT = al256(WS_SLOT_W + (size_t)(NASG + 256) * 4);
constexpr size_t WS_EDT = WS_EGUT + (size_t)NE * 512 * D * 2;
constexpr size_t WS_RA = WS_EDT + (size_t)NE * D * EH * 2;
constexpr size_t RA_BYTES = (size_t)NASG * D * 2;
constexpr size_t WS_HF = WS_RA;
constexpr size_t WS_KS = WS_HF + (size_t)2048 * SEQ * 4;
constexpr size_t WS_DELTA = WS_KS + (size_t)256 * 2 * FFTN * 8;
constexpr size_t WS_DECAY = WS_DELTA + (size_t)NAITEM * 16384 * 2;
constexpr size_t WS_PHYT = WS_DECAY + (size_t)NAITEM * 128 * 4;
static_assert(WS_PHYT + (size_t)NB * HYP * SEQ * 2 <= WS_RA + RA_BYTES, "region A overflow");
constexpr size_t WS_YBUF = WS_RA;
constexpr size_t WS_RB = WS_RA + RA_BYTES;
constexpr size_t WS_VT = WS_RB;
constexpr size_t WS_Q = WS_VT + (size_t)NB * HGW * NEXT * 2;
constexpr size_t WS_LF = WS_Q + (size_t)T * HGW * 2;
constexpr size_t WS_LB = WS_LF + (size_t)NB * NEXT * HGW * 4;
constexpr size_t WS_G = WS_LB + (size_t)NB * NEXT * HGW * 4;
constexpr size_t WS_SG1 = WS_G + (size_t)T * HGW * 2;
constexpr size_t WS_SG2 = WS_SG1 + (size_t)T * D * 2;
constexpr size_t WS_A1 = WS_SG2 + (size_t)T * D * 2;
constexpr size_t WS_SST = WS_A1 + (size_t)MA * D * 2;
constexpr size_t WS_YHG = WS_SST + (size_t)NCHAIN * NCH_LAT * 16384 * 2 + 256 * 512;
constexpr size_t WS_T1 = WS_YHG + (size_t)T * HGW * 2;
constexpr size_t WS_END = WS_T1 + (size_t)T * D * 4;
constexpr size_t WS_LOGIT = WS_VT, WS_HSH = WS_Q, WS_MB = WS_LF, WS_H2 = WS_LB, WS_YSH = WS_SG1, WS_YHYT = WS_A1, WS_YHY = WS_A1 + (size_t)NB * HYW * SEQ * 2, WS_HBUF = WS_SST;
static_assert((size_t)T * 256 * 4 <= (size_t)NB * HGW * NEXT * 2, "LOGIT fits VT");
static_assert(WS_YHY + (size_t)T * HYW * 2 <= WS_SST, "YHY fits A1");
static_assert((size_t)(NASG + 256) * EH * 2 <= (size_t)NCHAIN * NCH_LAT * 16384 * 2 + 256 * 512, "HBUF fits SST");
static_assert(WS_END <= (size_t)1073741824, "workspace map exceeds 1 GiB");
constexpr int CW_CNT = 0;
constexpr int CW_START = 512;
constexpr int CW_TOFF = 1024;
constexpr int CW_BAR = 4096;
constexpr int CW_UNITS = 8192;

constexpr int LDS_BYTES = 147456;
constexpr int LDS_BARST = LDS_BYTES - 64;

__device__ __forceinline__ unsigned f2bf(float f) { unsigned u = __float_as_uint(f); return (u + 0x7fffu + ((u >> 16) & 1u)) >> 16; }
__device__ __forceinline__ unsigned pk2(float lo, float hi) { return f2bf(lo) | (f2bf(hi) << 16); }
__device__ __forceinline__ float bf2f(unsigned b) { return __uint_as_float(b << 16); }
__device__ __forceinline__ float bflo(unsigned w) { return __uint_as_float(w << 16); }
__device__ __forceinline__ float bfhi(unsigned w) { return __uint_as_float(w & 0xffff0000u); }
__device__ __forceinline__ float sigmoidf_(float x) { return __builtin_amdgcn_rcpf(1.0f + __expf(-x)); }
__device__ __forceinline__ float siluf_(float x) { return x * __builtin_amdgcn_rcpf(1.0f + __expf(-x)); }
__device__ __forceinline__ unsigned f2h(float f) { return (unsigned)__builtin_bit_cast(unsigned short, (_Float16)f); }
__device__ __forceinline__ unsigned pkh2(float lo, float hi) { return f2h(lo) | (f2h(hi) << 16); }
__device__ __forceinline__ float h2f(unsigned short b) { return (float)__builtin_bit_cast(_Float16, b); }
__device__ __forceinline__ float wave_sum(float v) {
#pragma unroll
    for (int o = 1; o < 64; o <<= 1) v += __shfl_xor(v, o);
    return v;
}
#define LDS_WAIT() asm volatile("s_waitcnt lgkmcnt(0)" ::: "memory")

struct Params {
    const float* in[34];
    float* out;
    unsigned char* ws;
    int ph_lo, ph_hi;
};
enum { I_X = 0, I_C, I_CTX, I_CCTX, I_N1G, I_N2G, I_ADAW, I_ADAB, I_WIN, I_HCW, I_HCB, I_FW1, I_FB1, I_FW2, I_FB2, I_FW3, I_FB3, I_FW4, I_FFREQ, I_HSKIP,
       I_LBL, I_HGNG, I_WHY, I_WHG, I_WOUT, I_RW, I_RB, I_EG, I_EU, I_ED, I_SG, I_SU, I_SD, I_FG };
namespace pg8 {
constexpr int BM = 256, BK = 64, HALF = 128, HTB = HALF * BK * 2, STAGE_BYTES = 8 * HTB;
__host__ __device__ __forceinline__ int lds_byte(int r, int c) { const int st = (r >> 4) * 2 + (c >> 5), rr = r & 15, cc = c & 31, ob = rr * 64 + cc * 2; return st * 1024 + (ob ^ (((ob >> 9) & 1) << 5)); }
__host__ __device__ __forceinline__ void stage_rc(int b, int& R, int& C) { const int st = b / 1024, sb = b % 1024, swz = sb ^ (((sb >> 9) & 1) << 5); R = (st >> 1) * 16 + swz / 64; C = (st & 1) * 32 + (swz % 64) / 2; }
__host__ __device__ __forceinline__ int perm32(int rho) { const int n = rho >> 4, i = rho & 15; return 8 * (i >> 2) + 4 * n + (i & 3); }

struct Unit { int row0, lrow, pn, nvalid, aux, kind; unsigned boff; };
struct Gemm { const bf16_t* A; const bf16_t* Bt; int K; const int* rows; int ldb, kstepB; };

__device__ __forceinline__ unsigned cvt_pk_bf16(float lo, float hi) { unsigned r; asm volatile("v_cvt_pk_bf16_f32 %0, %1, %2" : "=v"(r) : "v"(lo), "v"(hi)); return r; }

template <class Epi, class Sched, bool GATHER>
__device__ __forceinline__ void gemm_phase(LAS unsigned char* lds, const Gemm g, const Sched& S, const Epi& E) {
    const int tid = threadIdx.x, wid = __builtin_amdgcn_readfirstlane(tid >> 6), lane = tid & 63, wr = wid >> 2, wc = wid & 3, fr = lane & 15, fq = lane >> 4;
    int K_ = g.K; asm volatile("" : "+s"(K_));
    const int K = K_, nt = K / BK; int ldb_ = g.ldb, ksb_ = g.kstepB; asm volatile("" : "+s"(ldb_), "+s"(ksb_));
    unsigned voffA[2], voffB[2]; int RA[2], CA[2];
#pragma unroll
    for (int i = 0; i < 2; ++i) { int R, C; stage_rc(tid * 16 + i * 8192, R, C); const int Rb = Epi::PERM ? ((R & ~31) + perm32(R & 31)) : R;
        voffA[i] = (unsigned)(R * K + C) * 2u; voffB[i] = (unsigned)(Rb * ldb_ + C * 2); RA[i] = R; CA[i] = C; }
    const size_t kstep = (size_t)(BK * 2);
    const size_t hstep = (size_t)HALF * K * 2;
    const size_t kstepB = (size_t)ksb_, hstepB = (size_t)HALF * ldb_;
    const unsigned ldsw = (unsigned)wid * 1024u;
    const int aoff = lds_byte(wr * 64 + fr, fq * 8), boff = lds_byte(wc * 32 + fr, fq * 8);
    unsigned vg0[2][2], vg1[2][2];
#define PG8_SA(b, h) (((b) * 2 + (h)) * HTB)
#define PG8_SB(b, h) ((4 + (b) * 2 + (h)) * HTB)
#define PG8_STAGE(bufoff, gbase, voff) do { _Pragma("unroll") for (int _i = 0; _i < 2; ++_i) \
        __builtin_amdgcn_global_load_lds((const unsigned*)((const char*)(gbase) + (voff)[_i]), (LAS unsigned*)(lds + (bufoff) + ldsw + _i * 8192), 16, 0, 0); } while (0)
#define PG8_STAGE_A(bufoff, gbase, h, w) do { _Pragma("unroll") for (int _i = 0; _i < 2; ++_i) { \
        const unsigned _o = GATHER ? ((w) ? vg1[h][_i] : vg0[h][_i]) : (voffA[_i] + (unsigned)((h) * hstep)); \
        __builtin_amdgcn_global_load_lds((const unsigned*)((const char*)(gbase) + _o), (LAS unsigned*)(lds + (bufoff) + ldsw + _i * 8192), 16, 0, 0); } } while (0)
#define PG8_LDA(dst, b, h) do { _Pragma("unroll") for (int m = 0; m < 4; ++m) _Pragma("unroll") for (int k = 0; k < 2; ++k) dst[m][k] = *(const LAS bf16x8*)(lds + PG8_SA(b, h) + aoff + m * 2048 + k * 1024); } while (0)
#define PG8_LDB(dst, b, h) do { _Pragma("unroll") for (int n = 0; n < 2; ++n) _Pragma("unroll") for (int k = 0; k < 2; ++k) dst[n][k] = *(const LAS bf16x8*)(lds + PG8_SB(b, h) + boff + n * 2048 + k * 1024); } while (0)
#define PG8_MMA(ai, bj, At, Bt) do { __builtin_amdgcn_s_setprio(1); _Pragma("unroll") for (int m = 0; m < 4; ++m) _Pragma("unroll") for (int n = 0; n < 2; ++n) _Pragma("unroll") for (int k = 0; k < 2; ++k) \
        acc[ai][bj][m][n] = __builtin_amdgcn_mfma_f32_16x16x32_bf16(Bt[n][k], At[m][k], acc[ai][bj][m][n], 0, 0, 0); __builtin_amdgcn_s_setprio(0); } while (0)
#define PG8_WAIT_V(n) asm volatile("s_waitcnt vmcnt(" #n ")" ::: "memory")
#define PG8_WAIT_L(n) asm volatile("s_waitcnt lgkmcnt(" #n ")" ::: "memory")
#define PG8_BAR __builtin_amdgcn_s_barrier()
#define PG8_SCHED __builtin_amdgcn_sched_barrier(0)
#define PG8_GOFF(dst, u) do { if (GATHER) { _Pragma("unroll") for (int _h = 0; _h < 2; ++_h) _Pragma("unroll") for (int _i = 0; _i < 2; ++_i) \
        dst[_h][_i] = (unsigned)(g.rows[(u).row0 + _h * HALF + RA[_i]] * K + CA[_i]) * 2u; } } while (0)
    Unit cur, nxt; int ui = 0;
    if (!S.next(0, cur)) return;
    f32x4 acc[2][2][4][2];
#pragma unroll
    for (int a = 0; a < 2; ++a)
#pragma unroll
        for (int b = 0; b < 2; ++b)
#pragma unroll
            for (int m = 0; m < 4; ++m)
#pragma unroll
                for (int n = 0; n < 2; ++n) acc[a][b][m][n] = (f32x4){0.f, 0.f, 0.f, 0.f};
    bf16x8 At[4][2], B0[2][2], B1[2][2];
    const char* cA = (const char*)g.A + (GATHER ? (size_t)0 : (size_t)cur.row0 * K * 2); const char* cB = (const char*)g.Bt + cur.boff;
    PG8_GOFF(vg0, cur);
#pragma unroll
    for (int _h = 0; _h < 2; ++_h)
#pragma unroll
        for (int _i = 0; _i < 2; ++_i) vg1[_h][_i] = vg0[_h][_i];
    PG8_STAGE(PG8_SB(0, 0), cB, voffB); PG8_STAGE_A(PG8_SA(0, 0), cA, 0, false); PG8_STAGE(PG8_SB(0, 1), cB + hstepB, voffB); PG8_STAGE_A(PG8_SA(0, 1), cA, 1, false);
    if (wr == 1) PG8_BAR;
    PG8_WAIT_V(4); PG8_BAR;
    PG8_STAGE(PG8_SB(1, 0), cB + kstepB, voffB); PG8_STAGE_A(PG8_SA(1, 0), cA + kstep, 0, false); PG8_STAGE(PG8_SB(1, 1), cB + hstepB + kstepB, voffB);
    PG8_WAIT_V(6); PG8_BAR;
    for (;;) {
        const bool has_next = S.next(ui + 1, nxt);
        if (has_next) PG8_GOFF(vg1, nxt);
        const char* nA = has_next ? (const char*)g.A + (GATHER ? (size_t)0 : (size_t)nxt.row0 * K * 2) : cA; const char* nB = has_next ? (const char*)g.Bt + nxt.boff : cB;
        const bool full = cur.nvalid > HALF;
        for (int t = 0; t < nt; t += 2) {
            const bool last = (t == nt - 2);
            const bool wn = last && has_next;
            const char* a1 = cA + (size_t)(t + 1) * kstep;
            const char* a2 = last ? nA : cA + (size_t)(t + 2) * kstep; const char* b2 = last ? nB : cB + (size_t)(t + 2) * kstepB;
            const char* a3 = a2 + kstep; const char* b3 = b2 + kstepB;
            PG8_LDB(B0, 0, 0); PG8_SCHED; PG8_LDA(At, 0, 0); PG8_STAGE_A(PG8_SA(1, 1), a1, 1, false);
            PG8_WAIT_L(8); PG8_BAR; PG8_WAIT_L(0); PG8_MMA(0, 0, At, B0); PG8_BAR; PG8_SCHED;
            PG8_LDB(B1, 0, 1); PG8_STAGE(PG8_SB(0, 0), b2, voffB);
            PG8_BAR; PG8_WAIT_L(0); PG8_MMA(0, 1, At, B1); PG8_BAR;
            if (full) PG8_LDA(At, 0, 1); PG8_STAGE_A(PG8_SA(0, 0), a2, 0, wn);
            PG8_BAR; PG8_WAIT_L(0); if (full) PG8_MMA(1, 0, At, B0); PG8_BAR; PG8_SCHED;
            PG8_STAGE(PG8_SB(0, 1), b2 + hstepB, voffB);
            PG8_WAIT_V(6); PG8_BAR; if (full) PG8_MMA(1, 1, At, B1); PG8_BAR;
            PG8_LDB(B0, 1, 0); PG8_SCHED; PG8_LDA(At, 1, 0); PG8_STAGE_A(PG8_SA(0, 1), a2, 1, wn);
            PG8_WAIT_L(8); PG8_BAR; PG8_WAIT_L(0); PG8_MMA(0, 0, At, B0); PG8_BAR; PG8_SCHED;
            PG8_LDB(B1, 1, 1); PG8_STAGE(PG8_SB(1, 0), b3, voffB);
            PG8_BAR; PG8_WAIT_L(0); PG8_MMA(0, 1, At, B1); PG8_BAR;
            if (full) PG8_LDA(At, 1, 1); PG8_STAGE_A(PG8_SA(1, 0), a3, 0, wn);
            PG8_BAR; PG8_WAIT_L(0); if (full) PG8_MMA(1, 0, At, B0); PG8_BAR; PG8_SCHED;
            PG8_STAGE(PG8_SB(1, 1), b3 + hstepB, voffB);
            PG8_WAIT_V(6); PG8_BAR; if (full) PG8_MMA(1, 1, At, B1); PG8_BAR;
        }
        { int fr_ = fr, fq_ = fq; asm volatile("" : "+v"(fr_), "+v"(fq_)); E(acc, cur, wr, wc, fr_, fq_); }
        if (!has_next) break;
#pragma unroll
        for (int a = 0; a < 2; ++a)
#pragma unroll
            for (int b = 0; b < 2; ++b)
#pragma unroll
                for (int m = 0; m < 4; ++m)
#pragma unroll
                    for (int n = 0; n < 2; ++n) acc[a][b][m][n] = (f32x4){0.f, 0.f, 0.f, 0.f};
        cur = nxt; cA = nA; cB = nB; ++ui;
#pragma unroll
        for (int _h = 0; _h < 2; ++_h)
#pragma unroll
            for (int _i = 0; _i < 2; ++_i) vg0[_h][_i] = vg1[_h][_i];
    }
    PG8_WAIT_V(0);
    if (wr == 0) PG8_BAR;
    PG8_BAR;
#undef PG8_SA
#undef PG8_SB
#undef PG8_STAGE
#undef PG8_STAGE_A
#undef PG8_LDA
#undef PG8_LDB
#undef PG8_MMA
#undef PG8_WAIT_V
#undef PG8_WAIT_L
#undef PG8_BAR
#undef PG8_SCHED
#undef PG8_GOFF
}

struct StaticOrder {
    int nM, nN, nwg, G, c, Kb;
    __device__ void init(int M, int N, int K, int G_, int c_) { nM = M / BM; nN = N / BM; nwg = nM * nN; G = G_; c = c_; Kb = K; }
    __device__ bool next(int i, Unit& u) const {
        const long L = (long)i * G + c; if (L >= nwg) return false;
        int wgid = (int)L; { const int NXCD = 8; const int q = nwg / NXCD, r = nwg % NXCD, xcd = wgid % NXCD, off = wgid / NXCD; wgid = (xcd < r ? xcd * (q + 1) : r * (q + 1) + (xcd - r) * q) + off; }
        const int WGM = 8; const int nig = WGM * nN, gid = wgid / nig, fm = gid * WGM, gsz = (nM - fm) < WGM ? (nM - fm) : WGM;
        u.row0 = (fm + ((wgid % nig) % gsz)) * BM; u.lrow = u.row0; u.pn = (wgid % nig) / gsz; u.nvalid = BM; u.aux = u.pn; u.kind = 0; u.boff = (unsigned)u.pn * (unsigned)(BM * 2) * (unsigned)Kb; return true;
    }
};
}
using pg8::Unit; using pg8::cvt_pk_bf16;
typedef const f32x4 (&AccRef)[2][2][4][2];

struct MoeOrder {
    const unsigned* units; int ntile, nsub, G, c; unsigned ebytes;
    __device__ bool next(int i, Unit& u) const {
        const long L = (long)i * G + c; const int nun = ntile * nsub; if (L >= nun) return false;
        int idx = (int)L; { const int q = nun / 8, r = nun % 8, xcd = idx % 8, off = idx / 8; idx = (xcd < r ? xcd * (q + 1) : r * (q + 1) + (xcd - r) * q) + off; }
        const int tile = idx / nsub, sub = idx % nsub;
        const u32x4 d = *(const u32x4*)(units + 4 * tile);
        u.row0 = (int)d.x; u.lrow = u.row0; u.pn = (int)d.y * nsub + sub; u.nvalid = (int)d.z; u.aux = sub; u.kind = 0; u.boff = d.y * ebytes + (unsigned)sub * 32768u; return true;
    }
};

struct EpiInT {
    static constexpr bool PERM = true;
    bf16_t* phyt; bf16_t* vt;
    __device__ __forceinline__ void operator()(AccRef acc, const Unit& u, int wr, int wc, int fr, int fq) const {
        const int pm = u.lrow >> 8, tb = u.pn * 256; const bool isctx = tb >= T;
        int b, nbase; if (!isctx) { b = tb >> 13; nbase = tb & (SEQ - 1); } else { b = (tb - T) >> 8; nbase = 0; }
        if (pm < 6 && isctx) return;
#pragma unroll
        for (int ai = 0; ai < 2; ++ai)
#pragma unroll
            for (int m = 0; m < 4; ++m) {
                const int f = u.lrow + ai * 128 + wr * 64 + m * 16 + fr;
                bf16_t* rowp = (pm < 6) ? phyt + ((size_t)(b * HYP + f) * SEQ + nbase) : vt + ((size_t)(b * HGW + (f - HYP)) * NEXT + (isctx ? 0 : CTXL) + nbase);
#pragma unroll
                for (int bj = 0; bj < 2; ++bj) { const int cu = bj * 128 + wc * 32 + 8 * fq; const f32x4 v0 = acc[ai][bj][m][0], v1 = acc[ai][bj][m][1];
                    u32x4 w; w.x = cvt_pk_bf16(v0[0], v0[1]); w.y = cvt_pk_bf16(v0[2], v0[3]); w.z = cvt_pk_bf16(v1[0], v1[1]); w.w = cvt_pk_bf16(v1[2], v1[3]);
                    *(u32x4*)(rowp + cu) = w; }
            }
    }
};
struct EpiInN {
    static constexpr bool PERM = true;
    bf16_t *q, *g, *sg1, *sg2; float *lf, *lb; const float* lbs;
    __device__ __forceinline__ void operator()(AccRef acc, const Unit& u, int wr, int wc, int fr, int fq) const {
        const int pn = u.pn; const bool isctx = u.lrow >= T;
        if (isctx && (pn < 2 || pn > 5)) return;
        float lbu[2][8];
        if (pn >= 2 && pn < 6) {
#pragma unroll
            for (int bj = 0; bj < 2; ++bj) { const float* lbp = lbs + (pn >= 4) * 512 + (pn & 1) * 256 + bj * 128 + wc * 32 + 8 * fq; const f32x4 l0 = *(const f32x4*)lbp, l1 = *(const f32x4*)(lbp + 4);
                lbu[bj][0] = l0[0]; lbu[bj][1] = l0[1]; lbu[bj][2] = l0[2]; lbu[bj][3] = l0[3]; lbu[bj][4] = l1[0]; lbu[bj][5] = l1[1]; lbu[bj][6] = l1[2]; lbu[bj][7] = l1[3]; } }
#pragma unroll
        for (int ai = 0; ai < 2; ++ai)
#pragma unroll
            for (int m = 0; m < 4; ++m) {
                const int r = u.lrow + ai * 128 + wr * 64 + m * 16 + fr;
                int b, nx; if (!isctx) { b = r >> 13; nx = CTXL + (r & (SEQ - 1)); } else { const int rr = r - T; b = rr >> 8; nx = rr & 255; }
#pragma unroll
                for (int bj = 0; bj < 2; ++bj) { const int cu = bj * 128 + wc * 32 + 8 * fq; const f32x4 v0 = acc[ai][bj][m][0], v1 = acc[ai][bj][m][1];
                    float x[8] = {v0[0], v0[1], v0[2], v0[3], v1[0], v1[1], v1[2], v1[3]};
                    if (pn >= 2 && pn < 6) {
                        const int dir = pn >= 4, col = (pn & 1) * 256 + cu;
                        float o[8];
#pragma unroll
                        for (int j = 0; j < 8; ++j) o[j] = __logf(lbu[bj][j] + (1.0f - lbu[bj][j]) * sigmoidf_(x[j]));
                        float* dst = (dir ? lb : lf) + ((size_t)(b * NEXT + nx) * HGW + col);
                        *(f32x4*)dst = (f32x4){o[0], o[1], o[2], o[3]}; *(f32x4*)(dst + 4) = (f32x4){o[4], o[5], o[6], o[7]};
                    } else {
                        bf16_t* dst;
                        if (pn < 2) { dst = q + (size_t)r * HGW + pn * 256 + cu;
#pragma unroll
                            for (int j = 0; j < 8; ++j) x[j] = siluf_(x[j]); }
                        else if (pn < 8) { dst = g + (size_t)r * HGW + (pn - 6) * 256 + cu;
#pragma unroll
                            for (int j = 0; j < 8; ++j) x[j] = siluf_(x[j]); }
                        else { dst = (pn < 12 ? sg1 + (size_t)r * D + (pn - 8) * 256 : sg2 + (size_t)r * D + (pn - 12) * 256) + cu;
#pragma unroll
                            for (int j = 0; j < 8; ++j) x[j] = sigmoidf_(x[j]); }
                        u32x4 w; w.x = cvt_pk_bf16(x[0], x[1]); w.y = cvt_pk_bf16(x[2], x[3]); w.z = cvt_pk_bf16(x[4], x[5]); w.w = cvt_pk_bf16(x[6], x[7]);
                        *(u32x4*)dst = w;
                    }
                }
            }
    }
};
struct EpiMerge1 {
    static constexpr bool PERM = false;
    const bf16_t* sg1; bf16_t* t1;
    __device__ __forceinline__ void operator()(AccRef acc, const Unit& u, int wr, int wc, int fr, int fq) const {
#pragma unroll
        for (int ai = 0; ai < 2; ++ai) { u32x2 s[4][2][2];
#pragma unroll
            for (int m = 0; m < 4; ++m) { const size_t ro = (size_t)(u.lrow + ai * 128 + wr * 64 + m * 16 + fr) * D + u.pn * 256 + wc * 32 + 4 * fq;
#pragma unroll
                for (int bj = 0; bj < 2; ++bj)
#pragma unroll
                    for (int n = 0; n < 2; ++n) s[m][bj][n] = *(const u32x2*)(sg1 + ro + bj * 128 + n * 16); }
#pragma unroll
            for (int m = 0; m < 4; ++m) { const size_t ro = (size_t)(u.lrow + ai * 128 + wr * 64 + m * 16 + fr) * D + u.pn * 256 + wc * 32 + 4 * fq;
#pragma unroll
                for (int bj = 0; bj < 2; ++bj)
#pragma unroll
                    for (int n = 0; n < 2; ++n) { const f32x4 a = acc[ai][bj][m][n]; const u32x2 sv = s[m][bj][n];
                        u32x2 w; w.x = cvt_pk_bf16(a[0] * bflo(sv.x), a[1] * bfhi(sv.x)); w.y = cvt_pk_bf16(a[2] * bflo(sv.y), a[3] * bfhi(sv.y));
                        *(u32x2*)(t1 + ro + bj * 128 + n * 16) = w; } } }
    }
};
struct EpiMerge2 {
    static constexpr bool PERM = false;
    const bf16_t* sg2; const bf16_t* t1; bf16_t* mb;
    __device__ __forceinline__ void operator()(AccRef acc, const Unit& u, int wr, int wc, int fr, int fq) const {
#pragma unroll
        for (int ai = 0; ai < 2; ++ai)
#pragma unroll
            for (int m = 0; m < 4; ++m) { u32x2 s[2][2]; u32x2 p[2][2];
                const size_t ro = (size_t)(u.lrow + ai * 128 + wr * 64 + m * 16 + fr) * D + u.pn * 256 + wc * 32 + 4 * fq;
#pragma unroll
                for (int bj = 0; bj < 2; ++bj)
#pragma unroll
                    for (int n = 0; n < 2; ++n) { s[bj][n] = *(const u32x2*)(sg2 + ro + bj * 128 + n * 16); p[bj][n] = *(const u32x2*)(t1 + ro + bj * 128 + n * 16); }
#pragma unroll
                for (int bj = 0; bj < 2; ++bj)
#pragma unroll
                    for (int n = 0; n < 2; ++n) { const f32x4 a = acc[ai][bj][m][n]; const u32x2 pq = p[bj][n]; const f32x4 pv = (f32x4){bflo(pq.x), bfhi(pq.x), bflo(pq.y), bfhi(pq.y)}; const u32x2 sv = s[bj][n];
                        u32x2 w; w.x = cvt_pk_bf16(pv[0] + a[0] * bflo(sv.x), pv[1] + a[1] * bfhi(sv.x)); w.y = cvt_pk_bf16(pv[2] + a[2] * bflo(sv.y), pv[3] + a[3] * bfhi(sv.y));
                        *(u32x2*)(mb + ro + bj * 128 + n * 16) = w; } }
    }
};
struct EpiWout {
    static constexpr bool PERM = false;
    const float* x; const float* posr; const float* posc; const float* ada; float* x1;
    __device__ __forceinline__ void operator()(AccRef acc, const Unit& u, int wr, int wc, int fr, int fq) const {
        const int b = u.lrow >> 13, cb = u.pn * 256 + wc * 32 + 4 * fq;
        f32x4 g1[2][2];
#pragma unroll
        for (int bj = 0; bj < 2; ++bj)
#pragma unroll
            for (int nn = 0; nn < 2; ++nn) g1[bj][nn] = *(const f32x4*)(ada + b * 6144 + 2 * D + cb + bj * 128 + nn * 16);
#pragma unroll
        for (int ai = 0; ai < 2; ++ai)
#pragma unroll
            for (int m = 0; m < 4; ++m) { f32x4 xv[2][2], pe[2][2];
                const int r = u.lrow + ai * 128 + wr * 64 + m * 16 + fr, n = r & (SEQ - 1);
#pragma unroll
                for (int bj = 0; bj < 2; ++bj)
#pragma unroll
                    for (int nn = 0; nn < 2; ++nn) { const int c = cb + bj * 128 + nn * 16; xv[bj][nn] = *(const f32x4*)(x + (size_t)r * D + c);
                        pe[bj][nn] = (c < 512) ? *(const f32x4*)(posr + (n >> 6) * 512 + c) : *(const f32x4*)(posc + (n & 63) * 512 + (c - 512)); }
#pragma unroll
                for (int bj = 0; bj < 2; ++bj)
#pragma unroll
                    for (int nn = 0; nn < 2; ++nn) *(f32x4*)(x1 + (size_t)r * D + cb + bj * 128 + nn * 16) = xv[bj][nn] + pe[bj][nn] + g1[bj][nn] * acc[ai][bj][m][nn]; }
    }
};
struct EpiLogit {
    static constexpr bool PERM = true;
    float* lg;
    __device__ __forceinline__ void operator()(AccRef acc, const Unit& u, int wr, int wc, int fr, int fq) const {
#pragma unroll
        for (int ai = 0; ai < 2; ++ai)
#pragma unroll
            for (int m = 0; m < 4; ++m) { float* rp = lg + (size_t)(u.lrow + ai * 128 + wr * 64 + m * 16 + fr) * NE + wc * 32 + 8 * fq;
#pragma unroll
                for (int bj = 0; bj < 2; ++bj) { *(f32x4*)(rp + bj * 128) = acc[ai][bj][m][0]; *(f32x4*)(rp + bj * 128 + 4) = acc[ai][bj][m][1]; } }
    }
};
struct EpiGU {
    static constexpr bool PERM = true;
    bf16_t* hout;
    __device__ __forceinline__ void operator()(AccRef acc, const Unit& u, int wr, int wc, int fr, int fq) const {
#pragma unroll
        for (int ai = 0; ai < 2; ++ai)
#pragma unroll
            for (int m = 0; m < 4; ++m) { const int rl = ai * 128 + wr * 64 + m * 16 + fr;
                if (rl < u.nvalid) { const f32x4 g0 = acc[ai][0][m][0], g1 = acc[ai][0][m][1], u0 = acc[ai][1][m][0], u1 = acc[ai][1][m][1];
                    u32x4 w; w.x = cvt_pk_bf16(siluf_(g0[0]) * u0[0], siluf_(g0[1]) * u0[1]); w.y = cvt_pk_bf16(siluf_(g0[2]) * u0[2], siluf_(g0[3]) * u0[3]);
                    w.z = cvt_pk_bf16(siluf_(g1[0]) * u1[0], siluf_(g1[1]) * u1[1]); w.w = cvt_pk_bf16(siluf_(g1[2]) * u1[2], siluf_(g1[3]) * u1[3]);
                    *(u32x4*)(hout + (size_t)(u.lrow + rl) * EH + u.aux * 128 + wc * 32 + 8 * fq) = w; } }
    }
};
template <bool HASW, bool FP8 = false> struct EpiDown {
    static constexpr bool PERM = true;
    bf16_t* yout; const float* wrow;
    __device__ __forceinline__ void operator()(AccRef acc, const Unit& u, int wr, int wc, int fr, int fq) const {
        char* base = (char*)yout + ((size_t)u.lrow * D + u.aux * 256 + wc * 32) * (FP8 ? 1 : 2);
        float wv[2][4];
#pragma unroll
        for (int ai = 0; ai < 2; ++ai)
#pragma unroll
            for (int m = 0; m < 4; ++m) { const int rl = ai * 128 + wr * 64 + m * 16 + fr; wv[ai][m] = (HASW && rl < u.nvalid) ? wrow[u.lrow + rl] : 1.0f; }
#pragma unroll
        for (int ai = 0; ai < 2; ++ai)
#pragma unroll
            for (int m = 0; m < 4; ++m) { const int rl = ai * 128 + wr * 64 + m * 16 + fr;
                if (rl < u.nvalid) { const float w_ = wv[ai][m];
                    const unsigned off = (unsigned)(rl * D + 8 * fq) * (FP8 ? 1u : 2u);
#pragma unroll
                    for (int bj = 0; bj < 2; ++bj) { const f32x4 v0 = acc[ai][bj][m][0] * w_, v1 = acc[ai][bj][m][1] * w_;
                        if (FP8) { int a = __builtin_amdgcn_cvt_pk_fp8_f32(v0[0], v0[1], 0, false); a = __builtin_amdgcn_cvt_pk_fp8_f32(v0[2], v0[3], a, true);
                            int c = __builtin_amdgcn_cvt_pk_fp8_f32(v1[0], v1[1], 0, false); c = __builtin_amdgcn_cvt_pk_fp8_f32(v1[2], v1[3], c, true);
                            *(u32x2*)(base + off + bj * 128) = (u32x2){(unsigned)a, (unsigned)c}; }
                        else { u32x4 w; w.x = cvt_pk_bf16(v0[0], v0[1]); w.y = cvt_pk_bf16(v0[2], v0[3]); w.z = cvt_pk_bf16(v1[0], v1[1]); w.w = cvt_pk_bf16(v1[2], v1[3]);
                            *(u32x4*)(base + off + bj * 256) = w; } } } }
    }
};

constexpr int RA1 = (int)((WS_A1 - WS_WINT) / (D * 2));
static_assert((WS_A1 - WS_WINT) % (D * 2) == 0, "A1 must sit a whole number of rows above WINT");
struct InOrder {
    int G, c;
    static constexpr int N0 = 6 * 64, N1 = 2 * 64, N2 = 64 * 16, NU = N0 + N1 + N2;
    __device__ bool next(int i, Unit& u) const {
        const long L = (long)i * G + c; if (L >= NU) return false;
        int idx = (int)L; { const int q = NU / 8, r = NU % 8, xcd = idx % 8, off = idx / 8; idx = (xcd < r ? xcd * (q + 1) : r * (q + 1) + (xcd - r) * q) + off; }
        int pm, pn, kind;
        if (idx < N0 + N1) { const int g = idx >> 5, jj = idx & 31; kind = 0; pm = 4 * (g & 1) + (jj & 3); pn = 8 * (g >> 1) + (jj >> 2); }
        else { const int j = idx - N0 - N1, g = j >> 7, jj = j & 127; kind = 1; pm = 8 * g + (jj & 7); pn = jj >> 3; }
        fill(u, kind, pm, pn); return true;
    }
    __device__ static void fill(Unit& u, int kind, int pm, int pn) {
        u.kind = kind; u.pn = pn; u.lrow = pm * 256; u.nvalid = 256; u.aux = pn;
        if (kind == 0) { u.row0 = pm * 256; u.boff = (unsigned)(RA1 + pn * 256) * (unsigned)(D * 2); }
        else { u.row0 = RA1 + pm * 256; u.boff = (unsigned)(2048 + pn * 256) * (unsigned)(D * 2); }
    }
};
struct CtxUnit {
    int idx;
    __device__ static int tile(int idx) { return idx < 4 ? (idx & 1) : ((idx - 4) >> 2); }
    __device__ bool next(int i, Unit& u) const { if (i) return false;
        if (idx < 4) InOrder::fill(u, 0, 6 + (idx >> 1), 64 + (idx & 1)); else InOrder::fill(u, 1, 64 + ((idx - 4) >> 2), 2 + ((idx - 4) & 3)); return true; }
};
struct EpiIn {
    static constexpr bool PERM = true;
    EpiInT t; EpiInN n;
    __device__ __forceinline__ void operator()(AccRef acc, const Unit& u, int wr, int wc, int fr, int fq) const { if (u.kind == 0) t(acc, u, wr, wc, fr, fq); else n(acc, u, wr, wc, fr, fq); }
};
struct P9Order {
    int G, c;
    __device__ bool next(int i, Unit& u) const {
        const long L = (long)i * G + c; if (L >= 192) return false; int idx = (int)L;
        { const int xcd = idx % 8, off = idx / 8; idx = xcd * 24 + off; }
        const int pm = idx / 3, k3 = idx % 3;
        u.row0 = pm * 256;
        if (k3 == 0) { u.kind = 0; u.pn = 0; u.aux = 0; u.boff = 0u; }
        else { u.kind = 1; u.pn = k3 - 1; u.aux = k3 - 1; u.boff = (unsigned)(WS_SHGUT - WS_ROUT) + (unsigned)(k3 - 1) * (unsigned)(256 * D * 2); }
        u.lrow = u.row0; u.nvalid = 256; return true;
    }
};
struct EpiP9 {
    static constexpr bool PERM = true;
    EpiLogit l; EpiGU g;
    __device__ __forceinline__ void operator()(AccRef acc, const Unit& u, int wr, int wc, int fr, int fq) const { if (u.kind == 0) l(acc, u, wr, wc, fr, fq); else g(acc, u, wr, wc, fr, fq); }
};
#define XB_TMO      128
#define XB_XCNT(j)  (256  + 64 * (j))
#define XB_XSUB(j)  (1280 + 64 * (j))
#define XB_XGEN(j)  (2304 + 64 * (j))
#define XB_TOP      3328
#define XB_TOPGEN   3392
#define XCD_BAR_WORDS 3456
#define XB_SPIN_CAP (1u << 18)

__device__ __forceinline__ unsigned xb_ld(unsigned* p)              { return __hip_atomic_load(p, __ATOMIC_RELAXED, __HIP_MEMORY_SCOPE_AGENT); }
__device__ __forceinline__ unsigned xb_add(unsigned* p, unsigned v) { return __hip_atomic_fetch_add(p, v, __ATOMIC_RELAXED, __HIP_MEMORY_SCOPE_AGENT); }
__device__ __forceinline__ unsigned xb_xcc_id() { return (unsigned)__builtin_amdgcn_s_getreg((3 << 11) | 20) & 0xFu; }
#define XB_SPIN(cond, bar) do { unsigned _sp = 0; while (cond) { __builtin_amdgcn_s_sleep(1); \
    if ((++_sp & 255u) == 0u) { if (xb_ld(&(bar)[XB_TMO])) break; if (_sp > XB_SPIN_CAP) { atomicAdd(&(bar)[XB_TMO], 1u); break; } } } } while (0)

struct XcdBarrier {
    unsigned* bar; unsigned x;
    volatile LAS unsigned* st;
};

__device__ __forceinline__ XcdBarrier xcd_barrier_post(unsigned* bar, volatile LAS unsigned* st) {
    XcdBarrier b; b.bar = bar; b.x = xb_xcc_id(); b.st = st;
    if (threadIdx.x == 0) (void)xb_add(&bar[XB_XCNT(b.x)], 1u);
    return b;
}
__device__ __forceinline__ void xcd_barrier_complete(unsigned* bar, unsigned x, unsigned& nloc, unsigned& nx) {
    const unsigned G = gridDim.x * gridDim.y * gridDim.z;
    unsigned sum, cnt, mine, sp = 0u;
    for (;;) {
        sum = 0u; cnt = 0u; mine = 0u;
#pragma unroll
        for (unsigned j = 0; j < 16; ++j) { const unsigned c = xb_ld(&bar[XB_XCNT(j)]); sum += c; cnt += (c > 0u) ? 1u : 0u; mine = (j == x) ? c : mine; }
        if (sum == G) break;
        __builtin_amdgcn_s_sleep(1);
        if ((++sp & 255u) == 0u) { if (xb_ld(&bar[XB_TMO])) break; if (sp > XB_SPIN_CAP) { atomicAdd(&bar[XB_TMO], 1u); break; } }
    }
    nloc = mine > 0u ? mine : 1u; nx = cnt > 0u ? cnt : 1u;
}

__device__ __forceinline__ void xcd_barrier(const XcdBarrier& b) {
    asm volatile("s_waitcnt vmcnt(0)" ::: "memory");
    __syncthreads();
    if (threadIdx.x == 0) {
        unsigned* bar = b.bar;
        __builtin_amdgcn_s_waitcnt(0);
        unsigned nloc = b.st[0], nx = b.st[1];
        if (nloc == 0u) { xcd_barrier_complete(bar, b.x, nloc, nx); b.st[0] = nloc; b.st[1] = nx; }
        const unsigned old = xb_add(&bar[XB_XSUB(b.x)], 1u);
        const unsigned gen = old / nloc;
        if (old + 1u == (gen + 1u) * nloc) {
            __builtin_amdgcn_fence(__ATOMIC_RELEASE, "agent");
            asm volatile("s_waitcnt vmcnt(0)" ::: "memory");
            const unsigned og = xb_add(&bar[XB_TOP], 1u);
            const unsigned tg = og / nx;
            if (og + 1u == (tg + 1u) * nx) xb_add(&bar[XB_TOPGEN], 1u);
            else XB_SPIN(xb_ld(&bar[XB_TOPGEN]) == tg, bar);
            __builtin_amdgcn_fence(__ATOMIC_ACQUIRE, "agent");
            xb_add(&bar[XB_XGEN(b.x)], 1u);
            asm volatile("s_waitcnt vmcnt(0)" ::: "memory");
        } else {
            XB_SPIN(xb_ld(&bar[XB_XGEN(b.x)]) == gen, bar);
            __builtin_amdgcn_fence(__ATOMIC_ACQUIRE, "agent");
            asm volatile("s_waitcnt vmcnt(0)" ::: "memory");
        }
    }
    __syncthreads();
}


struct Frame {
    LAS unsigned char* lds;
    const Params* p;
    unsigned char* ws;
    int tid, lane, wave, G, bx;
};
#define WSP(T_, off) ((T_*)(F.ws + (off)))

__device__ __forceinline__ void p0_transpose_item(const float* W, int N, bf16_t* WT, int K, int k0, int n0, int row0, LAS float* scr, int lane) {
#pragma unroll 8
    for (int i = 0; i < 32; ++i) { const int kk = 2 * i + (lane >> 5); scr[kk * 33 + (lane & 31)] = W[(size_t)(k0 + kk) * N + n0 + (lane & 31)]; }
    LDS_WAIT(); asm volatile("" ::: "memory");
    const int c = lane & 7;
#pragma unroll
    for (int j = 0; j < 4; ++j) { const int n = (lane >> 3) + 8 * j; const LAS float* s = scr + (8 * c) * 33 + n;
        u32x4 o; o.x = pk2(s[0 * 33], s[1 * 33]); o.y = pk2(s[2 * 33], s[3 * 33]); o.z = pk2(s[4 * 33], s[5 * 33]); o.w = pk2(s[6 * 33], s[7 * 33]);
        *(u32x4*)(WT + (size_t)(row0 + n) * K + k0 + 8 * c) = o; }
    LDS_WAIT(); asm volatile("" ::: "memory");
}
__device__ __forceinline__ int gu_row(int n0, int up) { return (n0 >> 7) * 256 + up * 128 + (n0 & 127); }

__device__ __forceinline__ void p0_transposes(Frame& F) {
    LAS float* scr = (LAS float*)(F.lds + F.wave * 16384);
    const int gw = F.bx * 8 + F.wave, NGW = F.G * 8;
    const float* const* in = F.p->in;
    constexpr int I_WIN_ = 16 * 192, I_WHY_ = 8 * 32, I_WHG_ = 8 * 32, I_WOUT_ = 16 * 32, I_R_ = 16 * 8, I_SG_ = 16 * 8, I_SU_ = 16 * 8, I_SD_ = 4 * 32;
    constexpr int NSMALL = I_WIN_ + I_WHY_ + I_WHG_ + I_WOUT_ + I_R_ + I_SG_ + I_SU_ + I_SD_;
    for (int it = gw; it < NSMALL; it += NGW) {
        int r = it;
        {
            if (r < I_WIN_) { const int kb = r / 192, nb = r % 192, n0 = nb * 32; const int f0 = (n0 >= 1536 && n0 < 2048) ? n0 + 512 : ((n0 >= 2048 && n0 < 2560) ? n0 - 512 : n0);
                p0_transpose_item(in[I_WIN], INC, WSP(bf16_t, WS_WINT), D, kb * 64, n0, f0, scr, F.lane); continue; } r -= I_WIN_;
            if (r < I_WHY_) { p0_transpose_item(in[I_WHY], D, WSP(bf16_t, WS_WHYT), HYW, (r / 32) * 64, (r % 32) * 32, (r % 32) * 32, scr, F.lane); continue; } r -= I_WHY_;
            if (r < I_WHG_) { p0_transpose_item(in[I_WHG], D, WSP(bf16_t, WS_WHGT), HGW, (r / 32) * 64, (r % 32) * 32, (r % 32) * 32, scr, F.lane); continue; } r -= I_WHG_;
            if (r < I_WOUT_) { p0_transpose_item(in[I_WOUT], D, WSP(bf16_t, WS_WOUTT), D, (r / 32) * 64, (r % 32) * 32, (r % 32) * 32, scr, F.lane); continue; } r -= I_WOUT_;
            if (r < I_R_) { p0_transpose_item(in[I_RW], NE, WSP(bf16_t, WS_ROUT), D, (r / 8) * 64, (r % 8) * 32, (r % 8) * 32, scr, F.lane); continue; } r -= I_R_;
            if (r < I_SG_) { p0_transpose_item(in[I_SG], EH, WSP(bf16_t, WS_SHGUT), D, (r / 8) * 64, (r % 8) * 32, gu_row((r % 8) * 32, 0), scr, F.lane); continue; } r -= I_SG_;
            if (r < I_SU_) { p0_transpose_item(in[I_SU], EH, WSP(bf16_t, WS_SHGUT), D, (r / 8) * 64, (r % 8) * 32, gu_row((r % 8) * 32, 1), scr, F.lane); continue; } r -= I_SU_;
            p0_transpose_item(in[I_SD], D, WSP(bf16_t, WS_SHDT), EH, (r / 32) * 64, (r % 32) * 32, (r % 32) * 32, scr, F.lane); continue;
        }
    }
}

template <int MODE  >
__device__ __forceinline__ void p0_x256_load(const float* W, int N, int k0, int n0, int tid, f32x4 (&v)[8]) {
    const int n4 = MODE ? ((tid >> 6) * 8 + (tid & 7)) : (tid & 63), kq = MODE ? ((tid >> 3) & 7) : (tid >> 6); const float* src = W + (size_t)(k0 + 8 * kq) * N + n0 + 4 * n4;
#pragma unroll
    for (int r = 0; r < 8; ++r) v[r] = __builtin_nontemporal_load((const f32x4*)(src + (size_t)r * N));
}
__device__ __forceinline__ void p0_x256_store(LAS unsigned char* ts, bf16_t* WT, int K, int k0, int row0, int mode, int tid, const f32x4 (&v)[8]) {
    const int n4 = tid & 63, kq = tid >> 6;
    __syncthreads();
#pragma unroll
    for (int i = 0; i < 4; ++i) { const int n = 4 * n4 + i;
        u32x4 o; o.x = pk2(v[0][i], v[1][i]); o.y = pk2(v[2][i], v[3][i]); o.z = pk2(v[4][i], v[5][i]); o.w = pk2(v[6][i], v[7][i]);
        *(LAS u32x4*)(ts + n * 128 + ((kq ^ (n4 & 7)) << 4)) = o; }
    __syncthreads();
#pragma unroll
    for (int q = 0; q < 4; ++q) { const int task = tid + 512 * q, n = task >> 3, part = task & 7;
        const u32x4 o = *(const LAS u32x4*)(ts + n * 128 + ((part ^ ((n >> 2) & 7)) << 4));
        const int row = mode == 0 ? row0 + n : ((n >> 7) * 256 + (mode - 1) * 128 + (n & 127));
        *(u32x4*)(WT + (size_t)(k0 >> 6) * K + row * 64 + 8 * part) = o; }
}
__device__ __forceinline__ void p0_x256_decode(const float* const* in, unsigned char* ws, int item, const float*& W, int& N, bf16_t*& WT, int& K, int& k0, int& n0, int& mode) {
    const int e = item / 48, r = item % 48;
    if (r < 16) { W = in[I_EG] + (size_t)e * D * EH; N = EH; WT = (bf16_t*)(ws + WS_EGUT) + (size_t)e * 512 * D; K = 512 * 64; k0 = r * 64; n0 = 0; mode = 1; }
    else if (r < 32) { W = in[I_EU] + (size_t)e * D * EH; N = EH; WT = (bf16_t*)(ws + WS_EGUT) + (size_t)e * 512 * D; K = 512 * 64; k0 = (r - 16) * 64; n0 = 0; mode = 2; }
    else { const int q = r - 32; W = in[I_ED] + (size_t)e * EH * D; N = D; WT = (bf16_t*)(ws + WS_EDT) + (size_t)e * D * EH; K = D * 64; k0 = (q >> 2) * 64; n0 = (q & 3) * 256; mode = 0; }
}
struct XpState { f32x4 v[8]; int it, end, stride; bool live; };
__device__ __forceinline__ void xp_issue(XpState& s, const float* const* in, unsigned char* ws, int tid) {
    s.live = s.it < s.end;
    if (s.live) { const float* W; int N, K, k0, n0, mode; bf16_t* WT; p0_x256_decode(in, ws, s.it, W, N, WT, K, k0, n0, mode); p0_x256_load<1>(W, N, k0, n0, tid, s.v); }
}
__device__ __forceinline__ void xp_finish(XpState& s, const float* const* in, unsigned char* ws, int tid) {
    if (s.live) { const float* W; int N, K, k0, n0, mode; bf16_t* WT; p0_x256_decode(in, ws, s.it, W, N, WT, K, k0, n0, mode);
        const int n4 = (tid >> 6) * 8 + (tid & 7), kq = (tid >> 3) & 7;
#pragma unroll
        for (int i = 0; i < 4; ++i) { const int n = 4 * n4 + i; const int row = mode == 0 ? n0 + n : ((n >> 7) * 256 + (mode - 1) * 128 + (n & 127));
            u32x4 o; o.x = pk2(s.v[0][i], s.v[1][i]); o.y = pk2(s.v[2][i], s.v[3][i]); o.z = pk2(s.v[4][i], s.v[5][i]); o.w = pk2(s.v[6][i], s.v[7][i]);
            *(u32x4*)(WT + (size_t)(k0 >> 6) * K + row * 64 + 8 * kq) = o; }
        s.it += s.stride; s.live = false; }
}
__device__ __forceinline__ void xp_step(XpState& s, const float* const* in, unsigned char* ws, int tid) { xp_finish(s, in, ws, tid); xp_issue(s, in, ws, tid); }
constexpr int XP_BG = 30;
constexpr int XP_K0 = 6;
constexpr int NCONV = 36;
__device__ __forceinline__ void conv_loop(const float* const* in, unsigned char* ws, int first, int stride, int end, int tid) {
    XpState a, b, c, d; a.stride = b.stride = c.stride = d.stride = 4 * stride; a.end = b.end = c.end = d.end = end; a.live = b.live = c.live = d.live = false;
    a.it = first; b.it = first + stride; c.it = first + 2 * stride; d.it = first + 3 * stride;
    xp_issue(a, in, ws, tid); xp_issue(b, in, ws, tid); xp_issue(c, in, ws, tid);
    while (a.live) {
        xp_issue(d, in, ws, tid); xp_finish(a, in, ws, tid);
        if (!b.live) break; xp_issue(a, in, ws, tid); xp_finish(b, in, ws, tid);
        if (!c.live) break; xp_issue(b, in, ws, tid); xp_finish(c, in, ws, tid);
        if (!d.live) break; xp_issue(c, in, ws, tid); xp_finish(d, in, ws, tid);
    }
}

__device__ __forceinline__ void p0_expert_transposes(Frame& F) {
    int tid = F.tid; asm volatile("" : "+v"(tid));
    constexpr int NIT = NE * 48;
    int it = F.bx + XP_BG * F.G; if (it >= NIT) return;
    const int p0end = (F.G == 256) ? 256 * (XP_BG + XP_K0) : NIT;
    if (it >= p0end) return;
    const float* W; int N, K, k0, n0, mode; bf16_t* WT;
    const float* W2; int N2, K2, k2, n2, mode2; bf16_t* WT2;
    f32x4 va[8], vb[8];
    p0_x256_decode(F.p->in, F.ws, it, W, N, WT, K, k0, n0, mode);
    p0_x256_load<0>(W, N, k0, n0, tid, va);
    for (;;) {
        __builtin_amdgcn_s_waitcnt(0);
        int nx = it + F.G; bool has = nx < p0end;
        if (has) { p0_x256_decode(F.p->in, F.ws, nx, W2, N2, WT2, K2, k2, n2, mode2); p0_x256_load<0>(W2, N2, k2, n2, tid, vb); }
        p0_x256_store(F.lds, WT, K, k0, n0, mode, tid, va);
        if (!has) break;
        it = nx;
        __builtin_amdgcn_s_waitcnt(0);
        nx = it + F.G; has = nx < p0end;
        if (has) { p0_x256_decode(F.p->in, F.ws, nx, W, N, WT, K, k0, n0, mode); p0_x256_load<0>(W, N, k0, n0, tid, va); }
        p0_x256_store(F.lds, WT2, K2, k2, n2, mode2, tid, vb);
        if (!has) break;
        it = nx;
    }
}

constexpr int ADA_KC = 4;
__device__ __forceinline__ void p0_ada_item(Frame& F, int item) {
    const int kc = item / 12, cb = item % 12, col = cb * 512 + F.tid;
    const float* in_c = F.p->in[I_C]; const float* in_cc = F.p->in[I_CCTX]; const float* w = F.p->in[I_ADAW];
    LAS float* sv = (LAS float*)F.lds;
    __syncthreads();
    for (int i = F.tid; i < 768; i += 512) { const int wh = i >> 8, k = kc * 256 + (i & 255); sv[i] = siluf_(wh == 0 ? in_c[k] : (wh == 1 ? in_c[D + k] : in_cc[k])); }
    __syncthreads();
    float a0 = 0.f, a1 = 0.f, a2 = 0.f;
    const float* wp = w + (size_t)(kc * 256) * 6144 + col;
#pragma unroll 16
    for (int k = 0; k < 256; ++k) { const float wv = wp[(size_t)k * 6144]; a0 += sv[k] * wv; a1 += sv[256 + k] * wv; a2 += sv[512 + k] * wv; }
    float* o = WSP(float, WS_ADAP) + (size_t)kc * 3 * 6144 + col;
    o[0] = a0; o[6144] = a1; o[2 * 6144] = a2;
}

__device__ __forceinline__ void p0_filter_item(Frame& F, int item) {
    LAS float* zb = (LAS float*)F.lds;
    LAS float* ab1 = zb + 32 * 36;
    LAS float* ab2 = ab1 + 32 * 64;
    const float* const* in = F.p->in; const int t0 = item * 32; int tid = F.tid; asm volatile("" : "+v"(tid));
    __syncthreads();
    for (int idx = tid; idx < 32 * 33; idx += 512) { const int t = idx / 33, e = idx % 33; const float tf = (float)(t0 + t); float v;
        if (e == 0) v = tf / (float)(SEQ - 1);
        else { const int k = (e - 1) & 15; const float band = 1e-4f + (float)k * ((15.0f - 1e-4f) / 15.0f); float sn, cs; sincospif(2.0f * tf * band / (float)SEQ, &sn, &cs); v = (e <= 16) ? cs : -sn; }
        zb[t * 36 + e] = v; }
    __syncthreads();
    {
        const int t = tid >> 4, jj = tid & 15;
#pragma unroll 1
        for (int q = 0; q < 4; ++q) { const int j = jj + 16 * q; float s = in[I_FB1][j];
#pragma unroll 3
            for (int e = 0; e < 33; ++e) s += zb[t * 36 + e] * in[I_FW1][e * 64 + j];
            ab1[t * 64 + j] = sinf(in[I_FFREQ][j] * s); }
    }
    __syncthreads();
    { const int t = tid >> 4, jj = tid & 15;
#pragma unroll 1
        for (int q = 0; q < 4; ++q) { const int j = jj + 16 * q; float s = in[I_FB2][j];
#pragma unroll 4
            for (int e = 0; e < 64; ++e) s += ab1[t * 64 + e] * in[I_FW2][e * 64 + j];
            ab2[t * 64 + j] = sinf(in[I_FFREQ][j] * s); }
    }
    __syncthreads();
    { const int t = tid >> 4, jj = tid & 15;
#pragma unroll 1
        for (int q = 0; q < 4; ++q) { const int j = jj + 16 * q; float s = in[I_FB3][j];
#pragma unroll 4
            for (int e = 0; e < 64; ++e) s += ab2[t * 64 + e] * in[I_FW3][e * 64 + j];
            ab1[t * 64 + j] = sinf(in[I_FFREQ][j] * s); }
    }
    __syncthreads();
    const float* w4 = in[I_FW4];
    const float MIND = -3.0701134573253945f, MAXD = -15.350567286626973f;
    const float delta = fabsf(MIND + (MAXD - MIND) * ((float)tid / 511.0f));
    bf16_t* hf = WSP(bf16_t, WS_HF);
#pragma unroll 1
    for (int half = 0; half < 4; ++half) {
        f32x2 acc[8][2];
#pragma unroll
        for (int t = 0; t < 8; ++t) { acc[t][0] = (f32x2){0.f, 0.f}; acc[t][1] = (f32x2){0.f, 0.f}; }
        f32x2 wa[4][2], wb[4][2];
#pragma unroll
        for (int jj = 0; jj < 4; ++jj) { wa[jj][0] = (f32x2){w4[(size_t)jj * 2048 + tid], w4[(size_t)jj * 2048 + tid + 512]}; wa[jj][1] = (f32x2){w4[(size_t)jj * 2048 + tid + 1024], w4[(size_t)jj * 2048 + tid + 1536]}; }
#pragma unroll 1
        for (int j4 = 0; j4 < 16; j4 += 2) {
#pragma unroll
            for (int jj = 0; jj < 4; ++jj) { const size_t o = (size_t)(4 * (j4 + 1) + jj) * 2048 + tid; wb[jj][0] = (f32x2){w4[o], w4[o + 512]}; wb[jj][1] = (f32x2){w4[o + 1024], w4[o + 1536]}; }
#pragma unroll
            for (int t = 0; t < 8; ++t) { const f32x4 a = *(const LAS f32x4*)(ab1 + (8 * half + t) * 64 + 4 * j4);
#pragma unroll
                for (int jj = 0; jj < 4; ++jj) { const f32x2 aa = (f32x2){a[jj], a[jj]}; acc[t][0] += aa * wa[jj][0]; acc[t][1] += aa * wa[jj][1]; } }
            if (j4 + 2 < 16) {
#pragma unroll
                for (int jj = 0; jj < 4; ++jj) { const size_t o = (size_t)(4 * (j4 + 2) + jj) * 2048 + tid; wa[jj][0] = (f32x2){w4[o], w4[o + 512]}; wa[jj][1] = (f32x2){w4[o + 1024], w4[o + 1536]}; } }
#pragma unroll
            for (int t = 0; t < 8; ++t) { const f32x4 a = *(const LAS f32x4*)(ab1 + (8 * half + t) * 64 + 4 * (j4 + 1));
#pragma unroll
                for (int jj = 0; jj < 4; ++jj) { const f32x2 aa = (f32x2){a[jj], a[jj]}; acc[t][0] += aa * wb[jj][0]; acc[t][1] += aa * wb[jj][1]; } }
        }
#pragma unroll
        for (int t4 = 0; t4 < 2; ++t4) { const int tb = t0 + 8 * half + 4 * t4;
            float dc[4];
#pragma unroll
            for (int k = 0; k < 4; ++k) dc[k] = expf(-((float)(tb + k) / (float)(SEQ - 1)) * delta);
#pragma unroll
            for (int i = 0; i < 4; ++i)
                *(u32x2*)(hf + (size_t)(tid + 512 * i) * SEQ + tb) = (u32x2){pk2(acc[4 * t4][i >> 1][i & 1] * dc[0], acc[4 * t4 + 1][i >> 1][i & 1] * dc[1]), pk2(acc[4 * t4 + 2][i >> 1][i & 1] * dc[2], acc[4 * t4 + 3][i >> 1][i & 1] * dc[3])};
        }
    }
}

__device__ __forceinline__ void p0_tables(Frame& F, int item) {
    if (item < 6) {
        const int idx = item * 16384 + F.tid * 32;
        for (int k = 0; k < 32; ++k) { const int id = idx + k; if (id >= 192 * 512) break;
            const int row = id >> 9, col = id & 511, i = col & 255; const float omega = 1.0f / powf(10000.0f, (float)i / 256.0f);
            const float pos = (float)(row < 128 ? row : row - 128); const float ang = pos * omega;
            const float v = (col < 256) ? sinf(ang) : cosf(ang);
            if (row < 128) WSP(float, WS_POSR)[row * 512 + col] = v; else WSP(float, WS_POSC)[(row - 128) * 512 + col] = v; }
    } else {
        for (int id = F.tid; id < 1024; id += 512) { const float l0 = F.p->in[I_LBL][id], l1 = F.p->in[I_LBL][1024 + id];
            WSP(float, WS_LBS)[id] = 1.0f / (1.0f + expf(l1 - l0)); }
    }
}

__device__ __forceinline__ void phase0(Frame& F) {
    for (int it = F.bx; it < 311; it += F.G) {
        if (it < 48) p0_ada_item(F, it);
        else if (it < 304) p0_filter_item(F, it - 48);
        else p0_tables(F, it - 304);
    }
    __syncthreads();
    p0_transposes(F);
    __syncthreads();
    p0_expert_transposes(F);
}

__device__ __forceinline__ void phase1(Frame& F) {
    const float* adap = WSP(float, WS_ADAP); const float* adab = F.p->in[I_ADAB];
    { const int gid = F.bx * 512 + F.tid; if (gid < 3 * 6144) { const int wh = gid / 6144, col = gid % 6144; float s = adab[col];
#pragma unroll
        for (int kc = 0; kc < ADA_KC; ++kc) s += adap[(size_t)(kc * 3 + wh) * 6144 + col]; WSP(float, WS_ADA)[gid] = s; } }
    LAS float* md = (LAS float*)F.lds;
    __syncthreads();
    for (int id = F.tid; id < 3 * 2048; id += 512) { const int wh = id >> 11, col = id & 2047; float s = adab[col];
#pragma unroll
        for (int kc = 0; kc < ADA_KC; ++kc) s += adap[(size_t)(kc * 3 + wh) * 6144 + col]; md[id] = s; }
    __syncthreads();
    const float* x = F.p->in[I_X]; const float* ctx = F.p->in[I_CTX]; const float* g1 = F.p->in[I_N1G];
    const float* posr = WSP(float, WS_POSR); const float* posc = WSP(float, WS_POSC); bf16_t* a1 = WSP(bf16_t, WS_A1);
    const int lane = F.lane;
#define P1_GG() f32x4 ggv[4]; _Pragma("unroll") for (int j = 0; j < 4; ++j) ggv[j] = *(const f32x4*)(g1 + 256 * j + 4 * lane)
#define P1_ROWS4(r0) do { f32x4 v[4][4]; const int wh = (r0) < T ? ((r0) >> 13) : 2; \
        _Pragma("unroll") for (int q = 0; q < 4; ++q) { const int r = (r0) + q; \
            if ((r0) < T) { const int n = r & (SEQ - 1); const f32x4* xr = (const f32x4*)(x + (size_t)r * D) + lane; \
                _Pragma("unroll") for (int j = 0; j < 4; ++j) { const int c = 256 * j + 4 * lane; const f32x4 pe = (c < 512) ? *(const f32x4*)(posr + (n >> 6) * 512 + c) : *(const f32x4*)(posc + (n & 63) * 512 + c - 512); v[q][j] = xr[64 * j] + pe; } \
            } else { const f32x4* xr = (const f32x4*)(ctx + (size_t)(r - T) * D) + lane; \
                _Pragma("unroll") for (int j = 0; j < 4; ++j) v[q][j] = xr[64 * j]; } } \
        _Pragma("unroll") for (int q = 0; q < 4; ++q) { float ss = 0.f; \
            _Pragma("unroll") for (int j = 0; j < 4; ++j) ss += (v[q][j][0] * v[q][j][0] + v[q][j][1] * v[q][j][1]) + (v[q][j][2] * v[q][j][2] + v[q][j][3] * v[q][j][3]); \
            const float rs = rsqrtf(wave_sum(ss) * (1.0f / D) + EPS); \
            u32x2* o8 = (u32x2*)(a1 + (size_t)((r0) + q) * D) + lane; \
            _Pragma("unroll") for (int j = 0; j < 4; ++j) { const int c = 256 * j + 4 * lane; const f32x4 gg = ggv[j]; \
                const f32x4 sh = *(const LAS f32x4*)(md + wh * 2048 + c), sc = *(const LAS f32x4*)(md + wh * 2048 + 1024 + c); \
                const f32x4 y = v[q][j] * rs * gg * (sc + 1.0f) + sh; \
                u32x2 w; w.x = pk2(y[0], y[1]); w.y = pk2(y[2], y[3]); o8[64 * j] = w; } } } while (0)
    const int nded = F.G > 24 ? 12 : 0;
    if (F.bx >= nded) { const int gw = (F.bx - nded) * 8 + F.wave, NGW = (F.G - nded) * 8; P1_GG();
        for (int r0 = gw * 4; r0 < T; r0 += NGW * 4) P1_ROWS4(r0); }
    for (int idx = F.bx; idx < 12; idx += (nded ? 12 : F.G)) {
        if (nded && F.bx >= 12) break;
        const int rbase = T + CtxUnit::tile(idx) * 256 + F.wave * 32;
        { P1_GG(); for (int i = 0; i < 32; i += 4) P1_ROWS4(rbase + i); }
        asm volatile("s_waitcnt vmcnt(0)" ::: "memory"); __syncthreads();
        { pg8::Gemm g{WSP(bf16_t, WS_WINT), WSP(bf16_t, WS_WINT), D, nullptr, 2 * D, 128}; CtxUnit S{idx};
          EpiIn E{EpiInT{WSP(bf16_t, WS_PHYT), WSP(bf16_t, WS_VT)}, EpiInN{WSP(bf16_t, WS_Q), WSP(bf16_t, WS_G), WSP(bf16_t, WS_SG1), WSP(bf16_t, WS_SG2), WSP(float, WS_LF), WSP(float, WS_LB), WSP(float, WS_LBS)}};
          pg8::gemm_phase<EpiIn, CtxUnit, false>(F.lds, g, S, E); }
        if (!nded) { __syncthreads(); for (int id = F.tid; id < 3 * 2048; id += 512) { const int wh = id >> 11, col = id & 2047; float s = adab[col];
            for (int kc = 0; kc < ADA_KC; ++kc) s += adap[(size_t)(kc * 3 + wh) * 6144 + col]; md[id] = s; } __syncthreads(); }
    }
#undef P1_ROWS4
#undef P1_GG
}

__device__ __forceinline__ void phase_h2(Frame& F) {
    const float* x1 = F.p->out; const float* g2 = F.p->in[I_N2G]; const float* ada = WSP(float, WS_ADA); bf16_t* h2 = WSP(bf16_t, WS_H2);
    const int gw = F.bx * 8 + F.wave, NGW = F.G * 8, lane = F.lane;
    f32x4 ggv[4];
#pragma unroll
    for (int j = 0; j < 4; ++j) ggv[j] = *(const f32x4*)(g2 + 256 * j + 4 * lane);
    const bool al = (F.G == 256); const int vw = ((F.bx & 7) * 32 + (F.bx >> 3)) * 8 + F.wave;
    for (int r0 = al ? vw * 8 : gw * 4, it_ = 0; al ? it_ < 2 : r0 < T; r0 += al ? 4 : NGW * 4, ++it_) { const int b = r0 >> 13;
        f32x4 v[4][4], shv[4], scv[4];
#pragma unroll
        for (int j = 0; j < 4; ++j) { const int c = 256 * j + 4 * lane; shv[j] = *(const f32x4*)(ada + b * 6144 + 3 * D + c); scv[j] = *(const f32x4*)(ada + b * 6144 + 4 * D + c); }
#pragma unroll
        for (int q = 0; q < 4; ++q) { const f32x4* xr = (const f32x4*)(x1 + (size_t)(r0 + q) * D) + lane;
#pragma unroll
            for (int j = 0; j < 4; ++j) v[q][j] = xr[64 * j]; }
#pragma unroll
        for (int q = 0; q < 4; ++q) { float ss = 0.f;
#pragma unroll
            for (int j = 0; j < 4; ++j) ss += (v[q][j][0] * v[q][j][0] + v[q][j][1] * v[q][j][1]) + (v[q][j][2] * v[q][j][2] + v[q][j][3] * v[q][j][3]);
            const float rs = rsqrtf(wave_sum(ss) * (1.0f / D) + EPS);
            u32x2* o8 = (u32x2*)(h2 + (size_t)(r0 + q) * D) + lane;
#pragma unroll
            for (int j = 0; j < 4; ++j) { const f32x4 gg = ggv[j], sh = shv[j], sc = scv[j];
                const f32x4 y = v[q][j] * rs * gg * (sc + 1.0f) + sh;
                u32x2 w; w.x = pk2(y[0], y[1]); w.y = pk2(y[2], y[3]); o8[64 * j] = w; } }
    }
}
constexpr int FPAD = 17920;
__device__ __forceinline__ int fphys(int i) { return i + (i >> 4) + ((i >> 9) << 4); }
__device__ constexpr float TWC[16] = {1.0f, 0.98078528040323044913f, 0.92387953251128675613f, 0.83146961230254523708f, 0.70710678118654752440f, 0.55557023301960222474f, 0.38268343236508977173f, 0.19509032201612826785f,
                                      0.0f, -0.19509032201612826785f, -0.38268343236508977173f, -0.55557023301960222474f, -0.70710678118654752440f, -0.83146961230254523708f, -0.92387953251128675613f, -0.98078528040323044913f};
__device__ constexpr float TWS[16] = {0.0f, 0.19509032201612826785f, 0.38268343236508977173f, 0.55557023301960222474f, 0.70710678118654752440f, 0.83146961230254523708f, 0.92387953251128675613f, 0.98078528040323044913f,
                                      1.0f, 0.98078528040323044913f, 0.92387953251128675613f, 0.83146961230254523708f, 0.70710678118654752440f, 0.55557023301960222474f, 0.38268343236508977173f, 0.19509032201612826785f};
__host__ __device__ constexpr int brev_c(int x, int bits) { int r = 0; for (int i = 0; i < bits; ++i) r = (r << 1) | ((x >> i) & 1); return r; }

typedef f32x2 cpx;
__device__ __forceinline__ cpx cmul(cpx a, cpx w) { return (cpx){a.x, a.x} * w + (cpx){a.y, a.y} * (cpx){-w.y, w.x}; }
template <int S0, int R, bool INV, bool ZHI = false, bool OLO = false>
__device__ __forceinline__ void fft_pass(LAS cpx* X, int tid) {
    constexpr int LOW = 14 - S0 - R, NR = 1 << R, NTASK = (1 << (14 - R)) / 512;
    asm volatile("" : "+v"(tid));
#pragma unroll 1
    for (int task = 0; task < NTASK; ++task) {
        const int g = tid + 512 * task;
        const int blo = g & ((1 << LOW) - 1), bhi = g >> LOW;
        const int base = (bhi << (LOW + R)) | blo;
        cpx v[NR];
#pragma unroll
        for (int j = 0; j < NR; ++j) { if (ZHI && j >= NR / 2) v[j] = (cpx){0.f, 0.f}; else v[j] = X[fphys(base | (j << LOW))]; }
        cpx w0 = (cpx){1.f, 0.f};
        if (LOW > 0) { float s, c; sincospif(-(float)blo * (1.0f / (float)(1 << (13 - S0))), &s, &c); w0 = (cpx){c, INV ? -s : s}; }
        if (INV && LOW > 0) {
            cpx cw = w0;
#pragma unroll
            for (int m = 1; m < NR; ++m) { const int j = brev_c(m, R); v[j] = cmul(v[j], cw); if (m + 1 < NR) cw = cmul(cw, w0); }
        }
        if (!INV) {
#pragma unroll
            for (int q = 0; q < R; ++q) { const int hj = 1 << (R - 1 - q);
#pragma unroll
                for (int j = 0; j < NR; ++j) { if (j & hj) continue; const int k32 = (j & (hj - 1)) << (5 - R + q);
                    cpx d;
                    if (ZHI && q == 0) d = v[j];
                    else { const cpx a = v[j], bb = v[j + hj]; v[j] = a + bb; d = a - bb; }
                    if (k32 == 0) v[j + hj] = d;
                    else if (k32 == 8) v[j + hj] = (cpx){d.y, -d.x};
                    else v[j + hj] = cmul(d, (cpx){TWC[k32], -TWS[k32]}); } }
        } else {
#pragma unroll
            for (int q = R - 1; q >= 0; --q) { const int hj = 1 << (R - 1 - q);
#pragma unroll
                for (int j = 0; j < NR; ++j) { if (j & hj) continue; const int k32 = (j & (hj - 1)) << (5 - R + q);
                    const cpx p = v[j], bb = v[j + hj]; cpx t;
                    if (k32 == 0) t = bb;
                    else if (k32 == 8) t = (cpx){-bb.y, bb.x};
                    else t = cmul(bb, (cpx){TWC[k32], TWS[k32]});
                    v[j] = p + t; if (!(OLO && q == 0)) v[j + hj] = p - t; } }
        }
        if (!INV && LOW > 0) {
            cpx cw = w0;
#pragma unroll
            for (int m = 1; m < NR; ++m) { const int j = brev_c(m, R); v[j] = cmul(v[j], cw); if (m + 1 < NR) cw = cmul(cw, w0); }
        }
#pragma unroll
        for (int j = 0; j < NR; ++j) { if (OLO && j >= NR / 2) continue; X[fphys(base | (j << LOW))] = v[j]; }
    }
}
#define XP_HOOK() xp_step(xp, F.p->in, F.ws, tid)
template <bool ZHI> __device__ __forceinline__ void fft_fwd(Frame& F, XpState& xp, LAS cpx* X, int tid) {
    fft_pass<0, 5, false, ZHI>(X, tid); __syncthreads(); XP_HOOK(); fft_pass<5, 5, false>(X, tid); __syncthreads(); XP_HOOK(); fft_pass<10, 4, false>(X, tid); __syncthreads(); XP_HOOK();
}
__device__ __forceinline__ void fft_inv(Frame& F, XpState& xp, LAS cpx* X, int tid) {
    fft_pass<10, 4, true>(X, tid); __syncthreads(); XP_HOOK(); fft_pass<5, 5, true>(X, tid); __syncthreads(); XP_HOOK(); fft_pass<0, 5, true, false, true>(X, tid); __syncthreads(); XP_HOOK();
}
struct SC8 { u32x4 c; unsigned l, r; };
__device__ __forceinline__ SC8 sconv8_load(const bf16_t* p, int n) {
    SC8 s; s.c = *(const u32x4*)(p + n); s.l = n > 0 ? (unsigned)p[n - 1] : 0u; s.r = n + 8 < SEQ ? (unsigned)p[n + 8] : 0u; return s;
}
__device__ __forceinline__ void sconv8_eval(const SC8& s, float w0, float w1, float w2, float bias, float (&o)[8]) {
    float v[10]; v[0] = bf2f(s.l); v[1] = bflo(s.c.x); v[2] = bfhi(s.c.x); v[3] = bflo(s.c.y); v[4] = bfhi(s.c.y); v[5] = bflo(s.c.z); v[6] = bfhi(s.c.z); v[7] = bflo(s.c.w); v[8] = bfhi(s.c.w); v[9] = bf2f(s.r);
#pragma unroll
    for (int i = 0; i < 8; ++i) o[i] = w0 * v[i] + w1 * v[i + 1] + w2 * v[i + 2] + bias;
}
__device__ __forceinline__ void hyena_item(Frame& F, int c, XpState& xp) {
    LAS cpx* X = (LAS cpx*)F.lds; LAS float* red = (LAS float*)(F.lds + (size_t)FPAD * 8);
    int tid = F.tid; asm volatile("" : "+v"(tid));
    const bf16_t* hf = WSP(bf16_t, WS_HF);
    __syncthreads();
    float s0 = 0.f, s1 = 0.f;
    {
        f32x4 fa[4], fb[4], ba[4], bb[4];
#pragma unroll
        for (int it = 0; it < 4; ++it) { const int j = 4 * (tid + 512 * it);
            const u32x2 w0 = *(const u32x2*)(hf + (size_t)c * SEQ + j), w1 = *(const u32x2*)(hf + (size_t)(1024 + c) * SEQ + j), w2 = *(const u32x2*)(hf + (size_t)(512 + c) * SEQ + j), w3 = *(const u32x2*)(hf + (size_t)(1536 + c) * SEQ + j);
            fa[it] = (f32x4){bflo(w0.x), bfhi(w0.x), bflo(w0.y), bfhi(w0.y)}; fb[it] = (f32x4){bflo(w1.x), bfhi(w1.x), bflo(w1.y), bfhi(w1.y)};
            ba[it] = (f32x4){bflo(w2.x), bfhi(w2.x), bflo(w2.y), bfhi(w2.y)}; bb[it] = (f32x4){bflo(w3.x), bfhi(w3.x), bflo(w3.y), bfhi(w3.y)}; }
#pragma unroll
        for (int it = 0; it < 4; ++it) { const int j = 4 * (tid + 512 * it);
#pragma unroll
            for (int i = 0; i < 4; ++i) { X[fphys(j + i)] = (cpx){fa[it][i], fb[it][i]}; s0 += fabsf(fa[it][i]); s1 += fabsf(fb[it][i]);
                const int m = j + i; if (m > 0) { X[fphys(FFTN - m)] = (cpx){ba[it][i], bb[it][i]}; s0 += fabsf(ba[it][i]); s1 += fabsf(bb[it][i]); } } }
        if (tid == 0) X[fphys(SEQ)] = (cpx){0.f, 0.f};
    }
    s0 = wave_sum(s0); s1 = wave_sum(s1);
    if (F.lane == 0) { red[F.wave] = s0; red[8 + F.wave] = s1; }
    __syncthreads();
    float S0 = 0.f, S1 = 0.f;
#pragma unroll
    for (int w = 0; w < 8; ++w) { S0 += red[w]; S1 += red[8 + w]; }
    fft_fwd<false>(F, xp, X, tid);
    unsigned* ks = WSP(unsigned, WS_KS) + (size_t)F.bx * 2 * FFTN;
    { const float i0 = 1.0f / S0, i1 = 1.0f / S1, sk0 = F.p->in[I_HSKIP][c], sk1 = F.p->in[I_HSKIP][512 + c];
#pragma unroll 8
        for (int it = 0; it < 32; ++it) { const int p = tid + 512 * it; const int k = (int)(__brev((unsigned)p) >> 18); const int pp = (int)(__brev((unsigned)((FFTN - k) & (FFTN - 1))) >> 18);
            const cpx A = X[fphys(p)], B = X[fphys(pp)];
            const float k1r = 0.5f * (A.x + B.x), k1i = 0.5f * (A.y - B.y), k2r = 0.5f * (A.y + B.y), k2i = -0.5f * (A.x - B.x);
            ks[p] = pkh2(k1r * i0 + sk0, k1i * i0); ks[FFTN + p] = pkh2(k2r * i1 + sk1, k2i * i1); } }
    __syncthreads();
    const bf16_t* ph = WSP(bf16_t, WS_PHYT); const float* cw = F.p->in[I_HCW]; const float* cb = F.p->in[I_HCB];
    { const float w0 = cw[c], w1 = cw[HYP + c], w2 = cw[2 * HYP + c], bs = cb[c];
        SC8 sa[2], sb[2];
#pragma unroll
        for (int it = 0; it < 2; ++it) { const int n = 8 * (tid + 512 * it); sa[it] = sconv8_load(ph + (size_t)c * SEQ, n); sb[it] = sconv8_load(ph + (size_t)(HYP + c) * SEQ, n); }
#pragma unroll
        for (int it = 0; it < 2; ++it) { const int n = 8 * (tid + 512 * it); float a[8], b[8]; sconv8_eval(sa[it], w0, w1, w2, bs, a); sconv8_eval(sb[it], w0, w1, w2, bs, b);
#pragma unroll
            for (int i = 0; i < 8; ++i) X[fphys(n + i)] = (cpx){a[i], b[i]}; } }
    __syncthreads();
    fft_fwd<true>(F, xp, X, tid);
    { unsigned kk[32]; const float invN = 1.0f / (float)FFTN;
#pragma unroll
        for (int it = 0; it < 32; ++it) kk[it] = ks[tid + 512 * it];
#pragma unroll
        for (int it = 0; it < 32; ++it) { const int q = fphys(tid + 512 * it); X[q] = cmul(X[q], (cpx){h2f((unsigned short)(kk[it] & 0xffffu)) * invN, h2f((unsigned short)(kk[it] >> 16)) * invN}); } }
    __syncthreads();
    fft_inv(F, xp, X, tid);
    { const int col = HYW + c; const float w0 = cw[col], w1 = cw[HYP + col], w2 = cw[2 * HYP + col], bs = cb[col];
        SC8 sa[2], sb[2];
#pragma unroll
        for (int it = 0; it < 2; ++it) { const int n = 8 * (tid + 512 * it); sa[it] = sconv8_load(ph + (size_t)col * SEQ, n); sb[it] = sconv8_load(ph + (size_t)(HYP + col) * SEQ, n); }
#pragma unroll
        for (int it = 0; it < 2; ++it) { const int n = 8 * (tid + 512 * it); float a[8], b[8]; sconv8_eval(sa[it], w0, w1, w2, bs, a); sconv8_eval(sb[it], w0, w1, w2, bs, b);
#pragma unroll
            for (int i = 0; i < 8; ++i) { const int q = fphys(n + i); X[q] = X[q] * (cpx){a[i], b[i]}; } } }
    __syncthreads();
    fft_fwd<true>(F, xp, X, tid);
    { unsigned kk[32]; const float invN = 1.0f / (float)FFTN;
#pragma unroll
        for (int it = 0; it < 32; ++it) kk[it] = ks[FFTN + tid + 512 * it];
#pragma unroll
        for (int it = 0; it < 32; ++it) { const int q = fphys(tid + 512 * it); X[q] = cmul(X[q], (cpx){h2f((unsigned short)(kk[it] & 0xffffu)) * invN, h2f((unsigned short)(kk[it] >> 16)) * invN}); } }
    __syncthreads();
    fft_inv(F, xp, X, tid);
    { const int col = 2 * HYW + c; const float w0 = cw[col], w1 = cw[HYP + col], w2 = cw[2 * HYP + col], bs = cb[col];
        bf16_t* yt = WSP(bf16_t, WS_YHYT);
        SC8 sa[2], sb[2]; u32x4 oa[2], ob[2];
#pragma unroll
        for (int it = 0; it < 2; ++it) { const int n = 8 * (tid + 512 * it); sa[it] = sconv8_load(ph + (size_t)col * SEQ, n); sb[it] = sconv8_load(ph + (size_t)(HYP + col) * SEQ, n); }
#pragma unroll
        for (int it = 0; it < 2; ++it) { const int n = 8 * (tid + 512 * it); float a[8], b[8]; sconv8_eval(sa[it], w0, w1, w2, bs, a); sconv8_eval(sb[it], w0, w1, w2, bs, b);
            cpx y[8];
#pragma unroll
            for (int i = 0; i < 8; ++i) y[i] = X[fphys(n + i)];
            oa[it] = (u32x4){pk2(y[0].x * a[0], y[1].x * a[1]), pk2(y[2].x * a[2], y[3].x * a[3]), pk2(y[4].x * a[4], y[5].x * a[5]), pk2(y[6].x * a[6], y[7].x * a[7])};
            ob[it] = (u32x4){pk2(y[0].y * b[0], y[1].y * b[1]), pk2(y[2].y * b[2], y[3].y * b[3]), pk2(y[4].y * b[4], y[5].y * b[5]), pk2(y[6].y * b[6], y[7].y * b[7])}; }
#pragma unroll
        for (int it = 0; it < 2; ++it) { const int n = 8 * (tid + 512 * it);
            *(u32x4*)(yt + (size_t)c * SEQ + n) = oa[it]; *(u32x4*)(yt + (size_t)(HYW + c) * SEQ + n) = ob[it]; } }
}

__device__ __forceinline__ bf16x8 lds_frag(const LAS bf16_t* base, int row, int stride, int k) { return *(const LAS bf16x8*)(base + row * stride + k); }
#define MFMA16(a, b, c) __builtin_amdgcn_mfma_f32_16x16x32_bf16(a, b, c, 0, 0, 0)

__device__ __forceinline__ void hg_delta_item(Frame& F, int item) {
    const int chain = item / NCH_EXT, j = item % NCH_EXT, dir = chain & 1, h = (chain >> 1) & 3, b = chain >> 3;
    const int cj = dir == 0 ? j : (j < 4 ? 3 - j : 135 - j), n0 = cj * 64;
    LAS float* segtot = (LAS float*)F.lds;
    LAS bf16_t* Kt = (LAS bf16_t*)(F.lds + 4096);
    LAS bf16_t* VTs = (LAS bf16_t*)(F.lds + 4096 + 18432);
    const int tid = F.tid, d = 2 * (tid & 63), seg = tid >> 6, lane = F.lane;
    const float* lfp = (dir ? WSP(float, WS_LB) : WSP(float, WS_LF)) + ((size_t)(b * NEXT + n0) * HGW + h * 128 + d);
    f32x2 lf[8], tot = (f32x2){0.f, 0.f};
#pragma unroll
    for (int i = 0; i < 8; ++i) { lf[i] = *(const f32x2*)(lfp + (size_t)(8 * seg + i) * HGW); tot += lf[i]; }
    __syncthreads();
    *(LAS f32x2*)(segtot + seg * 128 + d) = tot;
    { const bf16_t* vt = WSP(bf16_t, WS_VT) + ((size_t)(b * HGW + h * 128) * NEXT + n0);
        u32x4 tv[2];
#pragma unroll
        for (int q = 0; q < 2; ++q) { const int piece = tid + 512 * q, e = piece >> 3, part = piece & 7; tv[q] = *(const u32x4*)(vt + (size_t)e * NEXT + part * 8); }
#pragma unroll
        for (int q = 0; q < 2; ++q) { const int piece = tid + 512 * q, e = piece >> 3, part = piece & 7; *(LAS u32x4*)(VTs + e * 72 + part * 8) = tv[q]; } }
    __syncthreads();
    f32x2 later = (f32x2){0.f, 0.f}, total = later;
#pragma unroll
    for (int s = 0; s < 8; ++s) { const f32x2 v = *(const LAS f32x2*)(segtot + s * 128 + d); total += v; if (dir == 0 ? (s > seg) : (s < seg)) later += v; }
    f32x2 E[8];
    if (dir == 0) { f32x2 run = later;
#pragma unroll
        for (int i = 7; i >= 0; --i) { E[i] = run; run += lf[i]; } }
    else { f32x2 run = later;
#pragma unroll
        for (int i = 0; i < 8; ++i) { E[i] = run; run += lf[i]; } }
    float k0[8], k1[8];
#pragma unroll
    for (int i = 0; i < 8; ++i) { k0[i] = (1.0f - __expf(lf[i].x)) * __expf(E[i].x); k1[i] = (1.0f - __expf(lf[i].y)) * __expf(E[i].y); }
    *(LAS u32x4*)(Kt + d * 72 + 8 * seg) = (u32x4){pk2(k0[0], k0[1]), pk2(k0[2], k0[3]), pk2(k0[4], k0[5]), pk2(k0[6], k0[7])};
    *(LAS u32x4*)(Kt + (d + 1) * 72 + 8 * seg) = (u32x4){pk2(k1[0], k1[1]), pk2(k1[2], k1[3]), pk2(k1[4], k1[5]), pk2(k1[6], k1[7])};
    if (seg == 0) *(f32x2*)(WSP(float, WS_DECAY) + (size_t)item * 128 + d) = (f32x2){__expf(total.x), __expf(total.y)};
    __syncthreads();
    const int w = F.wave, lr = lane & 15, lq = lane >> 4;
    f32x4 acc[8];
#pragma unroll
    for (int et = 0; et < 8; ++et) acc[et] = (f32x4){0.f, 0.f, 0.f, 0.f};
#pragma unroll
    for (int ksi = 0; ksi < 2; ++ksi) { const bf16x8 a = lds_frag(Kt, 16 * w + lr, 72, 32 * ksi + 8 * lq);
#pragma unroll
        for (int et = 0; et < 8; ++et) acc[et] = MFMA16(a, lds_frag(VTs, 16 * et + lr, 72, 32 * ksi + 8 * lq), acc[et]); }
    bf16_t* dl = WSP(bf16_t, WS_DELTA) + (size_t)item * 16384;
#pragma unroll
    for (int et = 0; et < 8; ++et) { const int e = 16 * et + lr, d0 = 16 * w + 4 * lq;
        u32x2 o; o.x = pk2(acc[et][0], acc[et][1]); o.y = pk2(acc[et][2], acc[et][3]); *(u32x2*)(dl + e * 128 + d0) = o; }
}

__device__ __forceinline__ void hg_scan(Frame& F) {
    for (int gid = F.bx * 512 + F.tid; gid < NCHAIN * 8192; gid += F.G * 512) {
        const int chain = gid >> 13, idx = gid & 8191, dd = (2 * idx) & 127;
        const unsigned* dl = WSP(unsigned, WS_DELTA) + (size_t)chain * NCH_EXT * 8192 + idx;
        const float* dc = WSP(float, WS_DECAY) + (size_t)chain * NCH_EXT * 128 + dd;
        unsigned* ss = WSP(unsigned, WS_SST) + (size_t)chain * NCH_LAT * 8192 + idx;
        float s0 = 0.f, s1 = 0.f;
        unsigned dv[12], dw[12]; f32x2 cv[12], cw[12];
#pragma unroll
        for (int u = 0; u < 12; ++u) { dv[u] = dl[(size_t)u * 8192]; cv[u] = *(const f32x2*)(dc + (size_t)u * 128); }
#pragma unroll 1
        for (int j0 = 0; j0 < NCH_EXT; j0 += 12) {
            const bool more = j0 + 12 < NCH_EXT;
            if (more) {
#pragma unroll
                for (int u = 0; u < 12; ++u) { dw[u] = dl[(size_t)(j0 + 12 + u) * 8192]; cw[u] = *(const f32x2*)(dc + (size_t)(j0 + 12 + u) * 128); } }
#pragma unroll
            for (int u = 0; u < 12; ++u) { const int j = j0 + u;
                if (j >= 4) ss[(size_t)(j - 4) * 8192] = pk2(s0, s1);
                s0 = cv[u].x * s0 + bflo(dv[u]); s1 = cv[u].y * s1 + bfhi(dv[u]); }
#pragma unroll
            for (int u = 0; u < 12; ++u) { dv[u] = dw[u]; cv[u] = cw[u]; }
        }
    }
}

__device__ __forceinline__ void yhy_transpose_item(Frame& F, int item) {
    const int b = item >> 7, nb = item & 127, tid = F.tid;
    LAS bf16_t* ts = (LAS bf16_t*)F.lds;
    const bf16_t* src = WSP(bf16_t, WS_YHYT) + (size_t)b * HYW * SEQ + nb * 64;
    __syncthreads();
    { u32x4 tv[8];
#pragma unroll
    for (int q = 0; q < 8; ++q) { const int piece = tid + 512 * q, c = piece >> 3, part = piece & 7; tv[q] = *(const u32x4*)(src + (size_t)c * SEQ + part * 8); }
#pragma unroll
    for (int q = 0; q < 8; ++q) { const int piece = tid + 512 * q, c = piece >> 3, part = piece & 7; *(LAS u32x4*)(ts + c * 72 + part * 8) = tv[q]; } }
    __syncthreads();
    bf16_t* dst = WSP(bf16_t, WS_YHY) + (size_t)(b * SEQ + nb * 64) * HYW;
#pragma unroll
    for (int q = 0; q < 8; ++q) { const int task = tid + 512 * q, n = task & 63, cg = task >> 6;
        unsigned v[8];
#pragma unroll
        for (int i = 0; i < 8; ++i) v[i] = ts[(8 * cg + i) * 72 + n];
        *(u32x4*)(dst + (size_t)n * HYW + 8 * cg) = (u32x4){v[0] | (v[1] << 16), v[2] | (v[3] << 16), v[4] | (v[5] << 16), v[6] | (v[7] << 16)}; }
}

__device__ __forceinline__ void hg_out_item(Frame& F, int item) {
    const int b = item >> 9, h = (item >> 7) & 3, nc = item & 127;
    LAS float* segtot = (LAS float*)F.lds;
    LAS float* bref = (LAS float*)(F.lds + 4096);
    LAS float* red = (LAS float*)(F.lds + 4608);
    LAS bf16_t* Qd = (LAS bf16_t*)(F.lds + 5120);
    LAS bf16_t* Kd = (LAS bf16_t*)(F.lds + 22528);
    LAS bf16_t* Qb = (LAS bf16_t*)(F.lds + 39936);
    LAS bf16_t* VTs = (LAS bf16_t*)(F.lds + 57344);
    LAS bf16_t* Ss = (LAS bf16_t*)(F.lds + 75776);
    LAS bf16_t* att = (LAS bf16_t*)(F.lds + 110592);
    const int tid = F.tid, d = 2 * (tid & 63), seg = tid >> 6, lane = F.lane, w = F.wave, lr = lane & 15, lq = lane >> 4;
    const int nx0 = CTXL + nc * 64, r0 = b * SEQ + nc * 64;
    __syncthreads();
    { const bf16_t* vt = WSP(bf16_t, WS_VT) + ((size_t)(b * HGW + h * 128) * NEXT + nx0);
        u32x4 tv[2];
#pragma unroll
        for (int q = 0; q < 2; ++q) { const int piece = tid + 512 * q, e = piece >> 3, part = piece & 7; tv[q] = *(const u32x4*)(vt + (size_t)e * NEXT + part * 8); }
#pragma unroll
        for (int q = 0; q < 2; ++q) { const int piece = tid + 512 * q, e = piece >> 3, part = piece & 7; *(LAS u32x4*)(VTs + e * 72 + part * 8) = tv[q]; } }
    f32x4 acc[4];
#pragma unroll
    for (int i = 0; i < 4; ++i) acc[i] = (f32x4){0.f, 0.f, 0.f, 0.f};
    const bf16_t* qp = WSP(bf16_t, WS_Q) + ((size_t)r0 * HGW + h * 128 + d);
#pragma unroll 1
    for (int dir = 0; dir < 2; ++dir) {
        const int chain = (b * 4 + h) * 2 + dir, jlat = dir == 0 ? nc : 127 - nc;
        __syncthreads();
        { const bf16_t* sp = WSP(bf16_t, WS_SST) + (size_t)(chain * NCH_LAT + jlat) * 16384;
            u32x4 sv[4];
#pragma unroll
            for (int q = 0; q < 4; ++q) { const int piece = tid + 512 * q, e = piece >> 4, part = piece & 15; sv[q] = *(const u32x4*)(sp + e * 128 + part * 8); }
#pragma unroll
            for (int q = 0; q < 4; ++q) { const int piece = tid + 512 * q, e = piece >> 4, part = piece & 15; *(LAS u32x4*)(Ss + e * 136 + part * 8) = sv[q]; } }
        const float* lfp = (dir ? WSP(float, WS_LB) : WSP(float, WS_LF)) + ((size_t)(b * NEXT + nx0) * HGW + h * 128 + d);
        f32x2 lf[8], qv[8], tot = (f32x2){0.f, 0.f};
#pragma unroll
        for (int i = 0; i < 8; ++i) { lf[i] = *(const f32x2*)(lfp + (size_t)(8 * seg + i) * HGW); const unsigned qw = *(const unsigned*)(qp + (size_t)(8 * seg + i) * HGW); qv[i] = (f32x2){bflo(qw), bfhi(qw)}; tot += lf[i]; }
        *(LAS f32x2*)(segtot + seg * 128 + d) = tot;
        __syncthreads();
        f32x2 off = (f32x2){0.f, 0.f};
#pragma unroll
        for (int s = 0; s < 8; ++s) { const f32x2 v = *(const LAS f32x2*)(segtot + s * 128 + d); if (dir == 0 ? (s < seg) : (s > seg)) off += v; }
        f32x2 bb[8];
        if (dir == 0) { f32x2 run = off;
#pragma unroll
            for (int i = 0; i < 8; ++i) { run += lf[i]; bb[i] = run; } if (seg == 3) *(LAS f32x2*)(bref + d) = bb[7]; }
        else { f32x2 run = off;
#pragma unroll
            for (int i = 7; i >= 0; --i) { run += lf[i]; bb[i] = run; } if (seg == 4) *(LAS f32x2*)(bref + d) = bb[0]; }
        __syncthreads();
        { const f32x2 br = *(const LAS f32x2*)(bref + d); const f32x2 em = (f32x2){__expf(-br.x), __expf(-br.y)}, ep = (f32x2){__expf(br.x), __expf(br.y)};
#pragma unroll
            for (int i = 0; i < 8; ++i) { const int t = 8 * seg + i;
                const f32x2 eb = (f32x2){__expf(bb[i].x), __expf(bb[i].y)}, kk = (f32x2){1.0f - __expf(lf[i].x), 1.0f - __expf(lf[i].y)};
                const f32x2 qb = qv[i] * eb, qd = qb * em, kd = kk * ep * (f32x2){__builtin_amdgcn_rcpf(eb.x), __builtin_amdgcn_rcpf(eb.y)};
                *(LAS unsigned*)(Qd + t * 136 + d) = pk2(qd.x, qd.y); *(LAS unsigned*)(Kd + t * 136 + d) = pk2(kd.x, kd.y); *(LAS unsigned*)(Qb + t * 136 + d) = pk2(qb.x, qb.y); } }
        __syncthreads();
        {
            const int st = w & 3; f32x4 a2[2] = {(f32x4){0.f, 0.f, 0.f, 0.f}, (f32x4){0.f, 0.f, 0.f, 0.f}};
#pragma unroll
            for (int ksi = 0; ksi < 4; ++ksi) { const bf16x8 a = lds_frag(Kd, 16 * st + lr, 136, 32 * ksi + 8 * lq);
#pragma unroll
                for (int q = 0; q < 2; ++q) a2[q] = MFMA16(a, lds_frag(Qd, 16 * (2 * (w >> 2) + q) + lr, 136, 32 * ksi + 8 * lq), a2[q]); }
#pragma unroll
            for (int q = 0; q < 2; ++q) { const int t = 16 * (2 * (w >> 2) + q) + lr, s0 = 16 * st + 4 * lq; float v[4];
#pragma unroll
                for (int r = 0; r < 4; ++r) { const int s = s0 + r; v[r] = (dir == 0 ? (s <= t) : (s >= t)) ? a2[q][r] : 0.f; }
                u32x2 o; o.x = pk2(v[0], v[1]); o.y = pk2(v[2], v[3]); *(LAS u32x2*)(att + t * 72 + s0) = o; }
        }
        __syncthreads();
        { const int tt = w & 3;
#pragma unroll
            for (int ksi = 0; ksi < 2; ++ksi) { const bf16x8 a = lds_frag(att, 16 * tt + lr, 72, 32 * ksi + 8 * lq);
#pragma unroll
                for (int i = 0; i < 4; ++i) acc[i] = MFMA16(a, lds_frag(VTs, 16 * (4 * (w >> 2) + i) + lr, 72, 32 * ksi + 8 * lq), acc[i]); }
#pragma unroll
            for (int ksi = 0; ksi < 4; ++ksi) { const bf16x8 a = lds_frag(Qb, 16 * tt + lr, 136, 32 * ksi + 8 * lq);
#pragma unroll
                for (int i = 0; i < 4; ++i) acc[i] = MFMA16(a, lds_frag(Ss, 16 * (4 * (w >> 2) + i) + lr, 136, 32 * ksi + 8 * lq), acc[i]); }
        }
    }
    const int tt = w & 3, eh = w >> 2;
    float ssq[4];
#pragma unroll
    for (int r = 0; r < 4; ++r) { float s = 0.f;
#pragma unroll
        for (int i = 0; i < 4; ++i) s += acc[i][r] * acc[i][r];
        s += __shfl_xor(s, 1); s += __shfl_xor(s, 2); s += __shfl_xor(s, 4); s += __shfl_xor(s, 8); ssq[r] = s; }
    if (lr == 0) {
#pragma unroll
        for (int r = 0; r < 4; ++r) red[eh * 64 + 16 * tt + 4 * lq + r] = ssq[r]; }
    __syncthreads();
    const float* ng = F.p->in[I_HGNG]; const bf16_t* gp = WSP(bf16_t, WS_G); bf16_t* yo = WSP(bf16_t, WS_YHG);
    float ngv[4], gv[4][4];
#pragma unroll
    for (int i = 0; i < 4; ++i) ngv[i] = ng[16 * (4 * eh + i) + lr];
#pragma unroll
    for (int r = 0; r < 4; ++r)
#pragma unroll
        for (int i = 0; i < 4; ++i) gv[r][i] = bf2f(gp[(size_t)(r0 + 16 * tt + 4 * lq + r) * HGW + h * 128 + 16 * (4 * eh + i) + lr]);
#pragma unroll
    for (int r = 0; r < 4; ++r) { const int t = 16 * tt + 4 * lq + r; const float rs = rsqrtf((red[t] + red[64 + t]) * (1.0f / 128.0f) + EPS);
#pragma unroll
        for (int i = 0; i < 4; ++i) { const int e = 16 * (4 * eh + i) + lr; const size_t o = (size_t)(r0 + t) * HGW + h * 128 + e;
            yo[o] = (bf16_t)f2bf(acc[i][r] * rs * ngv[i] * gv[r][i]); } }
}
__device__ __forceinline__ void phase_route(Frame& F) {
    const float* lg = WSP(float, WS_LOGIT); const float* rb = F.p->in[I_RB];
    unsigned* cnt = WSP(unsigned, WS_CTL) + CW_CNT;
    int* re_ = WSP(int, WS_ROUTE_E); float* rw_ = WSP(float, WS_ROUTE_W); int* rp_ = WSP(int, WS_ROUTE_P);
    const int gw = F.bx * 8 + F.wave, NGW = F.G * 8, lane = F.lane;
    const f32x4 bias = *(const f32x4*)(rb + 4 * lane);
    const float NINF = -__builtin_inff();
    const bool al = (F.G == 256); const int tbase = al ? (((F.bx & 7) * 32 + (F.bx >> 3)) * 8 + F.wave) * 8 : gw, tstr = al ? 1 : NGW;
    f32x4 lpre[8];
#pragma unroll
    for (int i = 0; i < 8; ++i) { const int t = tbase + i * tstr; lpre[i] = t < T ? *(const f32x4*)(lg + (size_t)t * NE + 4 * lane) : (f32x4){0.f, 0.f, 0.f, 0.f}; }
    int ti = 0;
    for (int t = tbase; al ? ti < 8 : t < T; t += tstr, ++ti) {
        f32x4 l4 = lpre[0];
#pragma unroll
        for (int i = 1; i < 8; ++i) if (ti == i) l4 = lpre[i];
        if (ti >= 8) l4 = *(const f32x4*)(lg + (size_t)t * NE + 4 * lane);
        float sc[4], bs[4];
#pragma unroll
        for (int i = 0; i < 4; ++i) { sc[i] = sigmoidf_(l4[i]); bs[i] = sc[i] + bias[i]; }
        float m1 = fmaxf(bs[0], bs[1]), m2 = fminf(bs[0], bs[1]);
#pragma unroll
        for (int i = 2; i < 4; ++i) { const float v = bs[i]; m2 = fmaxf(m2, fminf(m1, v)); m1 = fmaxf(m1, v); }
#pragma unroll
        for (int o = 1; o < 8; o <<= 1) { const float o1 = __shfl_xor(m1, o), o2 = __shfl_xor(m2, o); const float n1 = fmaxf(m1, o1), n2 = fmaxf(fminf(m1, o1), fmaxf(m2, o2)); m1 = n1; m2 = n2; }
        const float gs = m1 + m2; const int mg = lane >> 3; int rank = 0;
#pragma unroll
        for (int g = 0; g < 8; ++g) { const float v = __shfl(gs, g * 8); rank += (v > gs || (v == gs && g < mg)) ? 1 : 0; }
        const bool sel = rank < 4;
        float cd[4];
#pragma unroll
        for (int i = 0; i < 4; ++i) cd[i] = sel ? bs[i] : NINF;
        int ek[8]; float sk[8]; float ssum = 0.f;
#pragma unroll
        for (int k = 0; k < 8; ++k) {
            float bv = cd[0]; int bi = 4 * lane;
#pragma unroll
            for (int i = 1; i < 4; ++i) if (cd[i] > bv) { bv = cd[i]; bi = 4 * lane + i; }
#pragma unroll
            for (int o = 32; o >= 1; o >>= 1) { const float ov = __shfl_xor(bv, o); const int oi = __shfl_xor(bi, o); if (ov > bv || (ov == bv && oi < bi)) { bv = ov; bi = oi; } }
            const int sub = bi & 3; const float mysc = sub == 0 ? sc[0] : (sub == 1 ? sc[1] : (sub == 2 ? sc[2] : sc[3]));
            const float s = __shfl(mysc, bi >> 2);
            if ((bi >> 2) == lane) {
#pragma unroll
                for (int i = 0; i < 4; ++i) if (i == sub) cd[i] = NINF; }
            ek[k] = bi; sk[k] = s; ssum += s;
        }
        const float scale = 2.5f / ssum;
        int me = ek[0]; float mw = sk[0];
#pragma unroll
        for (int k = 1; k < 8; ++k) if (lane == k) { me = ek[k]; mw = sk[k]; }
        if (lane < 8) { const int pos = (int)atomicAdd(cnt + me, 1u); re_[t * 8 + lane] = me; rw_[t * 8 + lane] = mw * scale; rp_[t * 8 + lane] = pos; }
    }
}
__device__ __forceinline__ void phase_scatter(Frame& F) {
    LAS int* st = (LAS int*)F.lds; LAS int* cn = st + 512;
    const unsigned* cnt = WSP(unsigned, WS_CTL) + CW_CNT;
    __syncthreads();
    if (F.tid < NE) cn[F.tid] = (int)cnt[F.tid];
    __syncthreads();
    if (F.tid <= NE) { int s = 0, tl = 0; for (int e = 0; e < F.tid; ++e) { s += cn[e]; tl += (cn[e] + 255) >> 8; } st[F.tid] = s;
        if (F.bx == 0) { unsigned* ctl = WSP(unsigned, WS_CTL); ctl[CW_START + F.tid] = (unsigned)s; ctl[CW_TOFF + F.tid] = (unsigned)tl;
            if (F.tid < NE) { const int c_ = cn[F.tid]; for (int j = 0; j * 256 < c_; ++j) { unsigned* up = ctl + CW_UNITS + 4 * (tl + j); up[0] = (unsigned)(s + 256 * j); up[1] = (unsigned)F.tid; up[2] = (unsigned)(c_ - 256 * j < 256 ? c_ - 256 * j : 256); up[3] = 0u; } } } }
    __syncthreads();
    const int* re_ = WSP(int, WS_ROUTE_E); const float* rw_ = WSP(float, WS_ROUTE_W); const int* rp_ = WSP(int, WS_ROUTE_P);
    int* stok = WSP(int, WS_SLOT_TOK); float* sw = WSP(float, WS_SLOT_W); int* sof = WSP(int, WS_SLOTOF);
    for (int a = F.bx * 512 + F.tid; a < NASG; a += F.G * 512) { const int slot = st[re_[a]] + rp_[a]; stok[slot] = a >> 3; sw[slot] = rw_[a]; sof[a] = slot; }
    if (F.bx == 0 && F.tid < 256) { stok[NASG + F.tid] = 0; sw[NASG + F.tid] = 0.f; }
}
__device__ __forceinline__ void phase_final(Frame& F) {
    float* out = F.p->out; const float* x1 = F.p->out;     const float* fg = F.p->in[I_FG]; const float* ada = WSP(float, WS_ADA);
    const unsigned char* yb8 = WSP(unsigned char, WS_YBUF); const bf16_t* ysh = WSP(bf16_t, WS_YSH); const int* sof = WSP(int, WS_SLOTOF);
    const int lane = F.lane, NGW = F.G * 8;
    const bool al = (F.G == 256); const int tbase = al ? (((F.bx & 7) * 32 + (F.bx >> 3)) * 8 + F.wave) * 8 : F.bx * 8 + F.wave, tstr = al ? 1 : NGW;
    f32x4 fgv[2][2];
#pragma unroll
    for (int j = 0; j < 2; ++j) { fgv[j][0] = *(const f32x4*)(fg + 512 * j + 8 * lane); fgv[j][1] = *(const f32x4*)(fg + 512 * j + 8 * lane + 4); }
    int it_ = 0;
    for (int t = tbase; al ? it_ < 8 : t < T; t += tstr, ++it_) { const int b = t >> 13;
        int sl[8];
#pragma unroll
        for (int k = 0; k < 8; ++k) sl[k] = sof[t * 8 + k];
        u32x4 ys[2]; u32x2 y[8][2]; f32x4 xv[2][2], g2[2][2];
#pragma unroll
        for (int j = 0; j < 2; ++j) { const int c = 512 * j + 8 * lane;
            ys[j] = *(const u32x4*)(ysh + (size_t)t * D + c); xv[j][0] = *(const f32x4*)(x1 + (size_t)t * D + c); xv[j][1] = *(const f32x4*)(x1 + (size_t)t * D + c + 4);
            g2[j][0] = *(const f32x4*)(ada + b * 6144 + 5 * D + c); g2[j][1] = *(const f32x4*)(ada + b * 6144 + 5 * D + c + 4);
#pragma unroll
            for (int k = 0; k < 8; ++k) y[k][j] = *(const u32x2*)(yb8 + (size_t)sl[k] * D + c); }
        f32x4 v[2][2]; float ss = 0.f;
#pragma unroll
        for (int j = 0; j < 2; ++j) { f32x4 m0 = (f32x4){bflo(ys[j].x), bfhi(ys[j].x), bflo(ys[j].y), bfhi(ys[j].y)}, m1 = (f32x4){bflo(ys[j].z), bfhi(ys[j].z), bflo(ys[j].w), bfhi(ys[j].w)};
#pragma unroll
            for (int k = 0; k < 8; ++k) { const f32x2 a0 = __builtin_amdgcn_cvt_pk_f32_fp8((int)y[k][j].x, false), a1 = __builtin_amdgcn_cvt_pk_f32_fp8((int)y[k][j].x, true), b0 = __builtin_amdgcn_cvt_pk_f32_fp8((int)y[k][j].y, false), b1 = __builtin_amdgcn_cvt_pk_f32_fp8((int)y[k][j].y, true);
                m0 += (f32x4){a0.x, a0.y, a1.x, a1.y}; m1 += (f32x4){b0.x, b0.y, b1.x, b1.y}; }
            v[j][0] = xv[j][0] + g2[j][0] * m0; v[j][1] = xv[j][1] + g2[j][1] * m1;
#pragma unroll
            for (int h = 0; h < 2; ++h) ss += (v[j][h][0] * v[j][h][0] + v[j][h][1] * v[j][h][1]) + (v[j][h][2] * v[j][h][2] + v[j][h][3] * v[j][h][3]); }
        const float rs = rsqrtf(wave_sum(ss) * (1.0f / D) + EPS);
#pragma unroll
        for (int j = 0; j < 2; ++j) { const int c = 512 * j + 8 * lane; *(f32x4*)(out + (size_t)t * D + c) = v[j][0] * rs * fgv[j][0]; *(f32x4*)(out + (size_t)t * D + c + 4) = v[j][1] * rs * fgv[j][1]; }
    }
}

constexpr int NPHASE = 15;
#ifndef REP_MASK
#define REP_MASK 0u
#endif
#define NREP(k) ((((REP_MASK) >> (k)) & 1u) ? 2 : 1)
#ifndef MK_LAUNCH_PER_PHASE
#define MK_LAUNCH_PER_PHASE 0
#endif
__global__ void __launch_bounds__(512) hyena_hgrn2_moe_fwd(Params p) {
    extern __shared__ __attribute__((aligned(16))) unsigned char lds_[];
    cg::grid_group grid = cg::this_grid();
    Frame F; F.lds = (LAS unsigned char*)lds_; F.p = &p; F.ws = p.ws; F.tid = threadIdx.x; F.lane = F.tid & 63; F.wave = __builtin_amdgcn_readfirstlane(F.tid >> 6); F.G = gridDim.x; F.bx = blockIdx.x;
    if (F.tid < 16) ((LAS unsigned*)(F.lds + LDS_BARST))[F.tid] = 0u;
    __syncthreads();
    XcdBarrier bar = xcd_barrier_post((unsigned*)(p.ws + WS_CTL) + CW_BAR, (volatile LAS unsigned*)(F.lds + LDS_BARST));
#ifdef ONLY_PHASE
#define IN(k) ((k) == ONLY_PHASE && p.ph_lo <= (k) && (k) < p.ph_hi)
#else
#define IN(k) (p.ph_lo <= (k) && (k) < p.ph_hi)
#endif
#define SEAM(k) do { if (IN(k) && IN((k) + 1)) xcd_barrier(bar); } while (0)
    if (p.ph_lo < 0) grid.sync();
    if (IN(0)) _Pragma("unroll 1") for (int rp = 0; rp < NREP(0); ++rp) { asm volatile("" : "+v"(F.tid)); if (rp) xcd_barrier(bar); phase0(F); }
    SEAM(0);
    if (IN(1)) _Pragma("unroll 1") for (int rp = 0; rp < NREP(1); ++rp) { asm volatile("" : "+v"(F.tid)); if (rp) xcd_barrier(bar); phase1(F); }
    SEAM(1);
    if (IN(2)) _Pragma("unroll 1") for (int rp = 0; rp < NREP(2); ++rp) { asm volatile("" : "+v"(F.tid)); if (rp) xcd_barrier(bar);
        __syncthreads();
        if (F.G == 256 && F.bx >= 256 - NCONV) {
            int tid = F.tid; conv_loop(p.in, F.ws, 256 * (XP_BG + XP_K0) + (F.bx - (256 - NCONV)), NCONV, NE * 48, tid);
        } else
        { pg8::Gemm g{WSP(bf16_t, WS_WINT), WSP(bf16_t, WS_WINT), D, nullptr, 2 * D, 128}; InOrder S{F.G == 256 ? 256 - NCONV : F.G, F.bx};
          EpiIn E{EpiInT{WSP(bf16_t, WS_PHYT), WSP(bf16_t, WS_VT)}, EpiInN{WSP(bf16_t, WS_Q), WSP(bf16_t, WS_G), WSP(bf16_t, WS_SG1), WSP(bf16_t, WS_SG2), WSP(float, WS_LF), WSP(float, WS_LB), WSP(float, WS_LBS)}};
          pg8::gemm_phase<EpiIn, InOrder, false>(F.lds, g, S, E); }
    }
    SEAM(2);
    if (IN(3)) _Pragma("unroll 1") for (int rp = 0; rp < NREP(3); ++rp) { asm volatile("" : "+v"(F.tid)); if (rp) xcd_barrier(bar);
        _Pragma("unroll 1") for (int r2 = 0; r2 < NREP(16); ++r2) { asm volatile("" : "+v"(F.tid));
            XpState xp; xp.it = F.bx; xp.stride = F.G; xp.end = (XP_BG * F.G < NE * 48) ? XP_BG * F.G : NE * 48; xp.live = false;
            for (int c = F.bx; c < HYW; c += F.G) hyena_item(F, c, xp);
            { int tid = F.tid; xp_finish(xp, p.in, F.ws, tid); while (xp.it < xp.end) { xp_issue(xp, p.in, F.ws, tid); xp_finish(xp, p.in, F.ws, tid); } } }
        _Pragma("unroll 1") for (int r2 = 0; r2 < NREP(17); ++r2) { asm volatile("" : "+v"(F.tid)); for (int it = F.bx; it < NAITEM; it += F.G) hg_delta_item(F, it); }
    }
    SEAM(3);
    if (IN(4)) _Pragma("unroll 1") for (int rp = 0; rp < NREP(4); ++rp) { asm volatile("" : "+v"(F.tid)); if (rp) xcd_barrier(bar);
        _Pragma("unroll 1") for (int r2 = 0; r2 < NREP(18); ++r2) { asm volatile("" : "+v"(F.tid)); hg_scan(F); }
        _Pragma("unroll 1") for (int r2 = 0; r2 < NREP(19); ++r2) { asm volatile("" : "+v"(F.tid)); for (int it = F.bx; it < NB * 128; it += F.G) yhy_transpose_item(F, it); }
    }
    SEAM(4);
    if (IN(5)) _Pragma("unroll 1") for (int rp = 0; rp < NREP(5); ++rp) { asm volatile("" : "+v"(F.tid)); if (rp) xcd_barrier(bar); for (int it = F.bx; it < NB * 4 * NCH_LAT; it += F.G) hg_out_item(F, it); }
    SEAM(5);
    if (IN(6)) _Pragma("unroll 1") for (int rp = 0; rp < NREP(6); ++rp) { asm volatile("" : "+v"(F.tid)); if (rp) xcd_barrier(bar);
        __syncthreads();
        { pg8::Gemm g{WSP(bf16_t, WS_YHY), WSP(bf16_t, WS_WHYT), HYW, nullptr, 2 * HYW, 128}; pg8::StaticOrder S; S.init(T, D, HYW, F.G, F.bx); EpiMerge1 E{WSP(bf16_t, WS_SG1), WSP(bf16_t, WS_T1)};
          pg8::gemm_phase<EpiMerge1, pg8::StaticOrder, false>(F.lds, g, S, E); }
        { pg8::Gemm g{WSP(bf16_t, WS_YHG), WSP(bf16_t, WS_WHGT), HGW, nullptr, 2 * HGW, 128}; pg8::StaticOrder S; S.init(T, D, HGW, F.G, F.bx); EpiMerge2 E{WSP(bf16_t, WS_SG2), WSP(bf16_t, WS_T1), WSP(bf16_t, WS_MB)};
          pg8::gemm_phase<EpiMerge2, pg8::StaticOrder, false>(F.lds, g, S, E); }
    }
    SEAM(6);
    if (IN(7)) _Pragma("unroll 1") for (int rp = 0; rp < NREP(7); ++rp) { asm volatile("" : "+v"(F.tid)); if (rp) xcd_barrier(bar);
        __syncthreads();
        pg8::Gemm g{WSP(bf16_t, WS_MB), WSP(bf16_t, WS_WOUTT), D, nullptr, 2 * D, 128}; pg8::StaticOrder S; S.init(T, D, D, F.G, F.bx);
        EpiWout E{p.in[I_X], WSP(float, WS_POSR), WSP(float, WS_POSC), WSP(float, WS_ADA), p.out};
        pg8::gemm_phase<EpiWout, pg8::StaticOrder, false>(F.lds, g, S, E);
    }
    SEAM(7);
    if (IN(8)) _Pragma("unroll 1") for (int rp = 0; rp < NREP(8); ++rp) { asm volatile("" : "+v"(F.tid)); if (rp) xcd_barrier(bar); phase_h2(F); }
    SEAM(8);
    if (IN(9)) _Pragma("unroll 1") for (int rp = 0; rp < NREP(9); ++rp) { asm volatile("" : "+v"(F.tid)); if (rp) xcd_barrier(bar);
        __syncthreads();
        { pg8::Gemm g{WSP(bf16_t, WS_H2), WSP(bf16_t, WS_ROUT), D, nullptr, 2 * D, 128}; P9Order S{F.G, F.bx}; EpiP9 E{EpiLogit{WSP(float, WS_LOGIT)}, EpiGU{WSP(bf16_t, WS_HSH)}};
          pg8::gemm_phase<EpiP9, P9Order, false>(F.lds, g, S, E); }
    }
    SEAM(9);
    if (IN(10)) _Pragma("unroll 1") for (int rp = 0; rp < NREP(10); ++rp) { asm volatile("" : "+v"(F.tid)); if (rp) xcd_barrier(bar); phase_route(F); }
    SEAM(10);
    if (IN(11)) _Pragma("unroll 1") for (int rp = 0; rp < NREP(11); ++rp) { asm volatile("" : "+v"(F.tid)); if (rp) xcd_barrier(bar); phase_scatter(F); }
    SEAM(11);
    if (IN(12)) _Pragma("unroll 1") for (int rp = 0; rp < NREP(12); ++rp) { asm volatile("" : "+v"(F.tid)); if (rp) xcd_barrier(bar);
        __syncthreads();
        pg8::Gemm g{WSP(bf16_t, WS_H2), WSP(bf16_t, WS_EGUT), D, WSP(int, WS_SLOT_TOK), 128, 512 * 128}; MoeOrder S{WSP(unsigned, WS_CTL) + CW_UNITS, (int)WSP(unsigned, WS_CTL)[CW_TOFF + NE], 2, F.G, F.bx, 1048576u}; EpiGU E{WSP(bf16_t, WS_HBUF)};
        pg8::gemm_phase<EpiGU, MoeOrder, true>(F.lds, g, S, E);
    }
    SEAM(12);
    if (IN(13)) _Pragma("unroll 1") for (int rp = 0; rp < NREP(13); ++rp) { asm volatile("" : "+v"(F.tid)); if (rp) xcd_barrier(bar);
        __syncthreads();
        { pg8::Gemm g{WSP(bf16_t, WS_HBUF), WSP(bf16_t, WS_EDT), EH, nullptr, 128, 1024 * 128}; MoeOrder S{WSP(unsigned, WS_CTL) + CW_UNITS, (int)WSP(unsigned, WS_CTL)[CW_TOFF + NE], 4, F.G, F.bx, 524288u}; EpiDown<true, true> E{WSP(bf16_t, WS_YBUF), WSP(float, WS_SLOT_W)};
          pg8::gemm_phase<EpiDown<true, true>, MoeOrder, false>(F.lds, g, S, E); }
        { pg8::Gemm g{WSP(bf16_t, WS_HSH), WSP(bf16_t, WS_SHDT), EH, nullptr, 2 * EH, 128}; pg8::StaticOrder S; S.init(T, D, EH, F.G, F.bx); EpiDown<false> E{WSP(bf16_t, WS_YSH), nullptr};
          pg8::gemm_phase<EpiDown<false>, pg8::StaticOrder, false>(F.lds, g, S, E); }
    }
    SEAM(13);
    if (IN(14)) _Pragma("unroll 1") for (int rp = 0; rp < NREP(14); ++rp) { asm volatile("" : "+v"(F.tid)); if (rp) xcd_barrier(bar); phase_final(F); }
#undef IN
#undef SEAM
}

extern "C" void kernel_launch(void* const* d_in, const int* in_sizes, int n_in, void* d_out, int out_size, void* d_ws, size_t ws_size, hipStream_t stream) {
    static int grid = 0;
    if (grid == 0) {
        if (n_in != 34 || out_size != T * D || ws_size < WS_END) { fprintf(stderr, "kernel_launch: unexpected shapes (n_in %d, out %d, ws %zu < %zu)\n", n_in, out_size, ws_size, (size_t)WS_END); grid = -1; return; }
        int dev = 0, cus = 0, per_cu = 0;
        if (hipGetDevice(&dev) != hipSuccess || hipDeviceGetAttribute(&cus, hipDeviceAttributeMultiprocessorCount, dev) != hipSuccess) { grid = -1; return; }
        if (hipFuncSetAttribute((const void*)hyena_hgrn2_moe_fwd, hipFuncAttributeMaxDynamicSharedMemorySize, LDS_BYTES) != hipSuccess) { fprintf(stderr, "kernel_launch: hipFuncSetAttribute failed\n"); grid = -1; return; }
        if (hipOccupancyMaxActiveBlocksPerMultiprocessor(&per_cu, (const void*)hyena_hgrn2_moe_fwd, 512, LDS_BYTES) != hipSuccess || per_cu < 1) { fprintf(stderr, "kernel_launch: occupancy query failed (%d)\n", per_cu); (void)hipGetLastError(); per_cu = 1; }
        grid = cus * per_cu; if (grid > 256) grid = 256;
    }
    if (grid < 0) return;
    if (hipMemsetAsync((char*)d_ws + WS_CTL, 0, CTL_BYTES, stream) != hipSuccess) { fprintf(stderr, "kernel_launch: memset failed\n"); return; }
    Params p{};
    for (int i = 0; i < 34; ++i) p.in[i] = (const float*)d_in[i];
    p.out = (float*)d_out; p.ws = (unsigned char*)d_ws;
#if MK_LAUNCH_PER_PHASE
    for (int k = 0; k < NPHASE; ++k) { p.ph_lo = k; p.ph_hi = k + 1; void* args[] = {&p};
        hipError_t e = hipLaunchCooperativeKernel((const void*)hyena_hgrn2_moe_fwd, dim3(grid), dim3(512), args, LDS_BYTES, stream);
        if (e != hipSuccess) { fprintf(stderr, "kernel_launch: launch %d failed: %s\n", k, hipGetErrorString(e)); break; } }
#else
    p.ph_lo = 0; p.ph_hi = NPHASE; void* args[] = {&p};
    hipError_t e = hipLaunchCooperativeKernel((const void*)hyena_hgrn2_moe_fwd, dim3(grid), dim3(512), args, LDS_BYTES, stream);
    if (e != hipSuccess) fprintf(stderr, "kernel_launch: cooperative launch failed: %s (grid %d)\n", hipGetErrorString(e), grid);
#endif
}
```

```cpp
#include <hip/hip_runtime.h>
#include <hip/hip_cooperative_groups.h>
#include <cstdio>
#include <cstdint>
namespace cg = cooperative_groups;

#define LAS __attribute__((address_space(3)))
typedef unsigned short bf16_t;
typedef short bf16x8 __attribute__((ext_vector_type(8)));
typedef float f32x4 __attribute__((ext_vector_type(4)));
typedef float f32x2 __attribute__((ext_vector_type(2)));
typedef unsigned u32x4 __attribute__((ext_vector_type(4)));
typedef unsigned u32x2 __attribute__((ext_vector_type(2)));

constexpr int D = 1024, NB = 2, SEQ = 8192, T = NB * SEQ, CTXL = 256, TC = NB * CTXL, MA = T + TC, NEXT = CTXL + SEQ;
constexpr int HYW = 512, HYP = 1536, HGW = 512, INC = 6144;
constexpr int NE = 256, TOPK = 8, EH = 256, NASG = T * TOPK;
constexpr int NCH_EXT = NEXT / 64  , NCH_LAT = SEQ / 64  , NCHAIN = 16, NAITEM = NCHAIN * NCH_EXT  ;
constexpr int FFTN = 16384;
constexpr float EPS = 1e-6f;

constexpr size_t al256(size_t x) { return (x + 255) & ~(size_t)255; }
constexpr size_t WS_CTL = 0, CTL_BYTES = 65536;
constexpr size_t WS_WINT = WS_CTL + CTL_BYTES;
constexpr size_t WS_WHYT = WS_WINT + (size_t)INC * D * 2;
constexpr size_t WS_WHGT = WS_WHYT + (size_t)D * HYW * 2;
constexpr size_t WS_WOUTT = WS_WHGT + (size_t)D * HGW * 2;
constexpr size_t WS_ROUT = WS_WOUTT + (size_t)D * D * 2;
constexpr size_t WS_SHGUT = WS_ROUT + (size_t)NE * D * 2;
constexpr size_t WS_SHDT = WS_SHGUT + (size_t)512 * D * 2;
constexpr size_t WS_ADAP = WS_SHDT + (size_t)D * 256 * 2;
constexpr size_t WS_ADA = WS_ADAP + (size_t)32 * 3 * 6144 * 4;
constexpr size_t WS_POSR = WS_ADA + (size_t)3 * 6144 * 4;
constexpr size_t WS_POSC = WS_POSR + (size_t)128 * 512 * 4;
constexpr size_t WS_LBS = WS_POSC + (size_t)64 * 512 * 4;
constexpr size_t WS_ROUTE_E = WS_LBS + 4096;
constexpr size_t WS_ROUTE_W = WS_ROUTE_E + (size_t)NASG * 4;
constexpr size_t WS_ROUTE_P = WS_ROUTE_W + (size_t)NASG * 4;
constexpr size_t WS_SLOTOF = WS_ROUTE_P + (size_t)NASG * 4;
constexpr size_t WS_SLOT_TOK = WS_SLOTOF + (size_t)NASG * 4;
constexpr size_t WS_SLOT_W = WS_SLOT_TOK + (size_t)(NASG + 256) * 4;
constexpr size_t WS_HIST = al256(WS_SLOT_W + (size_t)(NASG + 256) * 4);
constexpr size_t WS_PREF = WS_HIST + 256 * 256 * 4;
constexpr size_t WS_A3 = al256(WS_PREF + 256 * 256 * 4);
constexpr size_t WS_W4T = WS_A3 + (size_t)SEQ * 64 * 2;
constexpr size_t WS_EGUT = al256(WS_W4T + (size_t)2048 * 64 * 2);
constexpr size_t WS_EDT = WS_EGUT + (size_t)NE * 512 * D * 2;
constexpr size_t WS_RA = WS_EDT + (size_t)NE * D * EH * 2;
constexpr size_t RA_BYTES = (size_t)NASG * D * 2;
constexpr size_t WS_HF = WS_RA;
constexpr size_t WS_KS = WS_HF + (size_t)2048 * SEQ * 4;
constexpr size_t WS_DELTA = WS_KS + (size_t)256 * 2 * FFTN * 8;
constexpr size_t WS_DECAY = WS_DELTA + (size_t)NAITEM * 16384 * 2;
constexpr size_t WS_PHYT = WS_DECAY + (size_t)NAITEM * 128 * 4;
static_assert(WS_PHYT + (size_t)NB * HYP * SEQ * 2 <= WS_RA + RA_BYTES, "region A overflow");
constexpr size_t WS_YBUF = WS_RA;
constexpr size_t WS_RB = WS_RA + RA_BYTES;
constexpr size_t WS_VT = WS_RB;
constexpr size_t WS_Q = WS_VT + (size_t)NB * HGW * NEXT * 2;
constexpr size_t WS_LF = WS_Q + (size_t)T * HGW * 2;
constexpr size_t WS_LB = WS_LF + (size_t)NB * NEXT * HGW * 4;
constexpr size_t WS_G = WS_LB + (size_t)NB * NEXT * HGW * 4;
constexpr size_t WS_SG1 = WS_G + (size_t)T * HGW * 2;
constexpr size_t WS_SG2 = WS_SG1 + (size_t)T * D * 2;
constexpr size_t WS_A1 = WS_SG2 + (size_t)T * D * 2;
constexpr size_t WS_SST = WS_A1 + (size_t)MA * D * 2;
constexpr size_t WS_YHG = WS_SST + (size_t)NCHAIN * NCH_LAT * 16384 * 2 + 256 * 512;
constexpr size_t WS_T1 = WS_YHG + (size_t)T * HGW * 2;
constexpr size_t WS_END = WS_T1 + (size_t)T * D * 4;
constexpr size_t WS_LOGIT = WS_VT, WS_HSH = WS_Q, WS_MB = WS_LF, WS_H2 = WS_LB, WS_YSH = WS_SG1, WS_YHYT = WS_A1, WS_YHY = WS_A1 + (size_t)NB * HYW * SEQ * 2, WS_HBUF = WS_SST;
static_assert((size_t)T * 256 * 4 <= (size_t)NB * HGW * NEXT * 2, "LOGIT fits VT");
static_assert(WS_YHY + (size_t)T * HYW * 2 <= WS_SST, "YHY fits A1");
static_assert((size_t)(NASG + 256) * EH * 2 <= (size_t)NCHAIN * NCH_LAT * 16384 * 2 + 256 * 512, "HBUF fits SST");
static_assert(WS_END <= (size_t)1073741824, "workspace map exceeds 1 GiB");
constexpr int CW_CNT = 0;
constexpr int CW_START = 512;
constexpr int CW_TOFF = 1024;
constexpr int CW_PRE = 2048;
constexpr int CW_BAR = 4096;
constexpr int CW_UNITS = 8192;

constexpr int LDS_BYTES = 147456;
constexpr int LDS_BARST = LDS_BYTES - 64;

__device__ __forceinline__ unsigned f2bf(float f) { unsigned u = __float_as_uint(f); return (u + 0x7fffu + ((u >> 16) & 1u)) >> 16; }
__device__ __forceinline__ unsigned pk2(float lo, float hi) { return f2bf(lo) | (f2bf(hi) << 16); }
__device__ __forceinline__ float bf2f(unsigned b) { return __uint_as_float(b << 16); }
__device__ __forceinline__ float bflo(unsigned w) { return __uint_as_float(w << 16); }
__device__ __forceinline__ float bfhi(unsigned w) { return __uint_as_float(w & 0xffff0000u); }
__device__ __forceinline__ float sigmoidf_(float x) { return __builtin_amdgcn_rcpf(1.0f + __expf(-x)); }
__device__ __forceinline__ float siluf_(float x) { return x * __builtin_amdgcn_rcpf(1.0f + __expf(-x)); }
__device__ __forceinline__ unsigned f2h(float f) { return (unsigned)__builtin_bit_cast(unsigned short, (_Float16)f); }
__device__ __forceinline__ unsigned pkh2(float lo, float hi) { return f2h(lo) | (f2h(hi) << 16); }
__device__ __forceinline__ float h2f(unsigned short b) { return (float)__builtin_bit_cast(_Float16, b); }
__device__ __forceinline__ float wave_sum(float v) {
#pragma unroll
    for (int o = 1; o < 64; o <<= 1) v += __shfl_xor(v, o);
    return v;
}
#define LDS_WAIT() asm volatile("s_waitcnt lgkmcnt(0)" ::: "memory")
#define MFMA16(a, b, c) __builtin_amdgcn_mfma_f32_16x16x32_bf16(a, b, c, 0, 0, 0)

struct Params {
    const float* in[34];
    float* out;
    unsigned char* ws;
    int ph_lo, ph_hi;
};
enum { I_X = 0, I_C, I_CTX, I_CCTX, I_N1G, I_N2G, I_ADAW, I_ADAB, I_WIN, I_HCW, I_HCB, I_FW1, I_FB1, I_FW2, I_FB2, I_FW3, I_FB3, I_FW4, I_FFREQ, I_HSKIP,
       I_LBL, I_HGNG, I_WHY, I_WHG, I_WOUT, I_RW, I_RB, I_EG, I_EU, I_ED, I_SG, I_SU, I_SD, I_FG };
namespace pg8 {
constexpr int BM = 256, BK = 64, HALF = 128, HTB = HALF * BK * 2, STAGE_BYTES = 8 * HTB;
__host__ __device__ __forceinline__ int lds_byte(int r, int c) { const int st = (r >> 4) * 2 + (c >> 5), rr = r & 15, cc = c & 31, ob = rr * 64 + cc * 2; return st * 1024 + (ob ^ (((ob >> 9) & 1) << 5)); }
__host__ __device__ __forceinline__ void stage_rc(int b, int& R, int& C) { const int st = b / 1024, sb = b % 1024, swz = sb ^ (((sb >> 9) & 1) << 5); R = (st >> 1) * 16 + swz / 64; C = (st & 1) * 32 + (swz % 64) / 2; }
__host__ __device__ __forceinline__ int perm32(int rho) { const int n = rho >> 4, i = rho & 15; return 8 * (i >> 2) + 4 * n + (i & 3); }

struct Unit { int row0, lrow, pn, nvalid, aux, kind; unsigned boff; };
struct Gemm { const bf16_t* A; const bf16_t* Bt; int K; const int* rows; int ldb, kstepB; };

__device__ __forceinline__ unsigned cvt_pk_bf16(float lo, float hi) { unsigned r; asm volatile("v_cvt_pk_bf16_f32 %0, %1, %2" : "=v"(r) : "v"(lo), "v"(hi)); return r; }

template <class Epi, class Sched, bool GATHER>
__device__ __forceinline__ void gemm_phase(LAS unsigned char* lds, const Gemm g, const Sched& S, const Epi& E, unsigned long long* pacc = nullptr) {
#ifdef PROBE_CALL
    const unsigned long long c0_ = pacc ? __builtin_amdgcn_s_memrealtime() : 0ull; unsigned long long* pacc_call = pacc; pacc = nullptr;
#endif
    const int tid = threadIdx.x, wid = __builtin_amdgcn_readfirstlane(tid >> 6), lane = tid & 63, wr = wid >> 2, wc = wid & 3, fr = lane & 15, fq = lane >> 4;
    int K_ = g.K; asm volatile("" : "+s"(K_));
    const int K = K_, nt = K / BK; int ldb_ = g.ldb, ksb_ = g.kstepB; asm volatile("" : "+s"(ldb_), "+s"(ksb_));
    unsigned voffA[2], voffB[2]; int RA[2], CA[2];
#pragma unroll
    for (int i = 0; i < 2; ++i) { int R, C; stage_rc(tid * 16 + i * 8192, R, C); const int Rb = Epi::PERM ? ((R & ~31) + perm32(R & 31)) : R;
        voffA[i] = (unsigned)(R * K + C) * 2u; voffB[i] = (unsigned)(Rb * ldb_ + C * 2); RA[i] = R; CA[i] = C; }
    const size_t kstep = (size_t)(BK * 2);
    const size_t hstep = (size_t)HALF * K * 2;
    const size_t kstepB = (size_t)ksb_, hstepB = (size_t)HALF * ldb_;
    const unsigned ldsw = (unsigned)wid * 1024u;
    const int aoff = lds_byte(wr * 64 + fr, fq * 8), boff = lds_byte(wc * 32 + fr, fq * 8);
    unsigned vg0[2][2], vg1[2][2];
#define PG8_SA(b, h) (((b) * 2 + (h)) * HTB)
#define PG8_SB(b, h) ((4 + (b) * 2 + (h)) * HTB)
#define PG8_STAGE(bufoff, gbase, voff) do { _Pragma("unroll") for (int _i = 0; _i < 2; ++_i) \
        __builtin_amdgcn_global_load_lds((const unsigned*)((const char*)(gbase) + (voff)[_i]), (LAS unsigned*)(lds + (bufoff) + ldsw + _i * 8192), 16, 0, 0); } while (0)
#define PG8_STAGE_A(bufoff, gbase, h, w) do { _Pragma("unroll") for (int _i = 0; _i < 2; ++_i) { \
        const unsigned _o = GATHER ? ((w) ? vg1[h][_i] : vg0[h][_i]) : (voffA[_i] + (unsigned)((h) * hstep)); \
        __builtin_amdgcn_global_load_lds((const unsigned*)((const char*)(gbase) + _o), (LAS unsigned*)(lds + (bufoff) + ldsw + _i * 8192), 16, 0, 0); } } while (0)
#define PG8_LDA(dst, b, h) do { _Pragma("unroll") for (int m = 0; m < 4; ++m) _Pragma("unroll") for (int k = 0; k < 2; ++k) dst[m][k] = *(const LAS bf16x8*)(lds + PG8_SA(b, h) + aoff + m * 2048 + k * 1024); } while (0)
#define PG8_LDB(dst, b, h) do { _Pragma("unroll") for (int n = 0; n < 2; ++n) _Pragma("unroll") for (int k = 0; k < 2; ++k) dst[n][k] = *(const LAS bf16x8*)(lds + PG8_SB(b, h) + boff + n * 2048 + k * 1024); } while (0)
#define PG8_MMA(ai, bj, At, Bt) do { __builtin_amdgcn_s_setprio(1); _Pragma("unroll") for (int m = 0; m < 4; ++m) _Pragma("unroll") for (int n = 0; n < 2; ++n) _Pragma("unroll") for (int k = 0; k < 2; ++k) \
        acc[ai][bj][m][n] = __builtin_amdgcn_mfma_f32_16x16x32_bf16(Bt[n][k], At[m][k], acc[ai][bj][m][n], 0, 0, 0); __builtin_amdgcn_s_setprio(0); } while (0)
#define PG8_WAIT_V(n) asm volatile("s_waitcnt vmcnt(" #n ")" ::: "memory")
#define PG8_WAIT_L(n) asm volatile("s_waitcnt lgkmcnt(" #n ")" ::: "memory")
#define PG8_BAR __builtin_amdgcn_s_barrier()
#define PG8_SCHED __builtin_amdgcn_sched_barrier(0)
#define PG8_GOFF(dst, u) do { if (GATHER) { _Pragma("unroll") for (int _h = 0; _h < 2; ++_h) _Pragma("unroll") for (int _i = 0; _i < 2; ++_i) \
        dst[_h][_i] = (unsigned)(g.rows[(u).row0 + _h * HALF + RA[_i]] * K + CA[_i]) * 2u; } } while (0)
    Unit cur, nxt; int ui = 0;
    if (!S.next(0, cur)) return;
    f32x4 acc[2][2][4][2];
#pragma unroll
    for (int a = 0; a < 2; ++a)
#pragma unroll
        for (int b = 0; b < 2; ++b)
#pragma unroll
            for (int m = 0; m < 4; ++m)
#pragma unroll
                for (int n = 0; n < 2; ++n) acc[a][b][m][n] = (f32x4){0.f, 0.f, 0.f, 0.f};
    bf16x8 At[4][2], B0[2][2], B1[2][2];
    const char* cA = (const char*)g.A + (GATHER ? (size_t)0 : (size_t)cur.row0 * K * 2); const char* cB = (const char*)g.Bt + cur.boff;
    PG8_GOFF(vg0, cur);
#pragma unroll
    for (int _h = 0; _h < 2; ++_h)
#pragma unroll
        for (int _i = 0; _i < 2; ++_i) vg1[_h][_i] = vg0[_h][_i];
    PG8_STAGE(PG8_SB(0, 0), cB, voffB); PG8_STAGE_A(PG8_SA(0, 0), cA, 0, false); PG8_STAGE(PG8_SB(0, 1), cB + hstepB, voffB); PG8_STAGE_A(PG8_SA(0, 1), cA, 1, false);
    if (wr == 1) PG8_BAR;
    PG8_WAIT_V(4); PG8_BAR;
    PG8_STAGE(PG8_SB(1, 0), cB + kstepB, voffB); PG8_STAGE_A(PG8_SA(1, 0), cA + kstep, 0, false); PG8_STAGE(PG8_SB(1, 1), cB + hstepB + kstepB, voffB);
    PG8_WAIT_V(6); PG8_BAR;
    for (;;) {
        const bool has_next = S.next(ui + 1, nxt);
        if (has_next) PG8_GOFF(vg1, nxt);
        const char* nA = has_next ? (const char*)g.A + (GATHER ? (size_t)0 : (size_t)nxt.row0 * K * 2) : cA; const char* nB = has_next ? (const char*)g.Bt + nxt.boff : cB;
        const bool full = cur.nvalid > HALF;
        for (int t = 0; t < nt; t += 2) {
            const bool last = (t == nt - 2);
            const bool wn = last && has_next;
            const char* a1 = cA + (size_t)(t + 1) * kstep;
            const char* a2 = last ? nA : cA + (size_t)(t + 2) * kstep; const char* b2 = last ? nB : cB + (size_t)(t + 2) * kstepB;
            const char* a3 = a2 + kstep; const char* b3 = b2 + kstepB;
            PG8_LDB(B0, 0, 0); PG8_SCHED; PG8_LDA(At, 0, 0); PG8_STAGE_A(PG8_SA(1, 1), a1, 1, false);
            PG8_WAIT_L(8); PG8_BAR; PG8_WAIT_L(0); PG8_MMA(0, 0, At, B0); PG8_BAR; PG8_SCHED;
            PG8_LDB(B1, 0, 1); PG8_STAGE(PG8_SB(0, 0), b2, voffB);
            PG8_BAR; PG8_WAIT_L(0); PG8_MMA(0, 1, At, B1); PG8_BAR;
            if (full) PG8_LDA(At, 0, 1); PG8_STAGE_A(PG8_SA(0, 0), a2, 0, wn);
            PG8_BAR; PG8_WAIT_L(0); if (full) PG8_MMA(1, 0, At, B0); PG8_BAR; PG8_SCHED;
            PG8_STAGE(PG8_SB(0, 1), b2 + hstepB, voffB);
            PG8_WAIT_V(6); PG8_BAR; if (full) PG8_MMA(1, 1, At, B1); PG8_BAR;
            PG8_LDB(B0, 1, 0); PG8_SCHED; PG8_LDA(At, 1, 0); PG8_STAGE_A(PG8_SA(0, 1), a2, 1, wn);
            PG8_WAIT_L(8); PG8_BAR; PG8_WAIT_L(0); PG8_MMA(0, 0, At, B0); PG8_BAR; PG8_SCHED;
            PG8_LDB(B1, 1, 1); PG8_STAGE(PG8_SB(1, 0), b3, voffB);
            PG8_BAR; PG8_WAIT_L(0); PG8_MMA(0, 1, At, B1); PG8_BAR;
            if (full) PG8_LDA(At, 1, 1); PG8_STAGE_A(PG8_SA(1, 0), a3, 0, wn);
            PG8_BAR; PG8_WAIT_L(0); if (full) PG8_MMA(1, 0, At, B0); PG8_BAR; PG8_SCHED;
            PG8_STAGE(PG8_SB(1, 1), b3 + hstepB, voffB);
            PG8_WAIT_V(6); PG8_BAR; if (full) PG8_MMA(1, 1, At, B1); PG8_BAR;
        }
        { const unsigned long long e0_ = pacc ? __builtin_amdgcn_s_memrealtime() : 0ull; int fr_ = fr, fq_ = fq; asm volatile("" : "+v"(fr_), "+v"(fq_)); E(acc, cur, wr, wc, fr_, fq_); if (pacc) { asm volatile("s_waitcnt vmcnt(0)" ::: "memory"); *pacc += __builtin_amdgcn_s_memrealtime() - e0_; } }
        if (!has_next) break;
#pragma unroll
        for (int a = 0; a < 2; ++a)
#pragma unroll
            for (int b = 0; b < 2; ++b)
#pragma unroll
                for (int m = 0; m < 4; ++m)
#pragma unroll
                    for (int n = 0; n < 2; ++n) acc[a][b][m][n] = (f32x4){0.f, 0.f, 0.f, 0.f};
        cur = nxt; cA = nA; cB = nB; ++ui;
#pragma unroll
        for (int _h = 0; _h < 2; ++_h)
#pragma unroll
            for (int _i = 0; _i < 2; ++_i) vg0[_h][_i] = vg1[_h][_i];
    }
    PG8_WAIT_V(0);
    if (wr == 0) PG8_BAR;
    PG8_BAR;
#ifdef PROBE_CALL
    if (pacc_call) *pacc_call += __builtin_amdgcn_s_memrealtime() - c0_;
#endif
#undef PG8_SA
#undef PG8_SB
#undef PG8_STAGE
#undef PG8_STAGE_A
#undef PG8_LDA
#undef PG8_LDB
#undef PG8_MMA
#undef PG8_WAIT_V
#undef PG8_WAIT_L
#undef PG8_BAR
#undef PG8_SCHED
#undef PG8_GOFF
}

struct StaticOrder {
    int nM, nN, nwg, G, c, Kb;
    __device__ void init(int M, int N, int K, int G_, int c_) { nM = M / BM; nN = N / BM; nwg = nM * nN; G = G_; c = c_; Kb = K; }
    __device__ bool next(int i, Unit& u) const {
        const long L = (long)i * G + c; if (L >= nwg) return false;
        int wgid = (int)L; { const int NXCD = 8; const int q = nwg / NXCD, r = nwg % NXCD, xcd = wgid % NXCD, off = wgid / NXCD; wgid = (xcd < r ? xcd * (q + 1) : r * (q + 1) + (xcd - r) * q) + off; }
        const int WGM = 8; const int nig = WGM * nN, gid = wgid / nig, fm = gid * WGM, gsz = (nM - fm) < WGM ? (nM - fm) : WGM;
        u.row0 = (fm + ((wgid % nig) % gsz)) * BM; u.lrow = u.row0; u.pn = (wgid % nig) / gsz; u.nvalid = BM; u.aux = u.pn; u.kind = 0; u.boff = (unsigned)u.pn * (unsigned)(BM * 2) * (unsigned)Kb; return true;
    }
};
}
using pg8::Unit; using pg8::cvt_pk_bf16;
typedef const f32x4 (&AccRef)[2][2][4][2];

struct MoeOrder {
    const unsigned* units; int ntile, nsub, G, c; unsigned ebytes;
    __device__ bool next(int i, Unit& u) const {
        const long L = (long)i * G + c; const int nun = ntile * nsub; if (L >= nun) return false;
        int idx = (int)L; { const int q = nun / 8, r = nun % 8, xcd = idx % 8, off = idx / 8; idx = (xcd < r ? xcd * (q + 1) : r * (q + 1) + (xcd - r) * q) + off; }
        const int tile = idx / nsub, sub = idx % nsub;
        const u32x4 d = *(const u32x4*)(units + 4 * tile);
        u.row0 = (int)d.x; u.lrow = u.row0; u.pn = (int)d.y * nsub + sub; u.nvalid = (int)d.z; u.aux = sub; u.kind = 0; u.boff = d.y * ebytes + (unsigned)sub * 32768u; return true;
    }
};

struct EpiInT {
    static constexpr bool PERM = true;
    bf16_t* phyt; bf16_t* vt;
    __device__ __forceinline__ void operator()(AccRef acc, const Unit& u, int wr, int wc, int fr, int fq) const {
        const int pm = u.lrow >> 8, tb = u.pn * 256; const bool isctx = tb >= T;
        int b, nbase; if (!isctx) { b = tb >> 13; nbase = tb & (SEQ - 1); } else { b = (tb - T) >> 8; nbase = 0; }
        if (pm < 6 && isctx) return;
#pragma unroll
        for (int ai = 0; ai < 2; ++ai)
#pragma unroll
            for (int m = 0; m < 4; ++m) {
                const int f = u.lrow + ai * 128 + wr * 64 + m * 16 + fr;
                bf16_t* rowp = (pm < 6) ? phyt + ((size_t)(b * HYP + f) * SEQ + nbase) : vt + ((size_t)(b * HGW + (f - HYP)) * NEXT + (isctx ? 0 : CTXL) + nbase);
#pragma unroll
                for (int bj = 0; bj < 2; ++bj) { const int cu = bj * 128 + wc * 32 + 8 * fq; const f32x4 v0 = acc[ai][bj][m][0], v1 = acc[ai][bj][m][1];
                    u32x4 w; w.x = cvt_pk_bf16(v0[0], v0[1]); w.y = cvt_pk_bf16(v0[2], v0[3]); w.z = cvt_pk_bf16(v1[0], v1[1]); w.w = cvt_pk_bf16(v1[2], v1[3]);
                    *(u32x4*)(rowp + cu) = w; }
            }
    }
};
struct EpiInN {
    static constexpr bool PERM = true;
    bf16_t *q, *g, *sg1, *sg2; float *lf, *lb; const float* lbs;
    __device__ __forceinline__ void operator()(AccRef acc, const Unit& u, int wr, int wc, int fr, int fq) const {
        const int pn = u.pn; const bool isctx = u.lrow >= T;
        if (isctx && (pn < 2 || pn > 5)) return;
        float lbu[2][8];
        if (pn >= 2 && pn < 6) {
#pragma unroll
            for (int bj = 0; bj < 2; ++bj) { const float* lbp = lbs + (pn >= 4) * 512 + (pn & 1) * 256 + bj * 128 + wc * 32 + 8 * fq; const f32x4 l0 = *(const f32x4*)lbp, l1 = *(const f32x4*)(lbp + 4);
                lbu[bj][0] = l0[0]; lbu[bj][1] = l0[1]; lbu[bj][2] = l0[2]; lbu[bj][3] = l0[3]; lbu[bj][4] = l1[0]; lbu[bj][5] = l1[1]; lbu[bj][6] = l1[2]; lbu[bj][7] = l1[3]; } }
#pragma unroll
        for (int ai = 0; ai < 2; ++ai)
#pragma unroll
            for (int m = 0; m < 4; ++m) {
                const int r = u.lrow + ai * 128 + wr * 64 + m * 16 + fr;
                int b, nx; if (!isctx) { b = r >> 13; nx = CTXL + (r & (SEQ - 1)); } else { const int rr = r - T; b = rr >> 8; nx = rr & 255; }
#pragma unroll
                for (int bj = 0; bj < 2; ++bj) { const int cu = bj * 128 + wc * 32 + 8 * fq; const f32x4 v0 = acc[ai][bj][m][0], v1 = acc[ai][bj][m][1];
                    float x[8] = {v0[0], v0[1], v0[2], v0[3], v1[0], v1[1], v1[2], v1[3]};
                    if (pn >= 2 && pn < 6) {
                        const int dir = pn >= 4, col = (pn & 1) * 256 + cu;
                        float o[8];
#pragma unroll
                        for (int j = 0; j < 8; ++j) o[j] = __logf(lbu[bj][j] + (1.0f - lbu[bj][j]) * sigmoidf_(x[j]));
                        float* dst = (dir ? lb : lf) + ((size_t)(b * NEXT + nx) * HGW + col);
                        *(f32x4*)dst = (f32x4){o[0], o[1], o[2], o[3]}; *(f32x4*)(dst + 4) = (f32x4){o[4], o[5], o[6], o[7]};
                    } else {
                        bf16_t* dst;
                        if (pn < 2) { dst = q + (size_t)r * HGW + pn * 256 + cu;
#pragma unroll
                            for (int j = 0; j < 8; ++j) x[j] = siluf_(x[j]); }
                        else if (pn < 8) { dst = g + (size_t)r * HGW + (pn - 6) * 256 + cu;
#pragma unroll
                            for (int j = 0; j < 8; ++j) x[j] = siluf_(x[j]); }
                        else { dst = (pn < 12 ? sg1 + (size_t)r * D + (pn - 8) * 256 : sg2 + (size_t)r * D + (pn - 12) * 256) + cu;
#pragma unroll
                            for (int j = 0; j < 8; ++j) x[j] = sigmoidf_(x[j]); }
                        u32x4 w; w.x = cvt_pk_bf16(x[0], x[1]); w.y = cvt_pk_bf16(x[2], x[3]); w.z = cvt_pk_bf16(x[4], x[5]); w.w = cvt_pk_bf16(x[6], x[7]);
                        *(u32x4*)dst = w;
                    }
                }
            }
    }
};
struct EpiMerge1 {
    static constexpr bool PERM = false;
    const bf16_t* sg1; float* t1;
    __device__ __forceinline__ void operator()(AccRef acc, const Unit& u, int wr, int wc, int fr, int fq) const {
#pragma unroll
        for (int ai = 0; ai < 2; ++ai) { u32x2 s[4][2][2];
#pragma unroll
            for (int m = 0; m < 4; ++m) { const size_t ro = (size_t)(u.lrow + ai * 128 + wr * 64 + m * 16 + fr) * D + u.pn * 256 + wc * 32 + 4 * fq;
#pragma unroll
                for (int bj = 0; bj < 2; ++bj)
#pragma unroll
                    for (int n = 0; n < 2; ++n) s[m][bj][n] = *(const u32x2*)(sg1 + ro + bj * 128 + n * 16); }
#pragma unroll
            for (int m = 0; m < 4; ++m) { const size_t ro = (size_t)(u.lrow + ai * 128 + wr * 64 + m * 16 + fr) * D + u.pn * 256 + wc * 32 + 4 * fq;
#pragma unroll
                for (int bj = 0; bj < 2; ++bj)
#pragma unroll
                    for (int n = 0; n < 2; ++n) { const f32x4 a = acc[ai][bj][m][n]; const u32x2 sv = s[m][bj][n];
                        *(f32x4*)(t1 + ro + bj * 128 + n * 16) = (f32x4){a[0] * bflo(sv.x), a[1] * bfhi(sv.x), a[2] * bflo(sv.y), a[3] * bfhi(sv.y)}; } } }
    }
};
struct EpiMerge2 {
    static constexpr bool PERM = false;
    const bf16_t* sg2; const float* t1; bf16_t* mb;
    __device__ __forceinline__ void operator()(AccRef acc, const Unit& u, int wr, int wc, int fr, int fq) const {
#pragma unroll
        for (int ai = 0; ai < 2; ++ai)
#pragma unroll
            for (int mh = 0; mh < 2; ++mh) { u32x2 s[2][2][2]; f32x4 p[2][2][2];
#pragma unroll
                for (int mm = 0; mm < 2; ++mm) { const size_t ro = (size_t)(u.lrow + ai * 128 + wr * 64 + (2 * mh + mm) * 16 + fr) * D + u.pn * 256 + wc * 32 + 4 * fq;
#pragma unroll
                    for (int bj = 0; bj < 2; ++bj)
#pragma unroll
                        for (int n = 0; n < 2; ++n) { s[mm][bj][n] = *(const u32x2*)(sg2 + ro + bj * 128 + n * 16); p[mm][bj][n] = *(const f32x4*)(t1 + ro + bj * 128 + n * 16); } }
#pragma unroll
                for (int mm = 0; mm < 2; ++mm) { const int m = 2 * mh + mm; const size_t ro = (size_t)(u.lrow + ai * 128 + wr * 64 + m * 16 + fr) * D + u.pn * 256 + wc * 32 + 4 * fq;
#pragma unroll
                    for (int bj = 0; bj < 2; ++bj)
#pragma unroll
                        for (int n = 0; n < 2; ++n) { const f32x4 a = acc[ai][bj][m][n], pv = p[mm][bj][n]; const u32x2 sv = s[mm][bj][n];
                            u32x2 w; w.x = cvt_pk_bf16(pv[0] + a[0] * bflo(sv.x), pv[1] + a[1] * bfhi(sv.x)); w.y = cvt_pk_bf16(pv[2] + a[2] * bflo(sv.y), pv[3] + a[3] * bfhi(sv.y));
                            *(u32x2*)(mb + ro + bj * 128 + n * 16) = w; } } }
    }
};
struct EpiWout {
    static constexpr bool PERM = false;
    const float* x; const float* posr; const float* posc; const float* ada; float* x1;
    __device__ __forceinline__ void operator()(AccRef acc, const Unit& u, int wr, int wc, int fr, int fq) const {
        const int b = u.lrow >> 13, cb = u.pn * 256 + wc * 32 + 4 * fq;
        f32x4 g1[2][2];
#pragma unroll
        for (int bj = 0; bj < 2; ++bj)
#pragma unroll
            for (int nn = 0; nn < 2; ++nn) g1[bj][nn] = *(const f32x4*)(ada + b * 6144 + 2 * D + cb + bj * 128 + nn * 16);
#pragma unroll
        for (int ai = 0; ai < 2; ++ai)
#pragma unroll
            for (int mh = 0; mh < 2; ++mh) { f32x4 xv[2][2][2];
#pragma unroll
                for (int mm = 0; mm < 2; ++mm) { const int r = u.lrow + ai * 128 + wr * 64 + (2 * mh + mm) * 16 + fr;
#pragma unroll
                    for (int bj = 0; bj < 2; ++bj)
#pragma unroll
                        for (int nn = 0; nn < 2; ++nn) xv[mm][bj][nn] = *(const f32x4*)(x + (size_t)r * D + cb + bj * 128 + nn * 16); }
#pragma unroll
                for (int mm = 0; mm < 2; ++mm) { f32x4 pe[2][2]; const int m = 2 * mh + mm;
                    const int r = u.lrow + ai * 128 + wr * 64 + m * 16 + fr, n = r & (SEQ - 1);
#pragma unroll
                    for (int bj = 0; bj < 2; ++bj)
#pragma unroll
                        for (int nn = 0; nn < 2; ++nn) { const int c = cb + bj * 128 + nn * 16;
                            pe[bj][nn] = (c < 512) ? *(const f32x4*)(posr + (n >> 6) * 512 + c) : *(const f32x4*)(posc + (n & 63) * 512 + (c - 512)); }
#pragma unroll
                    for (int bj = 0; bj < 2; ++bj)
#pragma unroll
                        for (int nn = 0; nn < 2; ++nn) *(f32x4*)(x1 + (size_t)r * D + cb + bj * 128 + nn * 16) = xv[mm][bj][nn] + pe[bj][nn] + g1[bj][nn] * acc[ai][bj][m][nn]; } }
    }
};
struct EpiLogit {
    static constexpr bool PERM = true;
    float* lg;
    __device__ __forceinline__ void operator()(AccRef acc, const Unit& u, int wr, int wc, int fr, int fq) const {
#pragma unroll
        for (int ai = 0; ai < 2; ++ai)
#pragma unroll
            for (int m = 0; m < 4; ++m) { float* rp = lg + (size_t)(u.lrow + ai * 128 + wr * 64 + m * 16 + fr) * NE + wc * 32 + 8 * fq;
#pragma unroll
                for (int bj = 0; bj < 2; ++bj) { *(f32x4*)(rp + bj * 128) = acc[ai][bj][m][0]; *(f32x4*)(rp + bj * 128 + 4) = acc[ai][bj][m][1]; } }
    }
};
struct EpiGU {
    static constexpr bool PERM = true;
    bf16_t* hout; const float* wrow;
    __device__ __forceinline__ void operator()(AccRef acc, const Unit& u, int wr, int wc, int fr, int fq) const {
        float wv[2][4];
#pragma unroll
        for (int ai = 0; ai < 2; ++ai)
#pragma unroll
            for (int m = 0; m < 4; ++m) { const int rl = ai * 128 + wr * 64 + m * 16 + fr; wv[ai][m] = (wrow && rl < u.nvalid) ? wrow[u.lrow + rl] : 1.0f; }
#pragma unroll
        for (int ai = 0; ai < 2; ++ai)
#pragma unroll
            for (int m = 0; m < 4; ++m) { const int rl = ai * 128 + wr * 64 + m * 16 + fr;
                if (rl < u.nvalid) { const f32x4 g0 = acc[ai][0][m][0], g1 = acc[ai][0][m][1], u0 = acc[ai][1][m][0] * wv[ai][m], u1 = acc[ai][1][m][1] * wv[ai][m];
                    u32x4 w; w.x = cvt_pk_bf16(siluf_(g0[0]) * u0[0], siluf_(g0[1]) * u0[1]); w.y = cvt_pk_bf16(siluf_(g0[2]) * u0[2], siluf_(g0[3]) * u0[3]);
                    w.z = cvt_pk_bf16(siluf_(g1[0]) * u1[0], siluf_(g1[1]) * u1[1]); w.w = cvt_pk_bf16(siluf_(g1[2]) * u1[2], siluf_(g1[3]) * u1[3]);
                    *(u32x4*)(hout + (size_t)(u.lrow + rl) * EH + u.aux * 128 + wc * 32 + 8 * fq) = w; } }
    }
};
template <bool HASW, bool FP8 = false> struct EpiDown {
    static constexpr bool PERM = true;
    bf16_t* yout; const float* wrow;
    __device__ __forceinline__ void operator()(AccRef acc, const Unit& u, int wr, int wc, int fr, int fq) const {
        char* base = (char*)yout + ((size_t)u.lrow * D + u.aux * 256 + wc * 32) * (FP8 ? 1 : 2);
        float wv[2][4];
#pragma unroll
        for (int ai = 0; ai < 2; ++ai)
#pragma unroll
            for (int m = 0; m < 4; ++m) { const int rl = ai * 128 + wr * 64 + m * 16 + fr; wv[ai][m] = (HASW && rl < u.nvalid) ? wrow[u.lrow + rl] : 1.0f; }
#pragma unroll
        for (int ai = 0; ai < 2; ++ai)
#pragma unroll
            for (int m = 0; m < 4; ++m) { const int rl = ai * 128 + wr * 64 + m * 16 + fr;
                if (rl < u.nvalid) { const float w_ = wv[ai][m];
                    const unsigned off = (unsigned)(rl * D + 8 * fq) * (FP8 ? 1u : 2u);
#pragma unroll
                    for (int bj = 0; bj < 2; ++bj) { const f32x4 v0 = acc[ai][bj][m][0] * w_, v1 = acc[ai][bj][m][1] * w_;
                        if (FP8) { int a = __builtin_amdgcn_cvt_pk_fp8_f32(v0[0], v0[1], 0, false); a = __builtin_amdgcn_cvt_pk_fp8_f32(v0[2], v0[3], a, true);
                            int c = __builtin_amdgcn_cvt_pk_fp8_f32(v1[0], v1[1], 0, false); c = __builtin_amdgcn_cvt_pk_fp8_f32(v1[2], v1[3], c, true);
                            *(u32x2*)(base + off + bj * 128) = (u32x2){(unsigned)a, (unsigned)c}; }
                        else { u32x4 w; w.x = cvt_pk_bf16(v0[0], v0[1]); w.y = cvt_pk_bf16(v0[2], v0[3]); w.z = cvt_pk_bf16(v1[0], v1[1]); w.w = cvt_pk_bf16(v1[2], v1[3]);
                            *(u32x4*)(base + off + bj * 256) = w; } } } }
    }
};

constexpr int RA1 = (int)((WS_A1 - WS_WINT) / (D * 2));
static_assert((WS_A1 - WS_WINT) % (D * 2) == 0, "A1 must sit a whole number of rows above WINT");
struct InOrder {
    int G, c;
    static constexpr int N0 = 6 * 64, N1 = 2 * 64, N2 = 64 * 16, N3 = 12, NU = N0 + N1 + N2 + N3;
    __device__ bool next(int i, Unit& u) const {
        const long L = (long)i * G + c; if (L >= NU) return false;
        const int xcd = (int)(L % 8), p = (int)(L / 8), nT = xcd < 4 ? 65 : 64, tb = xcd < 4 ? 65 * xcd : 260 + 64 * (xcd - 4);
        if (p >= nT + 129) return false;
        int pm, pn, kind;
        if (p < nT) { const int uu = tb + p; kind = 0;
            if (uu < 512) { const int g = uu >> 5, jj = uu & 31; pm = 4 * (g & 1) + (jj & 3); pn = 8 * (g >> 1) + (jj >> 2); }
            else { const int j = uu - 512; pm = 6 + (j >> 1); pn = 64 + (j & 1); } }
        else { const int v = 129 * xcd + (p - nT); kind = 1;
            if (v < 1024) { const int g = v >> 7, jj = v & 127; pm = 8 * g + (jj & 7); pn = jj >> 3; }
            else { const int j = v - 1024; pm = 64 + (j >> 2); pn = 2 + (j & 3); } }
        fill(u, kind, pm, pn); return true;
    }
    __device__ static void fill(Unit& u, int kind, int pm, int pn) {
        u.kind = kind; u.pn = pn; u.lrow = pm * 256; u.nvalid = 256; u.aux = pn;
        if (kind == 0) { u.row0 = pm * 256; u.boff = (unsigned)(RA1 + pn * 256) * (unsigned)(D * 2); }
        else { u.row0 = RA1 + pm * 256; u.boff = (unsigned)(2048 + pn * 256) * (unsigned)(D * 2); }
    }
};
struct CtxUnit {
    int idx;
    __device__ static int tile(int idx) { return idx < 4 ? (idx & 1) : ((idx - 4) >> 2); }
    __device__ bool next(int i, Unit& u) const { if (i) return false;
        if (idx < 4) InOrder::fill(u, 0, 6 + (idx >> 1), 64 + (idx & 1)); else InOrder::fill(u, 1, 64 + ((idx - 4) >> 2), 2 + ((idx - 4) & 3)); return true; }
};
struct EpiIn {
    static constexpr bool PERM = true;
    EpiInT t; EpiInN n;
    __device__ __forceinline__ void operator()(AccRef acc, const Unit& u, int wr, int wc, int fr, int fq) const { if (u.kind == 0) t(acc, u, wr, wc, fr, fq); else n(acc, u, wr, wc, fr, fq); }
};
struct P9Order {
    int G, c;
    __device__ bool next(int i, Unit& u) const {
        const long L = (long)i * G + c; if (L >= 192) return false; int idx = (int)L;
        { const int xcd = idx % 8, off = idx / 8; idx = xcd * 24 + off; }
        const int pm = idx / 3, k3 = idx % 3;
        u.row0 = pm * 256;
        if (k3 == 0) { u.kind = 0; u.pn = 0; u.aux = 0; u.boff = 0u; }
        else { u.kind = 1; u.pn = k3 - 1; u.aux = k3 - 1; u.boff = (unsigned)(WS_SHGUT - WS_ROUT) + (unsigned)(k3 - 1) * (unsigned)(256 * D * 2); }
        u.lrow = u.row0; u.nvalid = 256; return true;
    }
};
struct EpiP9 {
    static constexpr bool PERM = true;
    EpiLogit l; EpiGU g;
    __device__ __forceinline__ void operator()(AccRef acc, const Unit& u, int wr, int wc, int fr, int fq) const { if (u.kind == 0) l(acc, u, wr, wc, fr, fq); else g(acc, u, wr, wc, fr, fq); }
};

constexpr int RYHG = (int)((WS_YHG - WS_YHY) / (HYW * 2));
static_assert((WS_YHG - WS_YHY) % (HYW * 2) == 0 && WS_YHG > WS_YHY, "YHG must sit a whole number of rows above YHY");
struct MergeOrder {
    pg8::StaticOrder so;
    __device__ bool next(int i, Unit& u) const {
        if (!so.next(i >> 1, u)) return false;
        u.kind = i & 1;
        if (u.kind) { u.row0 += RYHG; u.boff += (unsigned)(WS_WHGT - WS_WHYT); }
        return true;
    }
};
struct EpiMerge {
    static constexpr bool PERM = false;
    EpiMerge1 a; EpiMerge2 b;
    __device__ __forceinline__ void operator()(AccRef acc, const Unit& u, int wr, int wc, int fr, int fq) const { if (u.kind == 0) a(acc, u, wr, wc, fr, fq); else b(acc, u, wr, wc, fr, fq); }
};
#define XB_TMO      128
#define XB_XCNT(j)  (256  + 64 * (j))
#define XB_XSUB(j)  (1280 + 64 * (j))
#define XB_XGEN(j)  (2304 + 64 * (j))
#define XB_TOP      3328
#define XB_TOPGEN   3392
#define XCD_BAR_WORDS 3456
#define XB_SPIN_CAP (1u << 18)

__device__ __forceinline__ unsigned xb_ld(unsigned* p)              { return __hip_atomic_load(p, __ATOMIC_RELAXED, __HIP_MEMORY_SCOPE_AGENT); }
__device__ __forceinline__ unsigned xb_add(unsigned* p, unsigned v) { return __hip_atomic_fetch_add(p, v, __ATOMIC_RELAXED, __HIP_MEMORY_SCOPE_AGENT); }
__device__ __forceinline__ unsigned xb_xcc_id() { return (unsigned)__builtin_amdgcn_s_getreg((3 << 11) | 20) & 0xFu; }
#define XB_SPIN(cond, bar) do { unsigned _sp = 0; while (cond) { __builtin_amdgcn_s_sleep(1); \
    if ((++_sp & 255u) == 0u) { if (xb_ld(&(bar)[XB_TMO])) break; if (_sp > XB_SPIN_CAP) { atomicAdd(&(bar)[XB_TMO], 1u); break; } } } } while (0)

struct XcdBarrier {
    unsigned* bar; unsigned x;
    volatile LAS unsigned* st;
};

__device__ __forceinline__ XcdBarrier xcd_barrier_post(unsigned* bar, volatile LAS unsigned* st) {
    XcdBarrier b; b.bar = bar; b.x = xb_xcc_id(); b.st = st;
    if (threadIdx.x == 0) (void)xb_add(&bar[XB_XCNT(b.x)], 1u);
    return b;
}
__device__ __forceinline__ void xcd_barrier_complete(unsigned* bar, unsigned x, unsigned& nloc, unsigned& nx) {
    const unsigned G = gridDim.x * gridDim.y * gridDim.z;
    unsigned sum, cnt, mine, sp = 0u;
    for (;;) {
        sum = 0u; cnt = 0u; mine = 0u;
#pragma unroll
        for (unsigned j = 0; j < 16; ++j) { const unsigned c = xb_ld(&bar[XB_XCNT(j)]); sum += c; cnt += (c > 0u) ? 1u : 0u; mine = (j == x) ? c : mine; }
        if (sum == G) break;
        __builtin_amdgcn_s_sleep(1);
        if ((++sp & 255u) == 0u) { if (xb_ld(&bar[XB_TMO])) break; if (sp > XB_SPIN_CAP) { atomicAdd(&bar[XB_TMO], 1u); break; } }
    }
    nloc = mine > 0u ? mine : 1u; nx = cnt > 0u ? cnt : 1u;
}

__device__ __forceinline__ void xcd_barrier(const XcdBarrier& b) {
    asm volatile("s_waitcnt vmcnt(0)" ::: "memory");
    __syncthreads();
    if (threadIdx.x == 0) {
        unsigned* bar = b.bar;
        __builtin_amdgcn_s_waitcnt(0);
        unsigned nloc = b.st[0], nx = b.st[1];
        if (nloc == 0u) { xcd_barrier_complete(bar, b.x, nloc, nx); b.st[0] = nloc; b.st[1] = nx; }
        const unsigned old = xb_add(&bar[XB_XSUB(b.x)], 1u);
        const unsigned gen = old / nloc;
        if (old + 1u == (gen + 1u) * nloc) {
            __builtin_amdgcn_fence(__ATOMIC_RELEASE, "agent");
            asm volatile("s_waitcnt vmcnt(0)" ::: "memory");
            const unsigned og = xb_add(&bar[XB_TOP], 1u);
            const unsigned tg = og / nx;
            if (og + 1u == (tg + 1u) * nx) xb_add(&bar[XB_TOPGEN], 1u);
            else XB_SPIN(xb_ld(&bar[XB_TOPGEN]) == tg, bar);
            __builtin_amdgcn_fence(__ATOMIC_ACQUIRE, "agent");
            xb_add(&bar[XB_XGEN(b.x)], 1u);
            asm volatile("s_waitcnt vmcnt(0)" ::: "memory");
        } else {
            XB_SPIN(xb_ld(&bar[XB_XGEN(b.x)]) == gen, bar);
            __builtin_amdgcn_fence(__ATOMIC_ACQUIRE, "agent");
            asm volatile("s_waitcnt vmcnt(0)" ::: "memory");
        }
    }
    __syncthreads();
}


struct Frame {
    LAS unsigned char* lds;
    const Params* p;
    unsigned char* ws;
    int tid, lane, wave, G, bx;
};
#define WSP(T_, off) ((T_*)(F.ws + (off)))

__device__ __forceinline__ void p0_transpose_item(const float* W, int N, bf16_t* WT, int K, int k0, int n0, int row0, LAS float* scr, int lane) {
#pragma unroll 8
    for (int i = 0; i < 32; ++i) { const int kk = 2 * i + (lane >> 5); scr[kk * 33 + (lane & 31)] = W[(size_t)(k0 + kk) * N + n0 + (lane & 31)]; }
    LDS_WAIT(); asm volatile("" ::: "memory");
    const int c = lane & 7;
#pragma unroll
    for (int j = 0; j < 4; ++j) { const int n = (lane >> 3) + 8 * j; const LAS float* s = scr + (8 * c) * 33 + n;
        u32x4 o; o.x = pk2(s[0 * 33], s[1 * 33]); o.y = pk2(s[2 * 33], s[3 * 33]); o.z = pk2(s[4 * 33], s[5 * 33]); o.w = pk2(s[6 * 33], s[7 * 33]);
        *(u32x4*)(WT + (size_t)(row0 + n) * K + k0 + 8 * c) = o; }
    LDS_WAIT(); asm volatile("" ::: "memory");
}
__device__ __forceinline__ int gu_row(int n0, int up) { return (n0 >> 7) * 256 + up * 128 + (n0 & 127); }

__device__ __forceinline__ void p0_transposes(Frame& F) {
    LAS float* scr = (LAS float*)(F.lds + F.wave * 16384);
    const int gw = F.bx * 8 + F.wave, NGW = F.G * 8;
    const float* const* in = F.p->in;
    constexpr int I_WIN_ = 16 * 192, I_WHY_ = 8 * 32, I_WHG_ = 8 * 32, I_WOUT_ = 16 * 32, I_R_ = 16 * 8, I_SG_ = 16 * 8, I_SU_ = 16 * 8, I_SD_ = 4 * 32;
    constexpr int I_W4_ = 64;
    constexpr int NSMALL = I_WIN_ + I_WHY_ + I_WHG_ + I_WOUT_ + I_R_ + I_SG_ + I_SU_ + I_SD_ + I_W4_;
    for (int it = gw; it < NSMALL; it += NGW) {
        int r = it;
        {
            if (r < I_WIN_) { const int kb = r / 192, nb = r % 192, n0 = nb * 32; const int f0 = (n0 >= 1536 && n0 < 2048) ? n0 + 512 : ((n0 >= 2048 && n0 < 2560) ? n0 - 512 : n0);
                p0_transpose_item(in[I_WIN], INC, WSP(bf16_t, WS_WINT), D, kb * 64, n0, f0, scr, F.lane); continue; } r -= I_WIN_;
            if (r < I_WHY_) { p0_transpose_item(in[I_WHY], D, WSP(bf16_t, WS_WHYT), HYW, (r / 32) * 64, (r % 32) * 32, (r % 32) * 32, scr, F.lane); continue; } r -= I_WHY_;
            if (r < I_WHG_) { p0_transpose_item(in[I_WHG], D, WSP(bf16_t, WS_WHGT), HGW, (r / 32) * 64, (r % 32) * 32, (r % 32) * 32, scr, F.lane); continue; } r -= I_WHG_;
            if (r < I_WOUT_) { p0_transpose_item(in[I_WOUT], D, WSP(bf16_t, WS_WOUTT), D, (r / 32) * 64, (r % 32) * 32, (r % 32) * 32, scr, F.lane); continue; } r -= I_WOUT_;
            if (r < I_R_) { p0_transpose_item(in[I_RW], NE, WSP(bf16_t, WS_ROUT), D, (r / 8) * 64, (r % 8) * 32, (r % 8) * 32, scr, F.lane); continue; } r -= I_R_;
            if (r < I_SG_) { p0_transpose_item(in[I_SG], EH, WSP(bf16_t, WS_SHGUT), D, (r / 8) * 64, (r % 8) * 32, gu_row((r % 8) * 32, 0), scr, F.lane); continue; } r -= I_SG_;
            if (r < I_SU_) { p0_transpose_item(in[I_SU], EH, WSP(bf16_t, WS_SHGUT), D, (r / 8) * 64, (r % 8) * 32, gu_row((r % 8) * 32, 1), scr, F.lane); continue; } r -= I_SU_;
            if (r < I_SD_) { p0_transpose_item(in[I_SD], D, WSP(bf16_t, WS_SHDT), EH, (r / 32) * 64, (r % 32) * 32, (r % 32) * 32, scr, F.lane); continue; } r -= I_SD_;
            p0_transpose_item(in[I_FW4], 2048, WSP(bf16_t, WS_W4T), 64, 0, r * 32, r * 32, scr, F.lane); continue;
        }
    }
}

template <int MODE  >
__device__ __forceinline__ void p0_x256_load(const float* W, int N, int k0, int n0, int tid, f32x4 (&v)[8]) {
    const int n4 = MODE ? ((tid >> 6) * 8 + (tid & 7)) : (tid & 63), kq = MODE ? ((tid >> 3) & 7) : (tid >> 6); const float* src = W + (size_t)(k0 + 8 * kq) * N + n0 + 4 * n4;
#pragma unroll
    for (int r = 0; r < 8; ++r) v[r] = __builtin_nontemporal_load((const f32x4*)(src + (size_t)r * N));
}
__device__ __forceinline__ void p0_x256_store(LAS unsigned char* ts, bf16_t* WT, int K, int k0, int row0, int mode, int tid, const f32x4 (&v)[8]) {
    const int n4 = tid & 63, kq = tid >> 6;
    __syncthreads();
#pragma unroll
    for (int i = 0; i < 4; ++i) { const int n = 4 * n4 + i;
        u32x4 o; o.x = pk2(v[0][i], v[1][i]); o.y = pk2(v[2][i], v[3][i]); o.z = pk2(v[4][i], v[5][i]); o.w = pk2(v[6][i], v[7][i]);
        *(LAS u32x4*)(ts + n * 128 + ((kq ^ (n4 & 7)) << 4)) = o; }
    __syncthreads();
#pragma unroll
    for (int q = 0; q < 4; ++q) { const int task = tid + 512 * q, n = task >> 3, part = task & 7;
        const u32x4 o = *(const LAS u32x4*)(ts + n * 128 + ((part ^ ((n >> 2) & 7)) << 4));
        const int row = mode == 0 ? row0 + n : ((n >> 7) * 256 + (mode - 1) * 128 + (n & 127));
        if (K < 0) *(u32x4*)(WT + (size_t)row * (-K) + k0 + 8 * part) = o;
        else *(u32x4*)(WT + (size_t)(k0 >> 6) * K + row * 64 + 8 * part) = o; }
}
__device__ __forceinline__ void p0_small_decode(const float* const* in, unsigned char* ws, int item, const float*& W, int& N, bf16_t*& WT, int& K, int& k0, int& n0, int& row0, int& mode) {
    int r = item; mode = 0;
    if (r < 384) { const int kb = r / 24, nb = r % 24; W = in[I_WIN]; N = INC; WT = (bf16_t*)(ws + WS_WINT); K = -D; k0 = kb * 64; n0 = nb * 256;
        row0 = (n0 >= 1536 && n0 < 2048) ? n0 + 512 : ((n0 >= 2048 && n0 < 2560) ? n0 - 512 : n0); return; } r -= 384;
    if (r < 32) { W = in[I_WHY]; N = D; WT = (bf16_t*)(ws + WS_WHYT); K = -HYW; k0 = (r >> 2) * 64; n0 = (r & 3) * 256; row0 = n0; return; } r -= 32;
    if (r < 32) { W = in[I_WHG]; N = D; WT = (bf16_t*)(ws + WS_WHGT); K = -HGW; k0 = (r >> 2) * 64; n0 = (r & 3) * 256; row0 = n0; return; } r -= 32;
    if (r < 64) { W = in[I_WOUT]; N = D; WT = (bf16_t*)(ws + WS_WOUTT); K = -D; k0 = (r >> 2) * 64; n0 = (r & 3) * 256; row0 = n0; return; } r -= 64;
    if (r < 16) { W = in[I_RW]; N = NE; WT = (bf16_t*)(ws + WS_ROUT); K = -D; k0 = r * 64; n0 = 0; row0 = 0; return; } r -= 16;
    if (r < 16) { W = in[I_SG]; N = EH; WT = (bf16_t*)(ws + WS_SHGUT); K = -D; k0 = r * 64; n0 = 0; row0 = 0; mode = 1; return; } r -= 16;
    if (r < 16) { W = in[I_SU]; N = EH; WT = (bf16_t*)(ws + WS_SHGUT); K = -D; k0 = r * 64; n0 = 0; row0 = 0; mode = 2; return; } r -= 16;
    W = in[I_SD]; N = D; WT = (bf16_t*)(ws + WS_SHDT); K = -EH; k0 = (r >> 2) * 64; n0 = (r & 3) * 256; row0 = n0;
}
__device__ __forceinline__ void p0_small_transposes(Frame& F) {
    int tid = F.tid; asm volatile("" : "+v"(tid));
    for (int it = F.bx; it < 576; it += F.G) {
        const float* W; int N, K, k0, n0, row0, mode; bf16_t* WT; f32x4 v[8];
        p0_small_decode(F.p->in, F.ws, it, W, N, WT, K, k0, n0, row0, mode);
        p0_x256_load<0>(W, N, k0, n0, tid, v);
        p0_x256_store(F.lds, WT, K, k0, row0, mode, tid, v);
    }
}
__device__ __forceinline__ void p0_x256_decode(const float* const* in, unsigned char* ws, int item, const float*& W, int& N, bf16_t*& WT, int& K, int& k0, int& n0, int& mode) {
    const int e = item < NE * 32 ? (item >> 5) : ((item - NE * 32) >> 4), r = item < NE * 32 ? (item & 31) : 32 + ((item - NE * 32) & 15);
    if (r < 16) { W = in[I_EG] + (size_t)e * D * EH; N = EH; WT = (bf16_t*)(ws + WS_EGUT) + (size_t)e * 512 * D; K = 512 * 64; k0 = r * 64; n0 = 0; mode = 1; }
    else if (r < 32) { W = in[I_EU] + (size_t)e * D * EH; N = EH; WT = (bf16_t*)(ws + WS_EGUT) + (size_t)e * 512 * D; K = 512 * 64; k0 = (r - 16) * 64; n0 = 0; mode = 2; }
    else { const int q = r - 32; W = in[I_ED] + (size_t)e * EH * D; N = D; WT = (bf16_t*)(ws + WS_EDT) + (size_t)e * D * EH; K = D * 64; k0 = (q >> 2) * 64; n0 = (q & 3) * 256; mode = 0; }
}
struct XpState { f32x4 v[8]; int it, end, stride; bool live; };
__device__ __forceinline__ void xp_issue(XpState& s, const float* const* in, unsigned char* ws, int tid) {
    s.live = s.it < s.end;
    if (s.live) { const float* W; int N, K, k0, n0, mode; bf16_t* WT; p0_x256_decode(in, ws, s.it, W, N, WT, K, k0, n0, mode); p0_x256_load<1>(W, N, k0, n0, tid, s.v); }
}
__device__ __forceinline__ void xp_finish(XpState& s, const float* const* in, unsigned char* ws, int tid) {
    if (s.live) { const float* W; int N, K, k0, n0, mode; bf16_t* WT; p0_x256_decode(in, ws, s.it, W, N, WT, K, k0, n0, mode);
        const int n4 = (tid >> 6) * 8 + (tid & 7), kq = (tid >> 3) & 7;
#pragma unroll
        for (int i = 0; i < 4; ++i) { const int n = 4 * n4 + i; const int row = mode == 0 ? n0 + n : ((n >> 7) * 256 + (mode - 1) * 128 + (n & 127));
            u32x4 o; o.x = pk2(s.v[0][i], s.v[1][i]); o.y = pk2(s.v[2][i], s.v[3][i]); o.z = pk2(s.v[4][i], s.v[5][i]); o.w = pk2(s.v[6][i], s.v[7][i]);
            *(u32x4*)(WT + (size_t)(k0 >> 6) * K + row * 64 + 8 * kq) = o; }
        s.it += s.stride; s.live = false; }
}
__device__ __forceinline__ void xp_step(XpState& s, const float* const* in, unsigned char* ws, int tid) { xp_finish(s, in, ws, tid); xp_issue(s, in, ws, tid); }
constexpr int XP_BG = 28;
constexpr int XP_K0 = 0;
constexpr int NCONV = 34;
constexpr int NCONV2 = 38, XP_P13 = NCONV2 * 72;
__device__ __forceinline__ void conv_loop(const float* const* in, unsigned char* ws, int first, int stride, int end, int tid) {
    XpState a, b, c, d; a.stride = b.stride = c.stride = d.stride = 4 * stride; a.end = b.end = c.end = d.end = end; a.live = b.live = c.live = d.live = false;
    a.it = first; b.it = first + stride; c.it = first + 2 * stride; d.it = first + 3 * stride;
    xp_issue(a, in, ws, tid); xp_issue(b, in, ws, tid); xp_issue(c, in, ws, tid);
    while (a.live) {
        xp_issue(d, in, ws, tid); xp_finish(a, in, ws, tid);
        if (!b.live) break; xp_issue(a, in, ws, tid); xp_finish(b, in, ws, tid);
        if (!c.live) break; xp_issue(b, in, ws, tid); xp_finish(c, in, ws, tid);
        if (!d.live) break; xp_issue(c, in, ws, tid); xp_finish(d, in, ws, tid);
    }
}
__device__ __forceinline__ void conv_loop2(Frame& F, int first, int stride, int end) {
    const float* const* in = F.p->in; unsigned char* ws = F.ws;
    int tid = F.tid; asm volatile("" : "+v"(tid));
    const bool loader = tid < 256; const int lt = tid & 255;
    int nitem = first < end ? (end - 1 - first) / stride + 1 : 0;
    __syncthreads();
    if (loader) {
        const int n4 = lt & 63, kq = lt >> 6;
        f32x4 va[16], vb[16];
#define CL_LOAD(dst, item) do { const float* W; int N, K, k0, n0, mode; bf16_t* WT; p0_x256_decode(in, ws, (item), W, N, WT, K, k0, n0, mode); \
            const float* src = W + (size_t)(k0 + 16 * kq) * N + n0 + 4 * n4; _Pragma("unroll") for (int r = 0; r < 16; ++r) dst[r] = __builtin_nontemporal_load((const f32x4*)(src + (size_t)r * N)); } while (0)
#define CL_PUT(src, buf) do { LAS unsigned char* ts = F.lds + (buf) * 32768; _Pragma("unroll") for (int i = 0; i < 4; ++i) { const int n = 4 * n4 + i; _Pragma("unroll") for (int h = 0; h < 2; ++h) { \
            u32x4 o; o.x = pk2(src[8 * h][i], src[8 * h + 1][i]); o.y = pk2(src[8 * h + 2][i], src[8 * h + 3][i]); o.z = pk2(src[8 * h + 4][i], src[8 * h + 5][i]); o.w = pk2(src[8 * h + 6][i], src[8 * h + 7][i]); \
            *(LAS u32x4*)(ts + n * 128 + (((2 * kq + h) ^ (n4 & 7)) << 4)) = o; } } } while (0)
        if (nitem > 0) CL_LOAD(va, first);
        if (nitem > 1) CL_LOAD(vb, first + stride);
        for (int i = 0; i < nitem; i += 2) {
            CL_PUT(va, 0); __syncthreads();
            if (i + 2 < nitem) CL_LOAD(va, first + (i + 2) * stride);
            if (i + 1 >= nitem) break;
            CL_PUT(vb, 1); __syncthreads();
            if (i + 3 < nitem) CL_LOAD(vb, first + (i + 3) * stride);
        }
#undef CL_LOAD
#undef CL_PUT
    } else {
        for (int i = 0; i < nitem; ++i) {
            __syncthreads();
            const float* W; int N, K, k0, n0, mode; bf16_t* WT; p0_x256_decode(in, ws, first + i * stride, W, N, WT, K, k0, n0, mode);
            const LAS unsigned char* ts = F.lds + (i & 1) * 32768;
#pragma unroll
            for (int q = 0; q < 8; ++q) { const int task = lt + 256 * q, n = task >> 3, part = task & 7;
                const u32x4 o = *(const LAS u32x4*)(ts + n * 128 + ((part ^ ((n >> 2) & 7)) << 4));
                const int row = mode == 0 ? n0 + n : ((n >> 7) * 256 + (mode - 1) * 128 + (n & 127));
                *(u32x4*)(WT + (size_t)(k0 >> 6) * K + row * 64 + 8 * part) = o; }
        }
    }
    __syncthreads();
}

__device__ __forceinline__ void p0_expert_transposes(Frame& F) {
    int tid = F.tid; asm volatile("" : "+v"(tid));
    constexpr int NIT = NE * 48;
    int it = F.bx + XP_BG * F.G; if (it >= NIT) return;
    const int p0end = (F.G == 256) ? 256 * (XP_BG + XP_K0) : NIT;
    if (it >= p0end) return;
    const float* W; int N, K, k0, n0, mode; bf16_t* WT;
    const float* W2; int N2, K2, k2, n2, mode2; bf16_t* WT2;
    f32x4 va[8], vb[8];
    p0_x256_decode(F.p->in, F.ws, it, W, N, WT, K, k0, n0, mode);
    p0_x256_load<0>(W, N, k0, n0, tid, va);
    for (;;) {
        __builtin_amdgcn_s_waitcnt(0);
        int nx = it + F.G; bool has = nx < p0end;
        if (has) { p0_x256_decode(F.p->in, F.ws, nx, W2, N2, WT2, K2, k2, n2, mode2); p0_x256_load<0>(W2, N2, k2, n2, tid, vb); }
        p0_x256_store(F.lds, WT, K, k0, n0, mode, tid, va);
        if (!has) break;
        it = nx;
        __builtin_amdgcn_s_waitcnt(0);
        nx = it + F.G; has = nx < p0end;
        if (has) { p0_x256_decode(F.p->in, F.ws, nx, W, N, WT, K, k0, n0, mode); p0_x256_load<0>(W, N, k0, n0, tid, va); }
        p0_x256_store(F.lds, WT2, K2, k2, n2, mode2, tid, vb);
        if (!has) break;
        it = nx;
    }
}

constexpr int ADA_KC = 8;
__device__ __forceinline__ void p0_ada_item(Frame& F, int item) {
    const int kc = item / 12, cb = item % 12, c4 = F.tid & 127, ks = F.tid >> 7;
    const float* in_c = F.p->in[I_C]; const float* in_cc = F.p->in[I_CCTX]; const float* w = F.p->in[I_ADAW];
    LAS float* sv = (LAS float*)F.lds;
    LAS float* pr = sv + 384;
    __syncthreads();
    for (int i = F.tid; i < 384; i += 512) { const int wh = i >> 7, k = kc * 128 + (i & 127); sv[i] = siluf_(wh == 0 ? in_c[k] : (wh == 1 ? in_c[D + k] : in_cc[k])); }
    __syncthreads();
    f32x4 a0 = (f32x4){0.f, 0.f, 0.f, 0.f}, a1 = a0, a2 = a0;
    const float* wp = w + (size_t)(kc * 128 + ks * 32) * 6144 + cb * 512 + 4 * c4;
#pragma unroll 16
    for (int k = 0; k < 32; ++k) { const f32x4 wv = *(const f32x4*)(wp + (size_t)k * 6144); const int kk = ks * 32 + k; a0 += wv * sv[kk]; a1 += wv * sv[128 + kk]; a2 += wv * sv[256 + kk]; }
    *(LAS f32x4*)(pr + (ks * 3 + 0) * 512 + 4 * c4) = a0; *(LAS f32x4*)(pr + (ks * 3 + 1) * 512 + 4 * c4) = a1; *(LAS f32x4*)(pr + (ks * 3 + 2) * 512 + 4 * c4) = a2;
    __syncthreads();
    for (int i = F.tid; i < 3 * 512; i += 512) { const int wh = i >> 9, col = i & 511;
        WSP(float, WS_ADAP)[(size_t)(kc * 3 + wh) * 6144 + cb * 512 + col] = (pr[(0 * 3 + wh) * 512 + col] + pr[(1 * 3 + wh) * 512 + col]) + (pr[(2 * 3 + wh) * 512 + col] + pr[(3 * 3 + wh) * 512 + col]); }
}

__device__ __forceinline__ void p0_filter_item(Frame& F, int item, XpState& xp) {
    LAS float* zb = (LAS float*)F.lds;
    LAS float* ab1 = zb + 32 * 36;
    LAS float* ab2 = ab1 + 32 * 64;
    LAS float* w1s = ab2 + 32 * 64;
    LAS float* w2s = w1s + 33 * 64;
    LAS float* w3s = w2s + 64 * 64;
    const float* const* in = F.p->in; const int t0 = item * 32; int tid = F.tid; asm volatile("" : "+v"(tid));
    __syncthreads();
    for (int idx = tid; idx < 33 * 64; idx += 512) w1s[idx] = in[I_FW1][idx];
    for (int idx = tid; idx < 64 * 64; idx += 512) { w2s[idx] = in[I_FW2][idx]; w3s[idx] = in[I_FW3][idx]; }
    for (int idx = tid; idx < 32 * 33; idx += 512) { const int t = idx / 33, e = idx % 33; const float tf = (float)(t0 + t); float v;
        if (e == 0) v = tf / (float)(SEQ - 1);
        else { const int k = (e - 1) & 15; const float band = 1e-4f + (float)k * ((15.0f - 1e-4f) / 15.0f); float sn, cs; sincospif(2.0f * tf * band / (float)SEQ, &sn, &cs); v = (e <= 16) ? cs : -sn; }
        zb[t * 36 + e] = v; }
    __syncthreads();
    {
        const int t = tid >> 4, jj = tid & 15;
#pragma unroll 1
        for (int q = 0; q < 4; ++q) { const int j = jj + 16 * q; float s = in[I_FB1][j];
#pragma unroll
            for (int e = 0; e < 33; ++e) s += zb[t * 36 + e] * w1s[e * 64 + j];
            ab1[t * 64 + j] = sinf(in[I_FFREQ][j] * s); }
    }
    __syncthreads();
    { const int t = tid >> 4, jj = tid & 15;
#pragma unroll 1
        for (int q = 0; q < 4; ++q) { const int j = jj + 16 * q; float s = in[I_FB2][j];
#pragma unroll 16
            for (int e = 0; e < 64; ++e) s += ab1[t * 64 + e] * w2s[e * 64 + j];
            ab2[t * 64 + j] = sinf(in[I_FFREQ][j] * s); }
    }
    __syncthreads();
    { const int t = tid >> 4, jj = tid & 15;
#pragma unroll 1
        for (int q = 0; q < 4; ++q) { const int j = jj + 16 * q; float s = in[I_FB3][j];
#pragma unroll 16
            for (int e = 0; e < 64; ++e) s += ab2[t * 64 + e] * w3s[e * 64 + j];
            ab1[t * 64 + j] = sinf(in[I_FFREQ][j] * s); }
    }
    __syncthreads();
    { bf16_t* a3 = WSP(bf16_t, WS_A3) + (size_t)t0 * 64;
        const int t = tid >> 4, j4 = (tid & 15) * 4; const f32x4 v = *(const LAS f32x4*)(ab1 + t * 64 + j4);
        *(u32x2*)(a3 + t * 64 + j4) = (u32x2){pk2(v[0], v[1]), pk2(v[2], v[3])}; }
    (void)xp;
}
__device__ __forceinline__ void filter_out_item(Frame& F, int item) {
    const int t0 = item * 32, lane = F.lane, lr = lane & 15, lq = lane >> 4, w = F.wave;
    const bf16_t* a3 = WSP(bf16_t, WS_A3); const bf16_t* w4t = WSP(bf16_t, WS_W4T); bf16_t* hf = WSP(bf16_t, WS_HF);
    bf16x8 af[2][2];
#pragma unroll
    for (int tt = 0; tt < 2; ++tt)
#pragma unroll
        for (int ks = 0; ks < 2; ++ks) af[tt][ks] = *(const bf16x8*)(a3 + (size_t)(t0 + 16 * tt + lr) * 64 + 32 * ks + 8 * lq);
    const float MIND = -3.0701134573253945f, MAXD = -15.350567286626973f;
#pragma unroll 4
    for (int i = 0; i < 16; ++i) { const int nt = w * 16 + i, n = 16 * nt + lr;
        const bf16x8 b0 = *(const bf16x8*)(w4t + (size_t)n * 64 + 8 * lq), b1 = *(const bf16x8*)(w4t + (size_t)n * 64 + 32 + 8 * lq);
        const float delta = fabsf(MIND + (MAXD - MIND) * ((float)(n & 511) / 511.0f));
#pragma unroll
        for (int tt = 0; tt < 2; ++tt) { f32x4 acc = (f32x4){0.f, 0.f, 0.f, 0.f};
            acc = MFMA16(af[tt][0], b0, acc); acc = MFMA16(af[tt][1], b1, acc);
            const int tb = t0 + 16 * tt + 4 * lq; float dc[4];
#pragma unroll
            for (int k = 0; k < 4; ++k) dc[k] = __expf(-((float)(tb + k) / (float)(SEQ - 1)) * delta);
            *(u32x2*)(hf + (size_t)n * SEQ + tb) = (u32x2){pk2(acc[0] * dc[0], acc[1] * dc[1]), pk2(acc[2] * dc[2], acc[3] * dc[3])}; } }
}

__device__ __forceinline__ void p0_tables(Frame& F, int item) {
    if (item < 6) {
        const int idx = item * 16384 + F.tid * 32;
        for (int k = 0; k < 32; ++k) { const int id = idx + k; if (id >= 192 * 512) break;
            const int row = id >> 9, col = id & 511, i = col & 255; const float omega = 1.0f / powf(10000.0f, (float)i / 256.0f);
            const float pos = (float)(row < 128 ? row : row - 128); const float ang = pos * omega;
            const float v = (col < 256) ? sinf(ang) : cosf(ang);
            if (row < 128) WSP(float, WS_POSR)[row * 512 + col] = v; else WSP(float, WS_POSC)[(row - 128) * 512 + col] = v; }
    } else {
        for (int id = F.tid; id < 1024; id += 512) { const float l0 = F.p->in[I_LBL][id], l1 = F.p->in[I_LBL][1024 + id];
            WSP(float, WS_LBS)[id] = 1.0f / (1.0f + expf(l1 - l0)); }
    }
}

__device__ __forceinline__ void p1_rows(Frame& F) {
    const float* adap = WSP(float, WS_ADAP); const float* adab = F.p->in[I_ADAB];
    { const int gid = F.bx * 512 + F.tid; if (gid < 3 * 6144) { const int wh = gid / 6144, col = gid % 6144; float s = adab[col];
#pragma unroll
        for (int kc = 0; kc < ADA_KC; ++kc) s += adap[(size_t)(kc * 3 + wh) * 6144 + col]; WSP(float, WS_ADA)[gid] = s; } }
    LAS float* md = (LAS float*)F.lds;
    __syncthreads();
    for (int id = F.tid; id < 3 * 2048; id += 512) { const int wh = id >> 11, col = id & 2047; float s = adab[col];
#pragma unroll
        for (int kc = 0; kc < ADA_KC; ++kc) s += adap[(size_t)(kc * 3 + wh) * 6144 + col]; md[id] = s; }
    __syncthreads();
    const float* x = F.p->in[I_X]; const float* ctx = F.p->in[I_CTX]; const float* g1 = F.p->in[I_N1G];
    const float* posr = WSP(float, WS_POSR); const float* posc = WSP(float, WS_POSC); bf16_t* a1 = WSP(bf16_t, WS_A1);
    const int lane = F.lane;
#define P1_GG() f32x4 ggv[4]; _Pragma("unroll") for (int j = 0; j < 4; ++j) ggv[j] = *(const f32x4*)(g1 + 256 * j + 4 * lane)
#define P1_ROWS4(r0) do { f32x4 v[4][4]; const int wh = (r0) < T ? ((r0) >> 13) : 2; \
        _Pragma("unroll") for (int q = 0; q < 4; ++q) { const int r = (r0) + q; \
            if ((r0) < T) { const int n = r & (SEQ - 1); const f32x4* xr = (const f32x4*)(x + (size_t)r * D) + lane; \
                _Pragma("unroll") for (int j = 0; j < 4; ++j) { const int c = 256 * j + 4 * lane; const f32x4 pe = (c < 512) ? *(const f32x4*)(posr + (n >> 6) * 512 + c) : *(const f32x4*)(posc + (n & 63) * 512 + c - 512); v[q][j] = xr[64 * j] + pe; } \
            } else { const f32x4* xr = (const f32x4*)(ctx + (size_t)(r - T) * D) + lane; \
                _Pragma("unroll") for (int j = 0; j < 4; ++j) v[q][j] = xr[64 * j]; } } \
        _Pragma("unroll") for (int q = 0; q < 4; ++q) { float ss = 0.f; \
            _Pragma("unroll") for (int j = 0; j < 4; ++j) ss += (v[q][j][0] * v[q][j][0] + v[q][j][1] * v[q][j][1]) + (v[q][j][2] * v[q][j][2] + v[q][j][3] * v[q][j][3]); \
            const float rs = rsqrtf(wave_sum(ss) * (1.0f / D) + EPS); \
            u32x2* o8 = (u32x2*)(a1 + (size_t)((r0) + q) * D) + lane; \
            _Pragma("unroll") for (int j = 0; j < 4; ++j) { const int c = 256 * j + 4 * lane; const f32x4 gg = ggv[j]; \
                const f32x4 sh = *(const LAS f32x4*)(md + wh * 2048 + c), sc = *(const LAS f32x4*)(md + wh * 2048 + 1024 + c); \
                const f32x4 y = v[q][j] * rs * gg * (sc + 1.0f) + sh; \
                u32x2 w; w.x = pk2(y[0], y[1]); w.y = pk2(y[2], y[3]); o8[64 * j] = w; } } } while (0)
    { const int gw = F.bx * 8 + F.wave, NGW = F.G * 8; P1_GG();
        for (int r0 = gw * 4; r0 < MA; r0 += NGW * 4) P1_ROWS4(r0); }
#undef P1_ROWS4
#undef P1_GG
}


__device__ __forceinline__ void phase0(Frame& F, unsigned long long* pa = nullptr, int pmode = 0) {
    unsigned* pre = WSP(unsigned, WS_CTL) + CW_PRE;
    for (int it = F.bx; it < 103; it += F.G) {
        asm volatile("" : "+v"(F.tid));
        if (it < 96) p0_ada_item(F, it); else p0_tables(F, it - 96);
        if (it < 102) {
            asm volatile("s_waitcnt vmcnt(0)" ::: "memory"); __syncthreads();
            if (F.tid == 0) { __builtin_amdgcn_fence(__ATOMIC_RELEASE, "agent"); asm volatile("s_waitcnt vmcnt(0)" ::: "memory"); (void)xb_add(pre, 1u); }
        }
    }
    const bool early = F.bx < F.G / 2;
#pragma unroll 1
    for (int s = 0; s < 2; ++s) {
        asm volatile("" : "+v"(F.tid));
        if ((s == 0) == early) {
            if (F.tid == 0) { unsigned sp = 0; while (xb_ld(pre) < 102u && ++sp < (1u << 22)) __builtin_amdgcn_s_sleep(2);
                __builtin_amdgcn_fence(__ATOMIC_ACQUIRE, "agent"); asm volatile("s_waitcnt vmcnt(0)" ::: "memory"); }
            __syncthreads();
            p1_rows(F);
            __syncthreads();
        } else {
            XpState xp; xp.stride = F.G; xp.it = F.bx + XP_BG * F.G; xp.end = (F.G == 256) ? 256 * (XP_BG + XP_K0) : 0; xp.live = false;
            for (int it = F.bx; it < 359; it += F.G) {
                if (it < 103) continue;
                asm volatile("" : "+v"(F.tid));
                p0_filter_item(F, it - 103, xp);
            }
            __syncthreads();
            p0_transposes(F);
            { int tid = F.tid; xp_finish(xp, F.p->in, F.ws, tid); while (xp.it < xp.end) { xp_issue(xp, F.p->in, F.ws, tid); xp_finish(xp, F.p->in, F.ws, tid); } }
            __syncthreads();
            if (F.G != 256) p0_expert_transposes(F);
        }
    }
}

__device__ __forceinline__ void phase1(Frame& F) {
    for (int it = F.bx; it < SEQ / 32; it += F.G) filter_out_item(F, it);
}

__device__ __forceinline__ void phase_h2(Frame& F) {
    const float* x1 = F.p->out; const float* g2 = F.p->in[I_N2G]; const float* ada = WSP(float, WS_ADA); bf16_t* h2 = WSP(bf16_t, WS_H2);
    const int gw = F.bx * 8 + F.wave, NGW = F.G * 8, lane = F.lane;
    f32x4 ggv[4];
#pragma unroll
    for (int j = 0; j < 4; ++j) ggv[j] = *(const f32x4*)(g2 + 256 * j + 4 * lane);
    const bool al = (F.G == 256); const int vw = ((F.bx & 7) * 32 + (F.bx >> 3)) * 8 + F.wave;
    for (int r0 = al ? vw * 8 : gw * 4, it_ = 0; al ? it_ < 2 : r0 < T; r0 += al ? 4 : NGW * 4, ++it_) { const int b = r0 >> 13;
        f32x4 v[4][4], shv[4], scv[4];
#pragma unroll
        for (int j = 0; j < 4; ++j) { const int c = 256 * j + 4 * lane; shv[j] = *(const f32x4*)(ada + b * 6144 + 3 * D + c); scv[j] = *(const f32x4*)(ada + b * 6144 + 4 * D + c); }
#pragma unroll
        for (int q = 0; q < 4; ++q) { const f32x4* xr = (const f32x4*)(x1 + (size_t)(r0 + q) * D) + lane;
#pragma unroll
            for (int j = 0; j < 4; ++j) v[q][j] = xr[64 * j]; }
#pragma unroll
        for (int q = 0; q < 4; ++q) { float ss = 0.f;
#pragma unroll
            for (int j = 0; j < 4; ++j) ss += (v[q][j][0] * v[q][j][0] + v[q][j][1] * v[q][j][1]) + (v[q][j][2] * v[q][j][2] + v[q][j][3] * v[q][j][3]);
            const float rs = rsqrtf(wave_sum(ss) * (1.0f / D) + EPS);
            u32x2* o8 = (u32x2*)(h2 + (size_t)(r0 + q) * D) + lane;
#pragma unroll
            for (int j = 0; j < 4; ++j) { const f32x4 gg = ggv[j], sh = shv[j], sc = scv[j];
                const f32x4 y = v[q][j] * rs * gg * (sc + 1.0f) + sh;
                u32x2 w; w.x = pk2(y[0], y[1]); w.y = pk2(y[2], y[3]); o8[64 * j] = w; } }
    }
}
constexpr int FPAD = 17920;
__device__ __forceinline__ int fphys(int i) { return i + (i >> 4) + ((i >> 9) << 4); }
__device__ constexpr float TWC[16] = {1.0f, 0.98078528040323044913f, 0.92387953251128675613f, 0.83146961230254523708f, 0.70710678118654752440f, 0.55557023301960222474f, 0.38268343236508977173f, 0.19509032201612826785f,
                                      0.0f, -0.19509032201612826785f, -0.38268343236508977173f, -0.55557023301960222474f, -0.70710678118654752440f, -0.83146961230254523708f, -0.92387953251128675613f, -0.98078528040323044913f};
__device__ constexpr float TWS[16] = {0.0f, 0.19509032201612826785f, 0.38268343236508977173f, 0.55557023301960222474f, 0.70710678118654752440f, 0.83146961230254523708f, 0.92387953251128675613f, 0.98078528040323044913f,
                                      1.0f, 0.98078528040323044913f, 0.92387953251128675613f, 0.83146961230254523708f, 0.70710678118654752440f, 0.55557023301960222474f, 0.38268343236508977173f, 0.19509032201612826785f};
__host__ __device__ constexpr int brev_c(int x, int bits) { int r = 0; for (int i = 0; i < bits; ++i) r = (r << 1) | ((x >> i) & 1); return r; }

typedef f32x2 cpx;
__device__ __forceinline__ cpx cmul(cpx a, cpx w) { return (cpx){a.x, a.x} * w + (cpx){a.y, a.y} * (cpx){-w.y, w.x}; }
template <int S0, int R, bool INV, bool ZHI = false, bool OLO = false>
__device__ __forceinline__ void fft_pass(LAS cpx* X, int tid) {
    constexpr int LOW = 14 - S0 - R, NR = 1 << R, NTASK = (1 << (14 - R)) / 512;
    asm volatile("" : "+v"(tid));
#pragma unroll 1
    for (int task = 0; task < NTASK; ++task) {
        const int g = tid + 512 * task;
        const int blo = g & ((1 << LOW) - 1), bhi = g >> LOW;
        const int base = (bhi << (LOW + R)) | blo;
        cpx v[NR];
#pragma unroll
        for (int j = 0; j < NR; ++j) { if (ZHI && j >= NR / 2) v[j] = (cpx){0.f, 0.f}; else v[j] = X[fphys(base | (j << LOW))]; }
        cpx w0 = (cpx){1.f, 0.f};
        if (LOW > 0) { float s, c; sincospif(-(float)blo * (1.0f / (float)(1 << (13 - S0))), &s, &c); w0 = (cpx){c, INV ? -s : s}; }
        if (INV && LOW > 0) {
            cpx cw = w0;
#pragma unroll
            for (int m = 1; m < NR; ++m) { const int j = brev_c(m, R); v[j] = cmul(v[j], cw); if (m + 1 < NR) cw = cmul(cw, w0); }
        }
        if (!INV) {
#pragma unroll
            for (int q = 0; q < R; ++q) { const int hj = 1 << (R - 1 - q);
#pragma unroll
                for (int j = 0; j < NR; ++j) { if (j & hj) continue; const int k32 = (j & (hj - 1)) << (5 - R + q);
                    cpx d;
                    if (ZHI && q == 0) d = v[j];
                    else { const cpx a = v[j], bb = v[j + hj]; v[j] = a + bb; d = a - bb; }
                    if (k32 == 0) v[j + hj] = d;
                    else if (k32 == 8) v[j + hj] = (cpx){d.y, -d.x};
                    else v[j + hj] = cmul(d, (cpx){TWC[k32], -TWS[k32]}); } }
        } else {
#pragma unroll
            for (int q = R - 1; q >= 0; --q) { const int hj = 1 << (R - 1 - q);
#pragma unroll
                for (int j = 0; j < NR; ++j) { if (j & hj) continue; const int k32 = (j & (hj - 1)) << (5 - R + q);
                    const cpx p = v[j], bb = v[j + hj]; cpx t;
                    if (k32 == 0) t = bb;
                    else if (k32 == 8) t = (cpx){-bb.y, bb.x};
                    else t = cmul(bb, (cpx){TWC[k32], TWS[k32]});
                    v[j] = p + t; if (!(OLO && q == 0)) v[j + hj] = p - t; } }
        }
        if (!INV && LOW > 0) {
            cpx cw = w0;
#pragma unroll
            for (int m = 1; m < NR; ++m) { const int j = brev_c(m, R); v[j] = cmul(v[j], cw); if (m + 1 < NR) cw = cmul(cw, w0); }
        }
#pragma unroll
        for (int j = 0; j < NR; ++j) { if (OLO && j >= NR / 2) continue; X[fphys(base | (j << LOW))] = v[j]; }
    }
}
#define XP_HOOK() xp_step(xp, F.p->in, F.ws, tid)
template <bool ZHI> __device__ __forceinline__ void fft_fwd(Frame& F, XpState& xp, LAS cpx* X, int tid) {
    fft_pass<0, 5, false, ZHI>(X, tid); __syncthreads(); XP_HOOK(); fft_pass<5, 5, false>(X, tid); __syncthreads(); XP_HOOK(); fft_pass<10, 4, false>(X, tid); __syncthreads(); XP_HOOK();
}
__device__ __forceinline__ void fft_inv(Frame& F, XpState& xp, LAS cpx* X, int tid) {
    fft_pass<10, 4, true>(X, tid); __syncthreads(); XP_HOOK(); fft_pass<5, 5, true>(X, tid); __syncthreads(); XP_HOOK(); fft_pass<0, 5, true, false, true>(X, tid); __syncthreads(); XP_HOOK();
}
struct SC8 { u32x4 c; unsigned l, r; };
__device__ __forceinline__ SC8 sconv8_load(const bf16_t* p, int n) {
    SC8 s; s.c = *(const u32x4*)(p + n); s.l = n > 0 ? (unsigned)p[n - 1] : 0u; s.r = n + 8 < SEQ ? (unsigned)p[n + 8] : 0u; return s;
}
__device__ __forceinline__ void sconv8_eval(const SC8& s, float w0, float w1, float w2, float bias, float (&o)[8]) {
    float v[10]; v[0] = bf2f(s.l); v[1] = bflo(s.c.x); v[2] = bfhi(s.c.x); v[3] = bflo(s.c.y); v[4] = bfhi(s.c.y); v[5] = bflo(s.c.z); v[6] = bfhi(s.c.z); v[7] = bflo(s.c.w); v[8] = bfhi(s.c.w); v[9] = bf2f(s.r);
#pragma unroll
    for (int i = 0; i < 8; ++i) o[i] = w0 * v[i] + w1 * v[i + 1] + w2 * v[i + 2] + bias;
}
__device__ __forceinline__ void hyena_item(Frame& F, int c, XpState& xp) {
    LAS cpx* X = (LAS cpx*)F.lds; LAS float* red = (LAS float*)(F.lds + (size_t)FPAD * 8);
    int tid = F.tid; asm volatile("" : "+v"(tid));
    const bf16_t* hf = WSP(bf16_t, WS_HF);
    __syncthreads();
    float s0 = 0.f, s1 = 0.f;
    {
        f32x4 fa[4], fb[4], ba[4], bb[4];
#pragma unroll
        for (int it = 0; it < 4; ++it) { const int j = 4 * (tid + 512 * it);
            const u32x2 w0 = *(const u32x2*)(hf + (size_t)c * SEQ + j), w1 = *(const u32x2*)(hf + (size_t)(1024 + c) * SEQ + j), w2 = *(const u32x2*)(hf + (size_t)(512 + c) * SEQ + j), w3 = *(const u32x2*)(hf + (size_t)(1536 + c) * SEQ + j);
            fa[it] = (f32x4){bflo(w0.x), bfhi(w0.x), bflo(w0.y), bfhi(w0.y)}; fb[it] = (f32x4){bflo(w1.x), bfhi(w1.x), bflo(w1.y), bfhi(w1.y)};
            ba[it] = (f32x4){bflo(w2.x), bfhi(w2.x), bflo(w2.y), bfhi(w2.y)}; bb[it] = (f32x4){bflo(w3.x), bfhi(w3.x), bflo(w3.y), bfhi(w3.y)}; }
#pragma unroll
        for (int it = 0; it < 4; ++it) { const int j = 4 * (tid + 512 * it);
#pragma unroll
            for (int i = 0; i < 4; ++i) { X[fphys(j + i)] = (cpx){fa[it][i], fb[it][i]}; s0 += fabsf(fa[it][i]); s1 += fabsf(fb[it][i]);
                const int m = j + i; if (m > 0) { X[fphys(FFTN - m)] = (cpx){ba[it][i], bb[it][i]}; s0 += fabsf(ba[it][i]); s1 += fabsf(bb[it][i]); } } }
        if (tid == 0) X[fphys(SEQ)] = (cpx){0.f, 0.f};
    }
    s0 = wave_sum(s0); s1 = wave_sum(s1);
    if (F.lane == 0) { red[F.wave] = s0; red[8 + F.wave] = s1; }
    __syncthreads();
    float S0 = 0.f, S1 = 0.f;
#pragma unroll
    for (int w = 0; w < 8; ++w) { S0 += red[w]; S1 += red[8 + w]; }
    fft_fwd<false>(F, xp, X, tid);
    unsigned* ks = WSP(unsigned, WS_KS) + (size_t)F.bx * 2 * FFTN;
    { const float i0 = 1.0f / S0, i1 = 1.0f / S1, sk0 = F.p->in[I_HSKIP][c], sk1 = F.p->in[I_HSKIP][512 + c];
#pragma unroll 8
        for (int it = 0; it < 32; ++it) { const int p = tid + 512 * it; const int k = (int)(__brev((unsigned)p) >> 18); const int pp = (int)(__brev((unsigned)((FFTN - k) & (FFTN - 1))) >> 18);
            const cpx A = X[fphys(p)], B = X[fphys(pp)];
            const float k1r = 0.5f * (A.x + B.x), k1i = 0.5f * (A.y - B.y), k2r = 0.5f * (A.y + B.y), k2i = -0.5f * (A.x - B.x);
            ks[p] = pkh2(k1r * i0 + sk0, k1i * i0); ks[FFTN + p] = pkh2(k2r * i1 + sk1, k2i * i1); } }
    __syncthreads();
    const bf16_t* ph = WSP(bf16_t, WS_PHYT); const float* cw = F.p->in[I_HCW]; const float* cb = F.p->in[I_HCB];
    { const float w0 = cw[c], w1 = cw[HYP + c], w2 = cw[2 * HYP + c], bs = cb[c];
        SC8 sa[2], sb[2];
#pragma unroll
        for (int it = 0; it < 2; ++it) { const int n = 8 * (tid + 512 * it); sa[it] = sconv8_load(ph + (size_t)c * SEQ, n); sb[it] = sconv8_load(ph + (size_t)(HYP + c) * SEQ, n); }
#pragma unroll
        for (int it = 0; it < 2; ++it) { const int n = 8 * (tid + 512 * it); float a[8], b[8]; sconv8_eval(sa[it], w0, w1, w2, bs, a); sconv8_eval(sb[it], w0, w1, w2, bs, b);
#pragma unroll
            for (int i = 0; i < 8; ++i) X[fphys(n + i)] = (cpx){a[i], b[i]}; } }
    __syncthreads();
    fft_fwd<true>(F, xp, X, tid);
    { unsigned kk[32]; const float invN = 1.0f / (float)FFTN;
#pragma unroll
        for (int it = 0; it < 32; ++it) kk[it] = ks[tid + 512 * it];
#pragma unroll
        for (int it = 0; it < 32; ++it) { const int q = fphys(tid + 512 * it); X[q] = cmul(X[q], (cpx){h2f((unsigned short)(kk[it] & 0xffffu)) * invN, h2f((unsigned short)(kk[it] >> 16)) * invN}); } }
    __syncthreads();
    fft_inv(F, xp, X, tid);
    { const int col = HYW + c; const float w0 = cw[col], w1 = cw[HYP + col], w2 = cw[2 * HYP + col], bs = cb[col];
        SC8 sa[2], sb[2];
#pragma unroll
        for (int it = 0; it < 2; ++it) { const int n = 8 * (tid + 512 * it); sa[it] = sconv8_load(ph + (size_t)col * SEQ, n); sb[it] = sconv8_load(ph + (size_t)(HYP + col) * SEQ, n); }
#pragma unroll
        for (int it = 0; it < 2; ++it) { const int n = 8 * (tid + 512 * it); float a[8], b[8]; sconv8_eval(sa[it], w0, w1, w2, bs, a); sconv8_eval(sb[it], w0, w1, w2, bs, b);
#pragma unroll
            for (int i = 0; i < 8; ++i) { const int q = fphys(n + i); X[q] = X[q] * (cpx){a[i], b[i]}; } } }
    __syncthreads();
    fft_fwd<true>(F, xp, X, tid);
    { unsigned kk[32]; const float invN = 1.0f / (float)FFTN;
#pragma unroll
        for (int it = 0; it < 32; ++it) kk[it] = ks[FFTN + tid + 512 * it];
#pragma unroll
        for (int it = 0; it < 32; ++it) { const int q = fphys(tid + 512 * it); X[q] = cmul(X[q], (cpx){h2f((unsigned short)(kk[it] & 0xffffu)) * invN, h2f((unsigned short)(kk[it] >> 16)) * invN}); } }
    __syncthreads();
    fft_inv(F, xp, X, tid);
    { const int col = 2 * HYW + c; const float w0 = cw[col], w1 = cw[HYP + col], w2 = cw[2 * HYP + col], bs = cb[col];
        bf16_t* yt = WSP(bf16_t, WS_YHYT);
        SC8 sa[2], sb[2]; u32x4 oa[2], ob[2];
#pragma unroll
        for (int it = 0; it < 2; ++it) { const int n = 8 * (tid + 512 * it); sa[it] = sconv8_load(ph + (size_t)col * SEQ, n); sb[it] = sconv8_load(ph + (size_t)(HYP + col) * SEQ, n); }
#pragma unroll
        for (int it = 0; it < 2; ++it) { const int n = 8 * (tid + 512 * it); float a[8], b[8]; sconv8_eval(sa[it], w0, w1, w2, bs, a); sconv8_eval(sb[it], w0, w1, w2, bs, b);
            cpx y[8];
#pragma unroll
            for (int i = 0; i < 8; ++i) y[i] = X[fphys(n + i)];
            oa[it] = (u32x4){pk2(y[0].x * a[0], y[1].x * a[1]), pk2(y[2].x * a[2], y[3].x * a[3]), pk2(y[4].x * a[4], y[5].x * a[5]), pk2(y[6].x * a[6], y[7].x * a[7])};
            ob[it] = (u32x4){pk2(y[0].y * b[0], y[1].y * b[1]), pk2(y[2].y * b[2], y[3].y * b[3]), pk2(y[4].y * b[4], y[5].y * b[5]), pk2(y[6].y * b[6], y[7].y * b[7])}; }
#pragma unroll
        for (int it = 0; it < 2; ++it) { const int n = 8 * (tid + 512 * it);
            *(u32x4*)(yt + (size_t)c * SEQ + n) = oa[it]; *(u32x4*)(yt + (size_t)(HYW + c) * SEQ + n) = ob[it]; } }
}

__device__ __forceinline__ bf16x8 lds_frag(const LAS bf16_t* base, int row, int stride, int k) { return *(const LAS bf16x8*)(base + row * stride + k); }

__device__ __forceinline__ void hg_delta_item(Frame& F, int item) {
    const int chain = item / NCH_EXT, j = item % NCH_EXT, dir = chain & 1, h = (chain >> 1) & 3, b = chain >> 3;
    const int cj = dir == 0 ? j : (j < 4 ? 3 - j : 135 - j), n0 = cj * 64;
    LAS float* segtot = (LAS float*)F.lds;
    LAS bf16_t* Kt = (LAS bf16_t*)(F.lds + 4096);
    LAS bf16_t* VTs = (LAS bf16_t*)(F.lds + 4096 + 18432);
    const int tid = F.tid, d = 2 * (tid & 63), seg = tid >> 6, lane = F.lane;
    const float* lfp = (dir ? WSP(float, WS_LB) : WSP(float, WS_LF)) + ((size_t)(b * NEXT + n0) * HGW + h * 128 + d);
    f32x2 lf[8], tot = (f32x2){0.f, 0.f};
#pragma unroll
    for (int i = 0; i < 8; ++i) { lf[i] = *(const f32x2*)(lfp + (size_t)(8 * seg + i) * HGW); tot += lf[i]; }
    __syncthreads();
    *(LAS f32x2*)(segtot + seg * 128 + d) = tot;
    { const bf16_t* vt = WSP(bf16_t, WS_VT) + ((size_t)(b * HGW + h * 128) * NEXT + n0);
        u32x4 tv[2];
#pragma unroll
        for (int q = 0; q < 2; ++q) { const int piece = tid + 512 * q, e = piece >> 3, part = piece & 7; tv[q] = *(const u32x4*)(vt + (size_t)e * NEXT + part * 8); }
#pragma unroll
        for (int q = 0; q < 2; ++q) { const int piece = tid + 512 * q, e = piece >> 3, part = piece & 7; *(LAS u32x4*)(VTs + e * 72 + part * 8) = tv[q]; } }
    __syncthreads();
    f32x2 later = (f32x2){0.f, 0.f}, total = later;
#pragma unroll
    for (int s = 0; s < 8; ++s) { const f32x2 v = *(const LAS f32x2*)(segtot + s * 128 + d); total += v; if (dir == 0 ? (s > seg) : (s < seg)) later += v; }
    f32x2 E[8];
    if (dir == 0) { f32x2 run = later;
#pragma unroll
        for (int i = 7; i >= 0; --i) { E[i] = run; run += lf[i]; } }
    else { f32x2 run = later;
#pragma unroll
        for (int i = 0; i < 8; ++i) { E[i] = run; run += lf[i]; } }
    float k0[8], k1[8];
#pragma unroll
    for (int i = 0; i < 8; ++i) { k0[i] = (1.0f - __expf(lf[i].x)) * __expf(E[i].x); k1[i] = (1.0f - __expf(lf[i].y)) * __expf(E[i].y); }
    *(LAS u32x4*)(Kt + d * 72 + 8 * seg) = (u32x4){pk2(k0[0], k0[1]), pk2(k0[2], k0[3]), pk2(k0[4], k0[5]), pk2(k0[6], k0[7])};
    *(LAS u32x4*)(Kt + (d + 1) * 72 + 8 * seg) = (u32x4){pk2(k1[0], k1[1]), pk2(k1[2], k1[3]), pk2(k1[4], k1[5]), pk2(k1[6], k1[7])};
    if (seg == 0) *(f32x2*)(WSP(float, WS_DECAY) + (size_t)item * 128 + d) = (f32x2){__expf(total.x), __expf(total.y)};
    __syncthreads();
    const int w = F.wave, lr = lane & 15, lq = lane >> 4;
    f32x4 acc[8];
#pragma unroll
    for (int et = 0; et < 8; ++et) acc[et] = (f32x4){0.f, 0.f, 0.f, 0.f};
#pragma unroll
    for (int ksi = 0; ksi < 2; ++ksi) { const bf16x8 a = lds_frag(Kt, 16 * w + lr, 72, 32 * ksi + 8 * lq);
#pragma unroll
        for (int et = 0; et < 8; ++et) acc[et] = MFMA16(a, lds_frag(VTs, 16 * et + lr, 72, 32 * ksi + 8 * lq), acc[et]); }
    bf16_t* dl = WSP(bf16_t, WS_DELTA) + (size_t)item * 16384;
#pragma unroll
    for (int et = 0; et < 8; ++et) { const int e = 16 * et + lr, d0 = 16 * w + 4 * lq;
        u32x2 o; o.x = pk2(acc[et][0], acc[et][1]); o.y = pk2(acc[et][2], acc[et][3]); *(u32x2*)(dl + e * 128 + d0) = o; }
}

__device__ __forceinline__ void hg_scan(Frame& F) {
    for (int gid = F.bx * 512 + F.tid; gid < NCHAIN * 8192; gid += F.G * 512) {
        const int chain = gid >> 13, idx = gid & 8191, dd = (2 * idx) & 127;
        const unsigned* dl = WSP(unsigned, WS_DELTA) + (size_t)chain * NCH_EXT * 8192 + idx;
        const float* dc = WSP(float, WS_DECAY) + (size_t)chain * NCH_EXT * 128 + dd;
        unsigned* ss = WSP(unsigned, WS_SST) + (size_t)chain * NCH_LAT * 8192 + idx;
        float s0 = 0.f, s1 = 0.f;
        constexpr int SB = 22;
        unsigned dv[SB], dw[SB]; f32x2 cv[SB], cw[SB];
#pragma unroll
        for (int u = 0; u < SB; ++u) { dv[u] = dl[(size_t)u * 8192]; cv[u] = *(const f32x2*)(dc + (size_t)u * 128); }
#pragma unroll 1
        for (int j0 = 0; j0 < NCH_EXT; j0 += SB) {
            const bool more = j0 + SB < NCH_EXT;
            if (more) {
#pragma unroll
                for (int u = 0; u < SB; ++u) { dw[u] = dl[(size_t)(j0 + SB + u) * 8192]; cw[u] = *(const f32x2*)(dc + (size_t)(j0 + SB + u) * 128); } }
#pragma unroll
            for (int u = 0; u < SB; ++u) { const int j = j0 + u;
                if (j >= 4) ss[(size_t)(j - 4) * 8192] = pk2(s0, s1);
                s0 = cv[u].x * s0 + bflo(dv[u]); s1 = cv[u].y * s1 + bfhi(dv[u]); }
#pragma unroll
            for (int u = 0; u < SB; ++u) { dv[u] = dw[u]; cv[u] = cw[u]; }
        }
    }
}

__device__ __forceinline__ void yhy_transpose_item(Frame& F, int item) {
    const int b = item >> 7, nb = item & 127, tid = F.tid;
    LAS bf16_t* ts = (LAS bf16_t*)F.lds;
    const bf16_t* src = WSP(bf16_t, WS_YHYT) + (size_t)b * HYW * SEQ + nb * 64;
    __syncthreads();
    { u32x4 tv[8];
#pragma unroll
    for (int q = 0; q < 8; ++q) { const int piece = tid + 512 * q, c = piece >> 3, part = piece & 7; tv[q] = *(const u32x4*)(src + (size_t)c * SEQ + part * 8); }
#pragma unroll
    for (int q = 0; q < 8; ++q) { const int piece = tid + 512 * q, c = piece >> 3, part = piece & 7; *(LAS u32x4*)(ts + c * 72 + part * 8) = tv[q]; } }
    __syncthreads();
    bf16_t* dst = WSP(bf16_t, WS_YHY) + (size_t)(b * SEQ + nb * 64) * HYW;
#pragma unroll
    for (int q = 0; q < 8; ++q) { const int task = tid + 512 * q, n = task & 63, cg = task >> 6;
        unsigned v[8];
#pragma unroll
        for (int i = 0; i < 8; ++i) v[i] = ts[(8 * cg + i) * 72 + n];
        *(u32x4*)(dst + (size_t)n * HYW + 8 * cg) = (u32x4){v[0] | (v[1] << 16), v[2] | (v[3] << 16), v[4] | (v[5] << 16), v[6] | (v[7] << 16)}; }
}

__device__ __forceinline__ void hg_out_item(Frame& F, int item) {
    const int b = item >> 9, h = (item >> 7) & 3, nc = item & 127;
    LAS float* segtot = (LAS float*)F.lds;
    LAS float* bref = (LAS float*)(F.lds + 4096);
    LAS float* red = (LAS float*)(F.lds + 4608);
    LAS bf16_t* Qd = (LAS bf16_t*)(F.lds + 5120);
    LAS bf16_t* Kd = (LAS bf16_t*)(F.lds + 22528);
    LAS bf16_t* Qb = (LAS bf16_t*)(F.lds + 39936);
    LAS bf16_t* VTs = (LAS bf16_t*)(F.lds + 57344);
    LAS bf16_t* Ss = (LAS bf16_t*)(F.lds + 75776);
    LAS bf16_t* att = (LAS bf16_t*)(F.lds + 110592);
    const int tid = F.tid, d = 2 * (tid & 63), seg = tid >> 6, lane = F.lane, w = F.wave, lr = lane & 15, lq = lane >> 4;
    const int nx0 = CTXL + nc * 64, r0 = b * SEQ + nc * 64;
    __syncthreads();
    { const bf16_t* vt = WSP(bf16_t, WS_VT) + ((size_t)(b * HGW + h * 128) * NEXT + nx0);
        u32x4 tv[2];
#pragma unroll
        for (int q = 0; q < 2; ++q) { const int piece = tid + 512 * q, e = piece >> 3, part = piece & 7; tv[q] = *(const u32x4*)(vt + (size_t)e * NEXT + part * 8); }
#pragma unroll
        for (int q = 0; q < 2; ++q) { const int piece = tid + 512 * q, e = piece >> 3, part = piece & 7; *(LAS u32x4*)(VTs + e * 72 + part * 8) = tv[q]; } }
    f32x4 acc[4];
#pragma unroll
    for (int i = 0; i < 4; ++i) acc[i] = (f32x4){0.f, 0.f, 0.f, 0.f};
    const bf16_t* qp = WSP(bf16_t, WS_Q) + ((size_t)r0 * HGW + h * 128 + d);
#pragma unroll 1
    for (int dir = 0; dir < 2; ++dir) {
        const int chain = (b * 4 + h) * 2 + dir, jlat = dir == 0 ? nc : 127 - nc;
        __syncthreads();
        { const bf16_t* sp = WSP(bf16_t, WS_SST) + (size_t)(chain * NCH_LAT + jlat) * 16384;
            u32x4 sv[4];
#pragma unroll
            for (int q = 0; q < 4; ++q) { const int piece = tid + 512 * q, e = piece >> 4, part = piece & 15; sv[q] = *(const u32x4*)(sp + e * 128 + part * 8); }
#pragma unroll
            for (int q = 0; q < 4; ++q) { const int piece = tid + 512 * q, e = piece >> 4, part = piece & 15; *(LAS u32x4*)(Ss + e * 136 + part * 8) = sv[q]; } }
        const float* lfp = (dir ? WSP(float, WS_LB) : WSP(float, WS_LF)) + ((size_t)(b * NEXT + nx0) * HGW + h * 128 + d);
        f32x2 lf[8], qv[8], tot = (f32x2){0.f, 0.f};
#pragma unroll
        for (int i = 0; i < 8; ++i) { lf[i] = *(const f32x2*)(lfp + (size_t)(8 * seg + i) * HGW); const unsigned qw = *(const unsigned*)(qp + (size_t)(8 * seg + i) * HGW); qv[i] = (f32x2){bflo(qw), bfhi(qw)}; tot += lf[i]; }
        *(LAS f32x2*)(segtot + seg * 128 + d) = tot;
        __syncthreads();
        f32x2 off = (f32x2){0.f, 0.f};
#pragma unroll
        for (int s = 0; s < 8; ++s) { const f32x2 v = *(const LAS f32x2*)(segtot + s * 128 + d); if (dir == 0 ? (s < seg) : (s > seg)) off += v; }
        f32x2 bb[8];
        if (dir == 0) { f32x2 run = off;
#pragma unroll
            for (int i = 0; i < 8; ++i) { run += lf[i]; bb[i] = run; } if (seg == 3) *(LAS f32x2*)(bref + d) = bb[7]; }
        else { f32x2 run = off;
#pragma unroll
            for (int i = 7; i >= 0; --i) { run += lf[i]; bb[i] = run; } if (seg == 4) *(LAS f32x2*)(bref + d) = bb[0]; }
        __syncthreads();
        { const f32x2 br = *(const LAS f32x2*)(bref + d); const f32x2 em = (f32x2){__expf(-br.x), __expf(-br.y)}, ep = (f32x2){__expf(br.x), __expf(br.y)};
#pragma unroll
            for (int i = 0; i < 8; ++i) { const int t = 8 * seg + i;
                const f32x2 eb = (f32x2){__expf(bb[i].x), __expf(bb[i].y)}, kk = (f32x2){1.0f - __expf(lf[i].x), 1.0f - __expf(lf[i].y)};
                const f32x2 qb = qv[i] * eb, qd = qb * em, kd = kk * ep * (f32x2){__builtin_amdgcn_rcpf(eb.x), __builtin_amdgcn_rcpf(eb.y)};
                *(LAS unsigned*)(Qd + t * 136 + d) = pk2(qd.x, qd.y); *(LAS unsigned*)(Kd + t * 136 + d) = pk2(kd.x, kd.y); *(LAS unsigned*)(Qb + t * 136 + d) = pk2(qb.x, qb.y); } }
        __syncthreads();
        {
            const int st = w & 3; f32x4 a2[2] = {(f32x4){0.f, 0.f, 0.f, 0.f}, (f32x4){0.f, 0.f, 0.f, 0.f}};
#pragma unroll
            for (int ksi = 0; ksi < 4; ++ksi) { const bf16x8 a = lds_frag(Kd, 16 * st + lr, 136, 32 * ksi + 8 * lq);
#pragma unroll
                for (int q = 0; q < 2; ++q) a2[q] = MFMA16(a, lds_frag(Qd, 16 * (2 * (w >> 2) + q) + lr, 136, 32 * ksi + 8 * lq), a2[q]); }
#pragma unroll
            for (int q = 0; q < 2; ++q) { const int t = 16 * (2 * (w >> 2) + q) + lr, s0 = 16 * st + 4 * lq; float v[4];
#pragma unroll
                for (int r = 0; r < 4; ++r) { const int s = s0 + r; v[r] = (dir == 0 ? (s <= t) : (s >= t)) ? a2[q][r] : 0.f; }
                u32x2 o; o.x = pk2(v[0], v[1]); o.y = pk2(v[2], v[3]); *(LAS u32x2*)(att + t * 72 + s0) = o; }
        }
        __syncthreads();
        { const int tt = w & 3;
#pragma unroll
            for (int ksi = 0; ksi < 2; ++ksi) { const bf16x8 a = lds_frag(att, 16 * tt + lr, 72, 32 * ksi + 8 * lq);
#pragma unroll
                for (int i = 0; i < 4; ++i) acc[i] = MFMA16(a, lds_frag(VTs, 16 * (4 * (w >> 2) + i) + lr, 72, 32 * ksi + 8 * lq), acc[i]); }
#pragma unroll
            for (int ksi = 0; ksi < 4; ++ksi) { const bf16x8 a = lds_frag(Qb, 16 * tt + lr, 136, 32 * ksi + 8 * lq);
#pragma unroll
                for (int i = 0; i < 4; ++i) acc[i] = MFMA16(a, lds_frag(Ss, 16 * (4 * (w >> 2) + i) + lr, 136, 32 * ksi + 8 * lq), acc[i]); }
        }
    }
    const int tt = w & 3, eh = w >> 2;
    float ssq[4];
#pragma unroll
    for (int r = 0; r < 4; ++r) { float s = 0.f;
#pragma unroll
        for (int i = 0; i < 4; ++i) s += acc[i][r] * acc[i][r];
        s += __shfl_xor(s, 1); s += __shfl_xor(s, 2); s += __shfl_xor(s, 4); s += __shfl_xor(s, 8); ssq[r] = s; }
    if (lr == 0) {
#pragma unroll
        for (int r = 0; r < 4; ++r) red[eh * 64 + 16 * tt + 4 * lq + r] = ssq[r]; }
    __syncthreads();
    const float* ng = F.p->in[I_HGNG]; const bf16_t* gp = WSP(bf16_t, WS_G); bf16_t* yo = WSP(bf16_t, WS_YHG);
    float ngv[4], gv[4][4];
#pragma unroll
    for (int i = 0; i < 4; ++i) ngv[i] = ng[16 * (4 * eh + i) + lr];
#pragma unroll
    for (int r = 0; r < 4; ++r)
#pragma unroll
        for (int i = 0; i < 4; ++i) gv[r][i] = bf2f(gp[(size_t)(r0 + 16 * tt + 4 * lq + r) * HGW + h * 128 + 16 * (4 * eh + i) + lr]);
#pragma unroll
    for (int r = 0; r < 4; ++r) { const int t = 16 * tt + 4 * lq + r; const float rs = rsqrtf((red[t] + red[64 + t]) * (1.0f / 128.0f) + EPS);
#pragma unroll
        for (int i = 0; i < 4; ++i) { const int e = 16 * (4 * eh + i) + lr; const size_t o = (size_t)(r0 + t) * HGW + h * 128 + e;
            yo[o] = (bf16_t)f2bf(acc[i][r] * rs * ngv[i] * gv[r][i]); } }
}
__device__ __forceinline__ void phase_route(Frame& F) {
    const float* lg = WSP(float, WS_LOGIT); const float* rb = F.p->in[I_RB];
    LAS int* hist = (LAS int*)F.lds;
    int* re_ = WSP(int, WS_ROUTE_E); float* rw_ = WSP(float, WS_ROUTE_W); int* rp_ = WSP(int, WS_ROUTE_P);
    const int lane = F.lane, g = lane & 7, NGW = F.G * 8;
    __syncthreads();
    if (F.tid < NE) hist[F.tid] = 0;
    __syncthreads();
    const bool al = (F.G == 256); const int wv = al ? ((F.bx & 7) * 32 + (F.bx >> 3)) * 8 + F.wave : F.bx * 8 + F.wave;
    const float NINF = -__builtin_inff();
    float bias[32];
#pragma unroll
    for (int q = 0; q < 8; ++q) { const f32x4 b4 = *(const f32x4*)(rb + g * 32 + 4 * q); bias[4 * q] = b4[0]; bias[4 * q + 1] = b4[1]; bias[4 * q + 2] = b4[2]; bias[4 * q + 3] = b4[3]; }
    for (int t8 = wv * 8; t8 < T; t8 += NGW * 8) {
        const int t = t8 + (lane >> 3);
        float sc[32], cd[32];
#pragma unroll
        for (int q = 0; q < 8; ++q) { const f32x4 l4 = *(const f32x4*)(lg + (size_t)t * NE + g * 32 + 4 * q);
#pragma unroll
            for (int i = 0; i < 4; ++i) { sc[4 * q + i] = sigmoidf_(l4[i]); cd[4 * q + i] = sc[4 * q + i] + bias[4 * q + i]; } }
        float m1 = fmaxf(cd[0], cd[1]), m2 = fminf(cd[0], cd[1]);
#pragma unroll
        for (int i = 2; i < 32; ++i) { const float v = cd[i]; m2 = fmaxf(m2, fminf(m1, v)); m1 = fmaxf(m1, v); }
        const float gs = m1 + m2; int rank = 0;
#pragma unroll
        for (int gg = 0; gg < 8; ++gg) { const float v = __shfl(gs, (lane & ~7) + gg); rank += (v > gs || (v == gs && gg < g)) ? 1 : 0; }
        if (rank >= 4) {
#pragma unroll
            for (int i = 0; i < 32; ++i) cd[i] = NINF; }
        int me = 0; float mw = 0.f, ssum = 0.f;
#pragma unroll 1
        for (int k = 0; k < 8; ++k) {
            float bv = cd[0], bs = sc[0]; int bi = 0;
#pragma unroll
            for (int i = 1; i < 32; ++i) if (cd[i] > bv) { bv = cd[i]; bs = sc[i]; bi = i; }
            int gi = g * 32 + bi;
#pragma unroll
            for (int o = 1; o < 8; o <<= 1) { const float ov = __shfl_xor(bv, o), os = __shfl_xor(bs, o); const int oi = __shfl_xor(gi, o); if (ov > bv || (ov == bv && oi < gi)) { bv = ov; bs = os; gi = oi; } }
            if ((gi >> 5) == g) { const int li = gi & 31;
#pragma unroll
                for (int i = 0; i < 32; ++i) if (i == li) cd[i] = NINF; }
            ssum += bs; if (k == g) { me = gi; mw = bs; }
        }
        const int lrank = __hip_atomic_fetch_add(hist + me, 1, __ATOMIC_RELAXED, __HIP_MEMORY_SCOPE_WORKGROUP);
        re_[t * 8 + g] = me; rw_[t * 8 + g] = mw * (2.5f / ssum); rp_[t * 8 + g] = lrank | (F.bx << 16);
    }
    __syncthreads();
    if (F.tid < NE) WSP(int, WS_HIST)[F.bx * NE + F.tid] = hist[F.tid];
}
__device__ __forceinline__ void phase_prefix(Frame& F) {
    LAS int* sc = (LAS int*)F.lds;
    const int* hist = WSP(int, WS_HIST); int* pref = WSP(int, WS_PREF); unsigned* cnt = WSP(unsigned, WS_CTL) + CW_CNT;
    for (int e = F.bx; e < NE; e += F.G) {
        __syncthreads();
        const int i = F.tid; int v = (i < 256 && i < F.G) ? hist[i * NE + e] : 0;
        if (i < 256) sc[i] = v;
        __syncthreads();
        int cur = 0;
#pragma unroll
        for (int o = 1; o < 256; o <<= 1) { int x = 0; if (i < 256) { x = sc[cur * 256 + i]; if (i >= o) x += sc[cur * 256 + i - o]; sc[(cur ^ 1) * 256 + i] = x; } __syncthreads(); cur ^= 1; }
        if (i < 256) { const int inc = sc[cur * 256 + i]; pref[i * NE + e] = inc - v; if (i == 255) cnt[e] = (unsigned)inc; }
    }
}
__device__ __forceinline__ void phase_scatter(Frame& F) {
    LAS int* st = (LAS int*)F.lds; LAS int* cn = st + 512;
    const unsigned* cnt = WSP(unsigned, WS_CTL) + CW_CNT;
    __syncthreads();
    if (F.tid < NE) cn[F.tid] = (int)cnt[F.tid];
    __syncthreads();
    if (F.tid <= NE) { int s = 0, tl = 0; for (int e = 0; e < F.tid; ++e) { s += cn[e]; tl += (cn[e] + 255) >> 8; } st[F.tid] = s;
        if (F.bx == 0) { unsigned* ctl = WSP(unsigned, WS_CTL); ctl[CW_START + F.tid] = (unsigned)s; ctl[CW_TOFF + F.tid] = (unsigned)tl;
            if (F.tid < NE) { const int c_ = cn[F.tid]; for (int j = 0; j * 256 < c_; ++j) { unsigned* up = ctl + CW_UNITS + 4 * (tl + j); up[0] = (unsigned)(s + 256 * j); up[1] = (unsigned)F.tid; up[2] = (unsigned)(c_ - 256 * j < 256 ? c_ - 256 * j : 256); up[3] = 0u; } } } }
    __syncthreads();
    const int* re_ = WSP(int, WS_ROUTE_E); const float* rw_ = WSP(float, WS_ROUTE_W); const int* rp_ = WSP(int, WS_ROUTE_P);
    int* stok = WSP(int, WS_SLOT_TOK); float* sw = WSP(float, WS_SLOT_W); int* sof = WSP(int, WS_SLOTOF);
    const int* pref = WSP(int, WS_PREF);
    for (int a = F.bx * 512 + F.tid; a < NASG; a += F.G * 512) { const int e = re_[a], rp = rp_[a]; const int slot = st[e] + pref[(rp >> 16) * NE + e] + (rp & 0xffff); stok[slot] = a >> 3; sw[slot] = rw_[a]; sof[a] = slot; }
    if (F.bx == 0 && F.tid < 256) { stok[NASG + F.tid] = 0; sw[NASG + F.tid] = 0.f; }
}
__device__ __forceinline__ void phase_final(Frame& F) {
    float* out = F.p->out; const float* x1 = F.p->out;     const float* fg = F.p->in[I_FG]; const float* ada = WSP(float, WS_ADA);
    const unsigned char* yb8 = WSP(unsigned char, WS_YBUF); const bf16_t* ysh = WSP(bf16_t, WS_YSH); const int* sof = WSP(int, WS_SLOTOF);
    const int lane = F.lane, NGW = F.G * 8;
    const bool al = (F.G == 256); const int tbase = al ? (((F.bx & 7) * 32 + (F.bx >> 3)) * 8 + F.wave) * 8 : F.bx * 8 + F.wave, tstr = al ? 1 : NGW;
    f32x4 fgv[2][2];
#pragma unroll
    for (int j = 0; j < 2; ++j) { fgv[j][0] = *(const f32x4*)(fg + 512 * j + 8 * lane); fgv[j][1] = *(const f32x4*)(fg + 512 * j + 8 * lane + 4); }
    int it_ = 0;
    for (int t = tbase; al ? it_ < 8 : t < T; t += tstr, ++it_) { const int b = t >> 13;
        int sl[8];
#pragma unroll
        for (int k = 0; k < 8; ++k) sl[k] = sof[t * 8 + k];
        u32x4 ys[2]; u32x2 y[8][2]; f32x4 xv[2][2], g2[2][2];
#pragma unroll
        for (int j = 0; j < 2; ++j) { const int c = 512 * j + 8 * lane;
            ys[j] = *(const u32x4*)(ysh + (size_t)t * D + c); xv[j][0] = *(const f32x4*)(x1 + (size_t)t * D + c); xv[j][1] = *(const f32x4*)(x1 + (size_t)t * D + c + 4);
            g2[j][0] = *(const f32x4*)(ada + b * 6144 + 5 * D + c); g2[j][1] = *(const f32x4*)(ada + b * 6144 + 5 * D + c + 4);
#pragma unroll
            for (int k = 0; k < 8; ++k) y[k][j] = *(const u32x2*)(yb8 + (size_t)sl[k] * D + c); }
        f32x4 v[2][2]; float ss = 0.f;
#pragma unroll
        for (int j = 0; j < 2; ++j) { f32x4 m0 = (f32x4){bflo(ys[j].x), bfhi(ys[j].x), bflo(ys[j].y), bfhi(ys[j].y)}, m1 = (f32x4){bflo(ys[j].z), bfhi(ys[j].z), bflo(ys[j].w), bfhi(ys[j].w)};
#pragma unroll
            for (int k = 0; k < 8; ++k) { const f32x2 a0 = __builtin_amdgcn_cvt_pk_f32_fp8((int)y[k][j].x, false), a1 = __builtin_amdgcn_cvt_pk_f32_fp8((int)y[k][j].x, true), b0 = __builtin_amdgcn_cvt_pk_f32_fp8((int)y[k][j].y, false), b1 = __builtin_amdgcn_cvt_pk_f32_fp8((int)y[k][j].y, true);
                m0 += (f32x4){a0.x, a0.y, a1.x, a1.y}; m1 += (f32x4){b0.x, b0.y, b1.x, b1.y}; }
            v[j][0] = xv[j][0] + g2[j][0] * m0; v[j][1] = xv[j][1] + g2[j][1] * m1;
#pragma unroll
            for (int h = 0; h < 2; ++h) ss += (v[j][h][0] * v[j][h][0] + v[j][h][1] * v[j][h][1]) + (v[j][h][2] * v[j][h][2] + v[j][h][3] * v[j][h][3]); }
        const float rs = rsqrtf(wave_sum(ss) * (1.0f / D) + EPS);
#pragma unroll
        for (int j = 0; j < 2; ++j) { const int c = 512 * j + 8 * lane; *(f32x4*)(out + (size_t)t * D + c) = v[j][0] * rs * fgv[j][0]; *(f32x4*)(out + (size_t)t * D + c + 4) = v[j][1] * rs * fgv[j][1]; }
    }
}

constexpr int NPHASE = 16;
#ifndef REP_MASK
#define REP_MASK 0u
#endif
#define NREP(k) ((((REP_MASK) >> (k)) & 1u) ? 2 : 1)
#ifndef MK_LAUNCH_PER_PHASE
#define MK_LAUNCH_PER_PHASE 0
#endif
__global__ void __launch_bounds__(512) hyena_hgrn2_moe_fwd(Params p) {
    extern __shared__ __attribute__((aligned(16))) unsigned char lds_[];
    cg::grid_group grid = cg::this_grid();
    Frame F; F.lds = (LAS unsigned char*)lds_; F.p = &p; F.ws = p.ws; F.tid = threadIdx.x; F.lane = F.tid & 63; F.wave = __builtin_amdgcn_readfirstlane(F.tid >> 6); F.G = gridDim.x; F.bx = blockIdx.x;
    if (F.tid < 16) ((LAS unsigned*)(F.lds + LDS_BARST))[F.tid] = 0u;
    __syncthreads();
    XcdBarrier bar = xcd_barrier_post((unsigned*)(p.ws + WS_CTL) + CW_BAR, (volatile LAS unsigned*)(F.lds + LDS_BARST));
#ifdef ONLY_PHASE
#define IN(k) ((k) == ONLY_PHASE && p.ph_lo <= (k) && (k) < p.ph_hi)
#else
#define IN(k) (p.ph_lo <= (k) && (k) < p.ph_hi)
#endif
#ifndef PROBE_K
#define PROBE_K (-1)
#endif
#ifndef PROBE_EPI_K
#define PROBE_EPI_K (-1)
#endif
    unsigned long long pk_acc = 0ull;
#define PACC(k) (PROBE_EPI_K == (k) ? &pk_acc : (unsigned long long*)nullptr)
    unsigned long long pk_t0 = 0ull, pk_t1 = 0ull;
#define SEAM(k) do { if (IN(k) && IN((k) + 1)) xcd_barrier(bar); if (PROBE_K == (k) + 1) pk_t0 = __builtin_amdgcn_s_memrealtime(); if (PROBE_K == (k)) pk_t1 = __builtin_amdgcn_s_memrealtime(); } while (0)
    if (PROBE_K == 0) pk_t0 = __builtin_amdgcn_s_memrealtime();
    if (p.ph_lo < 0) grid.sync();
    if (IN(0)) _Pragma("unroll 1") for (int rp = 0; rp < NREP(0); ++rp) { asm volatile("" : "+v"(F.tid)); if (rp) xcd_barrier(bar); phase0(F, PROBE_EPI_K >= 100 ? &pk_acc : (unsigned long long*)nullptr, PROBE_EPI_K - 100); }
    SEAM(0);
    if (IN(1)) _Pragma("unroll 1") for (int rp = 0; rp < NREP(1); ++rp) { asm volatile("" : "+v"(F.tid)); if (rp) xcd_barrier(bar); phase1(F); }
    SEAM(1);
    if (IN(2)) _Pragma("unroll 1") for (int rp = 0; rp < NREP(2); ++rp) { asm volatile("" : "+v"(F.tid)); if (rp) xcd_barrier(bar);
        __syncthreads();
        if (F.G == 256 && F.bx >= 256 - NCONV) {
            conv_loop2(F, 256 * (XP_BG + XP_K0) + (F.bx - (256 - NCONV)), NCONV, NE * 48 - XP_P13);
        } else
        { pg8::Gemm g{WSP(bf16_t, WS_WINT), WSP(bf16_t, WS_WINT), D, nullptr, 2 * D, 128}; InOrder S{F.G == 256 ? 256 - NCONV : F.G, F.bx};
          EpiIn E{EpiInT{WSP(bf16_t, WS_PHYT), WSP(bf16_t, WS_VT)}, EpiInN{WSP(bf16_t, WS_Q), WSP(bf16_t, WS_G), WSP(bf16_t, WS_SG1), WSP(bf16_t, WS_SG2), WSP(float, WS_LF), WSP(float, WS_LB), WSP(float, WS_LBS)}};
          pg8::gemm_phase<EpiIn, InOrder, false>(F.lds, g, S, E, PACC(2)); }
    }
    SEAM(2);
    if (IN(3)) _Pragma("unroll 1") for (int rp = 0; rp < NREP(3); ++rp) { asm volatile("" : "+v"(F.tid)); if (rp) xcd_barrier(bar);
        _Pragma("unroll 1") for (int r2 = 0; r2 < NREP(16); ++r2) { asm volatile("" : "+v"(F.tid));
            XpState xp; xp.it = F.bx; xp.stride = F.G; xp.end = (XP_BG * F.G < NE * 48) ? XP_BG * F.G : NE * 48; xp.live = false;
            for (int c = F.bx; c < HYW; c += F.G) hyena_item(F, c, xp);
            { int tid = F.tid; xp_finish(xp, p.in, F.ws, tid); while (xp.it < xp.end) { xp_issue(xp, p.in, F.ws, tid); xp_finish(xp, p.in, F.ws, tid); } } }
        _Pragma("unroll 1") for (int r2 = 0; r2 < NREP(17); ++r2) { asm volatile("" : "+v"(F.tid)); for (int it = F.bx; it < NAITEM; it += F.G) hg_delta_item(F, it); }
    }
    SEAM(3);
    if (IN(4)) _Pragma("unroll 1") for (int rp = 0; rp < NREP(4); ++rp) { asm volatile("" : "+v"(F.tid)); if (rp) xcd_barrier(bar);
        _Pragma("unroll 1") for (int r2 = 0; r2 < NREP(18); ++r2) { asm volatile("" : "+v"(F.tid)); hg_scan(F); }
        _Pragma("unroll 1") for (int r2 = 0; r2 < NREP(19); ++r2) { asm volatile("" : "+v"(F.tid)); for (int it = F.bx; it < NB * 128; it += F.G) yhy_transpose_item(F, it); }
    }
    SEAM(4);
    if (IN(5)) _Pragma("unroll 1") for (int rp = 0; rp < NREP(5); ++rp) { asm volatile("" : "+v"(F.tid)); if (rp) xcd_barrier(bar); for (int it = F.bx; it < NB * 4 * NCH_LAT; it += F.G) hg_out_item(F, it); }
    SEAM(5);
    if (IN(6)) _Pragma("unroll 1") for (int rp = 0; rp < NREP(6); ++rp) { asm volatile("" : "+v"(F.tid)); if (rp) xcd_barrier(bar);
        __syncthreads();
        { pg8::Gemm g{WSP(bf16_t, WS_YHY), WSP(bf16_t, WS_WHYT), HYW, nullptr, 2 * HYW, 128}; MergeOrder S; S.so.init(T, D, HYW, F.G, F.bx);
          EpiMerge E{EpiMerge1{WSP(bf16_t, WS_SG1), WSP(float, WS_T1)}, EpiMerge2{WSP(bf16_t, WS_SG2), WSP(float, WS_T1), WSP(bf16_t, WS_MB)}};
          pg8::gemm_phase<EpiMerge, MergeOrder, false>(F.lds, g, S, E, PACC(6)); }
    }
    SEAM(6);
    if (IN(7)) _Pragma("unroll 1") for (int rp = 0; rp < NREP(7); ++rp) { asm volatile("" : "+v"(F.tid)); if (rp) xcd_barrier(bar);
        __syncthreads();
        pg8::Gemm g{WSP(bf16_t, WS_MB), WSP(bf16_t, WS_WOUTT), D, nullptr, 2 * D, 128}; pg8::StaticOrder S; S.init(T, D, D, F.G, F.bx);
        EpiWout E{p.in[I_X], WSP(float, WS_POSR), WSP(float, WS_POSC), WSP(float, WS_ADA), p.out};
        pg8::gemm_phase<EpiWout, pg8::StaticOrder, false>(F.lds, g, S, E, PACC(7));
    }
    SEAM(7);
    if (IN(8)) _Pragma("unroll 1") for (int rp = 0; rp < NREP(8); ++rp) { asm volatile("" : "+v"(F.tid)); if (rp) xcd_barrier(bar); phase_h2(F); }
    SEAM(8);
    if (IN(9)) _Pragma("unroll 1") for (int rp = 0; rp < NREP(9); ++rp) { asm volatile("" : "+v"(F.tid)); if (rp) xcd_barrier(bar);
        __syncthreads();
        { pg8::Gemm g{WSP(bf16_t, WS_H2), WSP(bf16_t, WS_ROUT), D, nullptr, 2 * D, 128}; P9Order S{F.G, F.bx}; EpiP9 E{EpiLogit{WSP(float, WS_LOGIT)}, EpiGU{WSP(bf16_t, WS_HSH), nullptr}};
          pg8::gemm_phase<EpiP9, P9Order, false>(F.lds, g, S, E); }
    }
    SEAM(9);
    if (IN(10)) _Pragma("unroll 1") for (int rp = 0; rp < NREP(10); ++rp) { asm volatile("" : "+v"(F.tid)); if (rp) xcd_barrier(bar); phase_route(F); }
    SEAM(10);
    if (IN(11)) phase_prefix(F);
    SEAM(11);
    if (IN(12)) _Pragma("unroll 1") for (int rp = 0; rp < NREP(12); ++rp) { asm volatile("" : "+v"(F.tid)); if (rp) xcd_barrier(bar); phase_scatter(F); }
    SEAM(12);
    if (IN(13)) _Pragma("unroll 1") for (int rp = 0; rp < NREP(13); ++rp) { asm volatile("" : "+v"(F.tid)); if (rp) xcd_barrier(bar);
        __syncthreads();
        if (F.G == 256 && F.bx >= 256 - NCONV2) {
            conv_loop2(F, NE * 48 - XP_P13 + (F.bx - (256 - NCONV2)), NCONV2, NE * 48);
        } else {
        pg8::Gemm g{WSP(bf16_t, WS_H2), WSP(bf16_t, WS_EGUT), D, WSP(int, WS_SLOT_TOK), 128, 512 * 128}; MoeOrder S{WSP(unsigned, WS_CTL) + CW_UNITS, (int)WSP(unsigned, WS_CTL)[CW_TOFF + NE], 2, F.G == 256 ? 256 - NCONV2 : F.G, F.bx, 1048576u}; EpiGU E{WSP(bf16_t, WS_HBUF), WSP(float, WS_SLOT_W)};
        pg8::gemm_phase<EpiGU, MoeOrder, true>(F.lds, g, S, E, PACC(13)); }
    }
    SEAM(13);
    if (IN(14)) _Pragma("unroll 1") for (int rp = 0; rp < NREP(14); ++rp) { asm volatile("" : "+v"(F.tid)); if (rp) xcd_barrier(bar);
        __syncthreads();
        { pg8::Gemm g{WSP(bf16_t, WS_HBUF), WSP(bf16_t, WS_EDT), EH, nullptr, 128, 1024 * 128}; MoeOrder S{WSP(unsigned, WS_CTL) + CW_UNITS, (int)WSP(unsigned, WS_CTL)[CW_TOFF + NE], 4, F.G, F.bx, 524288u}; EpiDown<false, true> E{WSP(bf16_t, WS_YBUF), nullptr};
          pg8::gemm_phase<EpiDown<false, true>, MoeOrder, false>(F.lds, g, S, E, PACC(14)); }
        { pg8::Gemm g{WSP(bf16_t, WS_HSH), WSP(bf16_t, WS_SHDT), EH, nullptr, 2 * EH, 128}; pg8::StaticOrder S; S.init(T, D, EH, F.G, F.bx); EpiDown<false> E{WSP(bf16_t, WS_YSH), nullptr};
          pg8::gemm_phase<EpiDown<false>, pg8::StaticOrder, false>(F.lds, g, S, E); }
    }
    SEAM(14);
    if (IN(15)) _Pragma("unroll 1") for (int rp = 0; rp < NREP(15); ++rp) { asm volatile("" : "+v"(F.tid)); if (rp) xcd_barrier(bar); phase_final(F); }
    if (PROBE_K >= 0) { if (PROBE_K == 15) pk_t1 = __builtin_amdgcn_s_memrealtime();
        if (F.bx == 0) { const unsigned long long te = __builtin_amdgcn_s_memrealtime(), span = 8ull * (PROBE_EPI_K >= 0 ? pk_acc : (pk_t1 - pk_t0)); while (__builtin_amdgcn_s_memrealtime() - te < span) __builtin_amdgcn_s_sleep(8); } }
#undef IN
#undef SEAM
}

extern "C" void kernel_launch(void* const* d_in, const int* in_sizes, int n_in, void* d_out, int out_size, void* d_ws, size_t ws_size, hipStream_t stream) {
    static int grid = 0;
    if (grid == 0) {
        if (n_in != 34 || out_size != T * D || ws_size < WS_END) { fprintf(stderr, "kernel_launch: unexpected shapes (n_in %d, out %d, ws %zu < %zu)\n", n_in, out_size, ws_size, (size_t)WS_END); grid = -1; return; }
        int dev = 0, cus = 0, per_cu = 0;
        if (hipGetDevice(&dev) != hipSuccess || hipDeviceGetAttribute(&cus, hipDeviceAttributeMultiprocessorCount, dev) != hipSuccess) { grid = -1; return; }
        if (hipFuncSetAttribute((const void*)hyena_hgrn2_moe_fwd, hipFuncAttributeMaxDynamicSharedMemorySize, LDS_BYTES) != hipSuccess) { fprintf(stderr, "kernel_launch: hipFuncSetAttribute failed\n"); grid = -1; return; }
        if (hipOccupancyMaxActiveBlocksPerMultiprocessor(&per_cu, (const void*)hyena_hgrn2_moe_fwd, 512, LDS_BYTES) != hipSuccess || per_cu < 1) { fprintf(stderr, "kernel_launch: occupancy query failed (%d)\n", per_cu); (void)hipGetLastError(); per_cu = 1; }
        grid = cus * per_cu; if (grid > 256) grid = 256;
    }
    if (grid < 0) return;
    if (hipMemsetAsync((char*)d_ws + WS_CTL, 0, CTL_BYTES, stream) != hipSuccess) { fprintf(stderr, "kernel_launch: memset failed\n"); return; }
    Params p{};
    for (int i = 0; i < 34; ++i) p.in[i] = (const float*)d_in[i];
    p.out = (float*)d_out; p.ws = (unsigned char*)d_ws;
#if MK_LAUNCH_PER_PHASE
    for (int k = 0; k < NPHASE; ++k) { p.ph_lo = k; p.ph_hi = k + 1; void* args[] = {&p};
        hipError_t e = hipLaunchCooperativeKernel((const void*)hyena_hgrn2_moe_fwd, dim3(grid), dim3(512), args, LDS_BYTES, stream);
        if (e != hipSuccess) { fprintf(stderr, "kernel_launch: launch %d failed: %s\n", k, hipGetErrorString(e)); break; } }
#else
    p.ph_lo = 0; p.ph_hi = NPHASE; void* args[] = {&p};
    hipError_t e = hipLaunchCooperativeKernel((const void*)hyena_hgrn2_moe_fwd, dim3(grid), dim3(512), args, LDS_BYTES, stream);
    if (e != hipSuccess) fprintf(stderr, "kernel_launch: cooperative launch failed: %s (grid %d)\n", hipGetErrorString(e), grid);
#endif
}
```

```cpp
#include <hip/hip_runtime.h>
#include <hip/hip_cooperative_groups.h>
#include <cstdio>
#include <cstdint>
namespace cg = cooperative_groups;

#define LAS __attribute__((address_space(3)))
typedef unsigned short bf16_t;
typedef short bf16x8 __attribute__((ext_vector_type(8)));
typedef float f32x4 __attribute__((ext_vector_type(4)));
typedef float f32x2 __attribute__((ext_vector_type(2)));
typedef unsigned u32x4 __attribute__((ext_vector_type(4)));
typedef unsigned u32x2 __attribute__((ext_vector_type(2)));

constexpr int D = 1024, NB = 2, SEQ = 8192, T = NB * SEQ, CTXL = 256, TC = NB * CTXL, MA = T + TC, NEXT = CTXL + SEQ;
constexpr int HYW = 512, HYP = 1536, HGW = 512, INC = 6144;
constexpr int NE = 256, TOPK = 8, EH = 256, NASG = T * TOPK;
constexpr int NCH_EXT = NEXT / 64  , NCH_LAT = SEQ / 64  , NCHAIN = 16, NAITEM = NCHAIN * NCH_EXT  ;
constexpr int FFTN = 16384;
constexpr float EPS = 1e-6f;

constexpr size_t al256(size_t x) { return (x + 255) & ~(size_t)255; }
constexpr size_t WS_CTL = 0, CTL_BYTES = 65536;
constexpr size_t WS_WINT = WS_CTL + CTL_BYTES;
constexpr size_t WS_WHYT = WS_WINT + (size_t)INC * D * 2;
constexpr size_t WS_WHGT = WS_WHYT + (size_t)D * HYW * 2;
constexpr size_t WS_WOUTT = WS_WHGT + (size_t)D * HGW * 2;
constexpr size_t WS_ROUT = WS_WOUTT + (size_t)D * D * 2;
constexpr size_t WS_SHGUT = WS_ROUT + (size_t)NE * D * 2;
constexpr size_t WS_SHDT = WS_SHGUT + (size_t)512 * D * 2;
constexpr size_t WS_ADAP = WS_SHDT + (size_t)D * 256 * 2;
constexpr size_t WS_ADA = WS_ADAP + (size_t)32 * 3 * 6144 * 4;
constexpr size_t WS_POSR = WS_ADA + (size_t)3 * 6144 * 4;
constexpr size_t WS_POSC = WS_POSR + (size_t)128 * 512 * 4;
constexpr size_t WS_LBS = WS_POSC + (size_t)64 * 512 * 4;
constexpr size_t WS_ROUTE_E = WS_LBS + 4096;
constexpr size_t WS_ROUTE_W = WS_ROUTE_E + (size_t)NASG * 4;
constexpr size_t WS_ROUTE_P = WS_ROUTE_W + (size_t)NASG * 4;
constexpr size_t WS_SLOTOF = WS_ROUTE_P + (size_t)NASG * 4;
constexpr size_t WS_SLOT_TOK = WS_SLOTOF + (size_t)NASG * 4;
constexpr size_t WS_SLOT_W = WS_SLOT_TOK + (size_t)(NASG + 256) * 4;
constexpr size_t WS_HIST = al256(WS_SLOT_W + (size_t)(NASG + 256) * 4);
constexpr size_t WS_PREF = WS_HIST + 256 * 256 * 4;
constexpr size_t WS_A3 = al256(WS_PREF + 256 * 256 * 4);
constexpr size_t WS_W4T = WS_A3 + (size_t)SEQ * 64 * 2;
constexpr size_t WS_EGUT = al256(WS_W4T + (size_t)2048 * 64 * 2);
constexpr size_t WS_EDT = WS_EGUT + (size_t)NE * 512 * D * 2;
constexpr size_t WS_RA = WS_EDT + (size_t)NE * D * EH * 2;
constexpr size_t RA_BYTES = (size_t)NASG * D * 2;
constexpr size_t WS_HF = WS_RA;
constexpr size_t WS_KS = WS_HF + (size_t)2048 * SEQ * 4;
constexpr size_t WS_DELTA = WS_KS + (size_t)256 * 2 * FFTN * 8;
constexpr size_t WS_DECAY = WS_DELTA + (size_t)NAITEM * 16384 * 2;
constexpr size_t WS_PHYT = WS_DECAY + (size_t)NAITEM * 128 * 4;
static_assert(WS_PHYT + (size_t)NB * HYP * SEQ * 2 <= WS_RA + RA_BYTES, "region A overflow");
constexpr size_t WS_YBUF = WS_RA;
constexpr size_t WS_RB = WS_RA + RA_BYTES;
constexpr size_t WS_VT = WS_RB;
constexpr size_t WS_Q = WS_VT + (size_t)NB * HGW * NEXT * 2;
constexpr size_t WS_LF = WS_Q + (size_t)T * HGW * 2;
constexpr size_t WS_LB = WS_LF + (size_t)NB * NEXT * HGW * 4;
constexpr size_t WS_G = WS_LB + (size_t)NB * NEXT * HGW * 4;
constexpr size_t WS_SG1 = WS_G + (size_t)T * HGW * 2;
constexpr size_t WS_SG2 = WS_SG1 + (size_t)T * D * 2;
constexpr size_t WS_A1 = WS_SG2 + (size_t)T * D * 2;
constexpr size_t WS_SST = WS_A1 + (size_t)MA * D * 2;
constexpr size_t WS_YHG = WS_SST + (size_t)NCHAIN * NCH_LAT * 16384 * 2 + 256 * 512;
constexpr size_t WS_T1 = WS_YHG + (size_t)T * HGW * 2;
constexpr size_t WS_END = WS_T1 + (size_t)T * D * 4;
constexpr size_t WS_LOGIT = WS_VT, WS_HSH = WS_Q, WS_MB = WS_LF, WS_H2 = WS_LB, WS_YSH = WS_SG1, WS_YHYT = WS_A1, WS_YHY = WS_A1 + (size_t)NB * HYW * SEQ * 2, WS_HBUF = WS_SST;
static_assert((size_t)T * 256 * 4 <= (size_t)NB * HGW * NEXT * 2, "LOGIT fits VT");
static_assert(WS_YHY + (size_t)T * HYW * 2 <= WS_SST, "YHY fits A1");
static_assert((size_t)(NASG + 256) * EH * 2 <= (size_t)NCHAIN * NCH_LAT * 16384 * 2 + 256 * 512, "HBUF fits SST");
static_assert(WS_END <= (size_t)1073741824, "workspace map exceeds 1 GiB");
constexpr int CW_CNT = 0;
constexpr int CW_START = 512;
constexpr int CW_TOFF = 1024;
constexpr int CW_BAR = 4096;
constexpr int CW_UNITS = 8192;

constexpr int LDS_BYTES = 147456;
constexpr int LDS_BARST = LDS_BYTES - 64;

__device__ __forceinline__ unsigned f2bf(float f) { unsigned u = __float_as_uint(f); return (u + 0x7fffu + ((u >> 16) & 1u)) >> 16; }
__device__ __forceinline__ unsigned pk2(float lo, float hi) { return f2bf(lo) | (f2bf(hi) << 16); }
__device__ __forceinline__ float bf2f(unsigned b) { return __uint_as_float(b << 16); }
__device__ __forceinline__ float bflo(unsigned w) { return __uint_as_float(w << 16); }
__device__ __forceinline__ float bfhi(unsigned w) { return __uint_as_float(w & 0xffff0000u); }
__device__ __forceinline__ float sigmoidf_(float x) { return __builtin_amdgcn_rcpf(1.0f + __expf(-x)); }
__device__ __forceinline__ float siluf_(float x) { return x * __builtin_amdgcn_rcpf(1.0f + __expf(-x)); }
__device__ __forceinline__ unsigned f2h(float f) { return (unsigned)__builtin_bit_cast(unsigned short, (_Float16)f); }
__device__ __forceinline__ unsigned pkh2(float lo, float hi) { return f2h(lo) | (f2h(hi) << 16); }
__device__ __forceinline__ float h2f(unsigned short b) { return (float)__builtin_bit_cast(_Float16, b); }
__device__ __forceinline__ float wave_sum(float v) {
#pragma unroll
    for (int o = 1; o < 64; o <<= 1) v += __shfl_xor(v, o);
    return v;
}
#define LDS_WAIT() asm volatile("s_waitcnt lgkmcnt(0)" ::: "memory")
#define MFMA16(a, b, c) __builtin_amdgcn_mfma_f32_16x16x32_bf16(a, b, c, 0, 0, 0)

struct Params {
    const float* in[34];
    float* out;
    unsigned char* ws;
    int ph_lo, ph_hi;
};
enum { I_X = 0, I_C, I_CTX, I_CCTX, I_N1G, I_N2G, I_ADAW, I_ADAB, I_WIN, I_HCW, I_HCB, I_FW1, I_FB1, I_FW2, I_FB2, I_FW3, I_FB3, I_FW4, I_FFREQ, I_HSKIP,
       I_LBL, I_HGNG, I_WHY, I_WHG, I_WOUT, I_RW, I_RB, I_EG, I_EU, I_ED, I_SG, I_SU, I_SD, I_FG };
namespace pg8 {
constexpr int BM = 256, BK = 64, HALF = 128, HTB = HALF * BK * 2, STAGE_BYTES = 8 * HTB;
__host__ __device__ __forceinline__ int lds_byte(int r, int c) { const int st = (r >> 4) * 2 + (c >> 5), rr = r & 15, cc = c & 31, ob = rr * 64 + cc * 2; return st * 1024 + (ob ^ (((ob >> 9) & 1) << 5)); }
__host__ __device__ __forceinline__ void stage_rc(int b, int& R, int& C) { const int st = b / 1024, sb = b % 1024, swz = sb ^ (((sb >> 9) & 1) << 5); R = (st >> 1) * 16 + swz / 64; C = (st & 1) * 32 + (swz % 64) / 2; }
__host__ __device__ __forceinline__ int perm32(int rho) { const int n = rho >> 4, i = rho & 15; return 8 * (i >> 2) + 4 * n + (i & 3); }

struct Unit { int row0, lrow, pn, nvalid, aux, kind; unsigned boff; };
struct Gemm { const bf16_t* A; const bf16_t* Bt; int K; const int* rows; int ldb, kstepB; };

__device__ __forceinline__ unsigned cvt_pk_bf16(float lo, float hi) { unsigned r; asm volatile("v_cvt_pk_bf16_f32 %0, %1, %2" : "=v"(r) : "v"(lo), "v"(hi)); return r; }

template <class Epi, class Sched, bool GATHER>
__device__ __forceinline__ void gemm_phase(LAS unsigned char* lds, const Gemm g, const Sched& S, const Epi& E, unsigned long long* pacc = nullptr) {
#ifdef PROBE_CALL
    const unsigned long long c0_ = pacc ? __builtin_amdgcn_s_memrealtime() : 0ull; unsigned long long* pacc_call = pacc; pacc = nullptr;
#endif
    const int tid = threadIdx.x, wid = __builtin_amdgcn_readfirstlane(tid >> 6), lane = tid & 63, wr = wid >> 2, wc = wid & 3, fr = lane & 15, fq = lane >> 4;
    int K_ = g.K; asm volatile("" : "+s"(K_));
    const int K = K_, nt = K / BK; int ldb_ = g.ldb, ksb_ = g.kstepB; asm volatile("" : "+s"(ldb_), "+s"(ksb_));
    unsigned voffA[2], voffB[2]; int RA[2], CA[2];
#pragma unroll
    for (int i = 0; i < 2; ++i) { int R, C; stage_rc(tid * 16 + i * 8192, R, C); const int Rb = Epi::PERM ? ((R & ~31) + perm32(R & 31)) : R;
        voffA[i] = (unsigned)(R * K + C) * 2u; voffB[i] = (unsigned)(Rb * ldb_ + C * 2); RA[i] = R; CA[i] = C; }
    const size_t kstep = (size_t)(BK * 2);
    const size_t hstep = (size_t)HALF * K * 2;
    const size_t kstepB = (size_t)ksb_, hstepB = (size_t)HALF * ldb_;
    const unsigned ldsw = (unsigned)wid * 1024u;
    const int aoff = lds_byte(wr * 64 + fr, fq * 8), boff = lds_byte(wc * 32 + fr, fq * 8);
    unsigned vg0[2][2], vg1[2][2];
#define PG8_SA(b, h) (((b) * 2 + (h)) * HTB)
#define PG8_SB(b, h) ((4 + (b) * 2 + (h)) * HTB)
#define PG8_STAGE(bufoff, gbase, voff) do { _Pragma("unroll") for (int _i = 0; _i < 2; ++_i) \
        __builtin_amdgcn_global_load_lds((const unsigned*)((const char*)(gbase) + (voff)[_i]), (LAS unsigned*)(lds + (bufoff) + ldsw + _i * 8192), 16, 0, 0); } while (0)
#define PG8_STAGE_A(bufoff, gbase, h, w) do { _Pragma("unroll") for (int _i = 0; _i < 2; ++_i) { \
        const unsigned _o = GATHER ? ((w) ? vg1[h][_i] : vg0[h][_i]) : (voffA[_i] + (unsigned)((h) * hstep)); \
        __builtin_amdgcn_global_load_lds((const unsigned*)((const char*)(gbase) + _o), (LAS unsigned*)(lds + (bufoff) + ldsw + _i * 8192), 16, 0, 0); } } while (0)
#define PG8_LDA(dst, b, h) do { _Pragma("unroll") for (int m = 0; m < 4; ++m) _Pragma("unroll") for (int k = 0; k < 2; ++k) dst[m][k] = *(const LAS bf16x8*)(lds + PG8_SA(b, h) + aoff + m * 2048 + k * 1024); } while (0)
#define PG8_LDB(dst, b, h) do { _Pragma("unroll") for (int n = 0; n < 2; ++n) _Pragma("unroll") for (int k = 0; k < 2; ++k) dst[n][k] = *(const LAS bf16x8*)(lds + PG8_SB(b, h) + boff + n * 2048 + k * 1024); } while (0)
#define PG8_MMA(ai, bj, At, Bt) do { __builtin_amdgcn_s_setprio(1); _Pragma("unroll") for (int m = 0; m < 4; ++m) _Pragma("unroll") for (int n = 0; n < 2; ++n) _Pragma("unroll") for (int k = 0; k < 2; ++k) \
        acc[ai][bj][m][n] = __builtin_amdgcn_mfma_f32_16x16x32_bf16(Bt[n][k], At[m][k], acc[ai][bj][m][n], 0, 0, 0); __builtin_amdgcn_s_setprio(0); } while (0)
#define PG8_WAIT_V(n) asm volatile("s_waitcnt vmcnt(" #n ")" ::: "memory")
#define PG8_WAIT_L(n) asm volatile("s_waitcnt lgkmcnt(" #n ")" ::: "memory")
#define PG8_BAR __builtin_amdgcn_s_barrier()
#define PG8_SCHED __builtin_amdgcn_sched_barrier(0)
#define PG8_GOFF(dst, u) do { if (GATHER) { _Pragma("unroll") for (int _h = 0; _h < 2; ++_h) _Pragma("unroll") for (int _i = 0; _i < 2; ++_i) \
        dst[_h][_i] = (unsigned)(g.rows[(u).row0 + _h * HALF + RA[_i]] * K + CA[_i]) * 2u; } } while (0)
    Unit cur, nxt; int ui = 0;
    if (!S.next(0, cur)) return;
    f32x4 acc[2][2][4][2];
#pragma unroll
    for (int a = 0; a < 2; ++a)
#pragma unroll
        for (int b = 0; b < 2; ++b)
#pragma unroll
            for (int m = 0; m < 4; ++m)
#pragma unroll
                for (int n = 0; n < 2; ++n) acc[a][b][m][n] = (f32x4){0.f, 0.f, 0.f, 0.f};
    bf16x8 At[4][2], B0[2][2], B1[2][2];
    const char* cA = (const char*)g.A + (GATHER ? (size_t)0 : (size_t)cur.row0 * K * 2); const char* cB = (const char*)g.Bt + cur.boff;
    PG8_GOFF(vg0, cur);
#pragma unroll
    for (int _h = 0; _h < 2; ++_h)
#pragma unroll
        for (int _i = 0; _i < 2; ++_i) vg1[_h][_i] = vg0[_h][_i];
    PG8_STAGE(PG8_SB(0, 0), cB, voffB); PG8_STAGE_A(PG8_SA(0, 0), cA, 0, false); PG8_STAGE(PG8_SB(0, 1), cB + hstepB, voffB); PG8_STAGE_A(PG8_SA(0, 1), cA, 1, false);
    if (wr == 1) PG8_BAR;
    PG8_WAIT_V(4); PG8_BAR;
    PG8_STAGE(PG8_SB(1, 0), cB + kstepB, voffB); PG8_STAGE_A(PG8_SA(1, 0), cA + kstep, 0, false); PG8_STAGE(PG8_SB(1, 1), cB + hstepB + kstepB, voffB);
    PG8_WAIT_V(6); PG8_BAR;
    for (;;) {
        const bool has_next = S.next(ui + 1, nxt);
        if (has_next) PG8_GOFF(vg1, nxt);
        const char* nA = has_next ? (const char*)g.A + (GATHER ? (size_t)0 : (size_t)nxt.row0 * K * 2) : cA; const char* nB = has_next ? (const char*)g.Bt + nxt.boff : cB;
        const bool full = cur.nvalid > HALF;
        for (int t = 0; t < nt; t += 2) {
            const bool last = (t == nt - 2);
            const bool wn = last && has_next;
            const char* a1 = cA + (size_t)(t + 1) * kstep;
            const char* a2 = last ? nA : cA + (size_t)(t + 2) * kstep; const char* b2 = last ? nB : cB + (size_t)(t + 2) * kstepB;
            const char* a3 = a2 + kstep; const char* b3 = b2 + kstepB;
            PG8_LDB(B0, 0, 0); PG8_SCHED; PG8_LDA(At, 0, 0); PG8_STAGE_A(PG8_SA(1, 1), a1, 1, false);
            PG8_WAIT_L(8); PG8_BAR; PG8_WAIT_L(0); PG8_MMA(0, 0, At, B0); PG8_BAR; PG8_SCHED;
            PG8_LDB(B1, 0, 1); PG8_STAGE(PG8_SB(0, 0), b2, voffB);
            PG8_BAR; PG8_WAIT_L(0); PG8_MMA(0, 1, At, B1); PG8_BAR;
            if (full) PG8_LDA(At, 0, 1); PG8_STAGE_A(PG8_SA(0, 0), a2, 0, wn);
            PG8_BAR; PG8_WAIT_L(0); if (full) PG8_MMA(1, 0, At, B0); PG8_BAR; PG8_SCHED;
            PG8_STAGE(PG8_SB(0, 1), b2 + hstepB, voffB);
            PG8_WAIT_V(6); PG8_BAR; if (full) PG8_MMA(1, 1, At, B1); PG8_BAR;
            PG8_LDB(B0, 1, 0); PG8_SCHED; PG8_LDA(At, 1, 0); PG8_STAGE_A(PG8_SA(0, 1), a2, 1, wn);
            PG8_WAIT_L(8); PG8_BAR; PG8_WAIT_L(0); PG8_MMA(0, 0, At, B0); PG8_BAR; PG8_SCHED;
            PG8_LDB(B1, 1, 1); PG8_STAGE(PG8_SB(1, 0), b3, voffB);
            PG8_BAR; PG8_WAIT_L(0); PG8_MMA(0, 1, At, B1); PG8_BAR;
            if (full) PG8_LDA(At, 1, 1); PG8_STAGE_A(PG8_SA(1, 0), a3, 0, wn);
            PG8_BAR; PG8_WAIT_L(0); if (full) PG8_MMA(1, 0, At, B0); PG8_BAR; PG8_SCHED;
            PG8_STAGE(PG8_SB(1, 1), b3 + hstepB, voffB);
            PG8_WAIT_V(6); PG8_BAR; if (full) PG8_MMA(1, 1, At, B1); PG8_BAR;
        }
        { const unsigned long long e0_ = pacc ? __builtin_amdgcn_s_memrealtime() : 0ull; int fr_ = fr, fq_ = fq; asm volatile("" : "+v"(fr_), "+v"(fq_)); E(acc, cur, wr, wc, fr_, fq_); if (pacc) { asm volatile("s_waitcnt vmcnt(0)" ::: "memory"); *pacc += __builtin_amdgcn_s_memrealtime() - e0_; } }
        if (!has_next) break;
#pragma unroll
        for (int a = 0; a < 2; ++a)
#pragma unroll
            for (int b = 0; b < 2; ++b)
#pragma unroll
                for (int m = 0; m < 4; ++m)
#pragma unroll
                    for (int n = 0; n < 2; ++n) acc[a][b][m][n] = (f32x4){0.f, 0.f, 0.f, 0.f};
        cur = nxt; cA = nA; cB = nB; ++ui;
#pragma unroll
        for (int _h = 0; _h < 2; ++_h)
#pragma unroll
            for (int _i = 0; _i < 2; ++_i) vg0[_h][_i] = vg1[_h][_i];
    }
    PG8_WAIT_V(0);
    if (wr == 0) PG8_BAR;
    PG8_BAR;
#ifdef PROBE_CALL
    if (pacc_call) *pacc_call += __builtin_amdgcn_s_memrealtime() - c0_;
#endif
#undef PG8_SA
#undef PG8_SB
#undef PG8_STAGE
#undef PG8_STAGE_A
#undef PG8_LDA
#undef PG8_LDB
#undef PG8_MMA
#undef PG8_WAIT_V
#undef PG8_WAIT_L
#undef PG8_BAR
#undef PG8_SCHED
#undef PG8_GOFF
}

struct StaticOrder {
    int nM, nN, nwg, G, c, Kb;
    __device__ void init(int M, int N, int K, int G_, int c_) { nM = M / BM; nN = N / BM; nwg = nM * nN; G = G_; c = c_; Kb = K; }
    __device__ bool next(int i, Unit& u) const {
        const long L = (long)i * G + c; if (L >= nwg) return false;
        int wgid = (int)L; { const int NXCD = 8; const int q = nwg / NXCD, r = nwg % NXCD, xcd = wgid % NXCD, off = wgid / NXCD; wgid = (xcd < r ? xcd * (q + 1) : r * (q + 1) + (xcd - r) * q) + off; }
        const int WGM = 8; const int nig = WGM * nN, gid = wgid / nig, fm = gid * WGM, gsz = (nM - fm) < WGM ? (nM - fm) : WGM;
        u.row0 = (fm + ((wgid % nig) % gsz)) * BM; u.lrow = u.row0; u.pn = (wgid % nig) / gsz; u.nvalid = BM; u.aux = u.pn; u.kind = 0; u.boff = (unsigned)u.pn * (unsigned)(BM * 2) * (unsigned)Kb; return true;
    }
};
}
using pg8::Unit; using pg8::cvt_pk_bf16;
typedef const f32x4 (&AccRef)[2][2][4][2];

struct MoeOrder {
    const unsigned* units; int ntile, nsub, G, c; unsigned ebytes;
    __device__ bool next(int i, Unit& u) const {
        const long L = (long)i * G + c; const int nun = ntile * nsub; if (L >= nun) return false;
        int idx = (int)L; { const int q = nun / 8, r = nun % 8, xcd = idx % 8, off = idx / 8; idx = (xcd < r ? xcd * (q + 1) : r * (q + 1) + (xcd - r) * q) + off; }
        const int tile = idx / nsub, sub = idx % nsub;
        const u32x4 d = *(const u32x4*)(units + 4 * tile);
        u.row0 = (int)d.x; u.lrow = u.row0; u.pn = (int)d.y * nsub + sub; u.nvalid = (int)d.z; u.aux = sub; u.kind = 0; u.boff = d.y * ebytes + (unsigned)sub * 32768u; return true;
    }
};

struct EpiInT {
    static constexpr bool PERM = true;
    bf16_t* phyt; bf16_t* vt;
    __device__ __forceinline__ void operator()(AccRef acc, const Unit& u, int wr, int wc, int fr, int fq) const {
        const int pm = u.lrow >> 8, tb = u.pn * 256; const bool isctx = tb >= T;
        int b, nbase; if (!isctx) { b = tb >> 13; nbase = tb & (SEQ - 1); } else { b = (tb - T) >> 8; nbase = 0; }
        if (pm < 6 && isctx) return;
#pragma unroll
        for (int ai = 0; ai < 2; ++ai)
#pragma unroll
            for (int m = 0; m < 4; ++m) {
                const int f = u.lrow + ai * 128 + wr * 64 + m * 16 + fr;
                bf16_t* rowp = (pm < 6) ? phyt + ((size_t)(b * HYP + f) * SEQ + nbase) : vt + ((size_t)(b * HGW + (f - HYP)) * NEXT + (isctx ? 0 : CTXL) + nbase);
#pragma unroll
                for (int bj = 0; bj < 2; ++bj) { const int cu = bj * 128 + wc * 32 + 8 * fq; const f32x4 v0 = acc[ai][bj][m][0], v1 = acc[ai][bj][m][1];
                    u32x4 w; w.x = cvt_pk_bf16(v0[0], v0[1]); w.y = cvt_pk_bf16(v0[2], v0[3]); w.z = cvt_pk_bf16(v1[0], v1[1]); w.w = cvt_pk_bf16(v1[2], v1[3]);
                    *(u32x4*)(rowp + cu) = w; }
            }
    }
};
struct EpiInN {
    static constexpr bool PERM = true;
    bf16_t *q, *g, *sg1, *sg2; float *lf, *lb; const float* lbs;
    __device__ __forceinline__ void operator()(AccRef acc, const Unit& u, int wr, int wc, int fr, int fq) const {
        const int pn = u.pn; const bool isctx = u.lrow >= T;
        if (isctx && (pn < 2 || pn > 5)) return;
        float lbu[2][8];
        if (pn >= 2 && pn < 6) {
#pragma unroll
            for (int bj = 0; bj < 2; ++bj) { const float* lbp = lbs + (pn >= 4) * 512 + (pn & 1) * 256 + bj * 128 + wc * 32 + 8 * fq; const f32x4 l0 = *(const f32x4*)lbp, l1 = *(const f32x4*)(lbp + 4);
                lbu[bj][0] = l0[0]; lbu[bj][1] = l0[1]; lbu[bj][2] = l0[2]; lbu[bj][3] = l0[3]; lbu[bj][4] = l1[0]; lbu[bj][5] = l1[1]; lbu[bj][6] = l1[2]; lbu[bj][7] = l1[3]; } }
#pragma unroll
        for (int ai = 0; ai < 2; ++ai)
#pragma unroll
            for (int m = 0; m < 4; ++m) {
                const int r = u.lrow + ai * 128 + wr * 64 + m * 16 + fr;
                int b, nx; if (!isctx) { b = r >> 13; nx = CTXL + (r & (SEQ - 1)); } else { const int rr = r - T; b = rr >> 8; nx = rr & 255; }
#pragma unroll
                for (int bj = 0; bj < 2; ++bj) { const int cu = bj * 128 + wc * 32 + 8 * fq; const f32x4 v0 = acc[ai][bj][m][0], v1 = acc[ai][bj][m][1];
                    float x[8] = {v0[0], v0[1], v0[2], v0[3], v1[0], v1[1], v1[2], v1[3]};
                    if (pn >= 2 && pn < 6) {
                        const int dir = pn >= 4, col = (pn & 1) * 256 + cu;
                        float o[8];
#pragma unroll
                        for (int j = 0; j < 8; ++j) o[j] = __logf(lbu[bj][j] + (1.0f - lbu[bj][j]) * sigmoidf_(x[j]));
                        float* dst = (dir ? lb : lf) + ((size_t)(b * NEXT + nx) * HGW + col);
                        *(f32x4*)dst = (f32x4){o[0], o[1], o[2], o[3]}; *(f32x4*)(dst + 4) = (f32x4){o[4], o[5], o[6], o[7]};
                    } else {
                        bf16_t* dst;
                        if (pn < 2) { dst = q + (size_t)r * HGW + pn * 256 + cu;
#pragma unroll
                            for (int j = 0; j < 8; ++j) x[j] = siluf_(x[j]); }
                        else if (pn < 8) { dst = g + (size_t)r * HGW + (pn - 6) * 256 + cu;
#pragma unroll
                            for (int j = 0; j < 8; ++j) x[j] = siluf_(x[j]); }
                        else { dst = (pn < 12 ? sg1 + (size_t)r * D + (pn - 8) * 256 : sg2 + (size_t)r * D + (pn - 12) * 256) + cu;
#pragma unroll
                            for (int j = 0; j < 8; ++j) x[j] = sigmoidf_(x[j]); }
                        u32x4 w; w.x = cvt_pk_bf16(x[0], x[1]); w.y = cvt_pk_bf16(x[2], x[3]); w.z = cvt_pk_bf16(x[4], x[5]); w.w = cvt_pk_bf16(x[6], x[7]);
                        *(u32x4*)dst = w;
                    }
                }
            }
    }
};
struct EpiMerge1 {
    static constexpr bool PERM = false;
    const bf16_t* sg1; float* t1;
    __device__ __forceinline__ void operator()(AccRef acc, const Unit& u, int wr, int wc, int fr, int fq) const {
#pragma unroll
        for (int ai = 0; ai < 2; ++ai) { u32x2 s[4][2][2];
#pragma unroll
            for (int m = 0; m < 4; ++m) { const size_t ro = (size_t)(u.lrow + ai * 128 + wr * 64 + m * 16 + fr) * D + u.pn * 256 + wc * 32 + 4 * fq;
#pragma unroll
                for (int bj = 0; bj < 2; ++bj)
#pragma unroll
                    for (int n = 0; n < 2; ++n) s[m][bj][n] = *(const u32x2*)(sg1 + ro + bj * 128 + n * 16); }
#pragma unroll
            for (int m = 0; m < 4; ++m) { const size_t ro = (size_t)(u.lrow + ai * 128 + wr * 64 + m * 16 + fr) * D + u.pn * 256 + wc * 32 + 4 * fq;
#pragma unroll
                for (int bj = 0; bj < 2; ++bj)
#pragma unroll
                    for (int n = 0; n < 2; ++n) { const f32x4 a = acc[ai][bj][m][n]; const u32x2 sv = s[m][bj][n];
                        *(f32x4*)(t1 + ro + bj * 128 + n * 16) = (f32x4){a[0] * bflo(sv.x), a[1] * bfhi(sv.x), a[2] * bflo(sv.y), a[3] * bfhi(sv.y)}; } } }
    }
};
struct EpiMerge2 {
    static constexpr bool PERM = false;
    const bf16_t* sg2; const float* t1; bf16_t* mb;
    __device__ __forceinline__ void operator()(AccRef acc, const Unit& u, int wr, int wc, int fr, int fq) const {
#pragma unroll
        for (int ai = 0; ai < 2; ++ai)
#pragma unroll
            for (int mh = 0; mh < 2; ++mh) { u32x2 s[2][2][2]; f32x4 p[2][2][2];
#pragma unroll
                for (int mm = 0; mm < 2; ++mm) { const size_t ro = (size_t)(u.lrow + ai * 128 + wr * 64 + (2 * mh + mm) * 16 + fr) * D + u.pn * 256 + wc * 32 + 4 * fq;
#pragma unroll
                    for (int bj = 0; bj < 2; ++bj)
#pragma unroll
                        for (int n = 0; n < 2; ++n) { s[mm][bj][n] = *(const u32x2*)(sg2 + ro + bj * 128 + n * 16); p[mm][bj][n] = *(const f32x4*)(t1 + ro + bj * 128 + n * 16); } }
#pragma unroll
                for (int mm = 0; mm < 2; ++mm) { const int m = 2 * mh + mm; const size_t ro = (size_t)(u.lrow + ai * 128 + wr * 64 + m * 16 + fr) * D + u.pn * 256 + wc * 32 + 4 * fq;
#pragma unroll
                    for (int bj = 0; bj < 2; ++bj)
#pragma unroll
                        for (int n = 0; n < 2; ++n) { const f32x4 a = acc[ai][bj][m][n], pv = p[mm][bj][n]; const u32x2 sv = s[mm][bj][n];
                            u32x2 w; w.x = cvt_pk_bf16(pv[0] + a[0] * bflo(sv.x), pv[1] + a[1] * bfhi(sv.x)); w.y = cvt_pk_bf16(pv[2] + a[2] * bflo(sv.y), pv[3] + a[3] * bfhi(sv.y));
                            *(u32x2*)(mb + ro + bj * 128 + n * 16) = w; } } }
    }
};
struct EpiWout {
    static constexpr bool PERM = false;
    const float* x; const float* posr; const float* posc; const float* ada; float* x1;
    __device__ __forceinline__ void operator()(AccRef acc, const Unit& u, int wr, int wc, int fr, int fq) const {
        const int b = u.lrow >> 13, cb = u.pn * 256 + wc * 32 + 4 * fq;
        f32x4 g1[2][2];
#pragma unroll
        for (int bj = 0; bj < 2; ++bj)
#pragma unroll
            for (int nn = 0; nn < 2; ++nn) g1[bj][nn] = *(const f32x4*)(ada + b * 6144 + 2 * D + cb + bj * 128 + nn * 16);
#pragma unroll
        for (int ai = 0; ai < 2; ++ai)
#pragma unroll
            for (int mh = 0; mh < 2; ++mh) { f32x4 xv[2][2][2];
#pragma unroll
                for (int mm = 0; mm < 2; ++mm) { const int r = u.lrow + ai * 128 + wr * 64 + (2 * mh + mm) * 16 + fr;
#pragma unroll
                    for (int bj = 0; bj < 2; ++bj)
#pragma unroll
                        for (int nn = 0; nn < 2; ++nn) xv[mm][bj][nn] = *(const f32x4*)(x + (size_t)r * D + cb + bj * 128 + nn * 16); }
#pragma unroll
                for (int mm = 0; mm < 2; ++mm) { f32x4 pe[2][2]; const int m = 2 * mh + mm;
                    const int r = u.lrow + ai * 128 + wr * 64 + m * 16 + fr, n = r & (SEQ - 1);
#pragma unroll
                    for (int bj = 0; bj < 2; ++bj)
#pragma unroll
                        for (int nn = 0; nn < 2; ++nn) { const int c = cb + bj * 128 + nn * 16;
                            pe[bj][nn] = (c < 512) ? *(const f32x4*)(posr + (n >> 6) * 512 + c) : *(const f32x4*)(posc + (n & 63) * 512 + (c - 512)); }
#pragma unroll
                    for (int bj = 0; bj < 2; ++bj)
#pragma unroll
                        for (int nn = 0; nn < 2; ++nn) *(f32x4*)(x1 + (size_t)r * D + cb + bj * 128 + nn * 16) = xv[mm][bj][nn] + pe[bj][nn] + g1[bj][nn] * acc[ai][bj][m][nn]; } }
    }
};
struct EpiLogit {
    static constexpr bool PERM = true;
    float* lg;
    __device__ __forceinline__ void operator()(AccRef acc, const Unit& u, int wr, int wc, int fr, int fq) const {
#pragma unroll
        for (int ai = 0; ai < 2; ++ai)
#pragma unroll
            for (int m = 0; m < 4; ++m) { float* rp = lg + (size_t)(u.lrow + ai * 128 + wr * 64 + m * 16 + fr) * NE + wc * 32 + 8 * fq;
#pragma unroll
                for (int bj = 0; bj < 2; ++bj) { *(f32x4*)(rp + bj * 128) = acc[ai][bj][m][0]; *(f32x4*)(rp + bj * 128 + 4) = acc[ai][bj][m][1]; } }
    }
};
struct EpiGU {
    static constexpr bool PERM = true;
    bf16_t* hout; const float* wrow;
    __device__ __forceinline__ void operator()(AccRef acc, const Unit& u, int wr, int wc, int fr, int fq) const {
        float wv[2][4];
#pragma unroll
        for (int ai = 0; ai < 2; ++ai)
#pragma unroll
            for (int m = 0; m < 4; ++m) { const int rl = ai * 128 + wr * 64 + m * 16 + fr; wv[ai][m] = (wrow && rl < u.nvalid) ? wrow[u.lrow + rl] : 1.0f; }
#pragma unroll
        for (int ai = 0; ai < 2; ++ai)
#pragma unroll
            for (int m = 0; m < 4; ++m) { const int rl = ai * 128 + wr * 64 + m * 16 + fr;
                if (rl < u.nvalid) { const f32x4 g0 = acc[ai][0][m][0], g1 = acc[ai][0][m][1], u0 = acc[ai][1][m][0] * wv[ai][m], u1 = acc[ai][1][m][1] * wv[ai][m];
                    u32x4 w; w.x = cvt_pk_bf16(siluf_(g0[0]) * u0[0], siluf_(g0[1]) * u0[1]); w.y = cvt_pk_bf16(siluf_(g0[2]) * u0[2], siluf_(g0[3]) * u0[3]);
                    w.z = cvt_pk_bf16(siluf_(g1[0]) * u1[0], siluf_(g1[1]) * u1[1]); w.w = cvt_pk_bf16(siluf_(g1[2]) * u1[2], siluf_(g1[3]) * u1[3]);
                    *(u32x4*)(hout + (size_t)(u.lrow + rl) * EH + u.aux * 128 + wc * 32 + 8 * fq) = w; } }
    }
};
template <bool HASW, bool FP8 = false> struct EpiDown {
    static constexpr bool PERM = true;
    bf16_t* yout; const float* wrow;
    __device__ __forceinline__ void operator()(AccRef acc, const Unit& u, int wr, int wc, int fr, int fq) const {
        char* base = (char*)yout + ((size_t)u.lrow * D + u.aux * 256 + wc * 32) * (FP8 ? 1 : 2);
        float wv[2][4];
#pragma unroll
        for (int ai = 0; ai < 2; ++ai)
#pragma unroll
            for (int m = 0; m < 4; ++m) { const int rl = ai * 128 + wr * 64 + m * 16 + fr; wv[ai][m] = (HASW && rl < u.nvalid) ? wrow[u.lrow + rl] : 1.0f; }
#pragma unroll
        for (int ai = 0; ai < 2; ++ai)
#pragma unroll
            for (int m = 0; m < 4; ++m) { const int rl = ai * 128 + wr * 64 + m * 16 + fr;
                if (rl < u.nvalid) { const float w_ = wv[ai][m];
                    const unsigned off = (unsigned)(rl * D + 8 * fq) * (FP8 ? 1u : 2u);
#pragma unroll
                    for (int bj = 0; bj < 2; ++bj) { const f32x4 v0 = acc[ai][bj][m][0] * w_, v1 = acc[ai][bj][m][1] * w_;
                        if (FP8) { int a = __builtin_amdgcn_cvt_pk_fp8_f32(v0[0], v0[1], 0, false); a = __builtin_amdgcn_cvt_pk_fp8_f32(v0[2], v0[3], a, true);
                            int c = __builtin_amdgcn_cvt_pk_fp8_f32(v1[0], v1[1], 0, false); c = __builtin_amdgcn_cvt_pk_fp8_f32(v1[2], v1[3], c, true);
                            *(u32x2*)(base + off + bj * 128) = (u32x2){(unsigned)a, (unsigned)c}; }
                        else { u32x4 w; w.x = cvt_pk_bf16(v0[0], v0[1]); w.y = cvt_pk_bf16(v0[2], v0[3]); w.z = cvt_pk_bf16(v1[0], v1[1]); w.w = cvt_pk_bf16(v1[2], v1[3]);
                            *(u32x4*)(base + off + bj * 256) = w; } } } }
    }
};

constexpr int RA1 = (int)((WS_A1 - WS_WINT) / (D * 2));
static_assert((WS_A1 - WS_WINT) % (D * 2) == 0, "A1 must sit a whole number of rows above WINT");
struct InOrder {
    int G, c;
    static constexpr int N0 = 6 * 64, N1 = 2 * 64, N2 = 64 * 16, N3 = 12, NU = N0 + N1 + N2 + N3;
    __device__ bool next(int i, Unit& u) const {
        const long L = (long)i * G + c; if (L >= NU) return false;
        const int xcd = (int)(L % 8), p = (int)(L / 8), nT = xcd < 4 ? 65 : 64, tb = xcd < 4 ? 65 * xcd : 260 + 64 * (xcd - 4);
        if (p >= nT + 129) return false;
        int pm, pn, kind;
        if (p < nT) { const int uu = tb + p; kind = 0;
            if (uu < 512) { const int g = uu >> 5, jj = uu & 31; pm = 4 * (g & 1) + (jj & 3); pn = 8 * (g >> 1) + (jj >> 2); }
            else { const int j = uu - 512; pm = 6 + (j >> 1); pn = 64 + (j & 1); } }
        else { const int v = 129 * xcd + (p - nT); kind = 1;
            if (v < 1024) { const int g = v >> 7, jj = v & 127; pm = 8 * g + (jj & 7); pn = jj >> 3; }
            else { const int j = v - 1024; pm = 64 + (j >> 2); pn = 2 + (j & 3); } }
        fill(u, kind, pm, pn); return true;
    }
    __device__ static void fill(Unit& u, int kind, int pm, int pn) {
        u.kind = kind; u.pn = pn; u.lrow = pm * 256; u.nvalid = 256; u.aux = pn;
        if (kind == 0) { u.row0 = pm * 256; u.boff = (unsigned)(RA1 + pn * 256) * (unsigned)(D * 2); }
        else { u.row0 = RA1 + pm * 256; u.boff = (unsigned)(2048 + pn * 256) * (unsigned)(D * 2); }
    }
};
struct CtxUnit {
    int idx;
    __device__ static int tile(int idx) { return idx < 4 ? (idx & 1) : ((idx - 4) >> 2); }
    __device__ bool next(int i, Unit& u) const { if (i) return false;
        if (idx < 4) InOrder::fill(u, 0, 6 + (idx >> 1), 64 + (idx & 1)); else InOrder::fill(u, 1, 64 + ((idx - 4) >> 2), 2 + ((idx - 4) & 3)); return true; }
};
struct EpiIn {
    static constexpr bool PERM = true;
    EpiInT t; EpiInN n;
    __device__ __forceinline__ void operator()(AccRef acc, const Unit& u, int wr, int wc, int fr, int fq) const { if (u.kind == 0) t(acc, u, wr, wc, fr, fq); else n(acc, u, wr, wc, fr, fq); }
};
struct P9Order {
    int G, c;
    __device__ bool next(int i, Unit& u) const {
        const long L = (long)i * G + c; if (L >= 192) return false; int idx = (int)L;
        { const int xcd = idx % 8, off = idx / 8; idx = xcd * 24 + off; }
        const int pm = idx / 3, k3 = idx % 3;
        u.row0 = pm * 256;
        if (k3 == 0) { u.kind = 0; u.pn = 0; u.aux = 0; u.boff = 0u; }
        else { u.kind = 1; u.pn = k3 - 1; u.aux = k3 - 1; u.boff = (unsigned)(WS_SHGUT - WS_ROUT) + (unsigned)(k3 - 1) * (unsigned)(256 * D * 2); }
        u.lrow = u.row0; u.nvalid = 256; return true;
    }
};
struct EpiP9 {
    static constexpr bool PERM = true;
    EpiLogit l; EpiGU g;
    __device__ __forceinline__ void operator()(AccRef acc, const Unit& u, int wr, int wc, int fr, int fq) const { if (u.kind == 0) l(acc, u, wr, wc, fr, fq); else g(acc, u, wr, wc, fr, fq); }
};

constexpr int RYHG = (int)((WS_YHG - WS_YHY) / (HYW * 2));
static_assert((WS_YHG - WS_YHY) % (HYW * 2) == 0 && WS_YHG > WS_YHY, "YHG must sit a whole number of rows above YHY");
struct MergeOrder {
    pg8::StaticOrder so;
    __device__ bool next(int i, Unit& u) const {
        if (!so.next(i >> 1, u)) return false;
        u.kind = i & 1;
        if (u.kind) { u.row0 += RYHG; u.boff += (unsigned)(WS_WHGT - WS_WHYT); }
        return true;
    }
};
struct EpiMerge {
    static constexpr bool PERM = false;
    EpiMerge1 a; EpiMerge2 b;
    __device__ __forceinline__ void operator()(AccRef acc, const Unit& u, int wr, int wc, int fr, int fq) const { if (u.kind == 0) a(acc, u, wr, wc, fr, fq); else b(acc, u, wr, wc, fr, fq); }
};
#define XB_TMO      128
#define XB_XCNT(j)  (256  + 64 * (j))
#define XB_XSUB(j)  (1280 + 64 * (j))
#define XB_XGEN(j)  (2304 + 64 * (j))
#define XB_TOP      3328
#define XB_TOPGEN   3392
#define XCD_BAR_WORDS 3456
#define XB_SPIN_CAP (1u << 18)

__device__ __forceinline__ unsigned xb_ld(unsigned* p)              { return __hip_atomic_load(p, __ATOMIC_RELAXED, __HIP_MEMORY_SCOPE_AGENT); }
__device__ __forceinline__ unsigned xb_add(unsigned* p, unsigned v) { return __hip_atomic_fetch_add(p, v, __ATOMIC_RELAXED, __HIP_MEMORY_SCOPE_AGENT); }
__device__ __forceinline__ unsigned xb_xcc_id() { return (unsigned)__builtin_amdgcn_s_getreg((3 << 11) | 20) & 0xFu; }
#define XB_SPIN(cond, bar) do { unsigned _sp = 0; while (cond) { __builtin_amdgcn_s_sleep(1); \
    if ((++_sp & 255u) == 0u) { if (xb_ld(&(bar)[XB_TMO])) break; if (_sp > XB_SPIN_CAP) { atomicAdd(&(bar)[XB_TMO], 1u); break; } } } } while (0)

struct XcdBarrier {
    unsigned* bar; unsigned x;
    volatile LAS unsigned* st;
};

__device__ __forceinline__ XcdBarrier xcd_barrier_post(unsigned* bar, volatile LAS unsigned* st) {
    XcdBarrier b; b.bar = bar; b.x = xb_xcc_id(); b.st = st;
    if (threadIdx.x == 0) (void)xb_add(&bar[XB_XCNT(b.x)], 1u);
    return b;
}
__device__ __forceinline__ void xcd_barrier_complete(unsigned* bar, unsigned x, unsigned& nloc, unsigned& nx) {
    const unsigned G = gridDim.x * gridDim.y * gridDim.z;
    unsigned sum, cnt, mine, sp = 0u;
    for (;;) {
        sum = 0u; cnt = 0u; mine = 0u;
#pragma unroll
        for (unsigned j = 0; j < 16; ++j) { const unsigned c = xb_ld(&bar[XB_XCNT(j)]); sum += c; cnt += (c > 0u) ? 1u : 0u; mine = (j == x) ? c : mine; }
        if (sum == G) break;
        __builtin_amdgcn_s_sleep(1);
        if ((++sp & 255u) == 0u) { if (xb_ld(&bar[XB_TMO])) break; if (sp > XB_SPIN_CAP) { atomicAdd(&bar[XB_TMO], 1u); break; } }
    }
    nloc = mine > 0u ? mine : 1u; nx = cnt > 0u ? cnt : 1u;
}

__device__ __attribute__((noinline)) void xcd_barrier(const XcdBarrier b) {
    asm volatile("s_waitcnt vmcnt(0)" ::: "memory");
    __syncthreads();
    if (threadIdx.x == 0) {
        unsigned* bar = b.bar;
        __builtin_amdgcn_s_waitcnt(0);
        unsigned nloc = b.st[0], nx = b.st[1];
        if (nloc == 0u) { xcd_barrier_complete(bar, b.x, nloc, nx); b.st[0] = nloc; b.st[1] = nx; }
        const unsigned old = xb_add(&bar[XB_XSUB(b.x)], 1u);
        const unsigned gen = old / nloc;
        if (old + 1u == (gen + 1u) * nloc) {
            __builtin_amdgcn_fence(__ATOMIC_RELEASE, "agent");
            asm volatile("s_waitcnt vmcnt(0)" ::: "memory");
            const unsigned og = xb_add(&bar[XB_TOP], 1u);
            const unsigned tg = og / nx;
            if (og + 1u == (tg + 1u) * nx) xb_add(&bar[XB_TOPGEN], 1u);
            else XB_SPIN(xb_ld(&bar[XB_TOPGEN]) == tg, bar);
            __builtin_amdgcn_fence(__ATOMIC_ACQUIRE, "agent");
            xb_add(&bar[XB_XGEN(b.x)], 1u);
            asm volatile("s_waitcnt vmcnt(0)" ::: "memory");
        } else {
            XB_SPIN(xb_ld(&bar[XB_XGEN(b.x)]) == gen, bar);
            __builtin_amdgcn_fence(__ATOMIC_ACQUIRE, "agent");
            asm volatile("s_waitcnt vmcnt(0)" ::: "memory");
        }
    }
    __syncthreads();
}


struct Frame {
    LAS unsigned char* lds;
    const Params* p;
    unsigned char* ws;
    int tid, lane, wave, G, bx;
};
#define WSP(T_, off) ((T_*)(F.ws + (off)))

__device__ __forceinline__ void p0_transpose_item(const float* W, int N, bf16_t* WT, int K, int k0, int n0, int row0, LAS float* scr, int lane) {
#pragma unroll 8
    for (int i = 0; i < 32; ++i) { const int kk = 2 * i + (lane >> 5); scr[kk * 33 + (lane & 31)] = W[(size_t)(k0 + kk) * N + n0 + (lane & 31)]; }
    LDS_WAIT(); asm volatile("" ::: "memory");
    const int c = lane & 7;
#pragma unroll
    for (int j = 0; j < 4; ++j) { const int n = (lane >> 3) + 8 * j; const LAS float* s = scr + (8 * c) * 33 + n;
        u32x4 o; o.x = pk2(s[0 * 33], s[1 * 33]); o.y = pk2(s[2 * 33], s[3 * 33]); o.z = pk2(s[4 * 33], s[5 * 33]); o.w = pk2(s[6 * 33], s[7 * 33]);
        *(u32x4*)(WT + (size_t)(row0 + n) * K + k0 + 8 * c) = o; }
    LDS_WAIT(); asm volatile("" ::: "memory");
}
__device__ __forceinline__ int gu_row(int n0, int up) { return (n0 >> 7) * 256 + up * 128 + (n0 & 127); }

__device__ __forceinline__ void p0_transposes(Frame& F) {
    LAS float* scr = (LAS float*)(F.lds + F.wave * 16384);
    const int gw = F.bx * 8 + F.wave, NGW = F.G * 8;
    const float* const* in = F.p->in;
    constexpr int I_WIN_ = 16 * 192, I_WHY_ = 8 * 32, I_WHG_ = 8 * 32, I_WOUT_ = 16 * 32, I_R_ = 16 * 8, I_SG_ = 16 * 8, I_SU_ = 16 * 8, I_SD_ = 4 * 32;
    constexpr int I_W4_ = 64;
    constexpr int NSMALL = I_WIN_ + I_WHY_ + I_WHG_ + I_WOUT_ + I_R_ + I_SG_ + I_SU_ + I_SD_ + I_W4_;
    for (int it = gw; it < NSMALL; it += NGW) {
        int r = it;
        {
            if (r < I_WIN_) { const int kb = r / 192, nb = r % 192, n0 = nb * 32; const int f0 = (n0 >= 1536 && n0 < 2048) ? n0 + 512 : ((n0 >= 2048 && n0 < 2560) ? n0 - 512 : n0);
                p0_transpose_item(in[I_WIN], INC, WSP(bf16_t, WS_WINT), D, kb * 64, n0, f0, scr, F.lane); continue; } r -= I_WIN_;
            if (r < I_WHY_) { p0_transpose_item(in[I_WHY], D, WSP(bf16_t, WS_WHYT), HYW, (r / 32) * 64, (r % 32) * 32, (r % 32) * 32, scr, F.lane); continue; } r -= I_WHY_;
            if (r < I_WHG_) { p0_transpose_item(in[I_WHG], D, WSP(bf16_t, WS_WHGT), HGW, (r / 32) * 64, (r % 32) * 32, (r % 32) * 32, scr, F.lane); continue; } r -= I_WHG_;
            if (r < I_WOUT_) { p0_transpose_item(in[I_WOUT], D, WSP(bf16_t, WS_WOUTT), D, (r / 32) * 64, (r % 32) * 32, (r % 32) * 32, scr, F.lane); continue; } r -= I_WOUT_;
            if (r < I_R_) { p0_transpose_item(in[I_RW], NE, WSP(bf16_t, WS_ROUT), D, (r / 8) * 64, (r % 8) * 32, (r % 8) * 32, scr, F.lane); continue; } r -= I_R_;
            if (r < I_SG_) { p0_transpose_item(in[I_SG], EH, WSP(bf16_t, WS_SHGUT), D, (r / 8) * 64, (r % 8) * 32, gu_row((r % 8) * 32, 0), scr, F.lane); continue; } r -= I_SG_;
            if (r < I_SU_) { p0_transpose_item(in[I_SU], EH, WSP(bf16_t, WS_SHGUT), D, (r / 8) * 64, (r % 8) * 32, gu_row((r % 8) * 32, 1), scr, F.lane); continue; } r -= I_SU_;
            if (r < I_SD_) { p0_transpose_item(in[I_SD], D, WSP(bf16_t, WS_SHDT), EH, (r / 32) * 64, (r % 32) * 32, (r % 32) * 32, scr, F.lane); continue; } r -= I_SD_;
            p0_transpose_item(in[I_FW4], 2048, WSP(bf16_t, WS_W4T), 64, 0, r * 32, r * 32, scr, F.lane); continue;
        }
    }
}

template <int MODE  >
__device__ __forceinline__ void p0_x256_load(const float* W, int N, int k0, int n0, int tid, f32x4 (&v)[8]) {
    const int n4 = MODE ? ((tid >> 6) * 8 + (tid & 7)) : (tid & 63), kq = MODE ? ((tid >> 3) & 7) : (tid >> 6); const float* src = W + (size_t)(k0 + 8 * kq) * N + n0 + 4 * n4;
#pragma unroll
    for (int r = 0; r < 8; ++r) v[r] = __builtin_nontemporal_load((const f32x4*)(src + (size_t)r * N));
}
__device__ __forceinline__ void p0_x256_store(LAS unsigned char* ts, bf16_t* WT, int K, int k0, int row0, int mode, int tid, const f32x4 (&v)[8]) {
    const int n4 = tid & 63, kq = tid >> 6;
    __syncthreads();
#pragma unroll
    for (int i = 0; i < 4; ++i) { const int n = 4 * n4 + i;
        u32x4 o; o.x = pk2(v[0][i], v[1][i]); o.y = pk2(v[2][i], v[3][i]); o.z = pk2(v[4][i], v[5][i]); o.w = pk2(v[6][i], v[7][i]);
        *(LAS u32x4*)(ts + n * 128 + ((kq ^ (n4 & 7)) << 4)) = o; }
    __syncthreads();
#pragma unroll
    for (int q = 0; q < 4; ++q) { const int task = tid + 512 * q, n = task >> 3, part = task & 7;
        const u32x4 o = *(const LAS u32x4*)(ts + n * 128 + ((part ^ ((n >> 2) & 7)) << 4));
        const int row = mode == 0 ? row0 + n : ((n >> 7) * 256 + (mode - 1) * 128 + (n & 127));
        if (K < 0) *(u32x4*)(WT + (size_t)row * (-K) + k0 + 8 * part) = o;
        else *(u32x4*)(WT + (size_t)(k0 >> 6) * K + row * 64 + 8 * part) = o; }
}
__device__ __forceinline__ void p0_small_decode(const float* const* in, unsigned char* ws, int item, const float*& W, int& N, bf16_t*& WT, int& K, int& k0, int& n0, int& row0, int& mode) {
    int r = item; mode = 0;
    if (r < 384) { const int kb = r / 24, nb = r % 24; W = in[I_WIN]; N = INC; WT = (bf16_t*)(ws + WS_WINT); K = -D; k0 = kb * 64; n0 = nb * 256;
        row0 = (n0 >= 1536 && n0 < 2048) ? n0 + 512 : ((n0 >= 2048 && n0 < 2560) ? n0 - 512 : n0); return; } r -= 384;
    if (r < 32) { W = in[I_WHY]; N = D; WT = (bf16_t*)(ws + WS_WHYT); K = -HYW; k0 = (r >> 2) * 64; n0 = (r & 3) * 256; row0 = n0; return; } r -= 32;
    if (r < 32) { W = in[I_WHG]; N = D; WT = (bf16_t*)(ws + WS_WHGT); K = -HGW; k0 = (r >> 2) * 64; n0 = (r & 3) * 256; row0 = n0; return; } r -= 32;
    if (r < 64) { W = in[I_WOUT]; N = D; WT = (bf16_t*)(ws + WS_WOUTT); K = -D; k0 = (r >> 2) * 64; n0 = (r & 3) * 256; row0 = n0; return; } r -= 64;
    if (r < 16) { W = in[I_RW]; N = NE; WT = (bf16_t*)(ws + WS_ROUT); K = -D; k0 = r * 64; n0 = 0; row0 = 0; return; } r -= 16;
    if (r < 16) { W = in[I_SG]; N = EH; WT = (bf16_t*)(ws + WS_SHGUT); K = -D; k0 = r * 64; n0 = 0; row0 = 0; mode = 1; return; } r -= 16;
    if (r < 16) { W = in[I_SU]; N = EH; WT = (bf16_t*)(ws + WS_SHGUT); K = -D; k0 = r * 64; n0 = 0; row0 = 0; mode = 2; return; } r -= 16;
    W = in[I_SD]; N = D; WT = (bf16_t*)(ws + WS_SHDT); K = -EH; k0 = (r >> 2) * 64; n0 = (r & 3) * 256; row0 = n0;
}
__device__ __forceinline__ void p0_small_transposes(Frame& F) {
    int tid = F.tid; asm volatile("" : "+v"(tid));
    for (int it = F.bx; it < 576; it += F.G) {
        const float* W; int N, K, k0, n0, row0, mode; bf16_t* WT; f32x4 v[8];
        p0_small_decode(F.p->in, F.ws, it, W, N, WT, K, k0, n0, row0, mode);
        p0_x256_load<0>(W, N, k0, n0, tid, v);
        p0_x256_store(F.lds, WT, K, k0, row0, mode, tid, v);
    }
}
__device__ __forceinline__ void p0_x256_decode(const float* const* in, unsigned char* ws, int item, const float*& W, int& N, bf16_t*& WT, int& K, int& k0, int& n0, int& mode) {
    const int e = item < NE * 32 ? (item >> 5) : ((item - NE * 32) >> 4), r = item < NE * 32 ? (item & 31) : 32 + ((item - NE * 32) & 15);
    if (r < 16) { W = in[I_EG] + (size_t)e * D * EH; N = EH; WT = (bf16_t*)(ws + WS_EGUT) + (size_t)e * 512 * D; K = 512 * 64; k0 = r * 64; n0 = 0; mode = 1; }
    else if (r < 32) { W = in[I_EU] + (size_t)e * D * EH; N = EH; WT = (bf16_t*)(ws + WS_EGUT) + (size_t)e * 512 * D; K = 512 * 64; k0 = (r - 16) * 64; n0 = 0; mode = 2; }
    else { const int q = r - 32; W = in[I_ED] + (size_t)e * EH * D; N = D; WT = (bf16_t*)(ws + WS_EDT) + (size_t)e * D * EH; K = D * 64; k0 = (q >> 2) * 64; n0 = (q & 3) * 256; mode = 0; }
}
struct XpState { f32x4 v[8]; int it, end, stride; bool live; };
__device__ __forceinline__ void xp_issue(XpState& s, const float* const* in, unsigned char* ws, int tid) {
    s.live = s.it < s.end;
    if (s.live) { const float* W; int N, K, k0, n0, mode; bf16_t* WT; p0_x256_decode(in, ws, s.it, W, N, WT, K, k0, n0, mode); p0_x256_load<1>(W, N, k0, n0, tid, s.v); }
}
__device__ __forceinline__ void xp_finish(XpState& s, const float* const* in, unsigned char* ws, int tid) {
    if (s.live) { const float* W; int N, K, k0, n0, mode; bf16_t* WT; p0_x256_decode(in, ws, s.it, W, N, WT, K, k0, n0, mode);
        const int n4 = (tid >> 6) * 8 + (tid & 7), kq = (tid >> 3) & 7;
#pragma unroll
        for (int i = 0; i < 4; ++i) { const int n = 4 * n4 + i; const int row = mode == 0 ? n0 + n : ((n >> 7) * 256 + (mode - 1) * 128 + (n & 127));
            u32x4 o; o.x = pk2(s.v[0][i], s.v[1][i]); o.y = pk2(s.v[2][i], s.v[3][i]); o.z = pk2(s.v[4][i], s.v[5][i]); o.w = pk2(s.v[6][i], s.v[7][i]);
            *(u32x4*)(WT + (size_t)(k0 >> 6) * K + row * 64 + 8 * kq) = o; }
        s.it += s.stride; s.live = false; }
}
__device__ __forceinline__ void xp_step(XpState& s, const float* const* in, unsigned char* ws, int tid) { xp_finish(s, in, ws, tid); xp_issue(s, in, ws, tid); }
constexpr int XP_BG = 28;
constexpr int XP_K0 = 0;
constexpr int NCONV = 34;
constexpr int NCONV2 = 38, XP_P13 = NCONV2 * 72;
__device__ __forceinline__ void conv_loop(const float* const* in, unsigned char* ws, int first, int stride, int end, int tid) {
    XpState a, b, c, d; a.stride = b.stride = c.stride = d.stride = 4 * stride; a.end = b.end = c.end = d.end = end; a.live = b.live = c.live = d.live = false;
    a.it = first; b.it = first + stride; c.it = first + 2 * stride; d.it = first + 3 * stride;
    xp_issue(a, in, ws, tid); xp_issue(b, in, ws, tid); xp_issue(c, in, ws, tid);
    while (a.live) {
        xp_issue(d, in, ws, tid); xp_finish(a, in, ws, tid);
        if (!b.live) break; xp_issue(a, in, ws, tid); xp_finish(b, in, ws, tid);
        if (!c.live) break; xp_issue(b, in, ws, tid); xp_finish(c, in, ws, tid);
        if (!d.live) break; xp_issue(c, in, ws, tid); xp_finish(d, in, ws, tid);
    }
}
__device__ __forceinline__ void conv_loop2(Frame& F, int first, int stride, int end) {
    const float* const* in = F.p->in; unsigned char* ws = F.ws;
    int tid = F.tid; asm volatile("" : "+v"(tid));
    const bool loader = tid < 256; const int lt = tid & 255;
    int nitem = first < end ? (end - 1 - first) / stride + 1 : 0;
    __syncthreads();
    if (loader) {
        const int n4 = lt & 63, kq = lt >> 6;
        f32x4 va[16], vb[16];
#define CL_LOAD(dst, item) do { const float* W; int N, K, k0, n0, mode; bf16_t* WT; p0_x256_decode(in, ws, (item), W, N, WT, K, k0, n0, mode); \
            const float* src = W + (size_t)(k0 + 16 * kq) * N + n0 + 4 * n4; _Pragma("unroll") for (int r = 0; r < 16; ++r) dst[r] = __builtin_nontemporal_load((const f32x4*)(src + (size_t)r * N)); } while (0)
#define CL_PUT(src, buf) do { LAS unsigned char* ts = F.lds + (buf) * 32768; _Pragma("unroll") for (int i = 0; i < 4; ++i) { const int n = 4 * n4 + i; _Pragma("unroll") for (int h = 0; h < 2; ++h) { \
            u32x4 o; o.x = pk2(src[8 * h][i], src[8 * h + 1][i]); o.y = pk2(src[8 * h + 2][i], src[8 * h + 3][i]); o.z = pk2(src[8 * h + 4][i], src[8 * h + 5][i]); o.w = pk2(src[8 * h + 6][i], src[8 * h + 7][i]); \
            *(LAS u32x4*)(ts + n * 128 + (((2 * kq + h) ^ (n4 & 7)) << 4)) = o; } } } while (0)
        if (nitem > 0) CL_LOAD(va, first);
        if (nitem > 1) CL_LOAD(vb, first + stride);
        for (int i = 0; i < nitem; i += 2) {
            CL_PUT(va, 0); __syncthreads();
            if (i + 2 < nitem) CL_LOAD(va, first + (i + 2) * stride);
            if (i + 1 >= nitem) break;
            CL_PUT(vb, 1); __syncthreads();
            if (i + 3 < nitem) CL_LOAD(vb, first + (i + 3) * stride);
        }
#undef CL_LOAD
#undef CL_PUT
    } else {
        for (int i = 0; i < nitem; ++i) {
            __syncthreads();
            const float* W; int N, K, k0, n0, mode; bf16_t* WT; p0_x256_decode(in, ws, first + i * stride, W, N, WT, K, k0, n0, mode);
            const LAS unsigned char* ts = F.lds + (i & 1) * 32768;
#pragma unroll
            for (int q = 0; q < 8; ++q) { const int task = lt + 256 * q, n = task >> 3, part = task & 7;
                const u32x4 o = *(const LAS u32x4*)(ts + n * 128 + ((part ^ ((n >> 2) & 7)) << 4));
                const int row = mode == 0 ? n0 + n : ((n >> 7) * 256 + (mode - 1) * 128 + (n & 127));
                *(u32x4*)(WT + (size_t)(k0 >> 6) * K + row * 64 + 8 * part) = o; }
        }
    }
    __syncthreads();
}

__device__ __forceinline__ void p0_expert_transposes(Frame& F) {
    int tid = F.tid; asm volatile("" : "+v"(tid));
    constexpr int NIT = NE * 48;
    int it = F.bx + XP_BG * F.G; if (it >= NIT) return;
    const int p0end = (F.G == 256) ? 256 * (XP_BG + XP_K0) : NIT;
    if (it >= p0end) return;
    const float* W; int N, K, k0, n0, mode; bf16_t* WT;
    const float* W2; int N2, K2, k2, n2, mode2; bf16_t* WT2;
    f32x4 va[8], vb[8];
    p0_x256_decode(F.p->in, F.ws, it, W, N, WT, K, k0, n0, mode);
    p0_x256_load<0>(W, N, k0, n0, tid, va);
    for (;;) {
        __builtin_amdgcn_s_waitcnt(0);
        int nx = it + F.G; bool has = nx < p0end;
        if (has) { p0_x256_decode(F.p->in, F.ws, nx, W2, N2, WT2, K2, k2, n2, mode2); p0_x256_load<0>(W2, N2, k2, n2, tid, vb); }
        p0_x256_store(F.lds, WT, K, k0, n0, mode, tid, va);
        if (!has) break;
        it = nx;
        __builtin_amdgcn_s_waitcnt(0);
        nx = it + F.G; has = nx < p0end;
        if (has) { p0_x256_decode(F.p->in, F.ws, nx, W, N, WT, K, k0, n0, mode); p0_x256_load<0>(W, N, k0, n0, tid, va); }
        p0_x256_store(F.lds, WT2, K2, k2, n2, mode2, tid, vb);
        if (!has) break;
        it = nx;
    }
}

constexpr int ADA_KC = 8;
__device__ __forceinline__ void p0_ada_item(Frame& F, int item) {
    const int kc = item / 12, cb = item % 12, c4 = F.tid & 127, ks = F.tid >> 7;
    const float* in_c = F.p->in[I_C]; const float* in_cc = F.p->in[I_CCTX]; const float* w = F.p->in[I_ADAW];
    LAS float* sv = (LAS float*)F.lds;
    LAS float* pr = sv + 384;
    __syncthreads();
    for (int i = F.tid; i < 384; i += 512) { const int wh = i >> 7, k = kc * 128 + (i & 127); sv[i] = siluf_(wh == 0 ? in_c[k] : (wh == 1 ? in_c[D + k] : in_cc[k])); }
    __syncthreads();
    f32x4 a0 = (f32x4){0.f, 0.f, 0.f, 0.f}, a1 = a0, a2 = a0;
    const float* wp = w + (size_t)(kc * 128 + ks * 32) * 6144 + cb * 512 + 4 * c4;
#pragma unroll 16
    for (int k = 0; k < 32; ++k) { const f32x4 wv = *(const f32x4*)(wp + (size_t)k * 6144); const int kk = ks * 32 + k; a0 += wv * sv[kk]; a1 += wv * sv[128 + kk]; a2 += wv * sv[256 + kk]; }
    *(LAS f32x4*)(pr + (ks * 3 + 0) * 512 + 4 * c4) = a0; *(LAS f32x4*)(pr + (ks * 3 + 1) * 512 + 4 * c4) = a1; *(LAS f32x4*)(pr + (ks * 3 + 2) * 512 + 4 * c4) = a2;
    __syncthreads();
    for (int i = F.tid; i < 3 * 512; i += 512) { const int wh = i >> 9, col = i & 511;
        WSP(float, WS_ADAP)[(size_t)(kc * 3 + wh) * 6144 + cb * 512 + col] = (pr[(0 * 3 + wh) * 512 + col] + pr[(1 * 3 + wh) * 512 + col]) + (pr[(2 * 3 + wh) * 512 + col] + pr[(3 * 3 + wh) * 512 + col]); }
}

__device__ __forceinline__ void p0_filter_item(Frame& F, int item, XpState& xp) {
    LAS float* zb = (LAS float*)F.lds;
    LAS float* ab1 = zb + 32 * 36;
    LAS float* ab2 = ab1 + 32 * 64;
    LAS float* w1s = ab2 + 32 * 64;
    LAS float* w2s = w1s + 33 * 64;
    LAS float* w3s = w2s + 64 * 64;
    const float* const* in = F.p->in; const int t0 = item * 32; int tid = F.tid; asm volatile("" : "+v"(tid));
    __syncthreads();
    for (int idx = tid; idx < 33 * 64; idx += 512) w1s[idx] = in[I_FW1][idx];
    for (int idx = tid; idx < 64 * 64; idx += 512) { w2s[idx] = in[I_FW2][idx]; w3s[idx] = in[I_FW3][idx]; }
    for (int idx = tid; idx < 32 * 33; idx += 512) { const int t = idx / 33, e = idx % 33; const float tf = (float)(t0 + t); float v;
        if (e == 0) v = tf / (float)(SEQ - 1);
        else { const int k = (e - 1) & 15; const float band = 1e-4f + (float)k * ((15.0f - 1e-4f) / 15.0f); float sn, cs; sincospif(2.0f * tf * band / (float)SEQ, &sn, &cs); v = (e <= 16) ? cs : -sn; }
        zb[t * 36 + e] = v; }
    __syncthreads();
    {
        const int t = tid >> 4, jj = tid & 15;
#pragma unroll 1
        for (int q = 0; q < 4; ++q) { const int j = jj + 16 * q; float s = in[I_FB1][j];
#pragma unroll
            for (int e = 0; e < 33; ++e) s += zb[t * 36 + e] * w1s[e * 64 + j];
            ab1[t * 64 + j] = sinf(in[I_FFREQ][j] * s); }
    }
    __syncthreads();
    { const int t = tid >> 4, jj = tid & 15;
#pragma unroll 1
        for (int q = 0; q < 4; ++q) { const int j = jj + 16 * q; float s = in[I_FB2][j];
#pragma unroll 16
            for (int e = 0; e < 64; ++e) s += ab1[t * 64 + e] * w2s[e * 64 + j];
            ab2[t * 64 + j] = sinf(in[I_FFREQ][j] * s); }
    }
    __syncthreads();
    { const int t = tid >> 4, jj = tid & 15;
#pragma unroll 1
        for (int q = 0; q < 4; ++q) { const int j = jj + 16 * q; float s = in[I_FB3][j];
#pragma unroll 16
            for (int e = 0; e < 64; ++e) s += ab2[t * 64 + e] * w3s[e * 64 + j];
            ab1[t * 64 + j] = sinf(in[I_FFREQ][j] * s); }
    }
    __syncthreads();
    { bf16_t* a3 = WSP(bf16_t, WS_A3) + (size_t)t0 * 64;
        const int t = tid >> 4, j4 = (tid & 15) * 4; const f32x4 v = *(const LAS f32x4*)(ab1 + t * 64 + j4);
        *(u32x2*)(a3 + t * 64 + j4) = (u32x2){pk2(v[0], v[1]), pk2(v[2], v[3])}; }
    (void)xp;
}
__device__ __forceinline__ void filter_out_item(Frame& F, int item) {
    const int t0 = item * 32, lane = F.lane, lr = lane & 15, lq = lane >> 4, w = F.wave;
    const bf16_t* a3 = WSP(bf16_t, WS_A3); const bf16_t* w4t = WSP(bf16_t, WS_W4T); bf16_t* hf = WSP(bf16_t, WS_HF);
    bf16x8 af[2][2];
#pragma unroll
    for (int tt = 0; tt < 2; ++tt)
#pragma unroll
        for (int ks = 0; ks < 2; ++ks) af[tt][ks] = *(const bf16x8*)(a3 + (size_t)(t0 + 16 * tt + lr) * 64 + 32 * ks + 8 * lq);
    const float MIND = -3.0701134573253945f, MAXD = -15.350567286626973f;
#pragma unroll 4
    for (int i = 0; i < 16; ++i) { const int nt = w * 16 + i, n = 16 * nt + lr;
        const bf16x8 b0 = *(const bf16x8*)(w4t + (size_t)n * 64 + 8 * lq), b1 = *(const bf16x8*)(w4t + (size_t)n * 64 + 32 + 8 * lq);
        const float delta = fabsf(MIND + (MAXD - MIND) * ((float)(n & 511) / 511.0f));
#pragma unroll
        for (int tt = 0; tt < 2; ++tt) { f32x4 acc = (f32x4){0.f, 0.f, 0.f, 0.f};
            acc = MFMA16(af[tt][0], b0, acc); acc = MFMA16(af[tt][1], b1, acc);
            const int tb = t0 + 16 * tt + 4 * lq; float dc[4];
#pragma unroll
            for (int k = 0; k < 4; ++k) dc[k] = __expf(-((float)(tb + k) / (float)(SEQ - 1)) * delta);
            *(u32x2*)(hf + (size_t)n * SEQ + tb) = (u32x2){pk2(acc[0] * dc[0], acc[1] * dc[1]), pk2(acc[2] * dc[2], acc[3] * dc[3])}; } }
}

__device__ __forceinline__ void p0_tables(Frame& F, int item) {
    if (item < 6) {
        const int idx = item * 16384 + F.tid * 32;
        for (int k = 0; k < 32; ++k) { const int id = idx + k; if (id >= 192 * 512) break;
            const int row = id >> 9, col = id & 511, i = col & 255; const float omega = 1.0f / powf(10000.0f, (float)i / 256.0f);
            const float pos = (float)(row < 128 ? row : row - 128); const float ang = pos * omega;
            const float v = (col < 256) ? sinf(ang) : cosf(ang);
            if (row < 128) WSP(float, WS_POSR)[row * 512 + col] = v; else WSP(float, WS_POSC)[(row - 128) * 512 + col] = v; }
    } else {
        for (int id = F.tid; id < 1024; id += 512) { const float l0 = F.p->in[I_LBL][id], l1 = F.p->in[I_LBL][1024 + id];
            WSP(float, WS_LBS)[id] = 1.0f / (1.0f + expf(l1 - l0)); }
    }
}

__device__ __forceinline__ void phase0(Frame& F, unsigned long long* pa = nullptr, int pmode = 0) {
    const unsigned long long q0_ = pa ? __builtin_amdgcn_s_memrealtime() : 0ull;
    XpState xp; xp.stride = F.G; xp.it = F.bx + XP_BG * F.G; xp.end = (F.G == 256) ? 256 * (XP_BG + XP_K0) : 0; xp.live = false;
    for (int it = F.bx; it < 359; it += F.G) {
        asm volatile("" : "+v"(F.tid));
        if (it < 96) p0_ada_item(F, it);
        else if (it < 352) p0_filter_item(F, it - 96, xp);
        else p0_tables(F, it - 352);
    }
    __syncthreads();
    p0_transposes(F);
    if (pa && pmode == 0) { asm volatile("s_waitcnt vmcnt(0)" ::: "memory"); *pa += __builtin_amdgcn_s_memrealtime() - q0_; }
    const unsigned long long q1_ = pa ? __builtin_amdgcn_s_memrealtime() : 0ull;
    { int tid = F.tid; xp_finish(xp, F.p->in, F.ws, tid); while (xp.it < xp.end) { xp_issue(xp, F.p->in, F.ws, tid); xp_finish(xp, F.p->in, F.ws, tid); } }
    __syncthreads();
    if (F.G != 256) p0_expert_transposes(F);
    if (pa && pmode == 1) { asm volatile("s_waitcnt vmcnt(0)" ::: "memory"); *pa += __builtin_amdgcn_s_memrealtime() - q1_; }
}

__device__ __forceinline__ void phase1(Frame& F) {
    const float* adap = WSP(float, WS_ADAP); const float* adab = F.p->in[I_ADAB];
    { const int gid = F.bx * 512 + F.tid; if (gid < 3 * 6144) { const int wh = gid / 6144, col = gid % 6144; float s = adab[col];
#pragma unroll
        for (int kc = 0; kc < ADA_KC; ++kc) s += adap[(size_t)(kc * 3 + wh) * 6144 + col]; WSP(float, WS_ADA)[gid] = s; } }
    LAS float* md = (LAS float*)F.lds;
    __syncthreads();
    for (int id = F.tid; id < 3 * 2048; id += 512) { const int wh = id >> 11, col = id & 2047; float s = adab[col];
#pragma unroll
        for (int kc = 0; kc < ADA_KC; ++kc) s += adap[(size_t)(kc * 3 + wh) * 6144 + col]; md[id] = s; }
    __syncthreads();
    const float* x = F.p->in[I_X]; const float* ctx = F.p->in[I_CTX]; const float* g1 = F.p->in[I_N1G];
    const float* posr = WSP(float, WS_POSR); const float* posc = WSP(float, WS_POSC); bf16_t* a1 = WSP(bf16_t, WS_A1);
    const int lane = F.lane;
#define P1_GG() f32x4 ggv[4]; _Pragma("unroll") for (int j = 0; j < 4; ++j) ggv[j] = *(const f32x4*)(g1 + 256 * j + 4 * lane)
#define P1_ROWS4(r0) do { f32x4 v[4][4]; const int wh = (r0) < T ? ((r0) >> 13) : 2; \
        _Pragma("unroll") for (int q = 0; q < 4; ++q) { const int r = (r0) + q; \
            if ((r0) < T) { const int n = r & (SEQ - 1); const f32x4* xr = (const f32x4*)(x + (size_t)r * D) + lane; \
                _Pragma("unroll") for (int j = 0; j < 4; ++j) { const int c = 256 * j + 4 * lane; const f32x4 pe = (c < 512) ? *(const f32x4*)(posr + (n >> 6) * 512 + c) : *(const f32x4*)(posc + (n & 63) * 512 + c - 512); v[q][j] = xr[64 * j] + pe; } \
            } else { const f32x4* xr = (const f32x4*)(ctx + (size_t)(r - T) * D) + lane; \
                _Pragma("unroll") for (int j = 0; j < 4; ++j) v[q][j] = xr[64 * j]; } } \
        _Pragma("unroll") for (int q = 0; q < 4; ++q) { float ss = 0.f; \
            _Pragma("unroll") for (int j = 0; j < 4; ++j) ss += (v[q][j][0] * v[q][j][0] + v[q][j][1] * v[q][j][1]) + (v[q][j][2] * v[q][j][2] + v[q][j][3] * v[q][j][3]); \
            const float rs = rsqrtf(wave_sum(ss) * (1.0f / D) + EPS); \
            u32x2* o8 = (u32x2*)(a1 + (size_t)((r0) + q) * D) + lane; \
            _Pragma("unroll") for (int j = 0; j < 4; ++j) { const int c = 256 * j + 4 * lane; const f32x4 gg = ggv[j]; \
                const f32x4 sh = *(const LAS f32x4*)(md + wh * 2048 + c), sc = *(const LAS f32x4*)(md + wh * 2048 + 1024 + c); \
                const f32x4 y = v[q][j] * rs * gg * (sc + 1.0f) + sh; \
                u32x2 w; w.x = pk2(y[0], y[1]); w.y = pk2(y[2], y[3]); o8[64 * j] = w; } } } while (0)
    { const int gw = F.bx * 8 + F.wave, NGW = F.G * 8; P1_GG();
        for (int r0 = gw * 4; r0 < MA; r0 += NGW * 4) P1_ROWS4(r0); }
    for (int it = F.bx; it < SEQ / 32; it += F.G) filter_out_item(F, it);
#undef P1_ROWS4
#undef P1_GG
}

__device__ __forceinline__ void phase_h2(Frame& F) {
    const float* x1 = F.p->out; const float* g2 = F.p->in[I_N2G]; const float* ada = WSP(float, WS_ADA); bf16_t* h2 = WSP(bf16_t, WS_H2);
    const int gw = F.bx * 8 + F.wave, NGW = F.G * 8, lane = F.lane;
    f32x4 ggv[4];
#pragma unroll
    for (int j = 0; j < 4; ++j) ggv[j] = *(const f32x4*)(g2 + 256 * j + 4 * lane);
    const bool al = (F.G == 256); const int vw = ((F.bx & 7) * 32 + (F.bx >> 3)) * 8 + F.wave;
    for (int r0 = al ? vw * 8 : gw * 4, it_ = 0; al ? it_ < 2 : r0 < T; r0 += al ? 4 : NGW * 4, ++it_) { const int b = r0 >> 13;
        f32x4 v[4][4], shv[4], scv[4];
#pragma unroll
        for (int j = 0; j < 4; ++j) { const int c = 256 * j + 4 * lane; shv[j] = *(const f32x4*)(ada + b * 6144 + 3 * D + c); scv[j] = *(const f32x4*)(ada + b * 6144 + 4 * D + c); }
#pragma unroll
        for (int q = 0; q < 4; ++q) { const f32x4* xr = (const f32x4*)(x1 + (size_t)(r0 + q) * D) + lane;
#pragma unroll
            for (int j = 0; j < 4; ++j) v[q][j] = xr[64 * j]; }
#pragma unroll
        for (int q = 0; q < 4; ++q) { float ss = 0.f;
#pragma unroll
            for (int j = 0; j < 4; ++j) ss += (v[q][j][0] * v[q][j][0] + v[q][j][1] * v[q][j][1]) + (v[q][j][2] * v[q][j][2] + v[q][j][3] * v[q][j][3]);
            const float rs = rsqrtf(wave_sum(ss) * (1.0f / D) + EPS);
            u32x2* o8 = (u32x2*)(h2 + (size_t)(r0 + q) * D) + lane;
#pragma unroll
            for (int j = 0; j < 4; ++j) { const f32x4 gg = ggv[j], sh = shv[j], sc = scv[j];
                const f32x4 y = v[q][j] * rs * gg * (sc + 1.0f) + sh;
                u32x2 w; w.x = pk2(y[0], y[1]); w.y = pk2(y[2], y[3]); o8[64 * j] = w; } }
    }
}
constexpr int FPAD = 17920;
__device__ __forceinline__ int fphys(int i) { return i + (i >> 4) + ((i >> 9) << 4); }
__device__ constexpr float TWC[16] = {1.0f, 0.98078528040323044913f, 0.92387953251128675613f, 0.83146961230254523708f, 0.70710678118654752440f, 0.55557023301960222474f, 0.38268343236508977173f, 0.19509032201612826785f,
                                      0.0f, -0.19509032201612826785f, -0.38268343236508977173f, -0.55557023301960222474f, -0.70710678118654752440f, -0.83146961230254523708f, -0.92387953251128675613f, -0.98078528040323044913f};
__device__ constexpr float TWS[16] = {0.0f, 0.19509032201612826785f, 0.38268343236508977173f, 0.55557023301960222474f, 0.70710678118654752440f, 0.83146961230254523708f, 0.92387953251128675613f, 0.98078528040323044913f,
                                      1.0f, 0.98078528040323044913f, 0.92387953251128675613f, 0.83146961230254523708f, 0.70710678118654752440f, 0.55557023301960222474f, 0.38268343236508977173f, 0.19509032201612826785f};
__host__ __device__ constexpr int brev_c(int x, int bits) { int r = 0; for (int i = 0; i < bits; ++i) r = (r << 1) | ((x >> i) & 1); return r; }

typedef f32x2 cpx;
__device__ __forceinline__ cpx cmul(cpx a, cpx w) { return (cpx){a.x, a.x} * w + (cpx){a.y, a.y} * (cpx){-w.y, w.x}; }
template <int S0, int R, bool INV, bool ZHI = false, bool OLO = false>
__device__ __forceinline__ void fft_pass(LAS cpx* X, int tid) {
    constexpr int LOW = 14 - S0 - R, NR = 1 << R, NTASK = (1 << (14 - R)) / 512;
    asm volatile("" : "+v"(tid));
#pragma unroll 1
    for (int task = 0; task < NTASK; ++task) {
        const int g = tid + 512 * task;
        const int blo = g & ((1 << LOW) - 1), bhi = g >> LOW;
        const int base = (bhi << (LOW + R)) | blo;
        cpx v[NR];
#pragma unroll
        for (int j = 0; j < NR; ++j) { if (ZHI && j >= NR / 2) v[j] = (cpx){0.f, 0.f}; else v[j] = X[fphys(base | (j << LOW))]; }
        cpx w0 = (cpx){1.f, 0.f};
        if (LOW > 0) { float s, c; sincospif(-(float)blo * (1.0f / (float)(1 << (13 - S0))), &s, &c); w0 = (cpx){c, INV ? -s : s}; }
        if (INV && LOW > 0) {
            cpx cw = w0;
#pragma unroll
            for (int m = 1; m < NR; ++m) { const int j = brev_c(m, R); v[j] = cmul(v[j], cw); if (m + 1 < NR) cw = cmul(cw, w0); }
        }
        if (!INV) {
#pragma unroll
            for (int q = 0; q < R; ++q) { const int hj = 1 << (R - 1 - q);
#pragma unroll
                for (int j = 0; j < NR; ++j) { if (j & hj) continue; const int k32 = (j & (hj - 1)) << (5 - R + q);
                    cpx d;
                    if (ZHI && q == 0) d = v[j];
                    else { const cpx a = v[j], bb = v[j + hj]; v[j] = a + bb; d = a - bb; }
                    if (k32 == 0) v[j + hj] = d;
                    else if (k32 == 8) v[j + hj] = (cpx){d.y, -d.x};
                    else v[j + hj] = cmul(d, (cpx){TWC[k32], -TWS[k32]}); } }
        } else {
#pragma unroll
            for (int q = R - 1; q >= 0; --q) { const int hj = 1 << (R - 1 - q);
#pragma unroll
                for (int j = 0; j < NR; ++j) { if (j & hj) continue; const int k32 = (j & (hj - 1)) << (5 - R + q);
                    const cpx p = v[j], bb = v[j + hj]; cpx t;
                    if (k32 == 0) t = bb;
                    else if (k32 == 8) t = (cpx){-bb.y, bb.x};
                    else t = cmul(bb, (cpx){TWC[k32], TWS[k32]});
                    v[j] = p + t; if (!(OLO && q == 0)) v[j + hj] = p - t; } }
        }
        if (!INV && LOW > 0) {
            cpx cw = w0;
#pragma unroll
            for (int m = 1; m < NR; ++m) { const int j = brev_c(m, R); v[j] = cmul(v[j], cw); if (m + 1 < NR) cw = cmul(cw, w0); }
        }
#pragma unroll
        for (int j = 0; j < NR; ++j) { if (OLO && j >= NR / 2) continue; X[fphys(base | (j << LOW))] = v[j]; }
    }
}
#define XP_HOOK() xp_step(xp, F.p->in, F.ws, tid)
template <bool ZHI> __device__ __forceinline__ void fft_fwd(Frame& F, XpState& xp, LAS cpx* X, int tid) {
    fft_pass<0, 5, false, ZHI>(X, tid); __syncthreads(); XP_HOOK(); fft_pass<5, 5, false>(X, tid); __syncthreads(); XP_HOOK(); fft_pass<10, 4, false>(X, tid); __syncthreads(); XP_HOOK();
}
__device__ __forceinline__ void fft_inv(Frame& F, XpState& xp, LAS cpx* X, int tid) {
    fft_pass<10, 4, true>(X, tid); __syncthreads(); XP_HOOK(); fft_pass<5, 5, true>(X, tid); __syncthreads(); XP_HOOK(); fft_pass<0, 5, true, false, true>(X, tid); __syncthreads(); XP_HOOK();
}
struct SC8 { u32x4 c; unsigned l, r; };
__device__ __forceinline__ SC8 sconv8_load(const bf16_t* p, int n) {
    SC8 s; s.c = *(const u32x4*)(p + n); s.l = n > 0 ? (unsigned)p[n - 1] : 0u; s.r = n + 8 < SEQ ? (unsigned)p[n + 8] : 0u; return s;
}
__device__ __forceinline__ void sconv8_eval(const SC8& s, float w0, float w1, float w2, float bias, float (&o)[8]) {
    float v[10]; v[0] = bf2f(s.l); v[1] = bflo(s.c.x); v[2] = bfhi(s.c.x); v[3] = bflo(s.c.y); v[4] = bfhi(s.c.y); v[5] = bflo(s.c.z); v[6] = bfhi(s.c.z); v[7] = bflo(s.c.w); v[8] = bfhi(s.c.w); v[9] = bf2f(s.r);
#pragma unroll
    for (int i = 0; i < 8; ++i) o[i] = w0 * v[i] + w1 * v[i + 1] + w2 * v[i + 2] + bias;
}
__device__ __forceinline__ void hyena_item(Frame& F, int c, XpState& xp) {
    LAS cpx* X = (LAS cpx*)F.lds; LAS float* red = (LAS float*)(F.lds + (size_t)FPAD * 8);
    int tid = F.tid; asm volatile("" : "+v"(tid));
    const bf16_t* hf = WSP(bf16_t, WS_HF);
    __syncthreads();
    float s0 = 0.f, s1 = 0.f;
    {
        f32x4 fa[4], fb[4], ba[4], bb[4];
#pragma unroll
        for (int it = 0; it < 4; ++it) { const int j = 4 * (tid + 512 * it);
            const u32x2 w0 = *(const u32x2*)(hf + (size_t)c * SEQ + j), w1 = *(const u32x2*)(hf + (size_t)(1024 + c) * SEQ + j), w2 = *(const u32x2*)(hf + (size_t)(512 + c) * SEQ + j), w3 = *(const u32x2*)(hf + (size_t)(1536 + c) * SEQ + j);
            fa[it] = (f32x4){bflo(w0.x), bfhi(w0.x), bflo(w0.y), bfhi(w0.y)}; fb[it] = (f32x4){bflo(w1.x), bfhi(w1.x), bflo(w1.y), bfhi(w1.y)};
            ba[it] = (f32x4){bflo(w2.x), bfhi(w2.x), bflo(w2.y), bfhi(w2.y)}; bb[it] = (f32x4){bflo(w3.x), bfhi(w3.x), bflo(w3.y), bfhi(w3.y)}; }
#pragma unroll
        for (int it = 0; it < 4; ++it) { const int j = 4 * (tid + 512 * it);
#pragma unroll
            for (int i = 0; i < 4; ++i) { X[fphys(j + i)] = (cpx){fa[it][i], fb[it][i]}; s0 += fabsf(fa[it][i]); s1 += fabsf(fb[it][i]);
                const int m = j + i; if (m > 0) { X[fphys(FFTN - m)] = (cpx){ba[it][i], bb[it][i]}; s0 += fabsf(ba[it][i]); s1 += fabsf(bb[it][i]); } } }
        if (tid == 0) X[fphys(SEQ)] = (cpx){0.f, 0.f};
    }
    s0 = wave_sum(s0); s1 = wave_sum(s1);
    if (F.lane == 0) { red[F.wave] = s0; red[8 + F.wave] = s1; }
    __syncthreads();
    float S0 = 0.f, S1 = 0.f;
#pragma unroll
    for (int w = 0; w < 8; ++w) { S0 += red[w]; S1 += red[8 + w]; }
    fft_fwd<false>(F, xp, X, tid);
    unsigned* ks = WSP(unsigned, WS_KS) + (size_t)F.bx * 2 * FFTN;
    { const float i0 = 1.0f / S0, i1 = 1.0f / S1, sk0 = F.p->in[I_HSKIP][c], sk1 = F.p->in[I_HSKIP][512 + c];
#pragma unroll 8
        for (int it = 0; it < 32; ++it) { const int p = tid + 512 * it; const int k = (int)(__brev((unsigned)p) >> 18); const int pp = (int)(__brev((unsigned)((FFTN - k) & (FFTN - 1))) >> 18);
            const cpx A = X[fphys(p)], B = X[fphys(pp)];
            const float k1r = 0.5f * (A.x + B.x), k1i = 0.5f * (A.y - B.y), k2r = 0.5f * (A.y + B.y), k2i = -0.5f * (A.x - B.x);
            ks[p] = pkh2(k1r * i0 + sk0, k1i * i0); ks[FFTN + p] = pkh2(k2r * i1 + sk1, k2i * i1); } }
    __syncthreads();
    const bf16_t* ph = WSP(bf16_t, WS_PHYT); const float* cw = F.p->in[I_HCW]; const float* cb = F.p->in[I_HCB];
    { const float w0 = cw[c], w1 = cw[HYP + c], w2 = cw[2 * HYP + c], bs = cb[c];
        SC8 sa[2], sb[2];
#pragma unroll
        for (int it = 0; it < 2; ++it) { const int n = 8 * (tid + 512 * it); sa[it] = sconv8_load(ph + (size_t)c * SEQ, n); sb[it] = sconv8_load(ph + (size_t)(HYP + c) * SEQ, n); }
#pragma unroll
        for (int it = 0; it < 2; ++it) { const int n = 8 * (tid + 512 * it); float a[8], b[8]; sconv8_eval(sa[it], w0, w1, w2, bs, a); sconv8_eval(sb[it], w0, w1, w2, bs, b);
#pragma unroll
            for (int i = 0; i < 8; ++i) X[fphys(n + i)] = (cpx){a[i], b[i]}; } }
    __syncthreads();
    fft_fwd<true>(F, xp, X, tid);
    { unsigned kk[32]; const float invN = 1.0f / (float)FFTN;
#pragma unroll
        for (int it = 0; it < 32; ++it) kk[it] = ks[tid + 512 * it];
#pragma unroll
        for (int it = 0; it < 32; ++it) { const int q = fphys(tid + 512 * it); X[q] = cmul(X[q], (cpx){h2f((unsigned short)(kk[it] & 0xffffu)) * invN, h2f((unsigned short)(kk[it] >> 16)) * invN}); } }
    __syncthreads();
    fft_inv(F, xp, X, tid);
    { const int col = HYW + c; const float w0 = cw[col], w1 = cw[HYP + col], w2 = cw[2 * HYP + col], bs = cb[col];
        SC8 sa[2], sb[2];
#pragma unroll
        for (int it = 0; it < 2; ++it) { const int n = 8 * (tid + 512 * it); sa[it] = sconv8_load(ph + (size_t)col * SEQ, n); sb[it] = sconv8_load(ph + (size_t)(HYP + col) * SEQ, n); }
#pragma unroll
        for (int it = 0; it < 2; ++it) { const int n = 8 * (tid + 512 * it); float a[8], b[8]; sconv8_eval(sa[it], w0, w1, w2, bs, a); sconv8_eval(sb[it], w0, w1, w2, bs, b);
#pragma unroll
            for (int i = 0; i < 8; ++i) { const int q = fphys(n + i); X[q] = X[q] * (cpx){a[i], b[i]}; } } }
    __syncthreads();
    fft_fwd<true>(F, xp, X, tid);
    { unsigned kk[32]; const float invN = 1.0f / (float)FFTN;
#pragma unroll
        for (int it = 0; it < 32; ++it) kk[it] = ks[FFTN + tid + 512 * it];
#pragma unroll
        for (int it = 0; it < 32; ++it) { const int q = fphys(tid + 512 * it); X[q] = cmul(X[q], (cpx){h2f((unsigned short)(kk[it] & 0xffffu)) * invN, h2f((unsigned short)(kk[it] >> 16)) * invN}); } }
    __syncthreads();
    fft_inv(F, xp, X, tid);
    { const int col = 2 * HYW + c; const float w0 = cw[col], w1 = cw[HYP + col], w2 = cw[2 * HYP + col], bs = cb[col];
        bf16_t* yt = WSP(bf16_t, WS_YHYT);
        SC8 sa[2], sb[2]; u32x4 oa[2], ob[2];
#pragma unroll
        for (int it = 0; it < 2; ++it) { const int n = 8 * (tid + 512 * it); sa[it] = sconv8_load(ph + (size_t)col * SEQ, n); sb[it] = sconv8_load(ph + (size_t)(HYP + col) * SEQ, n); }
#pragma unroll
        for (int it = 0; it < 2; ++it) { const int n = 8 * (tid + 512 * it); float a[8], b[8]; sconv8_eval(sa[it], w0, w1, w2, bs, a); sconv8_eval(sb[it], w0, w1, w2, bs, b);
            cpx y[8];
#pragma unroll
            for (int i = 0; i < 8; ++i) y[i] = X[fphys(n + i)];
            oa[it] = (u32x4){pk2(y[0].x * a[0], y[1].x * a[1]), pk2(y[2].x * a[2], y[3].x * a[3]), pk2(y[4].x * a[4], y[5].x * a[5]), pk2(y[6].x * a[6], y[7].x * a[7])};
            ob[it] = (u32x4){pk2(y[0].y * b[0], y[1].y * b[1]), pk2(y[2].y * b[2], y[3].y * b[3]), pk2(y[4].y * b[4], y[5].y * b[5]), pk2(y[6].y * b[6], y[7].y * b[7])}; }
#pragma unroll
        for (int it = 0; it < 2; ++it) { const int n = 8 * (tid + 512 * it);
            *(u32x4*)(yt + (size_t)c * SEQ + n) = oa[it]; *(u32x4*)(yt + (size_t)(HYW + c) * SEQ + n) = ob[it]; } }
}

__device__ __forceinline__ bf16x8 lds_frag(const LAS bf16_t* base, int row, int stride, int k) { return *(const LAS bf16x8*)(base + row * stride + k); }

__device__ __forceinline__ void hg_delta_item(Frame& F, int item) {
    const int chain = item / NCH_EXT, j = item % NCH_EXT, dir = chain & 1, h = (chain >> 1) & 3, b = chain >> 3;
    const int cj = dir == 0 ? j : (j < 4 ? 3 - j : 135 - j), n0 = cj * 64;
    LAS float* segtot = (LAS float*)F.lds;
    LAS bf16_t* Kt = (LAS bf16_t*)(F.lds + 4096);
    LAS bf16_t* VTs = (LAS bf16_t*)(F.lds + 4096 + 18432);
    const int tid = F.tid, d = 2 * (tid & 63), seg = tid >> 6, lane = F.lane;
    const float* lfp = (dir ? WSP(float, WS_LB) : WSP(float, WS_LF)) + ((size_t)(b * NEXT + n0) * HGW + h * 128 + d);
    f32x2 lf[8], tot = (f32x2){0.f, 0.f};
#pragma unroll
    for (int i = 0; i < 8; ++i) { lf[i] = *(const f32x2*)(lfp + (size_t)(8 * seg + i) * HGW); tot += lf[i]; }
    __syncthreads();
    *(LAS f32x2*)(segtot + seg * 128 + d) = tot;
    { const bf16_t* vt = WSP(bf16_t, WS_VT) + ((size_t)(b * HGW + h * 128) * NEXT + n0);
        u32x4 tv[2];
#pragma unroll
        for (int q = 0; q < 2; ++q) { const int piece = tid + 512 * q, e = piece >> 3, part = piece & 7; tv[q] = *(const u32x4*)(vt + (size_t)e * NEXT + part * 8); }
#pragma unroll
        for (int q = 0; q < 2; ++q) { const int piece = tid + 512 * q, e = piece >> 3, part = piece & 7; *(LAS u32x4*)(VTs + e * 72 + part * 8) = tv[q]; } }
    __syncthreads();
    f32x2 later = (f32x2){0.f, 0.f}, total = later;
#pragma unroll
    for (int s = 0; s < 8; ++s) { const f32x2 v = *(const LAS f32x2*)(segtot + s * 128 + d); total += v; if (dir == 0 ? (s > seg) : (s < seg)) later += v; }
    f32x2 E[8];
    if (dir == 0) { f32x2 run = later;
#pragma unroll
        for (int i = 7; i >= 0; --i) { E[i] = run; run += lf[i]; } }
    else { f32x2 run = later;
#pragma unroll
        for (int i = 0; i < 8; ++i) { E[i] = run; run += lf[i]; } }
    float k0[8], k1[8];
#pragma unroll
    for (int i = 0; i < 8; ++i) { k0[i] = (1.0f - __expf(lf[i].x)) * __expf(E[i].x); k1[i] = (1.0f - __expf(lf[i].y)) * __expf(E[i].y); }
    *(LAS u32x4*)(Kt + d * 72 + 8 * seg) = (u32x4){pk2(k0[0], k0[1]), pk2(k0[2], k0[3]), pk2(k0[4], k0[5]), pk2(k0[6], k0[7])};
    *(LAS u32x4*)(Kt + (d + 1) * 72 + 8 * seg) = (u32x4){pk2(k1[0], k1[1]), pk2(k1[2], k1[3]), pk2(k1[4], k1[5]), pk2(k1[6], k1[7])};
    if (seg == 0) *(f32x2*)(WSP(float, WS_DECAY) + (size_t)item * 128 + d) = (f32x2){__expf(total.x), __expf(total.y)};
    __syncthreads();
    const int w = F.wave, lr = lane & 15, lq = lane >> 4;
    f32x4 acc[8];
#pragma unroll
    for (int et = 0; et < 8; ++et) acc[et] = (f32x4){0.f, 0.f, 0.f, 0.f};
#pragma unroll
    for (int ksi = 0; ksi < 2; ++ksi) { const bf16x8 a = lds_frag(Kt, 16 * w + lr, 72, 32 * ksi + 8 * lq);
#pragma unroll
        for (int et = 0; et < 8; ++et) acc[et] = MFMA16(a, lds_frag(VTs, 16 * et + lr, 72, 32 * ksi + 8 * lq), acc[et]); }
    bf16_t* dl = WSP(bf16_t, WS_DELTA) + (size_t)item * 16384;
#pragma unroll
    for (int et = 0; et < 8; ++et) { const int e = 16 * et + lr, d0 = 16 * w + 4 * lq;
        u32x2 o; o.x = pk2(acc[et][0], acc[et][1]); o.y = pk2(acc[et][2], acc[et][3]); *(u32x2*)(dl + e * 128 + d0) = o; }
}

__device__ __forceinline__ void hg_scan(Frame& F) {
    for (int gid = F.bx * 512 + F.tid; gid < NCHAIN * 8192; gid += F.G * 512) {
        const int chain = gid >> 13, idx = gid & 8191, dd = (2 * idx) & 127;
        const unsigned* dl = WSP(unsigned, WS_DELTA) + (size_t)chain * NCH_EXT * 8192 + idx;
        const float* dc = WSP(float, WS_DECAY) + (size_t)chain * NCH_EXT * 128 + dd;
        unsigned* ss = WSP(unsigned, WS_SST) + (size_t)chain * NCH_LAT * 8192 + idx;
        float s0 = 0.f, s1 = 0.f;
        constexpr int SB = 22;
        unsigned dv[SB], dw[SB]; f32x2 cv[SB], cw[SB];
#pragma unroll
        for (int u = 0; u < SB; ++u) { dv[u] = dl[(size_t)u * 8192]; cv[u] = *(const f32x2*)(dc + (size_t)u * 128); }
#pragma unroll 1
        for (int j0 = 0; j0 < NCH_EXT; j0 += SB) {
            const bool more = j0 + SB < NCH_EXT;
            if (more) {
#pragma unroll
                for (int u = 0; u < SB; ++u) { dw[u] = dl[(size_t)(j0 + SB + u) * 8192]; cw[u] = *(const f32x2*)(dc + (size_t)(j0 + SB + u) * 128); } }
#pragma unroll
            for (int u = 0; u < SB; ++u) { const int j = j0 + u;
                if (j >= 4) ss[(size_t)(j - 4) * 8192] = pk2(s0, s1);
                s0 = cv[u].x * s0 + bflo(dv[u]); s1 = cv[u].y * s1 + bfhi(dv[u]); }
#pragma unroll
            for (int u = 0; u < SB; ++u) { dv[u] = dw[u]; cv[u] = cw[u]; }
        }
    }
}

__device__ __forceinline__ void yhy_transpose_item(Frame& F, int item) {
    const int b = item >> 7, nb = item & 127, tid = F.tid;
    LAS bf16_t* ts = (LAS bf16_t*)F.lds;
    const bf16_t* src = WSP(bf16_t, WS_YHYT) + (size_t)b * HYW * SEQ + nb * 64;
    __syncthreads();
    { u32x4 tv[8];
#pragma unroll
    for (int q = 0; q < 8; ++q) { const int piece = tid + 512 * q, c = piece >> 3, part = piece & 7; tv[q] = *(const u32x4*)(src + (size_t)c * SEQ + part * 8); }
#pragma unroll
    for (int q = 0; q < 8; ++q) { const int piece = tid + 512 * q, c = piece >> 3, part = piece & 7; *(LAS u32x4*)(ts + c * 72 + part * 8) = tv[q]; } }
    __syncthreads();
    bf16_t* dst = WSP(bf16_t, WS_YHY) + (size_t)(b * SEQ + nb * 64) * HYW;
#pragma unroll
    for (int q = 0; q < 8; ++q) { const int task = tid + 512 * q, n = task & 63, cg = task >> 6;
        unsigned v[8];
#pragma unroll
        for (int i = 0; i < 8; ++i) v[i] = ts[(8 * cg + i) * 72 + n];
        *(u32x4*)(dst + (size_t)n * HYW + 8 * cg) = (u32x4){v[0] | (v[1] << 16), v[2] | (v[3] << 16), v[4] | (v[5] << 16), v[6] | (v[7] << 16)}; }
}

__device__ __forceinline__ void hg_out_item(Frame& F, int item) {
    const int b = item >> 9, h = (item >> 7) & 3, nc = item & 127;
    LAS float* segtot = (LAS float*)F.lds;
    LAS float* bref = (LAS float*)(F.lds + 4096);
    LAS float* red = (LAS float*)(F.lds + 4608);
    LAS bf16_t* Qd = (LAS bf16_t*)(F.lds + 5120);
    LAS bf16_t* Kd = (LAS bf16_t*)(F.lds + 22528);
    LAS bf16_t* Qb = (LAS bf16_t*)(F.lds + 39936);
    LAS bf16_t* VTs = (LAS bf16_t*)(F.lds + 57344);
    LAS bf16_t* Ss = (LAS bf16_t*)(F.lds + 75776);
    LAS bf16_t* att = (LAS bf16_t*)(F.lds + 110592);
    const int tid = F.tid, d = 2 * (tid & 63), seg = tid >> 6, lane = F.lane, w = F.wave, lr = lane & 15, lq = lane >> 4;
    const int nx0 = CTXL + nc * 64, r0 = b * SEQ + nc * 64;
    __syncthreads();
    { const bf16_t* vt = WSP(bf16_t, WS_VT) + ((size_t)(b * HGW + h * 128) * NEXT + nx0);
        u32x4 tv[2];
#pragma unroll
        for (int q = 0; q < 2; ++q) { const int piece = tid + 512 * q, e = piece >> 3, part = piece & 7; tv[q] = *(const u32x4*)(vt + (size_t)e * NEXT + part * 8); }
#pragma unroll
        for (int q = 0; q < 2; ++q) { const int piece = tid + 512 * q, e = piece >> 3, part = piece & 7; *(LAS u32x4*)(VTs + e * 72 + part * 8) = tv[q]; } }
    f32x4 acc[4];
#pragma unroll
    for (int i = 0; i < 4; ++i) acc[i] = (f32x4){0.f, 0.f, 0.f, 0.f};
    const bf16_t* qp = WSP(bf16_t, WS_Q) + ((size_t)r0 * HGW + h * 128 + d);
#pragma unroll 1
    for (int dir = 0; dir < 2; ++dir) {
        const int chain = (b * 4 + h) * 2 + dir, jlat = dir == 0 ? nc : 127 - nc;
        __syncthreads();
        { const bf16_t* sp = WSP(bf16_t, WS_SST) + (size_t)(chain * NCH_LAT + jlat) * 16384;
            u32x4 sv[4];
#pragma unroll
            for (int q = 0; q < 4; ++q) { const int piece = tid + 512 * q, e = piece >> 4, part = piece & 15; sv[q] = *(const u32x4*)(sp + e * 128 + part * 8); }
#pragma unroll
            for (int q = 0; q < 4; ++q) { const int piece = tid + 512 * q, e = piece >> 4, part = piece & 15; *(LAS u32x4*)(Ss + e * 136 + part * 8) = sv[q]; } }
        const float* lfp = (dir ? WSP(float, WS_LB) : WSP(float, WS_LF)) + ((size_t)(b * NEXT + nx0) * HGW + h * 128 + d);
        f32x2 lf[8], qv[8], tot = (f32x2){0.f, 0.f};
#pragma unroll
        for (int i = 0; i < 8; ++i) { lf[i] = *(const f32x2*)(lfp + (size_t)(8 * seg + i) * HGW); const unsigned qw = *(const unsigned*)(qp + (size_t)(8 * seg + i) * HGW); qv[i] = (f32x2){bflo(qw), bfhi(qw)}; tot += lf[i]; }
        *(LAS f32x2*)(segtot + seg * 128 + d) = tot;
        __syncthreads();
        f32x2 off = (f32x2){0.f, 0.f};
#pragma unroll
        for (int s = 0; s < 8; ++s) { const f32x2 v = *(const LAS f32x2*)(segtot + s * 128 + d); if (dir == 0 ? (s < seg) : (s > seg)) off += v; }
        f32x2 bb[8];
        if (dir == 0) { f32x2 run = off;
#pragma unroll
            for (int i = 0; i < 8; ++i) { run += lf[i]; bb[i] = run; } if (seg == 3) *(LAS f32x2*)(bref + d) = bb[7]; }
        else { f32x2 run = off;
#pragma unroll
            for (int i = 7; i >= 0; --i) { run += lf[i]; bb[i] = run; } if (seg == 4) *(LAS f32x2*)(bref + d) = bb[0]; }
        __syncthreads();
        { const f32x2 br = *(const LAS f32x2*)(bref + d); const f32x2 em = (f32x2){__expf(-br.x), __expf(-br.y)}, ep = (f32x2){__expf(br.x), __expf(br.y)};
#pragma unroll
            for (int i = 0; i < 8; ++i) { const int t = 8 * seg + i;
                const f32x2 eb = (f32x2){__expf(bb[i].x), __expf(bb[i].y)}, kk = (f32x2){1.0f - __expf(lf[i].x), 1.0f - __expf(lf[i].y)};
                const f32x2 qb = qv[i] * eb, qd = qb * em, kd = kk * ep * (f32x2){__builtin_amdgcn_rcpf(eb.x), __builtin_amdgcn_rcpf(eb.y)};
                *(LAS unsigned*)(Qd + t * 136 + d) = pk2(qd.x, qd.y); *(LAS unsigned*)(Kd + t * 136 + d) = pk2(kd.x, kd.y); *(LAS unsigned*)(Qb + t * 136 + d) = pk2(qb.x, qb.y); } }
        __syncthreads();
        {
            const int st = w & 3; f32x4 a2[2] = {(f32x4){0.f, 0.f, 0.f, 0.f}, (f32x4){0.f, 0.f, 0.f, 0.f}};
#pragma unroll
            for (int ksi = 0; ksi < 4; ++ksi) { const bf16x8 a = lds_frag(Kd, 16 * st + lr, 136, 32 * ksi + 8 * lq);
#pragma unroll
                for (int q = 0; q < 2; ++q) a2[q] = MFMA16(a, lds_frag(Qd, 16 * (2 * (w >> 2) + q) + lr, 136, 32 * ksi + 8 * lq), a2[q]); }
#pragma unroll
            for (int q = 0; q < 2; ++q) { const int t = 16 * (2 * (w >> 2) + q) + lr, s0 = 16 * st + 4 * lq; float v[4];
#pragma unroll
                for (int r = 0; r < 4; ++r) { const int s = s0 + r; v[r] = (dir == 0 ? (s <= t) : (s >= t)) ? a2[q][r] : 0.f; }
                u32x2 o; o.x = pk2(v[0], v[1]); o.y = pk2(v[2], v[3]); *(LAS u32x2*)(att + t * 72 + s0) = o; }
        }
        __syncthreads();
        { const int tt = w & 3;
#pragma unroll
            for (int ksi = 0; ksi < 2; ++ksi) { const bf16x8 a = lds_frag(att, 16 * tt + lr, 72, 32 * ksi + 8 * lq);
#pragma unroll
                for (int i = 0; i < 4; ++i) acc[i] = MFMA16(a, lds_frag(VTs, 16 * (4 * (w >> 2) + i) + lr, 72, 32 * ksi + 8 * lq), acc[i]); }
#pragma unroll
            for (int ksi = 0; ksi < 4; ++ksi) { const bf16x8 a = lds_frag(Qb, 16 * tt + lr, 136, 32 * ksi + 8 * lq);
#pragma unroll
                for (int i = 0; i < 4; ++i) acc[i] = MFMA16(a, lds_frag(Ss, 16 * (4 * (w >> 2) + i) + lr, 136, 32 * ksi + 8 * lq), acc[i]); }
        }
    }
    const int tt = w & 3, eh = w >> 2;
    float ssq[4];
#pragma unroll
    for (int r = 0; r < 4; ++r) { float s = 0.f;
#pragma unroll
        for (int i = 0; i < 4; ++i) s += acc[i][r] * acc[i][r];
        s += __shfl_xor(s, 1); s += __shfl_xor(s, 2); s += __shfl_xor(s, 4); s += __shfl_xor(s, 8); ssq[r] = s; }
    if (lr == 0) {
#pragma unroll
        for (int r = 0; r < 4; ++r) red[eh * 64 + 16 * tt + 4 * lq + r] = ssq[r]; }
    __syncthreads();
    const float* ng = F.p->in[I_HGNG]; const bf16_t* gp = WSP(bf16_t, WS_G); bf16_t* yo = WSP(bf16_t, WS_YHG);
    float ngv[4], gv[4][4];
#pragma unroll
    for (int i = 0; i < 4; ++i) ngv[i] = ng[16 * (4 * eh + i) + lr];
#pragma unroll
    for (int r = 0; r < 4; ++r)
#pragma unroll
        for (int i = 0; i < 4; ++i) gv[r][i] = bf2f(gp[(size_t)(r0 + 16 * tt + 4 * lq + r) * HGW + h * 128 + 16 * (4 * eh + i) + lr]);
#pragma unroll
    for (int r = 0; r < 4; ++r) { const int t = 16 * tt + 4 * lq + r; const float rs = rsqrtf((red[t] + red[64 + t]) * (1.0f / 128.0f) + EPS);
#pragma unroll
        for (int i = 0; i < 4; ++i) { const int e = 16 * (4 * eh + i) + lr; const size_t o = (size_t)(r0 + t) * HGW + h * 128 + e;
            yo[o] = (bf16_t)f2bf(acc[i][r] * rs * ngv[i] * gv[r][i]); } }
}
__device__ __forceinline__ void phase_route(Frame& F) {
    const float* lg = WSP(float, WS_LOGIT); const float* rb = F.p->in[I_RB];
    LAS int* hist = (LAS int*)F.lds;
    int* re_ = WSP(int, WS_ROUTE_E); float* rw_ = WSP(float, WS_ROUTE_W); int* rp_ = WSP(int, WS_ROUTE_P);
    const int lane = F.lane, g = lane & 7, NGW = F.G * 8;
    __syncthreads();
    if (F.tid < NE) hist[F.tid] = 0;
    __syncthreads();
    const bool al = (F.G == 256); const int wv = al ? ((F.bx & 7) * 32 + (F.bx >> 3)) * 8 + F.wave : F.bx * 8 + F.wave;
    const float NINF = -__builtin_inff();
    float bias[32];
#pragma unroll
    for (int q = 0; q < 8; ++q) { const f32x4 b4 = *(const f32x4*)(rb + g * 32 + 4 * q); bias[4 * q] = b4[0]; bias[4 * q + 1] = b4[1]; bias[4 * q + 2] = b4[2]; bias[4 * q + 3] = b4[3]; }
    for (int t8 = wv * 8; t8 < T; t8 += NGW * 8) {
        const int t = t8 + (lane >> 3);
        float sc[32], cd[32];
#pragma unroll
        for (int q = 0; q < 8; ++q) { const f32x4 l4 = *(const f32x4*)(lg + (size_t)t * NE + g * 32 + 4 * q);
#pragma unroll
            for (int i = 0; i < 4; ++i) { sc[4 * q + i] = sigmoidf_(l4[i]); cd[4 * q + i] = sc[4 * q + i] + bias[4 * q + i]; } }
        float m1 = fmaxf(cd[0], cd[1]), m2 = fminf(cd[0], cd[1]);
#pragma unroll
        for (int i = 2; i < 32; ++i) { const float v = cd[i]; m2 = fmaxf(m2, fminf(m1, v)); m1 = fmaxf(m1, v); }
        const float gs = m1 + m2; int rank = 0;
#pragma unroll
        for (int gg = 0; gg < 8; ++gg) { const float v = __shfl(gs, (lane & ~7) + gg); rank += (v > gs || (v == gs && gg < g)) ? 1 : 0; }
        if (rank >= 4) {
#pragma unroll
            for (int i = 0; i < 32; ++i) cd[i] = NINF; }
        int me = 0; float mw = 0.f, ssum = 0.f;
#pragma unroll 1
        for (int k = 0; k < 8; ++k) {
            float bv = cd[0], bs = sc[0]; int bi = 0;
#pragma unroll
            for (int i = 1; i < 32; ++i) if (cd[i] > bv) { bv = cd[i]; bs = sc[i]; bi = i; }
            int gi = g * 32 + bi;
#pragma unroll
            for (int o = 1; o < 8; o <<= 1) { const float ov = __shfl_xor(bv, o), os = __shfl_xor(bs, o); const int oi = __shfl_xor(gi, o); if (ov > bv || (ov == bv && oi < gi)) { bv = ov; bs = os; gi = oi; } }
            if ((gi >> 5) == g) { const int li = gi & 31;
#pragma unroll
                for (int i = 0; i < 32; ++i) if (i == li) cd[i] = NINF; }
            ssum += bs; if (k == g) { me = gi; mw = bs; }
        }
        const int lrank = __hip_atomic_fetch_add(hist + me, 1, __ATOMIC_RELAXED, __HIP_MEMORY_SCOPE_WORKGROUP);
        re_[t * 8 + g] = me; rw_[t * 8 + g] = mw * (2.5f / ssum); rp_[t * 8 + g] = lrank | (F.bx << 16);
    }
    __syncthreads();
    if (F.tid < NE) WSP(int, WS_HIST)[F.bx * NE + F.tid] = hist[F.tid];
}
__device__ __forceinline__ void phase_prefix(Frame& F) {
    LAS int* sc = (LAS int*)F.lds;
    const int* hist = WSP(int, WS_HIST); int* pref = WSP(int, WS_PREF); unsigned* cnt = WSP(unsigned, WS_CTL) + CW_CNT;
    for (int e = F.bx; e < NE; e += F.G) {
        __syncthreads();
        const int i = F.tid; int v = (i < 256 && i < F.G) ? hist[i * NE + e] : 0;
        if (i < 256) sc[i] = v;
        __syncthreads();
        int cur = 0;
#pragma unroll
        for (int o = 1; o < 256; o <<= 1) { int x = 0; if (i < 256) { x = sc[cur * 256 + i]; if (i >= o) x += sc[cur * 256 + i - o]; sc[(cur ^ 1) * 256 + i] = x; } __syncthreads(); cur ^= 1; }
        if (i < 256) { const int inc = sc[cur * 256 + i]; pref[i * NE + e] = inc - v; if (i == 255) cnt[e] = (unsigned)inc; }
    }
}
__device__ __forceinline__ void phase_scatter(Frame& F) {
    LAS int* st = (LAS int*)F.lds; LAS int* cn = st + 512;
    const unsigned* cnt = WSP(unsigned, WS_CTL) + CW_CNT;
    __syncthreads();
    if (F.tid < NE) cn[F.tid] = (int)cnt[F.tid];
    __syncthreads();
    if (F.tid <= NE) { int s = 0, tl = 0; for (int e = 0; e < F.tid; ++e) { s += cn[e]; tl += (cn[e] + 255) >> 8; } st[F.tid] = s;
        if (F.bx == 0) { unsigned* ctl = WSP(unsigned, WS_CTL); ctl[CW_START + F.tid] = (unsigned)s; ctl[CW_TOFF + F.tid] = (unsigned)tl;
            if (F.tid < NE) { const int c_ = cn[F.tid]; for (int j = 0; j * 256 < c_; ++j) { unsigned* up = ctl + CW_UNITS + 4 * (tl + j); up[0] = (unsigned)(s + 256 * j); up[1] = (unsigned)F.tid; up[2] = (unsigned)(c_ - 256 * j < 256 ? c_ - 256 * j : 256); up[3] = 0u; } } } }
    __syncthreads();
    const int* re_ = WSP(int, WS_ROUTE_E); const float* rw_ = WSP(float, WS_ROUTE_W); const int* rp_ = WSP(int, WS_ROUTE_P);
    int* stok = WSP(int, WS_SLOT_TOK); float* sw = WSP(float, WS_SLOT_W); int* sof = WSP(int, WS_SLOTOF);
    const int* pref = WSP(int, WS_PREF);
    for (int a = F.bx * 512 + F.tid; a < NASG; a += F.G * 512) { const int e = re_[a], rp = rp_[a]; const int slot = st[e] + pref[(rp >> 16) * NE + e] + (rp & 0xffff); stok[slot] = a >> 3; sw[slot] = rw_[a]; sof[a] = slot; }
    if (F.bx == 0 && F.tid < 256) { stok[NASG + F.tid] = 0; sw[NASG + F.tid] = 0.f; }
}
__device__ __forceinline__ void phase_final(Frame& F) {
    float* out = F.p->out; const float* x1 = F.p->out;     const float* fg = F.p->in[I_FG]; const float* ada = WSP(float, WS_ADA);
    const unsigned char* yb8 = WSP(unsigned char, WS_YBUF); const bf16_t* ysh = WSP(bf16_t, WS_YSH); const int* sof = WSP(int, WS_SLOTOF);
    const int lane = F.lane, NGW = F.G * 8;
    const bool al = (F.G == 256); const int tbase = al ? (((F.bx & 7) * 32 + (F.bx >> 3)) * 8 + F.wave) * 8 : F.bx * 8 + F.wave, tstr = al ? 1 : NGW;
    f32x4 fgv[2][2];
#pragma unroll
    for (int j = 0; j < 2; ++j) { fgv[j][0] = *(const f32x4*)(fg + 512 * j + 8 * lane); fgv[j][1] = *(const f32x4*)(fg + 512 * j + 8 * lane + 4); }
    int it_ = 0;
    for (int t = tbase; al ? it_ < 8 : t < T; t += tstr, ++it_) { const int b = t >> 13;
        int sl[8];
#pragma unroll
        for (int k = 0; k < 8; ++k) sl[k] = sof[t * 8 + k];
        u32x4 ys[2]; u32x2 y[8][2]; f32x4 xv[2][2], g2[2][2];
#pragma unroll
        for (int j = 0; j < 2; ++j) { const int c = 512 * j + 8 * lane;
            ys[j] = *(const u32x4*)(ysh + (size_t)t * D + c); xv[j][0] = *(const f32x4*)(x1 + (size_t)t * D + c); xv[j][1] = *(const f32x4*)(x1 + (size_t)t * D + c + 4);
            g2[j][0] = *(const f32x4*)(ada + b * 6144 + 5 * D + c); g2[j][1] = *(const f32x4*)(ada + b * 6144 + 5 * D + c + 4);
#pragma unroll
            for (int k = 0; k < 8; ++k) y[k][j] = *(const u32x2*)(yb8 + (size_t)sl[k] * D + c); }
        f32x4 v[2][2]; float ss = 0.f;
#pragma unroll
        for (int j = 0; j < 2; ++j) { f32x4 m0 = (f32x4){bflo(ys[j].x), bfhi(ys[j].x), bflo(ys[j].y), bfhi(ys[j].y)}, m1 = (f32x4){bflo(ys[j].z), bfhi(ys[j].z), bflo(ys[j].w), bfhi(ys[j].w)};
#pragma unroll
            for (int k = 0; k < 8; ++k) { const f32x2 a0 = __builtin_amdgcn_cvt_pk_f32_fp8((int)y[k][j].x, false), a1 = __builtin_amdgcn_cvt_pk_f32_fp8((int)y[k][j].x, true), b0 = __builtin_amdgcn_cvt_pk_f32_fp8((int)y[k][j].y, false), b1 = __builtin_amdgcn_cvt_pk_f32_fp8((int)y[k][j].y, true);
                m0 += (f32x4){a0.x, a0.y, a1.x, a1.y}; m1 += (f32x4){b0.x, b0.y, b1.x, b1.y}; }
            v[j][0] = xv[j][0] + g2[j][0] * m0; v[j][1] = xv[j][1] + g2[j][1] * m1;
#pragma unroll
            for (int h = 0; h < 2; ++h) ss += (v[j][h][0] * v[j][h][0] + v[j][h][1] * v[j][h][1]) + (v[j][h][2] * v[j][h][2] + v[j][h][3] * v[j][h][3]); }
        const float rs = rsqrtf(wave_sum(ss) * (1.0f / D) + EPS);
#pragma unroll
        for (int j = 0; j < 2; ++j) { const int c = 512 * j + 8 * lane; *(f32x4*)(out + (size_t)t * D + c) = v[j][0] * rs * fgv[j][0]; *(f32x4*)(out + (size_t)t * D + c + 4) = v[j][1] * rs * fgv[j][1]; }
    }
}

constexpr int NPHASE = 16;
#ifndef REP_MASK
#define REP_MASK 0u
#endif
#define NREP(k) ((((REP_MASK) >> (k)) & 1u) ? 2 : 1)
#ifndef MK_LAUNCH_PER_PHASE
#define MK_LAUNCH_PER_PHASE 0
#endif
__global__ void __launch_bounds__(512) hyena_hgrn2_moe_fwd(Params p) {
    extern __shared__ __attribute__((aligned(16))) unsigned char lds_[];
    cg::grid_group grid = cg::this_grid();
    Frame F; F.lds = (LAS unsigned char*)lds_; F.p = &p; F.ws = p.ws; F.tid = threadIdx.x; F.lane = F.tid & 63; F.wave = __builtin_amdgcn_readfirstlane(F.tid >> 6); F.G = gridDim.x; F.bx = blockIdx.x;
    if (F.tid < 16) ((LAS unsigned*)(F.lds + LDS_BARST))[F.tid] = 0u;
    __syncthreads();
    XcdBarrier bar = xcd_barrier_post((unsigned*)(p.ws + WS_CTL) + CW_BAR, (volatile LAS unsigned*)(F.lds + LDS_BARST));
#ifdef ONLY_PHASE
#define IN(k) ((k) == ONLY_PHASE && p.ph_lo <= (k) && (k) < p.ph_hi)
#else
#define IN(k) (p.ph_lo <= (k) && (k) < p.ph_hi)
#endif
#ifndef PROBE_K
#define PROBE_K (-1)
#endif
#ifndef PROBE_EPI_K
#define PROBE_EPI_K (-1)
#endif
    unsigned long long pk_acc = 0ull;
#define PACC(k) (PROBE_EPI_K == (k) ? &pk_acc : (unsigned long long*)nullptr)
    unsigned long long pk_t0 = 0ull, pk_t1 = 0ull;
#define SEAM(k) do { if (IN(k) && IN((k) + 1)) xcd_barrier(bar); if (PROBE_K == (k) + 1) pk_t0 = __builtin_amdgcn_s_memrealtime(); if (PROBE_K == (k)) pk_t1 = __builtin_amdgcn_s_memrealtime(); } while (0)
    if (PROBE_K == 0) pk_t0 = __builtin_amdgcn_s_memrealtime();
    if (p.ph_lo < 0) grid.sync();
    if (IN(0)) _Pragma("unroll 1") for (int rp = 0; rp < NREP(0); ++rp) { asm volatile("" : "+v"(F.tid)); if (rp) xcd_barrier(bar); phase0(F, PROBE_EPI_K >= 100 ? &pk_acc : (unsigned long long*)nullptr, PROBE_EPI_K - 100); }
    SEAM(0);
    if (IN(1)) _Pragma("unroll 1") for (int rp = 0; rp < NREP(1); ++rp) { asm volatile("" : "+v"(F.tid)); if (rp) xcd_barrier(bar); phase1(F); }
    SEAM(1);
    if (IN(2)) _Pragma("unroll 1") for (int rp = 0; rp < NREP(2); ++rp) { asm volatile("" : "+v"(F.tid)); if (rp) xcd_barrier(bar);
        __syncthreads();
        if (F.G == 256 && F.bx >= 256 - NCONV) {
            conv_loop2(F, 256 * (XP_BG + XP_K0) + (F.bx - (256 - NCONV)), NCONV, NE * 48 - XP_P13);
        } else
        { pg8::Gemm g{WSP(bf16_t, WS_WINT), WSP(bf16_t, WS_WINT), D, nullptr, 2 * D, 128}; InOrder S{F.G == 256 ? 256 - NCONV : F.G, F.bx};
          EpiIn E{EpiInT{WSP(bf16_t, WS_PHYT), WSP(bf16_t, WS_VT)}, EpiInN{WSP(bf16_t, WS_Q), WSP(bf16_t, WS_G), WSP(bf16_t, WS_SG1), WSP(bf16_t, WS_SG2), WSP(float, WS_LF), WSP(float, WS_LB), WSP(float, WS_LBS)}};
          pg8::gemm_phase<EpiIn, InOrder, false>(F.lds, g, S, E, PACC(2)); }
    }
    SEAM(2);
    if (IN(3)) _Pragma("unroll 1") for (int rp = 0; rp < NREP(3); ++rp) { asm volatile("" : "+v"(F.tid)); if (rp) xcd_barrier(bar);
        _Pragma("unroll 1") for (int r2 = 0; r2 < NREP(16); ++r2) { asm volatile("" : "+v"(F.tid));
            XpState xp; xp.it = F.bx; xp.stride = F.G; xp.end = (XP_BG * F.G < NE * 48) ? XP_BG * F.G : NE * 48; xp.live = false;
            for (int c = F.bx; c < HYW; c += F.G) hyena_item(F, c, xp);
            { int tid = F.tid; xp_finish(xp, p.in, F.ws, tid); while (xp.it < xp.end) { xp_issue(xp, p.in, F.ws, tid); xp_finish(xp, p.in, F.ws, tid); } } }
        _Pragma("unroll 1") for (int r2 = 0; r2 < NREP(17); ++r2) { asm volatile("" : "+v"(F.tid)); for (int it = F.bx; it < NAITEM; it += F.G) hg_delta_item(F, it); }
    }
    SEAM(3);
    if (IN(4)) _Pragma("unroll 1") for (int rp = 0; rp < NREP(4); ++rp) { asm volatile("" : "+v"(F.tid)); if (rp) xcd_barrier(bar);
        _Pragma("unroll 1") for (int r2 = 0; r2 < NREP(18); ++r2) { asm volatile("" : "+v"(F.tid)); hg_scan(F); }
        _Pragma("unroll 1") for (int r2 = 0; r2 < NREP(19); ++r2) { asm volatile("" : "+v"(F.tid)); for (int it = F.bx; it < NB * 128; it += F.G) yhy_transpose_item(F, it); }
    }
    SEAM(4);
    if (IN(5)) _Pragma("unroll 1") for (int rp = 0; rp < NREP(5); ++rp) { asm volatile("" : "+v"(F.tid)); if (rp) xcd_barrier(bar); for (int it = F.bx; it < NB * 4 * NCH_LAT; it += F.G) hg_out_item(F, it); }
    SEAM(5);
    if (IN(6)) _Pragma("unroll 1") for (int rp = 0; rp < NREP(6); ++rp) { asm volatile("" : "+v"(F.tid)); if (rp) xcd_barrier(bar);
        __syncthreads();
        { pg8::Gemm g{WSP(bf16_t, WS_YHY), WSP(bf16_t, WS_WHYT), HYW, nullptr, 2 * HYW, 128}; MergeOrder S; S.so.init(T, D, HYW, F.G, F.bx);
          EpiMerge E{EpiMerge1{WSP(bf16_t, WS_SG1), WSP(float, WS_T1)}, EpiMerge2{WSP(bf16_t, WS_SG2), WSP(float, WS_T1), WSP(bf16_t, WS_MB)}};
          pg8::gemm_phase<EpiMerge, MergeOrder, false>(F.lds, g, S, E, PACC(6)); }
    }
    SEAM(6);
    if (IN(7)) _Pragma("unroll 1") for (int rp = 0; rp < NREP(7); ++rp) { asm volatile("" : "+v"(F.tid)); if (rp) xcd_barrier(bar);
        __syncthreads();
        pg8::Gemm g{WSP(bf16_t, WS_MB), WSP(bf16_t, WS_WOUTT), D, nullptr, 2 * D, 128}; pg8::StaticOrder S; S.init(T, D, D, F.G, F.bx);
        EpiWout E{p.in[I_X], WSP(float, WS_POSR), WSP(float, WS_POSC), WSP(float, WS_ADA), p.out};
        pg8::gemm_phase<EpiWout, pg8::StaticOrder, false>(F.lds, g, S, E, PACC(7));
    }
    SEAM(7);
    if (IN(8)) _Pragma("unroll 1") for (int rp = 0; rp < NREP(8); ++rp) { asm volatile("" : "+v"(F.tid)); if (rp) xcd_barrier(bar); phase_h2(F); }
    SEAM(8);
    if (IN(9)) _Pragma("unroll 1") for (int rp = 0; rp < NREP(9); ++rp) { asm volatile("" : "+v"(F.tid)); if (rp) xcd_barrier(bar);
        __syncthreads();
        { pg8::Gemm g{WSP(bf16_t, WS_H2), WSP(bf16_t, WS_ROUT), D, nullptr, 2 * D, 128}; P9Order S{F.G, F.bx}; EpiP9 E{EpiLogit{WSP(float, WS_LOGIT)}, EpiGU{WSP(bf16_t, WS_HSH), nullptr}};
          pg8::gemm_phase<EpiP9, P9Order, false>(F.lds, g, S, E); }
    }
    SEAM(9);
    if (IN(10)) _Pragma("unroll 1") for (int rp = 0; rp < NREP(10); ++rp) { asm volatile("" : "+v"(F.tid)); if (rp) xcd_barrier(bar); phase_route(F); }
    SEAM(10);
    if (IN(11)) phase_prefix(F);
    SEAM(11);
    if (IN(12)) _Pragma("unroll 1") for (int rp = 0; rp < NREP(12); ++rp) { asm volatile("" : "+v"(F.tid)); if (rp) xcd_barrier(bar); phase_scatter(F); }
    SEAM(12);
    if (IN(13)) _Pragma("unroll 1") for (int rp = 0; rp < NREP(13); ++rp) { asm volatile("" : "+v"(F.tid)); if (rp) xcd_barrier(bar);
        __syncthreads();
        if (F.G == 256 && F.bx >= 256 - NCONV2) {
            conv_loop2(F, NE * 48 - XP_P13 + (F.bx - (256 - NCONV2)), NCONV2, NE * 48);
        } else {
        pg8::Gemm g{WSP(bf16_t, WS_H2), WSP(bf16_t, WS_EGUT), D, WSP(int, WS_SLOT_TOK), 128, 512 * 128}; MoeOrder S{WSP(unsigned, WS_CTL) + CW_UNITS, (int)WSP(unsigned, WS_CTL)[CW_TOFF + NE], 2, F.G == 256 ? 256 - NCONV2 : F.G, F.bx, 1048576u}; EpiGU E{WSP(bf16_t, WS_HBUF), WSP(float, WS_SLOT_W)};
        pg8::gemm_phase<EpiGU, MoeOrder, true>(F.lds, g, S, E, PACC(13)); }
    }
    SEAM(13);
    if (IN(14)) _Pragma("unroll 1") for (int rp = 0; rp < NREP(14); ++rp) { asm volatile("" : "+v"(F.tid)); if (rp) xcd_barrier(bar);
        __syncthreads();
        { pg8::Gemm g{WSP(bf16_t, WS_HBUF), WSP(bf16_t, WS_EDT), EH, nullptr, 128, 1024 * 128}; MoeOrder S{WSP(unsigned, WS_CTL) + CW_UNITS, (int)WSP(unsigned, WS_CTL)[CW_TOFF + NE], 4, F.G, F.bx, 524288u}; EpiDown<false, true> E{WSP(bf16_t, WS_YBUF), nullptr};
          pg8::gemm_phase<EpiDown<false, true>, MoeOrder, false>(F.lds, g, S, E, PACC(14)); }
        { pg8::Gemm g{WSP(bf16_t, WS_HSH), WSP(bf16_t, WS_SHDT), EH, nullptr, 2 * EH, 128}; pg8::StaticOrder S; S.init(T, D, EH, F.G, F.bx); EpiDown<false> E{WSP(bf16_t, WS_YSH), nullptr};
          pg8::gemm_phase<EpiDown<false>, pg8::StaticOrder, false>(F.lds, g, S, E); }
    }
    SEAM(14);
    if (IN(15)) _Pragma("unroll 1") for (int rp = 0; rp < NREP(15); ++rp) { asm volatile("" : "+v"(F.tid)); if (rp) xcd_barrier(bar); phase_final(F); }
    if (PROBE_K >= 0) { if (PROBE_K == 15) pk_t1 = __builtin_amdgcn_s_memrealtime();
        if (F.bx == 0) { const unsigned long long te = __builtin_amdgcn_s_memrealtime(), span = 8ull * (PROBE_EPI_K >= 0 ? pk_acc : (pk_t1 - pk_t0)); while (__builtin_amdgcn_s_memrealtime() - te < span) __builtin_amdgcn_s_sleep(8); } }
#undef IN
#undef SEAM
}

extern "C" void kernel_launch(void* const* d_in, const int* in_sizes, int n_in, void* d_out, int out_size, void* d_ws, size_t ws_size, hipStream_t stream) {
    static int grid = 0;
    if (grid == 0) {
        if (n_in != 34 || out_size != T * D || ws_size < WS_END) { fprintf(stderr, "kernel_launch: unexpected shapes (n_in %d, out %d, ws %zu < %zu)\n", n_in, out_size, ws_size, (size_t)WS_END); grid = -1; return; }
        int dev = 0, cus = 0, per_cu = 0;
        if (hipGetDevice(&dev) != hipSuccess || hipDeviceGetAttribute(&cus, hipDeviceAttributeMultiprocessorCount, dev) != hipSuccess) { grid = -1; return; }
        if (hipFuncSetAttribute((const void*)hyena_hgrn2_moe_fwd, hipFuncAttributeMaxDynamicSharedMemorySize, LDS_BYTES) != hipSuccess) { fprintf(stderr, "kernel_launch: hipFuncSetAttribute failed\n"); grid = -1; return; }
        if (hipOccupancyMaxActiveBlocksPerMultiprocessor(&per_cu, (const void*)hyena_hgrn2_moe_fwd, 512, LDS_BYTES) != hipSuccess || per_cu < 1) { fprintf(stderr, "kernel_launch: occupancy query failed (%d)\n", per_cu); (void)hipGetLastError(); per_cu = 1; }
        grid = cus * per_cu; if (grid > 256) grid = 256;
    }
    if (grid < 0) return;
    if (hipMemsetAsync((char*)d_ws + WS_CTL, 0, CTL_BYTES, stream) != hipSuccess) { fprintf(stderr, "kernel_launch: memset failed\n"); return; }
    Params p{};
    for (int i = 0; i < 34; ++i) p.in[i] = (const float*)d_in[i];
    p.out = (float*)d_out; p.ws = (unsigned char*)d_ws;
#if MK_LAUNCH_PER_PHASE
    for (int k = 0; k < NPHASE; ++k) { p.ph_lo = k; p.ph_hi = k + 1; void* args[] = {&p};
        hipError_t e = hipLaunchCooperativeKernel((const void*)hyena_hgrn2_moe_fwd, dim3(grid), dim3(512), args, LDS_BYTES, stream);
        if (e != hipSuccess) { fprintf(stderr, "kernel_launch: launch %d failed: %s\n", k, hipGetErrorString(e)); break; } }
#else
    p.ph_lo = 0; p.ph_hi = NPHASE; void* args[] = {&p};
    hipError_t e = hipLaunchCooperativeKernel((const void*)hyena_hgrn2_moe_fwd, dim3(grid), dim3(512), args, LDS_BYTES, stream);
    if (e != hipSuccess) fprintf(stderr, "kernel_launch: cooperative launch failed: %s (grid %d)\n", hipGetErrorString(e), grid);
#endif
}
```

```cpp
#include <hip/hip_runtime.h>
#include <hip/hip_cooperative_groups.h>
#include <cstdio>
#include <cstdint>
namespace cg = cooperative_groups;

#define LAS __attribute__((address_space(3)))
typedef unsigned short bf16_t;
typedef short bf16x8 __attribute__((ext_vector_type(8)));
typedef float f32x4 __attribute__((ext_vector_type(4)));
typedef float f32x2 __attribute__((ext_vector_type(2)));
typedef unsigned u32x4 __attribute__((ext_vector_type(4)));
typedef unsigned u32x2 __attribute__((ext_vector_type(2)));

constexpr int D = 1024, NB = 2, SEQ = 8192, T = NB * SEQ, CTXL = 256, TC = NB * CTXL, MA = T + TC, NEXT = CTXL + SEQ;
constexpr int HYW = 512, HYP = 1536, HGW = 512, INC = 6144;
constexpr int NE = 256, TOPK = 8, EH = 256, NASG = T * TOPK;
constexpr int NCH_EXT = NEXT / 64  , NCH_LAT = SEQ / 64  , NCHAIN = 16, NAITEM = NCHAIN * NCH_EXT  ;
constexpr int FFTN = 16384;
constexpr float EPS = 1e-6f;

constexpr size_t al256(size_t x) { return (x + 255) & ~(size_t)255; }
constexpr size_t WS_CTL = 0, CTL_BYTES = 65536;
constexpr size_t WS_WINT = WS_CTL + CTL_BYTES;
constexpr size_t WS_WHYT = WS_WINT + (size_t)INC * D * 2;
constexpr size_t WS_WHGT = WS_WHYT + (size_t)D * HYW * 2;
constexpr size_t WS_WOUTT = WS_WHGT + (size_t)D * HGW * 2;
constexpr size_t WS_ROUT = WS_WOUTT + (size_t)D * D * 2;
constexpr size_t WS_SHGUT = WS_ROUT + (size_t)NE * D * 2;
constexpr size_t WS_SHDT = WS_SHGUT + (size_t)512 * D * 2;
constexpr size_t WS_ADAP = WS_SHDT + (size_t)D * 256 * 2;
constexpr size_t WS_ADA = WS_ADAP + (size_t)32 * 3 * 6144 * 4;
constexpr size_t WS_POSR = WS_ADA + (size_t)3 * 6144 * 4;
constexpr size_t WS_POSC = WS_POSR + (size_t)128 * 512 * 4;
constexpr size_t WS_LBS = WS_POSC + (size_t)64 * 512 * 4;
constexpr size_t WS_ROUTE_E = WS_LBS + 4096;
constexpr size_t WS_ROUTE_W = WS_ROUTE_E + (size_t)NASG * 4;
constexpr size_t WS_ROUTE_P = WS_ROUTE_W + (size_t)NASG * 4;
constexpr size_t WS_SLOTOF = WS_ROUTE_P + (size_t)NASG * 4;
constexpr size_t WS_SLOT_TOK = WS_SLOTOF + (size_t)NASG * 4;
constexpr size_t WS_SLOT_W = WS_SLOT_TOK + (size_t)(NASG + 256) * 4;
constexpr size_t WS_HIST = al256(WS_SLOT_W + (size_t)(NASG + 256) * 4);
constexpr size_t WS_PREF = WS_HIST + 256 * 256 * 4;
constexpr size_t WS_A3 = al256(WS_PREF + 256 * 256 * 4);
constexpr size_t WS_W4T = WS_A3 + (size_t)SEQ * 64 * 2;
constexpr size_t WS_EGUT = al256(WS_W4T + (size_t)2048 * 64 * 2);
constexpr size_t WS_EDT = WS_EGUT + (size_t)NE * 512 * D * 2;
constexpr size_t WS_RA = WS_EDT + (size_t)NE * D * EH * 2;
constexpr size_t RA_BYTES = (size_t)NASG * D * 2;
constexpr size_t WS_HF = WS_RA;
constexpr size_t WS_KS = WS_HF + (size_t)2048 * SEQ * 4;
constexpr size_t WS_DELTA = WS_KS + (size_t)256 * 2 * FFTN * 8;
constexpr size_t WS_DECAY = WS_DELTA + (size_t)NAITEM * 16384 * 2;
constexpr size_t WS_PHYT = WS_DECAY + (size_t)NAITEM * 128 * 4;
static_assert(WS_PHYT + (size_t)NB * HYP * SEQ * 2 <= WS_RA + RA_BYTES, "region A overflow");
constexpr size_t WS_YBUF = WS_RA;
constexpr size_t WS_RB = WS_RA + RA_BYTES;
constexpr size_t WS_VT = WS_RB;
constexpr size_t WS_Q = WS_VT + (size_t)NB * HGW * NEXT * 2;
constexpr size_t WS_LF = WS_Q + (size_t)T * HGW * 2;
constexpr size_t WS_LB = WS_LF + (size_t)NB * NEXT * HGW * 4;
constexpr size_t WS_G = WS_LB + (size_t)NB * NEXT * HGW * 4;
constexpr size_t WS_SG1 = WS_G + (size_t)T * HGW * 2;
constexpr size_t WS_SG2 = WS_SG1 + (size_t)T * D * 2;
constexpr size_t WS_A1 = WS_SG2 + (size_t)T * D * 2;
constexpr size_t WS_SST = WS_A1 + (size_t)MA * D * 2;
constexpr size_t WS_YHG = WS_SST + (size_t)NCHAIN * NCH_LAT * 16384 * 2 + 256 * 512;
constexpr size_t WS_T1 = WS_YHG + (size_t)T * HGW * 2;
constexpr size_t WS_END = WS_T1 + (size_t)T * D * 4;
constexpr size_t WS_X1B = WS_SG2;
constexpr size_t WS_LOGIT = WS_VT, WS_HSH = WS_Q, WS_MB = WS_LF, WS_H2 = WS_LB, WS_YSH = WS_SG1, WS_YHYT = WS_A1, WS_YHY = WS_A1 + (size_t)NB * HYW * SEQ * 2, WS_HBUF = WS_SST;
static_assert((size_t)T * 256 * 4 <= (size_t)NB * HGW * NEXT * 2, "LOGIT fits VT");
static_assert(WS_YHY + (size_t)T * HYW * 2 <= WS_SST, "YHY fits A1");
static_assert((size_t)(NASG + 256) * EH * 2 <= (size_t)NCHAIN * NCH_LAT * 16384 * 2 + 256 * 512, "HBUF fits SST");
static_assert(WS_END <= (size_t)1073741824, "workspace map exceeds 1 GiB");
constexpr int CW_CNT = 0;
constexpr int CW_START = 512;
constexpr int CW_TOFF = 1024;
constexpr int CW_BAR = 4096;
constexpr int CW_UNITS = 8192;

constexpr int LDS_BYTES = 147456;
constexpr int LDS_BARST = LDS_BYTES - 64;

__device__ __forceinline__ unsigned f2bf(float f) { unsigned u = __float_as_uint(f); return (u + 0x7fffu + ((u >> 16) & 1u)) >> 16; }
__device__ __forceinline__ unsigned pk2(float lo, float hi) { return f2bf(lo) | (f2bf(hi) << 16); }
__device__ __forceinline__ float bf2f(unsigned b) { return __uint_as_float(b << 16); }
__device__ __forceinline__ float bflo(unsigned w) { return __uint_as_float(w << 16); }
__device__ __forceinline__ float bfhi(unsigned w) { return __uint_as_float(w & 0xffff0000u); }
__device__ __forceinline__ float sigmoidf_(float x) { return __builtin_amdgcn_rcpf(1.0f + __expf(-x)); }
__device__ __forceinline__ float siluf_(float x) { return x * __builtin_amdgcn_rcpf(1.0f + __expf(-x)); }
__device__ __forceinline__ unsigned f2h(float f) { return (unsigned)__builtin_bit_cast(unsigned short, (_Float16)f); }
__device__ __forceinline__ unsigned pkh2(float lo, float hi) { return f2h(lo) | (f2h(hi) << 16); }
__device__ __forceinline__ float h2f(unsigned short b) { return (float)__builtin_bit_cast(_Float16, b); }
__device__ __forceinline__ float wave_sum(float v) {
#pragma unroll
    for (int o = 1; o < 64; o <<= 1) v += __shfl_xor(v, o);
    return v;
}
#define LDS_WAIT() asm volatile("s_waitcnt lgkmcnt(0)" ::: "memory")
#define MFMA16(a, b, c) __builtin_amdgcn_mfma_f32_16x16x32_bf16(a, b, c, 0, 0, 0)

struct Params {
    const float* in[34];
    float* out;
    unsigned char* ws;
    int ph_lo, ph_hi;
};
enum { I_X = 0, I_C, I_CTX, I_CCTX, I_N1G, I_N2G, I_ADAW, I_ADAB, I_WIN, I_HCW, I_HCB, I_FW1, I_FB1, I_FW2, I_FB2, I_FW3, I_FB3, I_FW4, I_FFREQ, I_HSKIP,
       I_LBL, I_HGNG, I_WHY, I_WHG, I_WOUT, I_RW, I_RB, I_EG, I_EU, I_ED, I_SG, I_SU, I_SD, I_FG };
namespace pg8 {
constexpr int BM = 256, BK = 64, HALF = 128, HTB = HALF * BK * 2, STAGE_BYTES = 8 * HTB;
__host__ __device__ __forceinline__ int lds_byte(int r, int c) { const int st = (r >> 4) * 2 + (c >> 5), rr = r & 15, cc = c & 31, ob = rr * 64 + cc * 2; return st * 1024 + (ob ^ (((ob >> 9) & 1) << 5)); }
__host__ __device__ __forceinline__ void stage_rc(int b, int& R, int& C) { const int st = b / 1024, sb = b % 1024, swz = sb ^ (((sb >> 9) & 1) << 5); R = (st >> 1) * 16 + swz / 64; C = (st & 1) * 32 + (swz % 64) / 2; }
__host__ __device__ __forceinline__ int perm32(int rho) { const int n = rho >> 4, i = rho & 15; return 8 * (i >> 2) + 4 * n + (i & 3); }

struct Unit { int row0, lrow, pn, nvalid, aux, kind; unsigned boff; };
struct Gemm { const bf16_t* A; const bf16_t* Bt; int K; const int* rows; int ldb, kstepB; };

__device__ __forceinline__ unsigned cvt_pk_bf16(float lo, float hi) { unsigned r; asm volatile("v_cvt_pk_bf16_f32 %0, %1, %2" : "=v"(r) : "v"(lo), "v"(hi)); return r; }

template <class Epi, class Sched, bool GATHER>
__device__ __forceinline__ void gemm_phase(LAS unsigned char* lds, const Gemm g, const Sched& S, const Epi& E, unsigned long long* pacc = nullptr) {
#ifdef PROBE_CALL
    const unsigned long long c0_ = pacc ? __builtin_amdgcn_s_memrealtime() : 0ull; unsigned long long* pacc_call = pacc; pacc = nullptr;
#endif
    const int tid = threadIdx.x, wid = __builtin_amdgcn_readfirstlane(tid >> 6), lane = tid & 63, wr = wid >> 2, wc = wid & 3, fr = lane & 15, fq = lane >> 4;
    int K_ = g.K; asm volatile("" : "+s"(K_));
    const int K = K_, nt = K / BK; int ldb_ = g.ldb, ksb_ = g.kstepB; asm volatile("" : "+s"(ldb_), "+s"(ksb_));
    unsigned voffA[2], voffB[2]; int RA[2], CA[2];
#pragma unroll
    for (int i = 0; i < 2; ++i) { int R, C; stage_rc(tid * 16 + i * 8192, R, C); const int Rb = Epi::PERM ? ((R & ~31) + perm32(R & 31)) : R;
        voffA[i] = (unsigned)(R * K + C) * 2u; voffB[i] = (unsigned)(Rb * ldb_ + C * 2); RA[i] = R; CA[i] = C; }
    const size_t kstep = (size_t)(BK * 2);
    const size_t hstep = (size_t)HALF * K * 2;
    const size_t kstepB = (size_t)ksb_, hstepB = (size_t)HALF * ldb_;
    const unsigned ldsw = (unsigned)wid * 1024u;
    const int aoff = lds_byte(wr * 64 + fr, fq * 8), boff = lds_byte(wc * 32 + fr, fq * 8);
    unsigned vg0[2][2], vg1[2][2];
#define PG8_SA(b, h) (((b) * 2 + (h)) * HTB)
#define PG8_SB(b, h) ((4 + (b) * 2 + (h)) * HTB)
#define PG8_STAGE(bufoff, gbase, voff) do { _Pragma("unroll") for (int _i = 0; _i < 2; ++_i) \
        __builtin_amdgcn_global_load_lds((const unsigned*)((const char*)(gbase) + (voff)[_i]), (LAS unsigned*)(lds + (bufoff) + ldsw + _i * 8192), 16, 0, 0); } while (0)
#define PG8_STAGE_A(bufoff, gbase, h, w) do { _Pragma("unroll") for (int _i = 0; _i < 2; ++_i) { \
        const unsigned _o = GATHER ? ((w) ? vg1[h][_i] : vg0[h][_i]) : (voffA[_i] + (unsigned)((h) * hstep)); \
        __builtin_amdgcn_global_load_lds((const unsigned*)((const char*)(gbase) + _o), (LAS unsigned*)(lds + (bufoff) + ldsw + _i * 8192), 16, 0, 0); } } while (0)
#define PG8_LDA(dst, b, h) do { _Pragma("unroll") for (int m = 0; m < 4; ++m) _Pragma("unroll") for (int k = 0; k < 2; ++k) dst[m][k] = *(const LAS bf16x8*)(lds + PG8_SA(b, h) + aoff + m * 2048 + k * 1024); } while (0)
#define PG8_LDB(dst, b, h) do { _Pragma("unroll") for (int n = 0; n < 2; ++n) _Pragma("unroll") for (int k = 0; k < 2; ++k) dst[n][k] = *(const LAS bf16x8*)(lds + PG8_SB(b, h) + boff + n * 2048 + k * 1024); } while (0)
#define PG8_MMA(ai, bj, At, Bt) do { __builtin_amdgcn_s_setprio(1); _Pragma("unroll") for (int m = 0; m < 4; ++m) _Pragma("unroll") for (int n = 0; n < 2; ++n) _Pragma("unroll") for (int k = 0; k < 2; ++k) \
        acc[ai][bj][m][n] = __builtin_amdgcn_mfma_f32_16x16x32_bf16(Bt[n][k], At[m][k], acc[ai][bj][m][n], 0, 0, 0); __builtin_amdgcn_s_setprio(0); } while (0)
#define PG8_WAIT_V(n) asm volatile("s_waitcnt vmcnt(" #n ")" ::: "memory")
#define PG8_WAIT_L(n) asm volatile("s_waitcnt lgkmcnt(" #n ")" ::: "memory")
#define PG8_BAR __builtin_amdgcn_s_barrier()
#define PG8_SCHED __builtin_amdgcn_sched_barrier(0)
#define PG8_GOFF(dst, u) do { if (GATHER) { _Pragma("unroll") for (int _h = 0; _h < 2; ++_h) _Pragma("unroll") for (int _i = 0; _i < 2; ++_i) \
        dst[_h][_i] = (unsigned)(g.rows[(u).row0 + _h * HALF + RA[_i]] * K + CA[_i]) * 2u; } } while (0)
    Unit cur, nxt; int ui = 0;
    if (!S.next(0, cur)) return;
    f32x4 acc[2][2][4][2];
#pragma unroll
    for (int a = 0; a < 2; ++a)
#pragma unroll
        for (int b = 0; b < 2; ++b)
#pragma unroll
            for (int m = 0; m < 4; ++m)
#pragma unroll
                for (int n = 0; n < 2; ++n) acc[a][b][m][n] = (f32x4){0.f, 0.f, 0.f, 0.f};
    bf16x8 At[4][2], B0[2][2], B1[2][2];
    const char* cA = (const char*)g.A + (GATHER ? (size_t)0 : (size_t)cur.row0 * K * 2); const char* cB = (const char*)g.Bt + cur.boff;
    PG8_GOFF(vg0, cur);
#pragma unroll
    for (int _h = 0; _h < 2; ++_h)
#pragma unroll
        for (int _i = 0; _i < 2; ++_i) vg1[_h][_i] = vg0[_h][_i];
    PG8_STAGE(PG8_SB(0, 0), cB, voffB); PG8_STAGE_A(PG8_SA(0, 0), cA, 0, false); PG8_STAGE(PG8_SB(0, 1), cB + hstepB, voffB); PG8_STAGE_A(PG8_SA(0, 1), cA, 1, false);
    if (wr == 1) PG8_BAR;
    PG8_WAIT_V(4); PG8_BAR;
    PG8_STAGE(PG8_SB(1, 0), cB + kstepB, voffB); PG8_STAGE_A(PG8_SA(1, 0), cA + kstep, 0, false); PG8_STAGE(PG8_SB(1, 1), cB + hstepB + kstepB, voffB);
    PG8_WAIT_V(6); PG8_BAR;
    for (;;) {
        const bool has_next = S.next(ui + 1, nxt);
        if (has_next) PG8_GOFF(vg1, nxt);
        const char* nA = has_next ? (const char*)g.A + (GATHER ? (size_t)0 : (size_t)nxt.row0 * K * 2) : cA; const char* nB = has_next ? (const char*)g.Bt + nxt.boff : cB;
        const bool full = cur.nvalid > HALF;
        for (int t = 0; t < nt; t += 2) {
            const bool last = (t == nt - 2);
            const bool wn = last && has_next;
            const char* a1 = cA + (size_t)(t + 1) * kstep;
            const char* a2 = last ? nA : cA + (size_t)(t + 2) * kstep; const char* b2 = last ? nB : cB + (size_t)(t + 2) * kstepB;
            const char* a3 = a2 + kstep; const char* b3 = b2 + kstepB;
            PG8_LDB(B0, 0, 0); PG8_SCHED; PG8_LDA(At, 0, 0); PG8_STAGE_A(PG8_SA(1, 1), a1, 1, false);
            PG8_WAIT_L(8); PG8_BAR; PG8_WAIT_L(0); PG8_MMA(0, 0, At, B0); PG8_BAR; PG8_SCHED;
            PG8_LDB(B1, 0, 1); PG8_STAGE(PG8_SB(0, 0), b2, voffB);
            PG8_BAR; PG8_WAIT_L(0); PG8_MMA(0, 1, At, B1); PG8_BAR;
            if (full) PG8_LDA(At, 0, 1); PG8_STAGE_A(PG8_SA(0, 0), a2, 0, wn);
            PG8_BAR; PG8_WAIT_L(0); if (full) PG8_MMA(1, 0, At, B0); PG8_BAR; PG8_SCHED;
            PG8_STAGE(PG8_SB(0, 1), b2 + hstepB, voffB);
            PG8_WAIT_V(6); PG8_BAR; if (full) PG8_MMA(1, 1, At, B1); PG8_BAR;
            PG8_LDB(B0, 1, 0); PG8_SCHED; PG8_LDA(At, 1, 0); PG8_STAGE_A(PG8_SA(0, 1), a2, 1, wn);
            PG8_WAIT_L(8); PG8_BAR; PG8_WAIT_L(0); PG8_MMA(0, 0, At, B0); PG8_BAR; PG8_SCHED;
            PG8_LDB(B1, 1, 1); PG8_STAGE(PG8_SB(1, 0), b3, voffB);
            PG8_BAR; PG8_WAIT_L(0); PG8_MMA(0, 1, At, B1); PG8_BAR;
            if (full) PG8_LDA(At, 1, 1); PG8_STAGE_A(PG8_SA(1, 0), a3, 0, wn);
            PG8_BAR; PG8_WAIT_L(0); if (full) PG8_MMA(1, 0, At, B0); PG8_BAR; PG8_SCHED;
            PG8_STAGE(PG8_SB(1, 1), b3 + hstepB, voffB);
            PG8_WAIT_V(6); PG8_BAR; if (full) PG8_MMA(1, 1, At, B1); PG8_BAR;
        }
        { const unsigned long long e0_ = pacc ? __builtin_amdgcn_s_memrealtime() : 0ull; int fr_ = fr, fq_ = fq; asm volatile("" : "+v"(fr_), "+v"(fq_)); E(acc, cur, wr, wc, fr_, fq_); if (pacc) { asm volatile("s_waitcnt vmcnt(0)" ::: "memory"); *pacc += __builtin_amdgcn_s_memrealtime() - e0_; } }
        if (!has_next) break;
#pragma unroll
        for (int a = 0; a < 2; ++a)
#pragma unroll
            for (int b = 0; b < 2; ++b)
#pragma unroll
                for (int m = 0; m < 4; ++m)
#pragma unroll
                    for (int n = 0; n < 2; ++n) acc[a][b][m][n] = (f32x4){0.f, 0.f, 0.f, 0.f};
        cur = nxt; cA = nA; cB = nB; ++ui;
#pragma unroll
        for (int _h = 0; _h < 2; ++_h)
#pragma unroll
            for (int _i = 0; _i < 2; ++_i) vg0[_h][_i] = vg1[_h][_i];
    }
    PG8_WAIT_V(0);
    if (wr == 0) PG8_BAR;
    PG8_BAR;
#ifdef PROBE_CALL
    if (pacc_call) *pacc_call += __builtin_amdgcn_s_memrealtime() - c0_;
#endif
#undef PG8_SA
#undef PG8_SB
#undef PG8_STAGE
#undef PG8_STAGE_A
#undef PG8_LDA
#undef PG8_LDB
#undef PG8_MMA
#undef PG8_WAIT_V
#undef PG8_WAIT_L
#undef PG8_BAR
#undef PG8_SCHED
#undef PG8_GOFF
}

struct StaticOrder {
    int nM, nN, nwg, G, c, Kb;
    __device__ void init(int M, int N, int K, int G_, int c_) { nM = M / BM; nN = N / BM; nwg = nM * nN; G = G_; c = c_; Kb = K; }
    __device__ bool next(int i, Unit& u) const {
        const long L = (long)i * G + c; if (L >= nwg) return false;
        int wgid = (int)L; { const int NXCD = 8; const int q = nwg / NXCD, r = nwg % NXCD, xcd = wgid % NXCD, off = wgid / NXCD; wgid = (xcd < r ? xcd * (q + 1) : r * (q + 1) + (xcd - r) * q) + off; }
        const int WGM = 8; const int nig = WGM * nN, gid = wgid / nig, fm = gid * WGM, gsz = (nM - fm) < WGM ? (nM - fm) : WGM;
        u.row0 = (fm + ((wgid % nig) % gsz)) * BM; u.lrow = u.row0; u.pn = (wgid % nig) / gsz; u.nvalid = BM; u.aux = u.pn; u.kind = 0; u.boff = (unsigned)u.pn * (unsigned)(BM * 2) * (unsigned)Kb; return true;
    }
};
}
using pg8::Unit; using pg8::cvt_pk_bf16;
typedef const f32x4 (&AccRef)[2][2][4][2];

struct MoeOrder {
    const LAS unsigned* units; int ntile, nsub, G, c; unsigned ebytes;
    __device__ bool next(int i, Unit& u) const {
        const long L = (long)i * G + c; const int nun = ntile * nsub; if (L >= nun) return false;
        int idx = (int)L; { const int q = nun / 8, r = nun % 8, xcd = idx % 8, off = idx / 8; idx = (xcd < r ? xcd * (q + 1) : r * (q + 1) + (xcd - r) * q) + off; }
        const int tile = idx / nsub, sub = idx % nsub;
        const u32x4 d = *(const LAS u32x4*)(units + 4 * tile);
        u.row0 = (int)d.x; u.lrow = u.row0; u.pn = (int)d.y * nsub + sub; u.nvalid = (int)d.z; u.aux = sub; u.kind = 0; u.boff = d.y * ebytes + (unsigned)sub * 32768u; return true;
    }
};

struct EpiInT {
    static constexpr bool PERM = true;
    bf16_t* phyt; bf16_t* vt;
    __device__ __forceinline__ void operator()(AccRef acc, const Unit& u, int wr, int wc, int fr, int fq) const {
        const int pm = u.lrow >> 8, tb = u.pn * 256; const bool isctx = tb >= T;
        int b, nbase; if (!isctx) { b = tb >> 13; nbase = tb & (SEQ - 1); } else { b = (tb - T) >> 8; nbase = 0; }
        if (pm < 6 && isctx) return;
#pragma unroll
        for (int ai = 0; ai < 2; ++ai)
#pragma unroll
            for (int m = 0; m < 4; ++m) {
                const int f = u.lrow + ai * 128 + wr * 64 + m * 16 + fr;
                bf16_t* rowp = (pm < 6) ? phyt + ((size_t)(b * HYP + f) * SEQ + nbase) : vt + ((size_t)(b * HGW + (f - HYP)) * NEXT + (isctx ? 0 : CTXL) + nbase);
#pragma unroll
                for (int bj = 0; bj < 2; ++bj) { const int cu = bj * 128 + wc * 32 + 8 * fq; const f32x4 v0 = acc[ai][bj][m][0], v1 = acc[ai][bj][m][1];
                    u32x4 w; w.x = cvt_pk_bf16(v0[0], v0[1]); w.y = cvt_pk_bf16(v0[2], v0[3]); w.z = cvt_pk_bf16(v1[0], v1[1]); w.w = cvt_pk_bf16(v1[2], v1[3]);
                    *(u32x4*)(rowp + cu) = w; }
            }
    }
};
struct EpiInN {
    static constexpr bool PERM = true;
    bf16_t *q, *g, *sg1, *sg2; float *lf, *lb; const float* lbs;
    __device__ __forceinline__ void operator()(AccRef acc, const Unit& u, int wr, int wc, int fr, int fq) const {
        const int pn = u.pn; const bool isctx = u.lrow >= T;
        if (isctx && (pn < 2 || pn > 5)) return;
        float lbu[2][8];
        if (pn >= 2 && pn < 6) {
#pragma unroll
            for (int bj = 0; bj < 2; ++bj) { const float* lbp = lbs + (pn >= 4) * 512 + (pn & 1) * 256 + bj * 128 + wc * 32 + 8 * fq; const f32x4 l0 = *(const f32x4*)lbp, l1 = *(const f32x4*)(lbp + 4);
                lbu[bj][0] = l0[0]; lbu[bj][1] = l0[1]; lbu[bj][2] = l0[2]; lbu[bj][3] = l0[3]; lbu[bj][4] = l1[0]; lbu[bj][5] = l1[1]; lbu[bj][6] = l1[2]; lbu[bj][7] = l1[3]; } }
#pragma unroll
        for (int ai = 0; ai < 2; ++ai)
#pragma unroll
            for (int m = 0; m < 4; ++m) {
                const int r = u.lrow + ai * 128 + wr * 64 + m * 16 + fr;
                int b, nx; if (!isctx) { b = r >> 13; nx = CTXL + (r & (SEQ - 1)); } else { const int rr = r - T; b = rr >> 8; nx = rr & 255; }
#pragma unroll
                for (int bj = 0; bj < 2; ++bj) { const int cu = bj * 128 + wc * 32 + 8 * fq; const f32x4 v0 = acc[ai][bj][m][0], v1 = acc[ai][bj][m][1];
                    float x[8] = {v0[0], v0[1], v0[2], v0[3], v1[0], v1[1], v1[2], v1[3]};
                    if (pn >= 2 && pn < 6) {
                        const int dir = pn >= 4, col = (pn & 1) * 256 + cu;
                        float o[8];
#pragma unroll
                        for (int j = 0; j < 8; ++j) o[j] = __logf(lbu[bj][j] + (1.0f - lbu[bj][j]) * sigmoidf_(x[j]));
                        float* dst = (dir ? lb : lf) + ((size_t)(b * NEXT + nx) * HGW + col);
                        *(f32x4*)dst = (f32x4){o[0], o[1], o[2], o[3]}; *(f32x4*)(dst + 4) = (f32x4){o[4], o[5], o[6], o[7]};
                    } else {
                        bf16_t* dst;
                        if (pn < 2) { dst = q + (size_t)r * HGW + pn * 256 + cu;
#pragma unroll
                            for (int j = 0; j < 8; ++j) x[j] = siluf_(x[j]); }
                        else if (pn < 8) { dst = g + (size_t)r * HGW + (pn - 6) * 256 + cu;
#pragma unroll
                            for (int j = 0; j < 8; ++j) x[j] = siluf_(x[j]); }
                        else { dst = (pn < 12 ? sg1 + (size_t)r * D + (pn - 8) * 256 : sg2 + (size_t)r * D + (pn - 12) * 256) + cu;
#pragma unroll
                            for (int j = 0; j < 8; ++j) x[j] = sigmoidf_(x[j]); }
                        u32x4 w; w.x = cvt_pk_bf16(x[0], x[1]); w.y = cvt_pk_bf16(x[2], x[3]); w.z = cvt_pk_bf16(x[4], x[5]); w.w = cvt_pk_bf16(x[6], x[7]);
                        *(u32x4*)dst = w;
                    }
                }
            }
    }
};
struct EpiMerge1 {
    static constexpr bool PERM = false;
    const bf16_t* sg1; bf16_t* t1;
    __device__ __forceinline__ void operator()(AccRef acc, const Unit& u, int wr, int wc, int fr, int fq) const {
#pragma unroll
        for (int ai = 0; ai < 2; ++ai) { u32x2 s[4][2][2];
#pragma unroll
            for (int m = 0; m < 4; ++m) { const size_t ro = (size_t)(u.lrow + ai * 128 + wr * 64 + m * 16 + fr) * D + u.pn * 256 + wc * 32 + 4 * fq;
#pragma unroll
                for (int bj = 0; bj < 2; ++bj)
#pragma unroll
                    for (int n = 0; n < 2; ++n) s[m][bj][n] = *(const u32x2*)(sg1 + ro + bj * 128 + n * 16); }
#pragma unroll
            for (int m = 0; m < 4; ++m) { const size_t ro = (size_t)(u.lrow + ai * 128 + wr * 64 + m * 16 + fr) * D + u.pn * 256 + wc * 32 + 4 * fq;
#pragma unroll
                for (int bj = 0; bj < 2; ++bj)
#pragma unroll
                    for (int n = 0; n < 2; ++n) { const f32x4 a = acc[ai][bj][m][n]; const u32x2 sv = s[m][bj][n];
                        u32x2 w; w.x = cvt_pk_bf16(a[0] * bflo(sv.x), a[1] * bfhi(sv.x)); w.y = cvt_pk_bf16(a[2] * bflo(sv.y), a[3] * bfhi(sv.y)); *(u32x2*)(t1 + ro + bj * 128 + n * 16) = w; } } }
    }
};
struct EpiMerge2 {
    static constexpr bool PERM = false;
    const bf16_t* sg2; const bf16_t* t1; bf16_t* mb;
    __device__ __forceinline__ void operator()(AccRef acc, const Unit& u, int wr, int wc, int fr, int fq) const {
#pragma unroll
        for (int ai = 0; ai < 2; ++ai)
#pragma unroll
            for (int mh = 0; mh < 2; ++mh) { u32x2 s[2][2][2], p[2][2][2];
#pragma unroll
                for (int mm = 0; mm < 2; ++mm) { const size_t ro = (size_t)(u.lrow + ai * 128 + wr * 64 + (2 * mh + mm) * 16 + fr) * D + u.pn * 256 + wc * 32 + 4 * fq;
#pragma unroll
                    for (int bj = 0; bj < 2; ++bj)
#pragma unroll
                        for (int n = 0; n < 2; ++n) { s[mm][bj][n] = *(const u32x2*)(sg2 + ro + bj * 128 + n * 16); p[mm][bj][n] = *(const u32x2*)(t1 + ro + bj * 128 + n * 16); } }
#pragma unroll
                for (int mm = 0; mm < 2; ++mm) { const int m = 2 * mh + mm; const size_t ro = (size_t)(u.lrow + ai * 128 + wr * 64 + m * 16 + fr) * D + u.pn * 256 + wc * 32 + 4 * fq;
#pragma unroll
                    for (int bj = 0; bj < 2; ++bj)
#pragma unroll
                        for (int n = 0; n < 2; ++n) { const f32x4 a = acc[ai][bj][m][n]; const u32x2 pw = p[mm][bj][n]; const f32x4 pv = (f32x4){bflo(pw.x), bfhi(pw.x), bflo(pw.y), bfhi(pw.y)}; const u32x2 sv = s[mm][bj][n];
                            u32x2 w; w.x = cvt_pk_bf16(pv[0] + a[0] * bflo(sv.x), pv[1] + a[1] * bfhi(sv.x)); w.y = cvt_pk_bf16(pv[2] + a[2] * bflo(sv.y), pv[3] + a[3] * bfhi(sv.y));
                            *(u32x2*)(mb + ro + bj * 128 + n * 16) = w; } } }
    }
};
struct EpiWout {
    static constexpr bool PERM = false;
    const float* x; const float* posr; const float* posc; const float* ada; bf16_t* x1;
    __device__ __forceinline__ void operator()(AccRef acc, const Unit& u, int wr, int wc, int fr, int fq) const {
        const int b = u.lrow >> 13, cb = u.pn * 256 + wc * 32 + 4 * fq;
        f32x4 g1[2][2];
#pragma unroll
        for (int bj = 0; bj < 2; ++bj)
#pragma unroll
            for (int nn = 0; nn < 2; ++nn) g1[bj][nn] = *(const f32x4*)(ada + b * 6144 + 2 * D + cb + bj * 128 + nn * 16);
#pragma unroll
        for (int ai = 0; ai < 2; ++ai)
#pragma unroll
            for (int mh = 0; mh < 2; ++mh) { f32x4 xv[2][2][2];
#pragma unroll
                for (int mm = 0; mm < 2; ++mm) { const int r = u.lrow + ai * 128 + wr * 64 + (2 * mh + mm) * 16 + fr;
#pragma unroll
                    for (int bj = 0; bj < 2; ++bj)
#pragma unroll
                        for (int nn = 0; nn < 2; ++nn) xv[mm][bj][nn] = *(const f32x4*)(x + (size_t)r * D + cb + bj * 128 + nn * 16); }
#pragma unroll
                for (int mm = 0; mm < 2; ++mm) { f32x4 pe[2][2]; const int m = 2 * mh + mm;
                    const int r = u.lrow + ai * 128 + wr * 64 + m * 16 + fr, n = r & (SEQ - 1);
#pragma unroll
                    for (int bj = 0; bj < 2; ++bj)
#pragma unroll
                        for (int nn = 0; nn < 2; ++nn) { const int c = cb + bj * 128 + nn * 16;
                            pe[bj][nn] = (c < 512) ? *(const f32x4*)(posr + (n >> 6) * 512 + c) : *(const f32x4*)(posc + (n & 63) * 512 + (c - 512)); }
#pragma unroll
                    for (int bj = 0; bj < 2; ++bj)
#pragma unroll
                        for (int nn = 0; nn < 2; ++nn) { const f32x4 o = xv[mm][bj][nn] + pe[bj][nn] + g1[bj][nn] * acc[ai][bj][m][nn]; u32x2 w; w.x = pk2(o[0], o[1]); w.y = pk2(o[2], o[3]);
                            *(u32x2*)(x1 + (size_t)r * D + cb + bj * 128 + nn * 16) = w; } } }
    }
};
struct EpiLogit {
    static constexpr bool PERM = true;
    float* lg;
    __device__ __forceinline__ void operator()(AccRef acc, const Unit& u, int wr, int wc, int fr, int fq) const {
#pragma unroll
        for (int ai = 0; ai < 2; ++ai)
#pragma unroll
            for (int m = 0; m < 4; ++m) { float* rp = lg + (size_t)(u.lrow + ai * 128 + wr * 64 + m * 16 + fr) * NE + wc * 32 + 8 * fq;
#pragma unroll
                for (int bj = 0; bj < 2; ++bj) { *(f32x4*)(rp + bj * 128) = acc[ai][bj][m][0]; *(f32x4*)(rp + bj * 128 + 4) = acc[ai][bj][m][1]; } }
    }
};
struct EpiGU {
    static constexpr bool PERM = true;
    bf16_t* hout; const float* wrow;
    __device__ __forceinline__ void operator()(AccRef acc, const Unit& u, int wr, int wc, int fr, int fq) const {
        float wv[2][4];
#pragma unroll
        for (int ai = 0; ai < 2; ++ai)
#pragma unroll
            for (int m = 0; m < 4; ++m) { const int rl = ai * 128 + wr * 64 + m * 16 + fr; wv[ai][m] = (wrow && rl < u.nvalid) ? wrow[u.lrow + rl] : 1.0f; }
#pragma unroll
        for (int ai = 0; ai < 2; ++ai)
#pragma unroll
            for (int m = 0; m < 4; ++m) { const int rl = ai * 128 + wr * 64 + m * 16 + fr;
                if (rl < u.nvalid) { const f32x4 g0 = acc[ai][0][m][0], g1 = acc[ai][0][m][1], u0 = acc[ai][1][m][0] * wv[ai][m], u1 = acc[ai][1][m][1] * wv[ai][m];
                    u32x4 w; w.x = cvt_pk_bf16(siluf_(g0[0]) * u0[0], siluf_(g0[1]) * u0[1]); w.y = cvt_pk_bf16(siluf_(g0[2]) * u0[2], siluf_(g0[3]) * u0[3]);
                    w.z = cvt_pk_bf16(siluf_(g1[0]) * u1[0], siluf_(g1[1]) * u1[1]); w.w = cvt_pk_bf16(siluf_(g1[2]) * u1[2], siluf_(g1[3]) * u1[3]);
                    *(u32x4*)(hout + (size_t)(u.lrow + rl) * EH + u.aux * 128 + wc * 32 + 8 * fq) = w; } }
    }
};
template <bool HASW, bool FP8 = false> struct EpiDown {
    static constexpr bool PERM = true;
    bf16_t* yout; const float* wrow;
    __device__ __forceinline__ void operator()(AccRef acc, const Unit& u, int wr, int wc, int fr, int fq) const {
        char* base = (char*)yout + ((size_t)u.lrow * D + u.aux * 256 + wc * 32) * (FP8 ? 1 : 2);
        float wv[2][4];
#pragma unroll
        for (int ai = 0; ai < 2; ++ai)
#pragma unroll
            for (int m = 0; m < 4; ++m) { const int rl = ai * 128 + wr * 64 + m * 16 + fr; wv[ai][m] = (HASW && rl < u.nvalid) ? wrow[u.lrow + rl] : 1.0f; }
#pragma unroll
        for (int ai = 0; ai < 2; ++ai)
#pragma unroll
            for (int m = 0; m < 4; ++m) { const int rl = ai * 128 + wr * 64 + m * 16 + fr;
                if (rl < u.nvalid) { const float w_ = wv[ai][m];
                    const unsigned off = (unsigned)(rl * D + 8 * fq) * (FP8 ? 1u : 2u);
#pragma unroll
                    for (int bj = 0; bj < 2; ++bj) { const f32x4 v0 = acc[ai][bj][m][0] * w_, v1 = acc[ai][bj][m][1] * w_;
                        if (FP8) { int a = __builtin_amdgcn_cvt_pk_fp8_f32(v0[0], v0[1], 0, false); a = __builtin_amdgcn_cvt_pk_fp8_f32(v0[2], v0[3], a, true);
                            int c = __builtin_amdgcn_cvt_pk_fp8_f32(v1[0], v1[1], 0, false); c = __builtin_amdgcn_cvt_pk_fp8_f32(v1[2], v1[3], c, true);
                            *(u32x2*)(base + off + bj * 128) = (u32x2){(unsigned)a, (unsigned)c}; }
                        else { u32x4 w; w.x = cvt_pk_bf16(v0[0], v0[1]); w.y = cvt_pk_bf16(v0[2], v0[3]); w.z = cvt_pk_bf16(v1[0], v1[1]); w.w = cvt_pk_bf16(v1[2], v1[3]);
                            *(u32x4*)(base + off + bj * 256) = w; } } } }
    }
};

constexpr int RA1 = (int)((WS_A1 - WS_WINT) / (D * 2));
static_assert((WS_A1 - WS_WINT) % (D * 2) == 0, "A1 must sit a whole number of rows above WINT");
struct InOrder {
    int G, c;
    static constexpr int N0 = 6 * 64, N1 = 2 * 64, N2 = 64 * 16, N3 = 12, NU = N0 + N1 + N2 + N3;
    __device__ bool next(int i, Unit& u) const {
        const long L = (long)i * G + c; if (L >= NU) return false;
        const int xcd = (int)(L % 8), p = (int)(L / 8), nT = xcd < 4 ? 65 : 64, tb = xcd < 4 ? 65 * xcd : 260 + 64 * (xcd - 4);
        if (p >= nT + 129) return false;
        int pm, pn, kind;
        if (p < nT) { const int uu = tb + p; kind = 0;
            if (uu < 512) { const int g = uu >> 5, jj = uu & 31; pm = 4 * (g & 1) + (jj & 3); pn = 8 * (g >> 1) + (jj >> 2); }
            else { const int j = uu - 512; pm = 6 + (j >> 1); pn = 64 + (j & 1); } }
        else { const int v = 129 * xcd + (p - nT); kind = 1;
            if (v < 1024) { const int g = v >> 7, jj = v & 127; pm = 8 * g + (jj & 7); pn = jj >> 3; }
            else { const int j = v - 1024; pm = 64 + (j >> 2); pn = 2 + (j & 3); } }
        fill(u, kind, pm, pn); return true;
    }
    __device__ static void fill(Unit& u, int kind, int pm, int pn) {
        u.kind = kind; u.pn = pn; u.lrow = pm * 256; u.nvalid = 256; u.aux = pn;
        if (kind == 0) { u.row0 = pm * 256; u.boff = (unsigned)(RA1 + pn * 256) * (unsigned)(D * 2); }
        else { u.row0 = RA1 + pm * 256; u.boff = (unsigned)(2048 + pn * 256) * (unsigned)(D * 2); }
    }
};
struct CtxUnit {
    int idx;
    __device__ static int tile(int idx) { return idx < 4 ? (idx & 1) : ((idx - 4) >> 2); }
    __device__ bool next(int i, Unit& u) const { if (i) return false;
        if (idx < 4) InOrder::fill(u, 0, 6 + (idx >> 1), 64 + (idx & 1)); else InOrder::fill(u, 1, 64 + ((idx - 4) >> 2), 2 + ((idx - 4) & 3)); return true; }
};
struct EpiIn {
    static constexpr bool PERM = true;
    EpiInT t; EpiInN n;
    __device__ __forceinline__ void operator()(AccRef acc, const Unit& u, int wr, int wc, int fr, int fq) const { if (u.kind == 0) t(acc, u, wr, wc, fr, fq); else n(acc, u, wr, wc, fr, fq); }
};
struct P9Order {
    int G, c;
    __device__ bool next(int i, Unit& u) const {
        const long L = (long)i * G + c; if (L >= 192) return false; int idx = (int)L;
        { const int xcd = idx % 8, off = idx / 8; idx = xcd * 24 + off; }
        const int pm = idx / 3, k3 = idx % 3;
        u.row0 = pm * 256;
        if (k3 == 0) { u.kind = 0; u.pn = 0; u.aux = 0; u.boff = 0u; }
        else { u.kind = 1; u.pn = k3 - 1; u.aux = k3 - 1; u.boff = (unsigned)(WS_SHGUT - WS_ROUT) + (unsigned)(k3 - 1) * (unsigned)(256 * D * 2); }
        u.lrow = u.row0; u.nvalid = 256; return true;
    }
};
struct EpiP9 {
    static constexpr bool PERM = true;
    EpiLogit l; EpiGU g;
    __device__ __forceinline__ void operator()(AccRef acc, const Unit& u, int wr, int wc, int fr, int fq) const { if (u.kind == 0) l(acc, u, wr, wc, fr, fq); else g(acc, u, wr, wc, fr, fq); }
};

constexpr int RYHG = (int)((WS_YHG - WS_YHY) / (HYW * 2));
static_assert((WS_YHG - WS_YHY) % (HYW * 2) == 0 && WS_YHG > WS_YHY, "YHG must sit a whole number of rows above YHY");
struct MergeOrder {
    pg8::StaticOrder so;
    __device__ bool next(int i, Unit& u) const {
        if (!so.next(i >> 1, u)) return false;
        u.kind = i & 1;
        if (u.kind) { u.row0 += RYHG; u.boff += (unsigned)(WS_WHGT - WS_WHYT); }
        return true;
    }
};
struct EpiMerge {
    static constexpr bool PERM = false;
    EpiMerge1 a; EpiMerge2 b;
    __device__ __forceinline__ void operator()(AccRef acc, const Unit& u, int wr, int wc, int fr, int fq) const { if (u.kind == 0) a(acc, u, wr, wc, fr, fq); else b(acc, u, wr, wc, fr, fq); }
};
#define XB_TMO      128
#define XB_XCNT(j)  (256  + 64 * (j))
#define XB_XSUB(j)  (1280 + 64 * (j))
#define XB_XGEN(j)  (2304 + 64 * (j))
#define XB_TOP      3328
#define XB_TOPGEN   3392
#define XCD_BAR_WORDS 3456
#define XB_SPIN_CAP (1u << 18)

__device__ __forceinline__ unsigned xb_ld(unsigned* p)              { return __hip_atomic_load(p, __ATOMIC_RELAXED, __HIP_MEMORY_SCOPE_AGENT); }
__device__ __forceinline__ unsigned xb_add(unsigned* p, unsigned v) { return __hip_atomic_fetch_add(p, v, __ATOMIC_RELAXED, __HIP_MEMORY_SCOPE_AGENT); }
__device__ __forceinline__ unsigned xb_xcc_id() { return (unsigned)__builtin_amdgcn_s_getreg((3 << 11) | 20) & 0xFu; }
#define XB_SPIN(cond, bar) do { unsigned _sp = 0; while (cond) { __builtin_amdgcn_s_sleep(1); \
    if ((++_sp & 255u) == 0u) { if (xb_ld(&(bar)[XB_TMO])) break; if (_sp > XB_SPIN_CAP) { atomicAdd(&(bar)[XB_TMO], 1u); break; } } } } while (0)

struct XcdBarrier {
    unsigned* bar; unsigned x;
    volatile LAS unsigned* st;
};

__device__ __forceinline__ XcdBarrier xcd_barrier_post(unsigned* bar, volatile LAS unsigned* st) {
    XcdBarrier b; b.bar = bar; b.x = xb_xcc_id(); b.st = st;
    if (threadIdx.x == 0) (void)xb_add(&bar[XB_XCNT(b.x)], 1u);
    return b;
}
__device__ __forceinline__ void xcd_barrier_complete(unsigned* bar, unsigned x, unsigned& nloc, unsigned& nx) {
    const unsigned G = gridDim.x * gridDim.y * gridDim.z;
    unsigned sum, cnt, mine, sp = 0u;
    for (;;) {
        sum = 0u; cnt = 0u; mine = 0u;
#pragma unroll
        for (unsigned j = 0; j < 16; ++j) { const unsigned c = xb_ld(&bar[XB_XCNT(j)]); sum += c; cnt += (c > 0u) ? 1u : 0u; mine = (j == x) ? c : mine; }
        if (sum == G) break;
        __builtin_amdgcn_s_sleep(1);
        if ((++sp & 255u) == 0u) { if (xb_ld(&bar[XB_TMO])) break; if (sp > XB_SPIN_CAP) { atomicAdd(&bar[XB_TMO], 1u); break; } }
    }
    nloc = mine > 0u ? mine : 1u; nx = cnt > 0u ? cnt : 1u;
}

__device__ __forceinline__ void xcd_barrier(const XcdBarrier& b) {
    asm volatile("s_waitcnt vmcnt(0)" ::: "memory");
    __syncthreads();
    if (threadIdx.x == 0) {
        unsigned* bar = b.bar;
        __builtin_amdgcn_s_waitcnt(0);
        unsigned nloc = b.st[0], nx = b.st[1];
        if (nloc == 0u) { xcd_barrier_complete(bar, b.x, nloc, nx); b.st[0] = nloc; b.st[1] = nx; }
        const unsigned old = xb_add(&bar[XB_XSUB(b.x)], 1u);
        const unsigned gen = old / nloc;
        if (old + 1u == (gen + 1u) * nloc) {
            __builtin_amdgcn_fence(__ATOMIC_RELEASE, "agent");
            asm volatile("s_waitcnt vmcnt(0)" ::: "memory");
            const unsigned og = xb_add(&bar[XB_TOP], 1u);
            const unsigned tg = og / nx;
            if (og + 1u == (tg + 1u) * nx) xb_add(&bar[XB_TOPGEN], 1u);
            else XB_SPIN(xb_ld(&bar[XB_TOPGEN]) == tg, bar);
            __builtin_amdgcn_fence(__ATOMIC_ACQUIRE, "agent");
            xb_add(&bar[XB_XGEN(b.x)], 1u);
            asm volatile("s_waitcnt vmcnt(0)" ::: "memory");
        } else {
            XB_SPIN(xb_ld(&bar[XB_XGEN(b.x)]) == gen, bar);
            __builtin_amdgcn_fence(__ATOMIC_ACQUIRE, "agent");
            asm volatile("s_waitcnt vmcnt(0)" ::: "memory");
        }
    }
    __syncthreads();
}


struct Frame {
    LAS unsigned char* lds;
    const Params* p;
    unsigned char* ws;
    int tid, lane, wave, G, bx;
};
#define WSP(T_, off) ((T_*)(F.ws + (off)))

__device__ __forceinline__ void p0_transpose_item(const float* W, int N, bf16_t* WT, int K, int k0, int n0, int row0, LAS float* scr, int lane) {
#pragma unroll 8
    for (int i = 0; i < 32; ++i) { const int kk = 2 * i + (lane >> 5); scr[kk * 33 + (lane & 31)] = W[(size_t)(k0 + kk) * N + n0 + (lane & 31)]; }
    LDS_WAIT(); asm volatile("" ::: "memory");
    const int c = lane & 7;
#pragma unroll
    for (int j = 0; j < 4; ++j) { const int n = (lane >> 3) + 8 * j; const LAS float* s = scr + (8 * c) * 33 + n;
        u32x4 o; o.x = pk2(s[0 * 33], s[1 * 33]); o.y = pk2(s[2 * 33], s[3 * 33]); o.z = pk2(s[4 * 33], s[5 * 33]); o.w = pk2(s[6 * 33], s[7 * 33]);
        *(u32x4*)(WT + (size_t)(row0 + n) * K + k0 + 8 * c) = o; }
    LDS_WAIT(); asm volatile("" ::: "memory");
}
__device__ __forceinline__ int gu_row(int n0, int up) { return (n0 >> 7) * 256 + up * 128 + (n0 & 127); }

__device__ __forceinline__ void p0_transposes(Frame& F) {
    LAS float* scr = (LAS float*)(F.lds + F.wave * 16384);
    const int gw = (F.G - 1 - F.bx) * 8 + F.wave, NGW = F.G * 8;
    const float* const* in = F.p->in;
    constexpr int I_WIN_ = 16 * 192, I_WHY_ = 8 * 32, I_WHG_ = 8 * 32, I_WOUT_ = 16 * 32, I_R_ = 16 * 8, I_SG_ = 16 * 8, I_SU_ = 16 * 8, I_SD_ = 4 * 32;
    constexpr int I_W4_ = 64;
    constexpr int NSMALL = I_WIN_ + I_WHY_ + I_WHG_ + I_WOUT_ + I_R_ + I_SG_ + I_SU_ + I_SD_ + I_W4_;
    for (int it = gw; it < NSMALL; it += NGW) {
        int r = it;
        {
            if (r < I_WIN_) { const int kb = r / 192, nb = r % 192, n0 = nb * 32; const int f0 = (n0 >= 1536 && n0 < 2048) ? n0 + 512 : ((n0 >= 2048 && n0 < 2560) ? n0 - 512 : n0);
                p0_transpose_item(in[I_WIN], INC, WSP(bf16_t, WS_WINT), D, kb * 64, n0, f0, scr, F.lane); continue; } r -= I_WIN_;
            if (r < I_WHY_) { p0_transpose_item(in[I_WHY], D, WSP(bf16_t, WS_WHYT), HYW, (r / 32) * 64, (r % 32) * 32, (r % 32) * 32, scr, F.lane); continue; } r -= I_WHY_;
            if (r < I_WHG_) { p0_transpose_item(in[I_WHG], D, WSP(bf16_t, WS_WHGT), HGW, (r / 32) * 64, (r % 32) * 32, (r % 32) * 32, scr, F.lane); continue; } r -= I_WHG_;
            if (r < I_WOUT_) { p0_transpose_item(in[I_WOUT], D, WSP(bf16_t, WS_WOUTT), D, (r / 32) * 64, (r % 32) * 32, (r % 32) * 32, scr, F.lane); continue; } r -= I_WOUT_;
            if (r < I_R_) { p0_transpose_item(in[I_RW], NE, WSP(bf16_t, WS_ROUT), D, (r / 8) * 64, (r % 8) * 32, (r % 8) * 32, scr, F.lane); continue; } r -= I_R_;
            if (r < I_SG_) { p0_transpose_item(in[I_SG], EH, WSP(bf16_t, WS_SHGUT), D, (r / 8) * 64, (r % 8) * 32, gu_row((r % 8) * 32, 0), scr, F.lane); continue; } r -= I_SG_;
            if (r < I_SU_) { p0_transpose_item(in[I_SU], EH, WSP(bf16_t, WS_SHGUT), D, (r / 8) * 64, (r % 8) * 32, gu_row((r % 8) * 32, 1), scr, F.lane); continue; } r -= I_SU_;
            if (r < I_SD_) { p0_transpose_item(in[I_SD], D, WSP(bf16_t, WS_SHDT), EH, (r / 32) * 64, (r % 32) * 32, (r % 32) * 32, scr, F.lane); continue; } r -= I_SD_;
            p0_transpose_item(in[I_FW4], 2048, WSP(bf16_t, WS_W4T), 64, 0, r * 32, r * 32, scr, F.lane); continue;
        }
    }
}

template <int MODE  >
__device__ __forceinline__ void p0_x256_load(const float* W, int N, int k0, int n0, int tid, f32x4 (&v)[8]) {
    const int n4 = MODE ? ((tid >> 6) * 8 + (tid & 7)) : (tid & 63), kq = MODE ? ((tid >> 3) & 7) : (tid >> 6); const float* src = W + (size_t)(k0 + 8 * kq) * N + n0 + 4 * n4;
#pragma unroll
    for (int r = 0; r < 8; ++r) v[r] = __builtin_nontemporal_load((const f32x4*)(src + (size_t)r * N));
}
__device__ __forceinline__ void p0_x256_store(LAS unsigned char* ts, bf16_t* WT, int K, int k0, int row0, int mode, int tid, const f32x4 (&v)[8]) {
    const int n4 = tid & 63, kq = tid >> 6;
    __syncthreads();
#pragma unroll
    for (int i = 0; i < 4; ++i) { const int n = 4 * n4 + i;
        u32x4 o; o.x = pk2(v[0][i], v[1][i]); o.y = pk2(v[2][i], v[3][i]); o.z = pk2(v[4][i], v[5][i]); o.w = pk2(v[6][i], v[7][i]);
        *(LAS u32x4*)(ts + n * 128 + ((kq ^ (n4 & 7)) << 4)) = o; }
    __syncthreads();
#pragma unroll
    for (int q = 0; q < 4; ++q) { const int task = tid + 512 * q, n = task >> 3, part = task & 7;
        const u32x4 o = *(const LAS u32x4*)(ts + n * 128 + ((part ^ ((n >> 2) & 7)) << 4));
        const int row = mode == 0 ? row0 + n : ((n >> 7) * 256 + (mode - 1) * 128 + (n & 127));
        if (K < 0) *(u32x4*)(WT + (size_t)row * (-K) + k0 + 8 * part) = o;
        else *(u32x4*)(WT + (size_t)(k0 >> 6) * K + row * 64 + 8 * part) = o; }
}
__device__ __forceinline__ void p0_small_decode(const float* const* in, unsigned char* ws, int item, const float*& W, int& N, bf16_t*& WT, int& K, int& k0, int& n0, int& row0, int& mode) {
    int r = item; mode = 0;
    if (r < 384) { const int kb = r / 24, nb = r % 24; W = in[I_WIN]; N = INC; WT = (bf16_t*)(ws + WS_WINT); K = -D; k0 = kb * 64; n0 = nb * 256;
        row0 = (n0 >= 1536 && n0 < 2048) ? n0 + 512 : ((n0 >= 2048 && n0 < 2560) ? n0 - 512 : n0); return; } r -= 384;
    if (r < 32) { W = in[I_WHY]; N = D; WT = (bf16_t*)(ws + WS_WHYT); K = -HYW; k0 = (r >> 2) * 64; n0 = (r & 3) * 256; row0 = n0; return; } r -= 32;
    if (r < 32) { W = in[I_WHG]; N = D; WT = (bf16_t*)(ws + WS_WHGT); K = -HGW; k0 = (r >> 2) * 64; n0 = (r & 3) * 256; row0 = n0; return; } r -= 32;
    if (r < 64) { W = in[I_WOUT]; N = D; WT = (bf16_t*)(ws + WS_WOUTT); K = -D; k0 = (r >> 2) * 64; n0 = (r & 3) * 256; row0 = n0; return; } r -= 64;
    if (r < 16) { W = in[I_RW]; N = NE; WT = (bf16_t*)(ws + WS_ROUT); K = -D; k0 = r * 64; n0 = 0; row0 = 0; return; } r -= 16;
    if (r < 16) { W = in[I_SG]; N = EH; WT = (bf16_t*)(ws + WS_SHGUT); K = -D; k0 = r * 64; n0 = 0; row0 = 0; mode = 1; return; } r -= 16;
    if (r < 16) { W = in[I_SU]; N = EH; WT = (bf16_t*)(ws + WS_SHGUT); K = -D; k0 = r * 64; n0 = 0; row0 = 0; mode = 2; return; } r -= 16;
    W = in[I_SD]; N = D; WT = (bf16_t*)(ws + WS_SHDT); K = -EH; k0 = (r >> 2) * 64; n0 = (r & 3) * 256; row0 = n0;
}
__device__ __forceinline__ void p0_small_transposes(Frame& F) {
    int tid = F.tid; asm volatile("" : "+v"(tid));
    for (int it = F.bx; it < 576; it += F.G) {
        const float* W; int N, K, k0, n0, row0, mode; bf16_t* WT; f32x4 v[8];
        p0_small_decode(F.p->in, F.ws, it, W, N, WT, K, k0, n0, row0, mode);
        p0_x256_load<0>(W, N, k0, n0, tid, v);
        p0_x256_store(F.lds, WT, K, k0, row0, mode, tid, v);
    }
}
__device__ __forceinline__ void p0_x256_decode(const float* const* in, unsigned char* ws, int item, const float*& W, int& N, bf16_t*& WT, int& K, int& k0, int& n0, int& mode) {
    const int e = item < NE * 32 ? (item >> 5) : ((item - NE * 32) >> 4), r = item < NE * 32 ? (item & 31) : 32 + ((item - NE * 32) & 15);
    if (r < 16) { W = in[I_EG] + (size_t)e * D * EH; N = EH; WT = (bf16_t*)(ws + WS_EGUT) + (size_t)e * 512 * D; K = 512 * 64; k0 = r * 64; n0 = 0; mode = 1; }
    else if (r < 32) { W = in[I_EU] + (size_t)e * D * EH; N = EH; WT = (bf16_t*)(ws + WS_EGUT) + (size_t)e * 512 * D; K = 512 * 64; k0 = (r - 16) * 64; n0 = 0; mode = 2; }
    else { const int q = r - 32; W = in[I_ED] + (size_t)e * EH * D; N = D; WT = (bf16_t*)(ws + WS_EDT) + (size_t)e * D * EH; K = D * 64; k0 = (q >> 2) * 64; n0 = (q & 3) * 256; mode = 0; }
}
struct XpState { f32x4 v[8]; int it, end, stride; bool live; };
__device__ __forceinline__ void xp_issue(XpState& s, const float* const* in, unsigned char* ws, int tid) {
    s.live = s.it < s.end;
    if (s.live) { const float* W; int N, K, k0, n0, mode; bf16_t* WT; p0_x256_decode(in, ws, s.it, W, N, WT, K, k0, n0, mode); p0_x256_load<1>(W, N, k0, n0, tid, s.v); }
}
__device__ __forceinline__ void xp_finish(XpState& s, const float* const* in, unsigned char* ws, int tid) {
    if (s.live) { const float* W; int N, K, k0, n0, mode; bf16_t* WT; p0_x256_decode(in, ws, s.it, W, N, WT, K, k0, n0, mode);
        const int n4 = (tid >> 6) * 8 + (tid & 7), kq = (tid >> 3) & 7;
#pragma unroll
        for (int i = 0; i < 4; ++i) { const int n = 4 * n4 + i; const int row = mode == 0 ? n0 + n : ((n >> 7) * 256 + (mode - 1) * 128 + (n & 127));
            u32x4 o; o.x = pk2(s.v[0][i], s.v[1][i]); o.y = pk2(s.v[2][i], s.v[3][i]); o.z = pk2(s.v[4][i], s.v[5][i]); o.w = pk2(s.v[6][i], s.v[7][i]);
            *(u32x4*)(WT + (size_t)(k0 >> 6) * K + row * 64 + 8 * kq) = o; }
        s.it += s.stride; s.live = false; }
}
__device__ __forceinline__ void xp_step(XpState& s, const float* const* in, unsigned char* ws, int tid) { xp_finish(s, in, ws, tid); xp_issue(s, in, ws, tid); }
constexpr int XP_BG = 28;
constexpr int XP_K0 = 0;
constexpr int NCONV = 34;
constexpr int NCONV2 = 38, XP_P13 = NCONV2 * 72;
__device__ __forceinline__ void conv_loop(const float* const* in, unsigned char* ws, int first, int stride, int end, int tid) {
    XpState a, b, c, d; a.stride = b.stride = c.stride = d.stride = 4 * stride; a.end = b.end = c.end = d.end = end; a.live = b.live = c.live = d.live = false;
    a.it = first; b.it = first + stride; c.it = first + 2 * stride; d.it = first + 3 * stride;
    xp_issue(a, in, ws, tid); xp_issue(b, in, ws, tid); xp_issue(c, in, ws, tid);
    while (a.live) {
        xp_issue(d, in, ws, tid); xp_finish(a, in, ws, tid);
        if (!b.live) break; xp_issue(a, in, ws, tid); xp_finish(b, in, ws, tid);
        if (!c.live) break; xp_issue(b, in, ws, tid); xp_finish(c, in, ws, tid);
        if (!d.live) break; xp_issue(c, in, ws, tid); xp_finish(d, in, ws, tid);
    }
}
__device__ __forceinline__ void conv_loop2(Frame& F, int first, int stride, int end) {
    const float* const* in = F.p->in; unsigned char* ws = F.ws;
    int tid = F.tid; asm volatile("" : "+v"(tid));
    const bool loader = tid < 256; const int lt = tid & 255;
    int nitem = first < end ? (end - 1 - first) / stride + 1 : 0;
    __syncthreads();
    if (loader) {
        const int n4 = lt & 63, kq = lt >> 6;
        f32x4 va[16], vb[16];
#define CL_LOAD(dst, item) do { const float* W; int N, K, k0, n0, mode; bf16_t* WT; p0_x256_decode(in, ws, (item), W, N, WT, K, k0, n0, mode); \
            const float* src = W + (size_t)(k0 + 16 * kq) * N + n0 + 4 * n4; _Pragma("unroll") for (int r = 0; r < 16; ++r) dst[r] = __builtin_nontemporal_load((const f32x4*)(src + (size_t)r * N)); } while (0)
#define CL_PUT(src, buf) do { LAS unsigned char* ts = F.lds + (buf) * 32768; _Pragma("unroll") for (int i = 0; i < 4; ++i) { const int n = 4 * n4 + i; _Pragma("unroll") for (int h = 0; h < 2; ++h) { \
            u32x4 o; o.x = pk2(src[8 * h][i], src[8 * h + 1][i]); o.y = pk2(src[8 * h + 2][i], src[8 * h + 3][i]); o.z = pk2(src[8 * h + 4][i], src[8 * h + 5][i]); o.w = pk2(src[8 * h + 6][i], src[8 * h + 7][i]); \
            *(LAS u32x4*)(ts + n * 128 + (((2 * kq + h) ^ (n4 & 7)) << 4)) = o; } } } while (0)
        if (nitem > 0) CL_LOAD(va, first);
        if (nitem > 1) CL_LOAD(vb, first + stride);
        for (int i = 0; i < nitem; i += 2) {
            CL_PUT(va, 0); __syncthreads();
            if (i + 2 < nitem) CL_LOAD(va, first + (i + 2) * stride);
            if (i + 1 >= nitem) break;
            CL_PUT(vb, 1); __syncthreads();
            if (i + 3 < nitem) CL_LOAD(vb, first + (i + 3) * stride);
        }
#undef CL_LOAD
#undef CL_PUT
    } else {
        for (int i = 0; i < nitem; ++i) {
            __syncthreads();
            const float* W; int N, K, k0, n0, mode; bf16_t* WT; p0_x256_decode(in, ws, first + i * stride, W, N, WT, K, k0, n0, mode);
            const LAS unsigned char* ts = F.lds + (i & 1) * 32768;
#pragma unroll
            for (int q = 0; q < 8; ++q) { const int task = lt + 256 * q, n = task >> 3, part = task & 7;
                const u32x4 o = *(const LAS u32x4*)(ts + n * 128 + ((part ^ ((n >> 2) & 7)) << 4));
                const int row = mode == 0 ? n0 + n : ((n >> 7) * 256 + (mode - 1) * 128 + (n & 127));
                *(u32x4*)(WT + (size_t)(k0 >> 6) * K + row * 64 + 8 * part) = o; }
        }
    }
    __syncthreads();
}

__device__ __forceinline__ void p0_expert_transposes(Frame& F) {
    int tid = F.tid; asm volatile("" : "+v"(tid));
    constexpr int NIT = NE * 48;
    int it = F.bx + XP_BG * F.G; if (it >= NIT) return;
    const int p0end = (F.G == 256) ? 256 * (XP_BG + XP_K0) : NIT;
    if (it >= p0end) return;
    const float* W; int N, K, k0, n0, mode; bf16_t* WT;
    const float* W2; int N2, K2, k2, n2, mode2; bf16_t* WT2;
    f32x4 va[8], vb[8];
    p0_x256_decode(F.p->in, F.ws, it, W, N, WT, K, k0, n0, mode);
    p0_x256_load<0>(W, N, k0, n0, tid, va);
    for (;;) {
        __builtin_amdgcn_s_waitcnt(0);
        int nx = it + F.G; bool has = nx < p0end;
        if (has) { p0_x256_decode(F.p->in, F.ws, nx, W2, N2, WT2, K2, k2, n2, mode2); p0_x256_load<0>(W2, N2, k2, n2, tid, vb); }
        p0_x256_store(F.lds, WT, K, k0, n0, mode, tid, va);
        if (!has) break;
        it = nx;
        __builtin_amdgcn_s_waitcnt(0);
        nx = it + F.G; has = nx < p0end;
        if (has) { p0_x256_decode(F.p->in, F.ws, nx, W, N, WT, K, k0, n0, mode); p0_x256_load<0>(W, N, k0, n0, tid, va); }
        p0_x256_store(F.lds, WT2, K2, k2, n2, mode2, tid, vb);
        if (!has) break;
        it = nx;
    }
}

constexpr int ADA_KC = 8;
__device__ __forceinline__ void p0_ada_item(Frame& F, int item) {
    const int kc = item / 12, cb = item % 12, c4 = F.tid & 127, ks = F.tid >> 7;
    const float* in_c = F.p->in[I_C]; const float* in_cc = F.p->in[I_CCTX]; const float* w = F.p->in[I_ADAW];
    LAS float* sv = (LAS float*)F.lds;
    LAS float* pr = sv + 384;
    __syncthreads();
    for (int i = F.tid; i < 384; i += 512) { const int wh = i >> 7, k = kc * 128 + (i & 127); sv[i] = siluf_(wh == 0 ? in_c[k] : (wh == 1 ? in_c[D + k] : in_cc[k])); }
    __syncthreads();
    f32x4 a0 = (f32x4){0.f, 0.f, 0.f, 0.f}, a1 = a0, a2 = a0;
    const float* wp = w + (size_t)(kc * 128 + ks * 32) * 6144 + cb * 512 + 4 * c4;
#pragma unroll 16
    for (int k = 0; k < 32; ++k) { const f32x4 wv = *(const f32x4*)(wp + (size_t)k * 6144); const int kk = ks * 32 + k; a0 += wv * sv[kk]; a1 += wv * sv[128 + kk]; a2 += wv * sv[256 + kk]; }
    *(LAS f32x4*)(pr + (ks * 3 + 0) * 512 + 4 * c4) = a0; *(LAS f32x4*)(pr + (ks * 3 + 1) * 512 + 4 * c4) = a1; *(LAS f32x4*)(pr + (ks * 3 + 2) * 512 + 4 * c4) = a2;
    __syncthreads();
    for (int i = F.tid; i < 3 * 512; i += 512) { const int wh = i >> 9, col = i & 511;
        WSP(float, WS_ADAP)[(size_t)(kc * 3 + wh) * 6144 + cb * 512 + col] = (pr[(0 * 3 + wh) * 512 + col] + pr[(1 * 3 + wh) * 512 + col]) + (pr[(2 * 3 + wh) * 512 + col] + pr[(3 * 3 + wh) * 512 + col]); }
}

__device__ __forceinline__ void p0_filter_item(Frame& F, int item, XpState& xp) {
    LAS float* zb = (LAS float*)F.lds;
    LAS float* ab1 = zb + 32 * 36;
    LAS float* ab2 = ab1 + 32 * 64;
    LAS float* w1s = ab2 + 32 * 64;
    LAS float* w2s = w1s + 33 * 64;
    LAS float* w3s = w2s + 64 * 64;
    const float* const* in = F.p->in; const int t0 = item * 32; int tid = F.tid; asm volatile("" : "+v"(tid));
    __syncthreads();
    for (int idx = tid; idx < 33 * 64; idx += 512) w1s[idx] = in[I_FW1][idx];
    for (int idx = tid; idx < 64 * 64; idx += 512) { w2s[idx] = in[I_FW2][idx]; w3s[idx] = in[I_FW3][idx]; }
    for (int idx = tid; idx < 32 * 33; idx += 512) { const int t = idx / 33, e = idx % 33; const float tf = (float)(t0 + t); float v;
        if (e == 0) v = tf / (float)(SEQ - 1);
        else { const int k = (e - 1) & 15; const float band = 1e-4f + (float)k * ((15.0f - 1e-4f) / 15.0f); float sn, cs; sincospif(2.0f * tf * band / (float)SEQ, &sn, &cs); v = (e <= 16) ? cs : -sn; }
        zb[t * 36 + e] = v; }
    __syncthreads();
    {
        const int t = tid >> 4, jj = tid & 15;
#pragma unroll 1
        for (int q = 0; q < 4; ++q) { const int j = jj + 16 * q; float s = in[I_FB1][j];
#pragma unroll
            for (int e = 0; e < 33; ++e) s += zb[t * 36 + e] * w1s[e * 64 + j];
            ab1[t * 64 + j] = sinf(in[I_FFREQ][j] * s); }
    }
    __syncthreads();
    { const int t = tid >> 4, jj = tid & 15;
#pragma unroll 1
        for (int q = 0; q < 4; ++q) { const int j = jj + 16 * q; float s = in[I_FB2][j];
#pragma unroll 16
            for (int e = 0; e < 64; ++e) s += ab1[t * 64 + e] * w2s[e * 64 + j];
            ab2[t * 64 + j] = sinf(in[I_FFREQ][j] * s); }
    }
    __syncthreads();
    { const int t = tid >> 4, jj = tid & 15;
#pragma unroll 1
        for (int q = 0; q < 4; ++q) { const int j = jj + 16 * q; float s = in[I_FB3][j];
#pragma unroll 16
            for (int e = 0; e < 64; ++e) s += ab2[t * 64 + e] * w3s[e * 64 + j];
            ab1[t * 64 + j] = sinf(in[I_FFREQ][j] * s); }
    }
    __syncthreads();
    { bf16_t* a3 = WSP(bf16_t, WS_A3) + (size_t)t0 * 64;
        const int t = tid >> 4, j4 = (tid & 15) * 4; const f32x4 v = *(const LAS f32x4*)(ab1 + t * 64 + j4);
        *(u32x2*)(a3 + t * 64 + j4) = (u32x2){pk2(v[0], v[1]), pk2(v[2], v[3])}; }
    (void)xp;
}
__device__ __forceinline__ void filter_out_item(Frame& F, int item) {
    const int t0 = item * 32, lane = F.lane, lr = lane & 15, lq = lane >> 4, w = F.wave;
    const bf16_t* a3 = WSP(bf16_t, WS_A3); const bf16_t* w4t = WSP(bf16_t, WS_W4T); bf16_t* hf = WSP(bf16_t, WS_HF);
    bf16x8 af[2][2];
#pragma unroll
    for (int tt = 0; tt < 2; ++tt)
#pragma unroll
        for (int ks = 0; ks < 2; ++ks) af[tt][ks] = *(const bf16x8*)(a3 + (size_t)(t0 + 16 * tt + lr) * 64 + 32 * ks + 8 * lq);
    const float MIND = -3.0701134573253945f, MAXD = -15.350567286626973f;
#pragma unroll 4
    for (int i = 0; i < 16; ++i) { const int nt = w * 16 + i, n = 16 * nt + lr;
        const bf16x8 b0 = *(const bf16x8*)(w4t + (size_t)n * 64 + 8 * lq), b1 = *(const bf16x8*)(w4t + (size_t)n * 64 + 32 + 8 * lq);
        const float delta = fabsf(MIND + (MAXD - MIND) * ((float)(n & 511) / 511.0f));
#pragma unroll
        for (int tt = 0; tt < 2; ++tt) { f32x4 acc = (f32x4){0.f, 0.f, 0.f, 0.f};
            acc = MFMA16(af[tt][0], b0, acc); acc = MFMA16(af[tt][1], b1, acc);
            const int tb = t0 + 16 * tt + 4 * lq; float dc[4];
#pragma unroll
            for (int k = 0; k < 4; ++k) dc[k] = __expf(-((float)(tb + k) / (float)(SEQ - 1)) * delta);
            *(u32x2*)(hf + (size_t)n * SEQ + tb) = (u32x2){pk2(acc[0] * dc[0], acc[1] * dc[1]), pk2(acc[2] * dc[2], acc[3] * dc[3])}; } }
}

__device__ __forceinline__ void p0_tables(Frame& F, int item) {
    if (item < 48) {
        const int idx = item * 2048 + F.tid * 4;
        for (int k = 0; k < 4; ++k) { const int id = idx + k; if (id >= 192 * 512) break;
            const int row = id >> 9, col = id & 511, i = col & 255; const float omega = 1.0f / powf(10000.0f, (float)i / 256.0f);
            const float pos = (float)(row < 128 ? row : row - 128); const float ang = pos * omega;
            const float v = (col < 256) ? sinf(ang) : cosf(ang);
            if (row < 128) WSP(float, WS_POSR)[row * 512 + col] = v; else WSP(float, WS_POSC)[(row - 128) * 512 + col] = v; }
    } else {
        for (int id = F.tid; id < 1024; id += 512) { const float l0 = F.p->in[I_LBL][id], l1 = F.p->in[I_LBL][1024 + id];
            WSP(float, WS_LBS)[id] = 1.0f / (1.0f + expf(l1 - l0)); }
    }
}

__device__ __forceinline__ void phase0(Frame& F, unsigned long long* pa = nullptr, int pmode = 0) {
    const unsigned long long q0_ = pa ? __builtin_amdgcn_s_memrealtime() : 0ull;
    XpState xp; xp.stride = F.G; xp.it = F.bx + XP_BG * F.G; xp.end = (F.G == 256) ? 256 * (XP_BG + XP_K0) : 0; xp.live = false;
    for (int it = F.bx; it < 401; it += F.G) {
        asm volatile("" : "+v"(F.tid));
        if (it < 96) p0_ada_item(F, it);
        else if (it < 352) p0_filter_item(F, it - 96, xp);
        else p0_tables(F, it - 352);
    }
    __syncthreads();
    p0_transposes(F);
    if (pa && pmode == 0) { asm volatile("s_waitcnt vmcnt(0)" ::: "memory"); *pa += __builtin_amdgcn_s_memrealtime() - q0_; }
    const unsigned long long q1_ = pa ? __builtin_amdgcn_s_memrealtime() : 0ull;
    { int tid = F.tid; xp_finish(xp, F.p->in, F.ws, tid); while (xp.it < xp.end) { xp_issue(xp, F.p->in, F.ws, tid); xp_finish(xp, F.p->in, F.ws, tid); } }
    __syncthreads();
    if (F.G != 256) p0_expert_transposes(F);
    if (pa && pmode == 1) { asm volatile("s_waitcnt vmcnt(0)" ::: "memory"); *pa += __builtin_amdgcn_s_memrealtime() - q1_; }
}

__device__ __forceinline__ void phase1(Frame& F) {
    const float* adap = WSP(float, WS_ADAP); const float* adab = F.p->in[I_ADAB];
    { const int gid = F.bx * 512 + F.tid; if (gid < 3 * 6144) { const int wh = gid / 6144, col = gid % 6144; float s = adab[col];
#pragma unroll
        for (int kc = 0; kc < ADA_KC; ++kc) s += adap[(size_t)(kc * 3 + wh) * 6144 + col]; WSP(float, WS_ADA)[gid] = s; } }
    LAS float* md = (LAS float*)F.lds;
    __syncthreads();
    for (int id = F.tid; id < 3 * 2048; id += 512) { const int wh = id >> 11, col = id & 2047; float s = adab[col];
#pragma unroll
        for (int kc = 0; kc < ADA_KC; ++kc) s += adap[(size_t)(kc * 3 + wh) * 6144 + col]; md[id] = s; }
    __syncthreads();
    const float* x = F.p->in[I_X]; const float* ctx = F.p->in[I_CTX]; const float* g1 = F.p->in[I_N1G];
    const float* posr = WSP(float, WS_POSR); const float* posc = WSP(float, WS_POSC); bf16_t* a1 = WSP(bf16_t, WS_A1);
    const int lane = F.lane;
#define P1_GG() f32x4 ggv[4]; _Pragma("unroll") for (int j = 0; j < 4; ++j) ggv[j] = *(const f32x4*)(g1 + 256 * j + 4 * lane)
#define P1_NR 8
#define P1_ROWS4(r0) do { f32x4 v[P1_NR][4]; const int wh = (r0) < T ? ((r0) >> 13) : 2; \
        _Pragma("unroll") for (int q = 0; q < P1_NR; ++q) { const int r = (r0) + q; \
            if ((r0) < T) { const int n = r & (SEQ - 1); const f32x4* xr = (const f32x4*)(x + (size_t)r * D) + lane; \
                _Pragma("unroll") for (int j = 0; j < 4; ++j) { const int c = 256 * j + 4 * lane; const f32x4 pe = (c < 512) ? *(const f32x4*)(posr + (n >> 6) * 512 + c) : *(const f32x4*)(posc + (n & 63) * 512 + c - 512); v[q][j] = xr[64 * j] + pe; } \
            } else { const f32x4* xr = (const f32x4*)(ctx + (size_t)(r - T) * D) + lane; \
                _Pragma("unroll") for (int j = 0; j < 4; ++j) v[q][j] = xr[64 * j]; } } \
        _Pragma("unroll") for (int q = 0; q < P1_NR; ++q) { float ss = 0.f; \
            _Pragma("unroll") for (int j = 0; j < 4; ++j) ss += (v[q][j][0] * v[q][j][0] + v[q][j][1] * v[q][j][1]) + (v[q][j][2] * v[q][j][2] + v[q][j][3] * v[q][j][3]); \
            const float rs = rsqrtf(wave_sum(ss) * (1.0f / D) + EPS); \
            u32x2* o8 = (u32x2*)(a1 + (size_t)((r0) + q) * D) + lane; \
            _Pragma("unroll") for (int j = 0; j < 4; ++j) { const int c = 256 * j + 4 * lane; const f32x4 gg = ggv[j]; \
                const f32x4 sh = *(const LAS f32x4*)(md + wh * 2048 + c), sc = *(const LAS f32x4*)(md + wh * 2048 + 1024 + c); \
                const f32x4 y = v[q][j] * rs * gg * (sc + 1.0f) + sh; \
                u32x2 w; w.x = pk2(y[0], y[1]); w.y = pk2(y[2], y[3]); o8[64 * j] = w; } } } while (0)
    { const int gw = F.bx * 8 + F.wave, NGW = F.G * 8; P1_GG();
        for (int r0 = gw * P1_NR; r0 < T; r0 += NGW * P1_NR) P1_ROWS4(r0);
#undef P1_NR
#define P1_NR 1
        for (int r0 = T + gw; r0 < MA; r0 += NGW) P1_ROWS4(r0); }
    for (int it = F.bx; it < SEQ / 32; it += F.G) filter_out_item(F, it);
#undef P1_ROWS4
#undef P1_NR
#undef P1_GG
}

__device__ __forceinline__ void phase_h2(Frame& F) {
    const bf16_t* x1 = WSP(bf16_t, WS_X1B); const float* g2 = F.p->in[I_N2G]; const float* ada = WSP(float, WS_ADA); bf16_t* h2 = WSP(bf16_t, WS_H2);
    const int gw = F.bx * 8 + F.wave, NGW = F.G * 8, lane = F.lane;
    f32x4 ggv[4];
#pragma unroll
    for (int j = 0; j < 4; ++j) ggv[j] = *(const f32x4*)(g2 + 256 * j + 4 * lane);
    const bool al = (F.G == 256); const int vw = ((F.bx & 7) * 32 + (F.bx >> 3)) * 8 + F.wave;
    for (int r0 = al ? vw * 8 : gw * 4, it_ = 0; al ? it_ < 2 : r0 < T; r0 += al ? 4 : NGW * 4, ++it_) { const int b = r0 >> 13;
        f32x4 v[4][4], shv[4], scv[4];
#pragma unroll
        for (int j = 0; j < 4; ++j) { const int c = 256 * j + 4 * lane; shv[j] = *(const f32x4*)(ada + b * 6144 + 3 * D + c); scv[j] = *(const f32x4*)(ada + b * 6144 + 4 * D + c); }
#pragma unroll
        for (int q = 0; q < 4; ++q) { const u32x2* xr = (const u32x2*)(x1 + (size_t)(r0 + q) * D) + lane;
#pragma unroll
            for (int j = 0; j < 4; ++j) { const u32x2 w = xr[64 * j]; v[q][j] = (f32x4){bflo(w.x), bfhi(w.x), bflo(w.y), bfhi(w.y)}; } }
#pragma unroll
        for (int q = 0; q < 4; ++q) { float ss = 0.f;
#pragma unroll
            for (int j = 0; j < 4; ++j) ss += (v[q][j][0] * v[q][j][0] + v[q][j][1] * v[q][j][1]) + (v[q][j][2] * v[q][j][2] + v[q][j][3] * v[q][j][3]);
            const float rs = rsqrtf(wave_sum(ss) * (1.0f / D) + EPS);
            u32x2* o8 = (u32x2*)(h2 + (size_t)(r0 + q) * D) + lane;
#pragma unroll
            for (int j = 0; j < 4; ++j) { const f32x4 gg = ggv[j], sh = shv[j], sc = scv[j];
                const f32x4 y = v[q][j] * rs * gg * (sc + 1.0f) + sh;
                u32x2 w; w.x = pk2(y[0], y[1]); w.y = pk2(y[2], y[3]); o8[64 * j] = w; } }
    }
}
constexpr int FPAD = 17920;
__device__ __forceinline__ int fphys(int i) { return i + (i >> 4) + ((i >> 9) << 4); }
__device__ constexpr float TWC[16] = {1.0f, 0.98078528040323044913f, 0.92387953251128675613f, 0.83146961230254523708f, 0.70710678118654752440f, 0.55557023301960222474f, 0.38268343236508977173f, 0.19509032201612826785f,
                                      0.0f, -0.19509032201612826785f, -0.38268343236508977173f, -0.55557023301960222474f, -0.70710678118654752440f, -0.83146961230254523708f, -0.92387953251128675613f, -0.98078528040323044913f};
__device__ constexpr float TWS[16] = {0.0f, 0.19509032201612826785f, 0.38268343236508977173f, 0.55557023301960222474f, 0.70710678118654752440f, 0.83146961230254523708f, 0.92387953251128675613f, 0.98078528040323044913f,
                                      1.0f, 0.98078528040323044913f, 0.92387953251128675613f, 0.83146961230254523708f, 0.70710678118654752440f, 0.55557023301960222474f, 0.38268343236508977173f, 0.19509032201612826785f};
__host__ __device__ constexpr int brev_c(int x, int bits) { int r = 0; for (int i = 0; i < bits; ++i) r = (r << 1) | ((x >> i) & 1); return r; }

typedef f32x2 cpx;
__device__ __forceinline__ cpx cmul(cpx a, cpx w) { return (cpx){a.x, a.x} * w + (cpx){a.y, a.y} * (cpx){-w.y, w.x}; }
template <int S0, int R, bool INV, bool ZHI = false, bool OLO = false>
__device__ __forceinline__ void fft_pass(LAS cpx* X, int tid) {
    constexpr int LOW = 14 - S0 - R, NR = 1 << R, NTASK = (1 << (14 - R)) / 512;
    asm volatile("" : "+v"(tid));
#pragma unroll 1
    for (int task = 0; task < NTASK; ++task) {
        const int g = tid + 512 * task;
        const int blo = g & ((1 << LOW) - 1), bhi = g >> LOW;
        const int base = (bhi << (LOW + R)) | blo;
        cpx v[NR];
#pragma unroll
        for (int j = 0; j < NR; ++j) { if (ZHI && j >= NR / 2) v[j] = (cpx){0.f, 0.f}; else v[j] = X[fphys(base | (j << LOW))]; }
        cpx w0 = (cpx){1.f, 0.f};
        if (LOW > 0) { float s, c; sincospif(-(float)blo * (1.0f / (float)(1 << (13 - S0))), &s, &c); w0 = (cpx){c, INV ? -s : s}; }
        if (INV && LOW > 0) {
            cpx cw = w0;
#pragma unroll
            for (int m = 1; m < NR; ++m) { const int j = brev_c(m, R); v[j] = cmul(v[j], cw); if (m + 1 < NR) cw = cmul(cw, w0); }
        }
        if (!INV) {
#pragma unroll
            for (int q = 0; q < R; ++q) { const int hj = 1 << (R - 1 - q);
#pragma unroll
                for (int j = 0; j < NR; ++j) { if (j & hj) continue; const int k32 = (j & (hj - 1)) << (5 - R + q);
                    cpx d;
                    if (ZHI && q == 0) d = v[j];
                    else { const cpx a = v[j], bb = v[j + hj]; v[j] = a + bb; d = a - bb; }
                    if (k32 == 0) v[j + hj] = d;
                    else if (k32 == 8) v[j + hj] = (cpx){d.y, -d.x};
                    else v[j + hj] = cmul(d, (cpx){TWC[k32], -TWS[k32]}); } }
        } else {
#pragma unroll
            for (int q = R - 1; q >= 0; --q) { const int hj = 1 << (R - 1 - q);
#pragma unroll
                for (int j = 0; j < NR; ++j) { if (j & hj) continue; const int k32 = (j & (hj - 1)) << (5 - R + q);
                    const cpx p = v[j], bb = v[j + hj]; cpx t;
                    if (k32 == 0) t = bb;
                    else if (k32 == 8) t = (cpx){-bb.y, bb.x};
                    else t = cmul(bb, (cpx){TWC[k32], TWS[k32]});
                    v[j] = p + t; if (!(OLO && q == 0)) v[j + hj] = p - t; } }
        }
        if (!INV && LOW > 0) {
            cpx cw = w0;
#pragma unroll
            for (int m = 1; m < NR; ++m) { const int j = brev_c(m, R); v[j] = cmul(v[j], cw); if (m + 1 < NR) cw = cmul(cw, w0); }
        }
#pragma unroll
        for (int j = 0; j < NR; ++j) { if (OLO && j >= NR / 2) continue; X[fphys(base | (j << LOW))] = v[j]; }
    }
}
#define XP_HOOK() xp_step(xp, F.p->in, F.ws, tid)
template <bool ZHI> __device__ __forceinline__ void fft_fwd(Frame& F, XpState& xp, LAS cpx* X, int tid) {
    fft_pass<0, 5, false, ZHI>(X, tid); __syncthreads(); XP_HOOK(); fft_pass<5, 5, false>(X, tid); __syncthreads(); XP_HOOK(); fft_pass<10, 4, false>(X, tid); __syncthreads(); XP_HOOK();
}
__device__ __forceinline__ void fft_inv(Frame& F, XpState& xp, LAS cpx* X, int tid) {
    fft_pass<10, 4, true>(X, tid); __syncthreads(); XP_HOOK(); fft_pass<5, 5, true>(X, tid); __syncthreads(); XP_HOOK(); fft_pass<0, 5, true, false, true>(X, tid); __syncthreads(); XP_HOOK();
}
struct SC8 { u32x4 c; unsigned l, r; };
__device__ __forceinline__ SC8 sconv8_load(const bf16_t* p, int n) {
    SC8 s; s.c = *(const u32x4*)(p + n); s.l = n > 0 ? (unsigned)p[n - 1] : 0u; s.r = n + 8 < SEQ ? (unsigned)p[n + 8] : 0u; return s;
}
__device__ __forceinline__ void sconv8_eval(const SC8& s, float w0, float w1, float w2, float bias, float (&o)[8]) {
    float v[10]; v[0] = bf2f(s.l); v[1] = bflo(s.c.x); v[2] = bfhi(s.c.x); v[3] = bflo(s.c.y); v[4] = bfhi(s.c.y); v[5] = bflo(s.c.z); v[6] = bfhi(s.c.z); v[7] = bflo(s.c.w); v[8] = bfhi(s.c.w); v[9] = bf2f(s.r);
#pragma unroll
    for (int i = 0; i < 8; ++i) o[i] = w0 * v[i] + w1 * v[i + 1] + w2 * v[i + 2] + bias;
}
__device__ __forceinline__ void hyena_item(Frame& F, int c, XpState& xp) {
    LAS cpx* X = (LAS cpx*)F.lds; LAS float* red = (LAS float*)(F.lds + (size_t)FPAD * 8);
    int tid = F.tid; asm volatile("" : "+v"(tid));
    const bf16_t* hf = WSP(bf16_t, WS_HF);
    __syncthreads();
    float s0 = 0.f, s1 = 0.f;
    {
        f32x4 fa[4], fb[4], ba[4], bb[4];
#pragma unroll
        for (int it = 0; it < 4; ++it) { const int j = 4 * (tid + 512 * it);
            const u32x2 w0 = *(const u32x2*)(hf + (size_t)c * SEQ + j), w1 = *(const u32x2*)(hf + (size_t)(1024 + c) * SEQ + j), w2 = *(const u32x2*)(hf + (size_t)(512 + c) * SEQ + j), w3 = *(const u32x2*)(hf + (size_t)(1536 + c) * SEQ + j);
            fa[it] = (f32x4){bflo(w0.x), bfhi(w0.x), bflo(w0.y), bfhi(w0.y)}; fb[it] = (f32x4){bflo(w1.x), bfhi(w1.x), bflo(w1.y), bfhi(w1.y)};
            ba[it] = (f32x4){bflo(w2.x), bfhi(w2.x), bflo(w2.y), bfhi(w2.y)}; bb[it] = (f32x4){bflo(w3.x), bfhi(w3.x), bflo(w3.y), bfhi(w3.y)}; }
#pragma unroll
        for (int it = 0; it < 4; ++it) { const int j = 4 * (tid + 512 * it);
#pragma unroll
            for (int i = 0; i < 4; ++i) { X[fphys(j + i)] = (cpx){fa[it][i], fb[it][i]}; s0 += fabsf(fa[it][i]); s1 += fabsf(fb[it][i]);
                const int m = j + i; if (m > 0) { X[fphys(FFTN - m)] = (cpx){ba[it][i], bb[it][i]}; s0 += fabsf(ba[it][i]); s1 += fabsf(bb[it][i]); } } }
        if (tid == 0) X[fphys(SEQ)] = (cpx){0.f, 0.f};
    }
    s0 = wave_sum(s0); s1 = wave_sum(s1);
    if (F.lane == 0) { red[F.wave] = s0; red[8 + F.wave] = s1; }
    __syncthreads();
    float S0 = 0.f, S1 = 0.f;
#pragma unroll
    for (int w = 0; w < 8; ++w) { S0 += red[w]; S1 += red[8 + w]; }
    fft_fwd<false>(F, xp, X, tid);
    unsigned* ks = WSP(unsigned, WS_KS) + (size_t)F.bx * 2 * FFTN;
    { const float i0 = 1.0f / S0, i1 = 1.0f / S1, sk0 = F.p->in[I_HSKIP][c], sk1 = F.p->in[I_HSKIP][512 + c];
#pragma unroll 8
        for (int it = 0; it < 32; ++it) { const int p = tid + 512 * it; const int k = (int)(__brev((unsigned)p) >> 18); const int pp = (int)(__brev((unsigned)((FFTN - k) & (FFTN - 1))) >> 18);
            const cpx A = X[fphys(p)], B = X[fphys(pp)];
            const float k1r = 0.5f * (A.x + B.x), k1i = 0.5f * (A.y - B.y), k2r = 0.5f * (A.y + B.y), k2i = -0.5f * (A.x - B.x);
            ks[p] = pkh2(k1r * i0 + sk0, k1i * i0); ks[FFTN + p] = pkh2(k2r * i1 + sk1, k2i * i1); } }
    __syncthreads();
    const bf16_t* ph = WSP(bf16_t, WS_PHYT); const float* cw = F.p->in[I_HCW]; const float* cb = F.p->in[I_HCB];
    { const float w0 = cw[c], w1 = cw[HYP + c], w2 = cw[2 * HYP + c], bs = cb[c];
        SC8 sa[2], sb[2];
#pragma unroll
        for (int it = 0; it < 2; ++it) { const int n = 8 * (tid + 512 * it); sa[it] = sconv8_load(ph + (size_t)c * SEQ, n); sb[it] = sconv8_load(ph + (size_t)(HYP + c) * SEQ, n); }
#pragma unroll
        for (int it = 0; it < 2; ++it) { const int n = 8 * (tid + 512 * it); float a[8], b[8]; sconv8_eval(sa[it], w0, w1, w2, bs, a); sconv8_eval(sb[it], w0, w1, w2, bs, b);
#pragma unroll
            for (int i = 0; i < 8; ++i) X[fphys(n + i)] = (cpx){a[i], b[i]}; } }
    __syncthreads();
    fft_fwd<true>(F, xp, X, tid);
    { unsigned kk[32]; const float invN = 1.0f / (float)FFTN;
#pragma unroll
        for (int it = 0; it < 32; ++it) kk[it] = ks[tid + 512 * it];
#pragma unroll
        for (int it = 0; it < 32; ++it) { const int q = fphys(tid + 512 * it); X[q] = cmul(X[q], (cpx){h2f((unsigned short)(kk[it] & 0xffffu)) * invN, h2f((unsigned short)(kk[it] >> 16)) * invN}); } }
    __syncthreads();
    fft_inv(F, xp, X, tid);
    { const int col = HYW + c; const float w0 = cw[col], w1 = cw[HYP + col], w2 = cw[2 * HYP + col], bs = cb[col];
        SC8 sa[2], sb[2];
#pragma unroll
        for (int it = 0; it < 2; ++it) { const int n = 8 * (tid + 512 * it); sa[it] = sconv8_load(ph + (size_t)col * SEQ, n); sb[it] = sconv8_load(ph + (size_t)(HYP + col) * SEQ, n); }
#pragma unroll
        for (int it = 0; it < 2; ++it) { const int n = 8 * (tid + 512 * it); float a[8], b[8]; sconv8_eval(sa[it], w0, w1, w2, bs, a); sconv8_eval(sb[it], w0, w1, w2, bs, b);
#pragma unroll
            for (int i = 0; i < 8; ++i) { const int q = fphys(n + i); X[q] = X[q] * (cpx){a[i], b[i]}; } } }
    __syncthreads();
    fft_fwd<true>(F, xp, X, tid);
    { unsigned kk[32]; const float invN = 1.0f / (float)FFTN;
#pragma unroll
        for (int it = 0; it < 32; ++it) kk[it] = ks[FFTN + tid + 512 * it];
#pragma unroll
        for (int it = 0; it < 32; ++it) { const int q = fphys(tid + 512 * it); X[q] = cmul(X[q], (cpx){h2f((unsigned short)(kk[it] & 0xffffu)) * invN, h2f((unsigned short)(kk[it] >> 16)) * invN}); } }
    __syncthreads();
    fft_inv(F, xp, X, tid);
    { const int col = 2 * HYW + c; const float w0 = cw[col], w1 = cw[HYP + col], w2 = cw[2 * HYP + col], bs = cb[col];
        bf16_t* yt = WSP(bf16_t, WS_YHYT);
        SC8 sa[2], sb[2]; u32x4 oa[2], ob[2];
#pragma unroll
        for (int it = 0; it < 2; ++it) { const int n = 8 * (tid + 512 * it); sa[it] = sconv8_load(ph + (size_t)col * SEQ, n); sb[it] = sconv8_load(ph + (size_t)(HYP + col) * SEQ, n); }
#pragma unroll
        for (int it = 0; it < 2; ++it) { const int n = 8 * (tid + 512 * it); float a[8], b[8]; sconv8_eval(sa[it], w0, w1, w2, bs, a); sconv8_eval(sb[it], w0, w1, w2, bs, b);
            cpx y[8];
#pragma unroll
            for (int i = 0; i < 8; ++i) y[i] = X[fphys(n + i)];
            oa[it] = (u32x4){pk2(y[0].x * a[0], y[1].x * a[1]), pk2(y[2].x * a[2], y[3].x * a[3]), pk2(y[4].x * a[4], y[5].x * a[5]), pk2(y[6].x * a[6], y[7].x * a[7])};
            ob[it] = (u32x4){pk2(y[0].y * b[0], y[1].y * b[1]), pk2(y[2].y * b[2], y[3].y * b[3]), pk2(y[4].y * b[4], y[5].y * b[5]), pk2(y[6].y * b[6], y[7].y * b[7])}; }
#pragma unroll
        for (int it = 0; it < 2; ++it) { const int n = 8 * (tid + 512 * it);
            *(u32x4*)(yt + (size_t)c * SEQ + n) = oa[it]; *(u32x4*)(yt + (size_t)(HYW + c) * SEQ + n) = ob[it]; } }
}

__device__ __forceinline__ bf16x8 lds_frag(const LAS bf16_t* base, int row, int stride, int k) { return *(const LAS bf16x8*)(base + row * stride + k); }

__device__ __forceinline__ void hg_delta_items(Frame& F) {
    LAS float* segtot = (LAS float*)F.lds;
    LAS bf16_t* Kt = (LAS bf16_t*)(F.lds + 4096);
    LAS bf16_t* VTs = (LAS bf16_t*)(F.lds + 4096 + 18432);
    const int tid = F.tid, d = 2 * (tid & 63), seg = tid >> 6, lane = F.lane;
    f32x2 lf[8]; u32x4 tv[2];
#define HGD_LOAD(item_) do { const int chain_ = (item_) / NCH_EXT, j_ = (item_) % NCH_EXT, dir_ = chain_ & 1, h_ = (chain_ >> 1) & 3, b_ = chain_ >> 3; \
        const int cj_ = dir_ == 0 ? j_ : (j_ < 4 ? 3 - j_ : 135 - j_), n0_ = cj_ * 64; \
        const float* lfp_ = (dir_ ? WSP(float, WS_LB) : WSP(float, WS_LF)) + ((size_t)(b_ * NEXT + n0_) * HGW + h_ * 128 + d); \
        _Pragma("unroll") for (int i = 0; i < 8; ++i) lf[i] = *(const f32x2*)(lfp_ + (size_t)(8 * seg + i) * HGW); \
        const bf16_t* vt_ = WSP(bf16_t, WS_VT) + ((size_t)(b_ * HGW + h_ * 128) * NEXT + n0_); \
        _Pragma("unroll") for (int q = 0; q < 2; ++q) { const int piece = tid + 512 * q, e = piece >> 3, part = piece & 7; tv[q] = *(const u32x4*)(vt_ + (size_t)e * NEXT + part * 8); } } while (0)
    int item = F.bx;
    if (item < NAITEM) HGD_LOAD(item);
#pragma unroll 1
    for (; item < NAITEM; item += F.G) {
        const int chain = item / NCH_EXT, dir = chain & 1;
        f32x2 tot = (f32x2){0.f, 0.f};
#pragma unroll
        for (int i = 0; i < 8; ++i) tot += lf[i];
        __syncthreads();
        *(LAS f32x2*)(segtot + seg * 128 + d) = tot;
#pragma unroll
        for (int q = 0; q < 2; ++q) { const int piece = tid + 512 * q, e = piece >> 3, part = piece & 7; *(LAS u32x4*)(VTs + e * 72 + part * 8) = tv[q]; }
        __syncthreads();
        f32x2 later = (f32x2){0.f, 0.f}, total = later;
#pragma unroll
        for (int s = 0; s < 8; ++s) { const f32x2 v = *(const LAS f32x2*)(segtot + s * 128 + d); total += v; if (dir == 0 ? (s > seg) : (s < seg)) later += v; }
        f32x2 E[8];
        if (dir == 0) { f32x2 run = later;
#pragma unroll
            for (int i = 7; i >= 0; --i) { E[i] = run; run += lf[i]; } }
        else { f32x2 run = later;
#pragma unroll
            for (int i = 0; i < 8; ++i) { E[i] = run; run += lf[i]; } }
        float k0[8], k1[8];
#pragma unroll
        for (int i = 0; i < 8; ++i) { k0[i] = (1.0f - __expf(lf[i].x)) * __expf(E[i].x); k1[i] = (1.0f - __expf(lf[i].y)) * __expf(E[i].y); }
        *(LAS u32x4*)(Kt + d * 72 + 8 * seg) = (u32x4){pk2(k0[0], k0[1]), pk2(k0[2], k0[3]), pk2(k0[4], k0[5]), pk2(k0[6], k0[7])};
        *(LAS u32x4*)(Kt + (d + 1) * 72 + 8 * seg) = (u32x4){pk2(k1[0], k1[1]), pk2(k1[2], k1[3]), pk2(k1[4], k1[5]), pk2(k1[6], k1[7])};
        if (item + F.G < NAITEM) HGD_LOAD(item + F.G);
        if (seg == 0) *(f32x2*)(WSP(float, WS_DECAY) + (size_t)item * 128 + d) = (f32x2){__expf(total.x), __expf(total.y)};
        __syncthreads();
        const int w = F.wave, lr = lane & 15, lq = lane >> 4;
        f32x4 acc[8];
#pragma unroll
        for (int et = 0; et < 8; ++et) acc[et] = (f32x4){0.f, 0.f, 0.f, 0.f};
#pragma unroll
        for (int ksi = 0; ksi < 2; ++ksi) { const bf16x8 a = lds_frag(Kt, 16 * w + lr, 72, 32 * ksi + 8 * lq);
#pragma unroll
            for (int et = 0; et < 8; ++et) acc[et] = MFMA16(a, lds_frag(VTs, 16 * et + lr, 72, 32 * ksi + 8 * lq), acc[et]); }
        bf16_t* dl = WSP(bf16_t, WS_DELTA) + (size_t)item * 16384;
#pragma unroll
        for (int et = 0; et < 8; ++et) { const int e = 16 * et + lr, d0 = 16 * w + 4 * lq;
            u32x2 o; o.x = pk2(acc[et][0], acc[et][1]); o.y = pk2(acc[et][2], acc[et][3]); *(u32x2*)(dl + e * 128 + d0) = o; }
    }
#undef HGD_LOAD
}

__device__ __forceinline__ void hg_scan(Frame& F) {
    for (int gid = F.bx * 512 + F.tid; gid < NCHAIN * 8192; gid += F.G * 512) {
        const int chain = gid >> 13, idx = gid & 8191, dd = (2 * idx) & 127;
        const unsigned* dl = WSP(unsigned, WS_DELTA) + (size_t)chain * NCH_EXT * 8192 + idx;
        const float* dc = WSP(float, WS_DECAY) + (size_t)chain * NCH_EXT * 128 + dd;
        unsigned* ss = WSP(unsigned, WS_SST) + (size_t)chain * NCH_LAT * 8192 + idx;
        float s0 = 0.f, s1 = 0.f;
        constexpr int SB = 22;
        unsigned dv[SB], dw[SB]; f32x2 cv[SB], cw[SB];
#pragma unroll
        for (int u = 0; u < SB; ++u) { dv[u] = dl[(size_t)u * 8192]; cv[u] = *(const f32x2*)(dc + (size_t)u * 128); }
#pragma unroll 1
        for (int j0 = 0; j0 < NCH_EXT; j0 += SB) {
            const bool more = j0 + SB < NCH_EXT;
            if (more) {
#pragma unroll
                for (int u = 0; u < SB; ++u) { dw[u] = dl[(size_t)(j0 + SB + u) * 8192]; cw[u] = *(const f32x2*)(dc + (size_t)(j0 + SB + u) * 128); } }
#pragma unroll
            for (int u = 0; u < SB; ++u) { const int j = j0 + u;
                if (j >= 4) ss[(size_t)(j - 4) * 8192] = pk2(s0, s1);
                s0 = cv[u].x * s0 + bflo(dv[u]); s1 = cv[u].y * s1 + bfhi(dv[u]); }
#pragma unroll
            for (int u = 0; u < SB; ++u) { dv[u] = dw[u]; cv[u] = cw[u]; }
        }
    }
}

__device__ __forceinline__ void yhy_load(Frame& F, int item, u32x4 (&tv)[8]) {
    const int b = item >> 7, nb = item & 127, tid = F.tid;
    const bf16_t* src = WSP(bf16_t, WS_YHYT) + (size_t)b * HYW * SEQ + nb * 64;
#pragma unroll
    for (int q = 0; q < 8; ++q) { const int piece = tid + 512 * q, c = piece >> 3, part = piece & 7; tv[q] = *(const u32x4*)(src + (size_t)c * SEQ + part * 8); }
}
__device__ __forceinline__ void yhy_finish(Frame& F, int item, const u32x4 (&tv)[8]) {
    const int b = item >> 7, nb = item & 127, tid = F.tid;
    LAS bf16_t* ts = (LAS bf16_t*)F.lds;
    __syncthreads();
#pragma unroll
    for (int q = 0; q < 8; ++q) { const int piece = tid + 512 * q, c = piece >> 3, part = piece & 7; *(LAS u32x4*)(ts + c * 72 + part * 8) = tv[q]; }
    __syncthreads();
    bf16_t* dst = WSP(bf16_t, WS_YHY) + (size_t)(b * SEQ + nb * 64) * HYW;
#pragma unroll
    for (int q = 0; q < 8; ++q) { const int task = tid + 512 * q, n = task & 63, cg = task >> 6;
        unsigned v[8];
#pragma unroll
        for (int i = 0; i < 8; ++i) v[i] = ts[(8 * cg + i) * 72 + n];
        *(u32x4*)(dst + (size_t)n * HYW + 8 * cg) = (u32x4){v[0] | (v[1] << 16), v[2] | (v[3] << 16), v[4] | (v[5] << 16), v[6] | (v[7] << 16)}; }
}
__device__ __forceinline__ void yhy_transpose_item(Frame& F, int item) { u32x4 tv[8]; yhy_load(F, item, tv); yhy_finish(F, item, tv); }

__device__ __forceinline__ void hg_out_items(Frame& F) {
    LAS float* segtot = (LAS float*)F.lds;
    LAS float* bref = (LAS float*)(F.lds + 4096);
    LAS float* red = (LAS float*)(F.lds + 4608);
    LAS bf16_t* Qd = (LAS bf16_t*)(F.lds + 5120);
    LAS bf16_t* Kd = (LAS bf16_t*)(F.lds + 22528);
    LAS bf16_t* Qb = (LAS bf16_t*)(F.lds + 39936);
    LAS bf16_t* VTs = (LAS bf16_t*)(F.lds + 57344);
    LAS bf16_t* Ss = (LAS bf16_t*)(F.lds + 75776);
    LAS bf16_t* att = (LAS bf16_t*)(F.lds + 110592);
    int tid = F.tid; const int w = F.wave, tt = w & 3, eh = w >> 2;
    int d = 2 * (tid & 63), seg = tid >> 6, lane = tid & 63, lr = lane & 15, lq = lane >> 4;
    u32x4 sv[4], tv[2]; f32x2 lf[8]; unsigned qw[8];
#define HG_LOAD_DIR(item_, dir_) do { const int b_ = (item_) >> 9, h_ = ((item_) >> 7) & 3, nc_ = (item_) & 127, chain_ = (b_ * 4 + h_) * 2 + (dir_), jlat_ = (dir_) == 0 ? nc_ : 127 - nc_; \
        const bf16_t* sp_ = WSP(bf16_t, WS_SST) + (size_t)(chain_ * NCH_LAT + jlat_) * 16384; \
        _Pragma("unroll") for (int q = 0; q < 4; ++q) { const int piece = tid + 512 * q, e = piece >> 4, part = piece & 15; sv[q] = *(const u32x4*)(sp_ + e * 128 + part * 8); } \
        const float* lfp_ = ((dir_) ? WSP(float, WS_LB) : WSP(float, WS_LF)) + ((size_t)(b_ * NEXT + CTXL + nc_ * 64) * HGW + h_ * 128 + d); \
        _Pragma("unroll") for (int i = 0; i < 8; ++i) lf[i] = *(const f32x2*)(lfp_ + (size_t)(8 * seg + i) * HGW); } while (0)
#define HG_LOAD_HEAD(item_) do { const int b_ = (item_) >> 9, h_ = ((item_) >> 7) & 3, nc_ = (item_) & 127; \
        const bf16_t* qp_ = WSP(bf16_t, WS_Q) + ((size_t)(b_ * SEQ + nc_ * 64) * HGW + h_ * 128 + d); \
        _Pragma("unroll") for (int i = 0; i < 8; ++i) qw[i] = *(const unsigned*)(qp_ + (size_t)(8 * seg + i) * HGW); \
        const bf16_t* vt_ = WSP(bf16_t, WS_VT) + ((size_t)(b_ * HGW + h_ * 128) * NEXT + CTXL + nc_ * 64); \
        _Pragma("unroll") for (int q = 0; q < 2; ++q) { const int piece = tid + 512 * q, e = piece >> 3, part = piece & 7; tv[q] = *(const u32x4*)(vt_ + (size_t)e * NEXT + part * 8); } } while (0)
    constexpr int NITEM = NB * 4 * NCH_LAT;
    int item = F.bx;
    if (item < NITEM) { HG_LOAD_HEAD(item); HG_LOAD_DIR(item, 0); }
#pragma unroll 1
    for (; item < NITEM; item += F.G) {
    asm volatile("" : "+v"(tid)); d = 2 * (tid & 63); seg = tid >> 6; lane = tid & 63; lr = lane & 15; lq = lane >> 4;
    const int b = item >> 9, h = (item >> 7) & 3, nc = item & 127;
    const int r0 = b * SEQ + nc * 64;
    float ngv[4]; bf16_t gr[4][4];
    { const float* ng = F.p->in[I_HGNG]; const bf16_t* gp = WSP(bf16_t, WS_G);
#pragma unroll
      for (int i = 0; i < 4; ++i) ngv[i] = ng[16 * (4 * eh + i) + lr];
#pragma unroll
      for (int r = 0; r < 4; ++r)
#pragma unroll
          for (int i = 0; i < 4; ++i) gr[r][i] = gp[(size_t)(r0 + 16 * tt + 4 * lq + r) * HGW + h * 128 + 16 * (4 * eh + i) + lr]; }
    __syncthreads();
#pragma unroll
    for (int q = 0; q < 2; ++q) { const int piece = tid + 512 * q, e = piece >> 3, part = piece & 7; *(LAS u32x4*)(VTs + e * 72 + part * 8) = tv[q]; }
    f32x4 acc[4];
#pragma unroll
    for (int i = 0; i < 4; ++i) acc[i] = (f32x4){0.f, 0.f, 0.f, 0.f};
#pragma unroll 1
    for (int dir = 0; dir < 2; ++dir) {
        __syncthreads();
        {
#pragma unroll
            for (int q = 0; q < 4; ++q) { const int piece = tid + 512 * q, e = piece >> 4, part = piece & 15; *(LAS u32x4*)(Ss + e * 136 + part * 8) = sv[q]; } }
        f32x2 qv[8], tot = (f32x2){0.f, 0.f};
#pragma unroll
        for (int i = 0; i < 8; ++i) { qv[i] = (f32x2){bflo(qw[i]), bfhi(qw[i])}; tot += lf[i]; }
        *(LAS f32x2*)(segtot + seg * 128 + d) = tot;
        __syncthreads();
        f32x2 off = (f32x2){0.f, 0.f};
#pragma unroll
        for (int s = 0; s < 8; ++s) { const f32x2 v = *(const LAS f32x2*)(segtot + s * 128 + d); if (dir == 0 ? (s < seg) : (s > seg)) off += v; }
        f32x2 bb[8];
        if (dir == 0) { f32x2 run = off;
#pragma unroll
            for (int i = 0; i < 8; ++i) { run += lf[i]; bb[i] = run; } if (seg == 3) *(LAS f32x2*)(bref + d) = bb[7]; }
        else { f32x2 run = off;
#pragma unroll
            for (int i = 7; i >= 0; --i) { run += lf[i]; bb[i] = run; } if (seg == 4) *(LAS f32x2*)(bref + d) = bb[0]; }
        __syncthreads();
        { const f32x2 br = *(const LAS f32x2*)(bref + d); const f32x2 em = (f32x2){__expf(-br.x), __expf(-br.y)}, ep = (f32x2){__expf(br.x), __expf(br.y)};
#pragma unroll
            for (int i = 0; i < 8; ++i) { const int t = 8 * seg + i;
                const f32x2 eb = (f32x2){__expf(bb[i].x), __expf(bb[i].y)}, kk = (f32x2){1.0f - __expf(lf[i].x), 1.0f - __expf(lf[i].y)};
                const f32x2 qb = qv[i] * eb, qd = qb * em, kd = kk * ep * (f32x2){__builtin_amdgcn_rcpf(eb.x), __builtin_amdgcn_rcpf(eb.y)};
                *(LAS unsigned*)(Qd + t * 136 + d) = pk2(qd.x, qd.y); *(LAS unsigned*)(Kd + t * 136 + d) = pk2(kd.x, kd.y); *(LAS unsigned*)(Qb + t * 136 + d) = pk2(qb.x, qb.y); } }
        if (dir == 0) HG_LOAD_DIR(item, 1);
        else if (item + F.G < NITEM) { HG_LOAD_HEAD(item + F.G); HG_LOAD_DIR(item + F.G, 0); }
        __syncthreads();
        {
            const int st = w & 3; f32x4 a2[2] = {(f32x4){0.f, 0.f, 0.f, 0.f}, (f32x4){0.f, 0.f, 0.f, 0.f}};
#pragma unroll
            for (int ksi = 0; ksi < 4; ++ksi) { const bf16x8 a = lds_frag(Kd, 16 * st + lr, 136, 32 * ksi + 8 * lq);
#pragma unroll
                for (int q = 0; q < 2; ++q) a2[q] = MFMA16(a, lds_frag(Qd, 16 * (2 * (w >> 2) + q) + lr, 136, 32 * ksi + 8 * lq), a2[q]); }
#pragma unroll
            for (int q = 0; q < 2; ++q) { const int t = 16 * (2 * (w >> 2) + q) + lr, s0 = 16 * st + 4 * lq; float v[4];
#pragma unroll
                for (int r = 0; r < 4; ++r) { const int s = s0 + r; v[r] = (dir == 0 ? (s <= t) : (s >= t)) ? a2[q][r] : 0.f; }
                u32x2 o; o.x = pk2(v[0], v[1]); o.y = pk2(v[2], v[3]); *(LAS u32x2*)(att + t * 72 + s0) = o; }
        }
        __syncthreads();
        { const int tt = w & 3;
#pragma unroll
            for (int ksi = 0; ksi < 2; ++ksi) { const bf16x8 a = lds_frag(att, 16 * tt + lr, 72, 32 * ksi + 8 * lq);
#pragma unroll
                for (int i = 0; i < 4; ++i) acc[i] = MFMA16(a, lds_frag(VTs, 16 * (4 * (w >> 2) + i) + lr, 72, 32 * ksi + 8 * lq), acc[i]); }
#pragma unroll
            for (int ksi = 0; ksi < 4; ++ksi) { const bf16x8 a = lds_frag(Qb, 16 * tt + lr, 136, 32 * ksi + 8 * lq);
#pragma unroll
                for (int i = 0; i < 4; ++i) acc[i] = MFMA16(a, lds_frag(Ss, 16 * (4 * (w >> 2) + i) + lr, 136, 32 * ksi + 8 * lq), acc[i]); }
        }
    }
    float ssq[4];
#pragma unroll
    for (int r = 0; r < 4; ++r) { float s = 0.f;
#pragma unroll
        for (int i = 0; i < 4; ++i) s += acc[i][r] * acc[i][r];
        s += __shfl_xor(s, 1); s += __shfl_xor(s, 2); s += __shfl_xor(s, 4); s += __shfl_xor(s, 8); ssq[r] = s; }
    if (lr == 0) {
#pragma unroll
        for (int r = 0; r < 4; ++r) red[eh * 64 + 16 * tt + 4 * lq + r] = ssq[r]; }
    __syncthreads();
    bf16_t* yo = WSP(bf16_t, WS_YHG);
#pragma unroll
    for (int r = 0; r < 4; ++r) { const int t = 16 * tt + 4 * lq + r; const float rs = rsqrtf((red[t] + red[64 + t]) * (1.0f / 128.0f) + EPS);
#pragma unroll
        for (int i = 0; i < 4; ++i) { const int e = 16 * (4 * eh + i) + lr; const size_t o = (size_t)(r0 + t) * HGW + h * 128 + e;
            yo[o] = (bf16_t)f2bf(acc[i][r] * rs * ngv[i] * bf2f(gr[r][i])); } }
    }
#undef HG_LOAD_DIR
#undef HG_LOAD_HEAD
}
__device__ __forceinline__ void phase_route(Frame& F) {
    const float* lg = WSP(float, WS_LOGIT); const float* rb = F.p->in[I_RB];
    LAS int* hist = (LAS int*)F.lds;
    int* re_ = WSP(int, WS_ROUTE_E); float* rw_ = WSP(float, WS_ROUTE_W); int* rp_ = WSP(int, WS_ROUTE_P);
    const int lane = F.lane, g = lane & 7, NGW = F.G * 8;
    __syncthreads();
    if (F.tid < NE) hist[F.tid] = 0;
    __syncthreads();
    const bool al = (F.G == 256); const int wv = al ? ((F.bx & 7) * 32 + (F.bx >> 3)) * 8 + F.wave : F.bx * 8 + F.wave;
    const float NINF = -__builtin_inff();
    float bias[32];
#pragma unroll
    for (int q = 0; q < 8; ++q) { const f32x4 b4 = *(const f32x4*)(rb + g * 32 + 4 * q); bias[4 * q] = b4[0]; bias[4 * q + 1] = b4[1]; bias[4 * q + 2] = b4[2]; bias[4 * q + 3] = b4[3]; }
    for (int t8 = wv * 8; t8 < T; t8 += NGW * 8) {
        const int t = t8 + (lane >> 3);
        float sc[32], cd[32];
#pragma unroll
        for (int q = 0; q < 8; ++q) { const f32x4 l4 = *(const f32x4*)(lg + (size_t)t * NE + g * 32 + 4 * q);
#pragma unroll
            for (int i = 0; i < 4; ++i) { sc[4 * q + i] = sigmoidf_(l4[i]); cd[4 * q + i] = sc[4 * q + i] + bias[4 * q + i]; } }
        float m1 = fmaxf(cd[0], cd[1]), m2 = fminf(cd[0], cd[1]);
#pragma unroll
        for (int i = 2; i < 32; ++i) { const float v = cd[i]; m2 = fmaxf(m2, fminf(m1, v)); m1 = fmaxf(m1, v); }
        const float gs = m1 + m2; int rank = 0;
#pragma unroll
        for (int gg = 0; gg < 8; ++gg) { const float v = __shfl(gs, (lane & ~7) + gg); rank += (v > gs || (v == gs && gg < g)) ? 1 : 0; }
        if (rank >= 4) {
#pragma unroll
            for (int i = 0; i < 32; ++i) cd[i] = NINF; }
        int me = 0; float mw = 0.f, ssum = 0.f;
#pragma unroll 1
        for (int k = 0; k < 8; ++k) {
            float bv = cd[0], bs = sc[0]; int bi = 0;
#pragma unroll
            for (int i = 1; i < 32; ++i) if (cd[i] > bv) { bv = cd[i]; bs = sc[i]; bi = i; }
            int gi = g * 32 + bi;
#pragma unroll
            for (int o = 1; o < 8; o <<= 1) { const float ov = __shfl_xor(bv, o), os = __shfl_xor(bs, o); const int oi = __shfl_xor(gi, o); if (ov > bv || (ov == bv && oi < gi)) { bv = ov; bs = os; gi = oi; } }
            if ((gi >> 5) == g) { const int li = gi & 31;
#pragma unroll
                for (int i = 0; i < 32; ++i) if (i == li) cd[i] = NINF; }
            ssum += bs; if (k == g) { me = gi; mw = bs; }
        }
        const int lrank = __hip_atomic_fetch_add(hist + me, 1, __ATOMIC_RELAXED, __HIP_MEMORY_SCOPE_WORKGROUP);
        re_[t * 8 + g] = me; rw_[t * 8 + g] = mw * (2.5f / ssum); rp_[t * 8 + g] = lrank | (F.bx << 16);
    }
    __syncthreads();
    if (F.tid < NE) WSP(int, WS_HIST)[F.bx * NE + F.tid] = hist[F.tid];
}
__device__ __forceinline__ void phase_prefix(Frame& F) {
    LAS int* sc = (LAS int*)F.lds;
    const int* hist = WSP(int, WS_HIST); int* pref = WSP(int, WS_PREF); unsigned* cnt = WSP(unsigned, WS_CTL) + CW_CNT;
    for (int e = F.bx; e < NE; e += F.G) {
        __syncthreads();
        const int i = F.tid; int v = (i < 256 && i < F.G) ? hist[i * NE + e] : 0;
        if (i < 256) sc[i] = v;
        __syncthreads();
        int cur = 0;
#pragma unroll
        for (int o = 1; o < 256; o <<= 1) { int x = 0; if (i < 256) { x = sc[cur * 256 + i]; if (i >= o) x += sc[cur * 256 + i - o]; sc[(cur ^ 1) * 256 + i] = x; } __syncthreads(); cur ^= 1; }
        if (i < 256) { const int inc = sc[cur * 256 + i]; pref[i * NE + e] = inc - v; if (i == 255) cnt[e] = (unsigned)inc; }
    }
}
__device__ __forceinline__ void phase_scatter(Frame& F) {
    LAS int* st = (LAS int*)F.lds; LAS int* cn = st + 512;
    const unsigned* cnt = WSP(unsigned, WS_CTL) + CW_CNT;
    __syncthreads();
    if (F.tid < NE) cn[F.tid] = (int)cnt[F.tid];
    __syncthreads();
    if (F.tid <= NE) { int s = 0, tl = 0; for (int e = 0; e < F.tid; ++e) { s += cn[e]; tl += (cn[e] + 255) >> 8; } st[F.tid] = s;
        if (F.bx == 0) { unsigned* ctl = WSP(unsigned, WS_CTL); ctl[CW_START + F.tid] = (unsigned)s; ctl[CW_TOFF + F.tid] = (unsigned)tl;
            if (F.tid < NE) { const int c_ = cn[F.tid]; for (int j = 0; j * 256 < c_; ++j) { unsigned* up = ctl + CW_UNITS + 4 * (tl + j); up[0] = (unsigned)(s + 256 * j); up[1] = (unsigned)F.tid; up[2] = (unsigned)(c_ - 256 * j < 256 ? c_ - 256 * j : 256); up[3] = 0u; } } } }
    __syncthreads();
    const int* re_ = WSP(int, WS_ROUTE_E); const float* rw_ = WSP(float, WS_ROUTE_W); const int* rp_ = WSP(int, WS_ROUTE_P);
    int* stok = WSP(int, WS_SLOT_TOK); float* sw = WSP(float, WS_SLOT_W); int* sof = WSP(int, WS_SLOTOF);
    const int* pref = WSP(int, WS_PREF);
    for (int a = F.bx * 512 + F.tid; a < NASG; a += F.G * 512) { const int e = re_[a], rp = rp_[a]; const int slot = st[e] + pref[(rp >> 16) * NE + e] + (rp & 0xffff); stok[slot] = a >> 3; sw[slot] = rw_[a]; sof[a] = slot; }
    if (F.bx == 0 && F.tid < 256) { stok[NASG + F.tid] = 0; sw[NASG + F.tid] = 0.f; }
}
__device__ __forceinline__ void phase_final(Frame& F) {
    float* out = F.p->out; const bf16_t* x1 = WSP(bf16_t, WS_X1B);     const float* fg = F.p->in[I_FG]; const float* ada = WSP(float, WS_ADA);
    const unsigned char* yb8 = WSP(unsigned char, WS_YBUF); const bf16_t* ysh = WSP(bf16_t, WS_YSH); const int* sof = WSP(int, WS_SLOTOF);
    const int lane = F.lane, NGW = F.G * 8;
    const bool al = (F.G == 256); const int tbase = al ? (((F.bx & 7) * 32 + (F.bx >> 3)) * 8 + F.wave) * 8 : F.bx * 8 + F.wave, tstr = al ? 1 : NGW;
    f32x4 fgv[2][2];
#pragma unroll
    for (int j = 0; j < 2; ++j) { fgv[j][0] = *(const f32x4*)(fg + 512 * j + 8 * lane); fgv[j][1] = *(const f32x4*)(fg + 512 * j + 8 * lane + 4); }
    int it_ = 0;
    for (int t = tbase; al ? it_ < 8 : t < T; t += tstr, ++it_) { const int b = t >> 13;
        int sl[8];
#pragma unroll
        for (int k = 0; k < 8; ++k) sl[k] = sof[t * 8 + k];
        u32x4 ys[2], xr[2]; u32x2 y[8][2]; f32x4 g2[2][2];
#pragma unroll
        for (int j = 0; j < 2; ++j) { const int c = 512 * j + 8 * lane;
            ys[j] = *(const u32x4*)(ysh + (size_t)t * D + c); xr[j] = *(const u32x4*)(x1 + (size_t)t * D + c);
            g2[j][0] = *(const f32x4*)(ada + b * 6144 + 5 * D + c); g2[j][1] = *(const f32x4*)(ada + b * 6144 + 5 * D + c + 4);
#pragma unroll
            for (int k = 0; k < 8; ++k) y[k][j] = *(const u32x2*)(yb8 + (size_t)sl[k] * D + c); }
        f32x4 v[2][2]; float ss = 0.f;
#pragma unroll
        for (int j = 0; j < 2; ++j) { f32x4 m0 = (f32x4){bflo(ys[j].x), bfhi(ys[j].x), bflo(ys[j].y), bfhi(ys[j].y)}, m1 = (f32x4){bflo(ys[j].z), bfhi(ys[j].z), bflo(ys[j].w), bfhi(ys[j].w)};
#pragma unroll
            for (int k = 0; k < 8; ++k) { const f32x2 a0 = __builtin_amdgcn_cvt_pk_f32_fp8((int)y[k][j].x, false), a1 = __builtin_amdgcn_cvt_pk_f32_fp8((int)y[k][j].x, true), b0 = __builtin_amdgcn_cvt_pk_f32_fp8((int)y[k][j].y, false), b1 = __builtin_amdgcn_cvt_pk_f32_fp8((int)y[k][j].y, true);
                m0 += (f32x4){a0.x, a0.y, a1.x, a1.y}; m1 += (f32x4){b0.x, b0.y, b1.x, b1.y}; }
            v[j][0] = (f32x4){bflo(xr[j].x), bfhi(xr[j].x), bflo(xr[j].y), bfhi(xr[j].y)} + g2[j][0] * m0; v[j][1] = (f32x4){bflo(xr[j].z), bfhi(xr[j].z), bflo(xr[j].w), bfhi(xr[j].w)} + g2[j][1] * m1;
#pragma unroll
            for (int h = 0; h < 2; ++h) ss += (v[j][h][0] * v[j][h][0] + v[j][h][1] * v[j][h][1]) + (v[j][h][2] * v[j][h][2] + v[j][h][3] * v[j][h][3]); }
        const float rs = rsqrtf(wave_sum(ss) * (1.0f / D) + EPS);
#pragma unroll
        for (int j = 0; j < 2; ++j) { const int c = 512 * j + 8 * lane; *(f32x4*)(out + (size_t)t * D + c) = v[j][0] * rs * fgv[j][0]; *(f32x4*)(out + (size_t)t * D + c + 4) = v[j][1] * rs * fgv[j][1]; }
    }
}

#define MOE_UNITS_TO_LDS() do { const u32x4* gu_ = (const u32x4*)(WSP(unsigned, WS_CTL) + CW_UNITS); LAS u32x4* lu_ = (LAS u32x4*)(F.lds + 131072); const int nt_ = (int)WSP(unsigned, WS_CTL)[CW_TOFF + NE]; \
        for (int i_ = F.tid; i_ < nt_ && i_ < 1016; i_ += 512) lu_[i_] = gu_[i_]; __syncthreads(); } while (0)
constexpr int NPHASE = 16;
#ifndef REP_MASK
#define REP_MASK 0u
#endif
#define NREP(k) ((((REP_MASK) >> (k)) & 1u) ? 2 : 1)
#ifndef MK_LAUNCH_PER_PHASE
#define MK_LAUNCH_PER_PHASE 0
#endif
__global__ void __launch_bounds__(512) hyena_hgrn2_moe_fwd(Params p) {
    extern __shared__ __attribute__((aligned(16))) unsigned char lds_[];
    cg::grid_group grid = cg::this_grid();
    Frame F; F.lds = (LAS unsigned char*)lds_; F.p = &p; F.ws = p.ws; F.tid = threadIdx.x; F.lane = F.tid & 63; F.wave = __builtin_amdgcn_readfirstlane(F.tid >> 6); F.G = gridDim.x; F.bx = blockIdx.x;
    if (F.tid < 16) ((LAS unsigned*)(F.lds + LDS_BARST))[F.tid] = 0u;
    __syncthreads();
    XcdBarrier bar = xcd_barrier_post((unsigned*)(p.ws + WS_CTL) + CW_BAR, (volatile LAS unsigned*)(F.lds + LDS_BARST));
#ifdef ONLY_PHASE
#define IN(k) ((k) == ONLY_PHASE && p.ph_lo <= (k) && (k) < p.ph_hi)
#else
#define IN(k) (p.ph_lo <= (k) && (k) < p.ph_hi)
#endif
#ifndef PROBE_K
#define PROBE_K (-1)
#endif
#ifndef PROBE_EPI_K
#define PROBE_EPI_K (-1)
#endif
    unsigned long long pk_acc = 0ull;
#define PACC(k) (PROBE_EPI_K == (k) ? &pk_acc : (unsigned long long*)nullptr)
    unsigned long long pk_t0 = 0ull, pk_t1 = 0ull;
#define SEAM(k) do { if (IN(k) && IN((k) + 1)) xcd_barrier(bar); if (PROBE_K == (k) + 1) pk_t0 = __builtin_amdgcn_s_memrealtime(); if (PROBE_K == (k)) pk_t1 = __builtin_amdgcn_s_memrealtime(); } while (0)
    if (PROBE_K == 0) pk_t0 = __builtin_amdgcn_s_memrealtime();
    if (p.ph_lo < 0) grid.sync();
    if (IN(0)) _Pragma("unroll 1") for (int rp = 0; rp < NREP(0); ++rp) { asm volatile("" : "+v"(F.tid)); if (rp) xcd_barrier(bar); phase0(F, PROBE_EPI_K >= 100 ? &pk_acc : (unsigned long long*)nullptr, PROBE_EPI_K - 100); }
    SEAM(0);
    if (IN(1)) _Pragma("unroll 1") for (int rp = 0; rp < NREP(1); ++rp) { asm volatile("" : "+v"(F.tid)); if (rp) xcd_barrier(bar); phase1(F); }
    SEAM(1);
    if (IN(2)) _Pragma("unroll 1") for (int rp = 0; rp < NREP(2); ++rp) { asm volatile("" : "+v"(F.tid)); if (rp) xcd_barrier(bar);
        __syncthreads();
        if (F.G == 256 && F.bx >= 256 - NCONV) {
            conv_loop2(F, 256 * (XP_BG + XP_K0) + (F.bx - (256 - NCONV)), NCONV, NE * 48 - XP_P13);
        } else
        { pg8::Gemm g{WSP(bf16_t, WS_WINT), WSP(bf16_t, WS_WINT), D, nullptr, 2 * D, 128}; InOrder S{F.G == 256 ? 256 - NCONV : F.G, F.bx};
          EpiIn E{EpiInT{WSP(bf16_t, WS_PHYT), WSP(bf16_t, WS_VT)}, EpiInN{WSP(bf16_t, WS_Q), WSP(bf16_t, WS_G), WSP(bf16_t, WS_SG1), WSP(bf16_t, WS_SG2), WSP(float, WS_LF), WSP(float, WS_LB), WSP(float, WS_LBS)}};
          pg8::gemm_phase<EpiIn, InOrder, false>(F.lds, g, S, E, PACC(2)); }
    }
    SEAM(2);
    if (IN(3)) _Pragma("unroll 1") for (int rp = 0; rp < NREP(3); ++rp) { asm volatile("" : "+v"(F.tid)); if (rp) xcd_barrier(bar);
        _Pragma("unroll 1") for (int r2 = 0; r2 < NREP(16); ++r2) { asm volatile("" : "+v"(F.tid));
            XpState xp; xp.it = F.bx; xp.stride = F.G; xp.end = (XP_BG * F.G < NE * 48) ? XP_BG * F.G : NE * 48; xp.live = false;
            for (int c = F.bx; c < HYW; c += F.G) hyena_item(F, c, xp);
            { int tid = F.tid; xp_finish(xp, p.in, F.ws, tid); while (xp.it < xp.end) { xp_issue(xp, p.in, F.ws, tid); xp_finish(xp, p.in, F.ws, tid); } } }
        _Pragma("unroll 1") for (int r2 = 0; r2 < NREP(17); ++r2) { asm volatile("" : "+v"(F.tid)); hg_delta_items(F); }
    }
    SEAM(3);
    if (IN(4)) _Pragma("unroll 1") for (int rp = 0; rp < NREP(4); ++rp) { asm volatile("" : "+v"(F.tid)); if (rp) xcd_barrier(bar);
        { asm volatile("" : "+v"(F.tid));
          u32x4 tv0[8]; const bool has0 = F.bx < NB * 128;
          if (has0) yhy_load(F, F.bx, tv0);
          hg_scan(F);
          asm volatile("" : "+v"(F.tid));
          if (has0) yhy_finish(F, F.bx, tv0);
          for (int it = F.bx + F.G; it < NB * 128; it += F.G) yhy_transpose_item(F, it); }
    }
    SEAM(4);
    if (IN(5)) _Pragma("unroll 1") for (int rp = 0; rp < NREP(5); ++rp) { asm volatile("" : "+v"(F.tid)); if (rp) xcd_barrier(bar); hg_out_items(F); }
    SEAM(5);
    if (IN(6)) _Pragma("unroll 1") for (int rp = 0; rp < NREP(6); ++rp) { asm volatile("" : "+v"(F.tid)); if (rp) xcd_barrier(bar);
        __syncthreads();
        { pg8::Gemm g{WSP(bf16_t, WS_YHY), WSP(bf16_t, WS_WHYT), HYW, nullptr, 2 * HYW, 128}; MergeOrder S; S.so.init(T, D, HYW, F.G, F.bx);
          EpiMerge E{EpiMerge1{WSP(bf16_t, WS_SG1), WSP(bf16_t, WS_MB)}, EpiMerge2{WSP(bf16_t, WS_SG2), WSP(bf16_t, WS_MB), WSP(bf16_t, WS_MB)}};
          pg8::gemm_phase<EpiMerge, MergeOrder, false>(F.lds, g, S, E, PACC(6)); }
    }
    SEAM(6);
    if (IN(7)) _Pragma("unroll 1") for (int rp = 0; rp < NREP(7); ++rp) { asm volatile("" : "+v"(F.tid)); if (rp) xcd_barrier(bar);
        __syncthreads();
        pg8::Gemm g{WSP(bf16_t, WS_MB), WSP(bf16_t, WS_WOUTT), D, nullptr, 2 * D, 128}; pg8::StaticOrder S; S.init(T, D, D, F.G, F.bx);
        EpiWout E{p.in[I_X], WSP(float, WS_POSR), WSP(float, WS_POSC), WSP(float, WS_ADA), WSP(bf16_t, WS_X1B)};
        pg8::gemm_phase<EpiWout, pg8::StaticOrder, false>(F.lds, g, S, E, PACC(7));
    }
    SEAM(7);
    if (IN(8)) _Pragma("unroll 1") for (int rp = 0; rp < NREP(8); ++rp) { asm volatile("" : "+v"(F.tid)); if (rp) xcd_barrier(bar); phase_h2(F); }
    SEAM(8);
    if (IN(9)) _Pragma("unroll 1") for (int rp = 0; rp < NREP(9); ++rp) { asm volatile("" : "+v"(F.tid)); if (rp) xcd_barrier(bar);
        __syncthreads();
        { pg8::Gemm g{WSP(bf16_t, WS_H2), WSP(bf16_t, WS_ROUT), D, nullptr, 2 * D, 128}; P9Order S{F.G, F.bx}; EpiP9 E{EpiLogit{WSP(float, WS_LOGIT)}, EpiGU{WSP(bf16_t, WS_HSH), nullptr}};
          pg8::gemm_phase<EpiP9, P9Order, false>(F.lds, g, S, E); }
    }
    SEAM(9);
    if (IN(10)) _Pragma("unroll 1") for (int rp = 0; rp < NREP(10); ++rp) { asm volatile("" : "+v"(F.tid)); if (rp) xcd_barrier(bar); phase_route(F); }
    SEAM(10);
    if (IN(11)) phase_prefix(F);
    SEAM(11);
    if (IN(12)) _Pragma("unroll 1") for (int rp = 0; rp < NREP(12); ++rp) { asm volatile("" : "+v"(F.tid)); if (rp) xcd_barrier(bar); phase_scatter(F); }
    SEAM(12);
    if (IN(13)) _Pragma("unroll 1") for (int rp = 0; rp < NREP(13); ++rp) { asm volatile("" : "+v"(F.tid)); if (rp) xcd_barrier(bar);
        __syncthreads();
        if (F.G == 256 && F.bx >= 256 - NCONV2) {
            conv_loop2(F, NE * 48 - XP_P13 + (F.bx - (256 - NCONV2)), NCONV2, NE * 48);
        } else {
        MOE_UNITS_TO_LDS();
        pg8::Gemm g{WSP(bf16_t, WS_H2), WSP(bf16_t, WS_EGUT), D, WSP(int, WS_SLOT_TOK), 128, 512 * 128}; MoeOrder S{(const LAS unsigned*)(F.lds + 131072), (int)WSP(unsigned, WS_CTL)[CW_TOFF + NE], 2, F.G == 256 ? 256 - NCONV2 : F.G, F.bx, 1048576u}; EpiGU E{WSP(bf16_t, WS_HBUF), WSP(float, WS_SLOT_W)};
        pg8::gemm_phase<EpiGU, MoeOrder, true>(F.lds, g, S, E, PACC(13)); }
    }
    SEAM(13);
    if (IN(14)) _Pragma("unroll 1") for (int rp = 0; rp < NREP(14); ++rp) { asm volatile("" : "+v"(F.tid)); if (rp) xcd_barrier(bar);
        __syncthreads();
        MOE_UNITS_TO_LDS();
        { pg8::Gemm g{WSP(bf16_t, WS_HBUF), WSP(bf16_t, WS_EDT), EH, nullptr, 128, 1024 * 128}; MoeOrder S{(const LAS unsigned*)(F.lds + 131072), (int)WSP(unsigned, WS_CTL)[CW_TOFF + NE], 4, F.G, F.bx, 524288u}; EpiDown<false, true> E{WSP(bf16_t, WS_YBUF), nullptr};
          pg8::gemm_phase<EpiDown<false, true>, MoeOrder, false>(F.lds, g, S, E, PACC(14)); }
        { pg8::Gemm g{WSP(bf16_t, WS_HSH), WSP(bf16_t, WS_SHDT), EH, nullptr, 2 * EH, 128}; pg8::StaticOrder S; S.init(T, D, EH, F.G, F.bx); EpiDown<false> E{WSP(bf16_t, WS_YSH), nullptr};
          pg8::gemm_phase<EpiDown<false>, pg8::StaticOrder, false>(F.lds, g, S, E); }
    }
    SEAM(14);
    if (IN(15)) _Pragma("unroll 1") for (int rp = 0; rp < NREP(15); ++rp) { asm volatile("" : "+v"(F.tid)); if (rp) xcd_barrier(bar); phase_final(F); }
    if (PROBE_K >= 0) { if (PROBE_K == 15) pk_t1 = __builtin_amdgcn_s_memrealtime();
        if (F.bx == 0) { const unsigned long long te = __builtin_amdgcn_s_memrealtime(), span = 8ull * (PROBE_EPI_K >= 0 ? pk_acc : (pk_t1 - pk_t0)); while (__builtin_amdgcn_s_memrealtime() - te < span) __builtin_amdgcn_s_sleep(8); } }
#undef IN
#undef SEAM
}

extern "C" void kernel_launch(void* const* d_in, const int* in_sizes, int n_in, void* d_out, int out_size, void* d_ws, size_t ws_size, hipStream_t stream) {
    static int grid = 0;
    if (grid == 0) {
        if (n_in != 34 || out_size != T * D || ws_size < WS_END) { fprintf(stderr, "kernel_launch: unexpected shapes (n_in %d, out %d, ws %zu < %zu)\n", n_in, out_size, ws_size, (size_t)WS_END); grid = -1; return; }
        int dev = 0, cus = 0, per_cu = 0;
        if (hipGetDevice(&dev) != hipSuccess || hipDeviceGetAttribute(&cus, hipDeviceAttributeMultiprocessorCount, dev) != hipSuccess) { grid = -1; return; }
        if (hipFuncSetAttribute((const void*)hyena_hgrn2_moe_fwd, hipFuncAttributeMaxDynamicSharedMemorySize, LDS_BYTES) != hipSuccess) { fprintf(stderr, "kernel_launch: hipFuncSetAttribute failed\n"); grid = -1; return; }
        if (hipOccupancyMaxActiveBlocksPerMultiprocessor(&per_cu, (const void*)hyena_hgrn2_moe_fwd, 512, LDS_BYTES) != hipSuccess || per_cu < 1) { fprintf(stderr, "kernel_launch: occupancy query failed (%d)\n", per_cu); (void)hipGetLastError(); per_cu = 1; }
        grid = cus * per_cu; if (grid > 256) grid = 256;
    }
    if (grid < 0) return;
    if (hipMemsetAsync((char*)d_ws + WS_CTL, 0, CTL_BYTES, stream) != hipSuccess) { fprintf(stderr, "kernel_launch: memset failed\n"); return; }
    Params p{};
    for (int i = 0; i < 34; ++i) p.in[i] = (const float*)d_in[i];
    p.out = (float*)d_out; p.ws = (unsigned char*)d_ws;
#if MK_LAUNCH_PER_PHASE
    for (int k = 0; k < NPHASE; ++k) { p.ph_lo = k; p.ph_hi = k + 1; void* args[] = {&p};
        hipError_t e = hipLaunchCooperativeKernel((const void*)hyena_hgrn2_moe_fwd, dim3(grid), dim3(512), args, LDS_BYTES, stream);
        if (e != hipSuccess) { fprintf(stderr, "kernel_launch: launch %d failed: %s\n", k, hipGetErrorString(e)); break; } }
#else
    p.ph_lo = 0; p.ph_hi = NPHASE; void* args[] = {&p};
    hipError_t e = hipLaunchCooperativeKernel((const void*)hyena_hgrn2_moe_fwd, dim3(grid), dim3(512), args, LDS_BYTES, stream);
    if (e != hipSuccess) fprintf(stderr, "kernel_launch: cooperative launch failed: %s (grid %d)\n", hipGetErrorString(e), grid);
#endif
}
```
